# Optimizing an MI355X kernel written in HIP

```python
import jax
import jax.numpy as jnp
from jax import lax
import numpy as np

D_MODEL = 2048
BATCH = 32
SEQ = 256
DEPTH = 4
DEC_BATCH = 2
DEC_SEQ = 4096
PAST_LEN = 512

GRID_W = 64
N_MIXERS = 3
N_WIN = (DEPTH + 2) // 3
N_MLA = (DEPTH + 1) // 3
N_GLA = DEPTH // 3
Q_BLOCK = 128
EPS = 1e-6
ROPE_BASE = 10000.0
NEG = -1e30
WIN_HEADS = 16
WIN_KV_HEADS = 4
WIN_GROUP = WIN_HEADS // WIN_KV_HEADS
WIN_HEAD_DIM = D_MODEL // WIN_HEADS
WINDOW = 128
MLA_HEADS = 16
MLA_Q_RANK = 512
MLA_KV_RANK = 256
MLA_NOPE = 128
MLA_ROPE = 64
MLA_V = 128
MLA_SCALE = (MLA_NOPE + MLA_ROPE) ** -0.5
GLA_HEADS = 4
GLA_DK = D_MODEL // 2 // GLA_HEADS
GLA_DV = D_MODEL // GLA_HEADS
GLA_GATE_RANK = 16
GLA_TAU = 16.0
GLA_CHUNK = 64
FFN_HIDDEN = 4 * D_MODEL

kernel_name = 'hybrid_diffusion_win_mla_gla_step'


def rmsnorm(x, g):
    xf = x.astype(jnp.float32)
    y = xf * lax.rsqrt(jnp.mean(xf * xf, axis=-1, keepdims=True) + EPS)
    return (y * g.astype(jnp.float32)).astype(x.dtype)


def modulation(cond, w, b):
    m = jax.nn.silu(cond) @ w + b
    return jnp.split(m[..., None, :], 6, axis=-1)


def modulate(x, g, shift, scale):
    return rmsnorm(x, g) * (1 + scale) + shift


def grid_positions(n_tokens):
    rows = n_tokens // GRID_W
    row = jnp.repeat(jnp.arange(rows, dtype=jnp.int32), GRID_W)
    col = jnp.tile(jnp.arange(GRID_W, dtype=jnp.int32), rows)
    return row, col


def rope_1d(x, pos):
    half = x.shape[-1] // 2
    inv_freq = ROPE_BASE ** (-jnp.arange(half, dtype=jnp.float32) / half)
    ang = pos.astype(jnp.float32)[:, None] * inv_freq[None, :]
    cos = jnp.cos(ang)[None, :, None, :]
    sin = jnp.sin(ang)[None, :, None, :]
    xf = x.astype(jnp.float32)
    x1, x2 = xf[..., :half], xf[..., half:]
    return jnp.concatenate([x1 * cos - x2 * sin, x2 * cos + x1 * sin], axis=-1).astype(x.dtype)


def axial_rope(x):
    row, col = grid_positions(x.shape[1])
    r = x.shape[-1] // 2
    return jnp.concatenate([rope_1d(x[..., :r], row), rope_1d(x[..., r:], col)], axis=-1)


def attn_core(q, k, v, valid, sink):
    s = jnp.einsum('bqhgd,bkhd->bhgqk', q, k, preferred_element_type=jnp.float32)
    if valid is not None:
        s = jnp.where(valid, s, NEG)
    if sink is not None:
        sk = jnp.broadcast_to(sink.astype(jnp.float32)[None, :, :, None, None], s.shape[:-1] + (1,))
        p = jax.nn.softmax(jnp.concatenate([s, sk], axis=-1), axis=-1)[..., :-1]
    else:
        p = jax.nn.softmax(s, axis=-1)
    return jnp.einsum('bhgqk,bkhe->bqhge', p.astype(v.dtype), v)


def dense_attention(q, k, v, sink):
    B, Lq = q.shape[:2]
    nb = Lq // Q_BLOCK
    qb = jnp.moveaxis(q.reshape((B, nb, Q_BLOCK) + q.shape[2:]), 1, 0)
    ob = lax.map(lambda qq: attn_core(qq, k, v, None, sink), qb)
    return jnp.moveaxis(ob, 0, 1).reshape((B, Lq) + ob.shape[3:])


def window_attention(q, k, v, k_ctx, v_ctx, sink):
    B, L = q.shape[:2]
    nb = L // Q_BLOCK
    Lc = k_ctx.shape[1]
    pad = ((0, 0), (Q_BLOCK, Q_BLOCK), (0, 0), (0, 0))
    kp, vp = jnp.pad(k, pad), jnp.pad(v, pad)
    qi = jnp.arange(Q_BLOCK)[:, None]
    kj = jnp.arange(3 * Q_BLOCK)[None, :] - Q_BLOCK
    rel_ok = jnp.abs(kj - qi) <= WINDOW
    ctx_ok = jnp.ones((Q_BLOCK, Lc), dtype=bool)

    def one_block(n):
        start = n * Q_BLOCK
        qq = lax.dynamic_slice_in_dim(q, start, Q_BLOCK, axis=1)
        kk = lax.dynamic_slice_in_dim(kp, start, 3 * Q_BLOCK, axis=1)
        vv = lax.dynamic_slice_in_dim(vp, start, 3 * Q_BLOCK, axis=1)
        key_pos = start + kj
        valid = rel_ok & (key_pos >= 0) & (key_pos < L)
        valid = jnp.concatenate([ctx_ok, valid], axis=1)
        return attn_core(qq, jnp.concatenate([k_ctx, kk], axis=1),
                         jnp.concatenate([v_ctx, vv], axis=1), valid, sink)

    ob = lax.map(one_block, jnp.arange(nb))
    return jnp.moveaxis(ob, 0, 1).reshape((B, L) + ob.shape[3:])


def win_qkv(h, w_qkv):
    B, L, _ = h.shape
    qkv = h @ w_qkv
    nq = WIN_HEADS * WIN_HEAD_DIM
    nkv = WIN_KV_HEADS * WIN_HEAD_DIM
    q = qkv[..., :nq].reshape(B, L, WIN_HEADS, WIN_HEAD_DIM)
    k = qkv[..., nq:nq + nkv].reshape(B, L, WIN_KV_HEADS, WIN_HEAD_DIM)
    v = qkv[..., nq + nkv:].reshape(B, L, WIN_KV_HEADS, WIN_HEAD_DIM)
    return q, k, v


def win_group(q):
    B, L = q.shape[:2]
    return (q * WIN_HEAD_DIM ** -0.5).reshape(B, L, WIN_KV_HEADS, WIN_GROUP, WIN_HEAD_DIM)


def win_context(h, w_qkv, sink, w_o):
    B, L, _ = h.shape
    q, k, v = win_qkv(h, w_qkv)
    o = dense_attention(win_group(q), k, v, sink.reshape(WIN_KV_HEADS, WIN_GROUP))
    return o.reshape(B, L, -1) @ w_o, k, v


def win_latent(h, k_ctx, v_ctx, w_qkv, sink, w_o):
    B, L, _ = h.shape
    q, k, v = win_qkv(h, w_qkv)
    q, k = axial_rope(q), axial_rope(k)
    o = window_attention(win_group(q), k, v, k_ctx, v_ctx, sink.reshape(WIN_KV_HEADS, WIN_GROUP))
    return o.reshape(B, L, -1) @ w_o


def mla_down(h, w_down, q_norm, kv_norm, w_uq):
    B, L, _ = h.shape
    d = h @ w_down
    cq = rmsnorm(d[..., :MLA_Q_RANK], q_norm)
    ckv = rmsnorm(d[..., MLA_Q_RANK:MLA_Q_RANK + MLA_KV_RANK], kv_norm)
    k_rope = d[..., MLA_Q_RANK + MLA_KV_RANK:]
    q = (cq @ w_uq).reshape(B, L, MLA_HEADS, MLA_NOPE + MLA_ROPE)
    return q, ckv, k_rope


def mla_expand(ckv, k_rope, w_ukv):
    B, L, _ = ckv.shape
    kv = (ckv @ w_ukv).reshape(B, L, MLA_HEADS, MLA_NOPE + MLA_V)
    k = jnp.concatenate([kv[..., :MLA_NOPE],
                         jnp.broadcast_to(k_rope[:, :, None, :], (B, L, MLA_HEADS, MLA_ROPE))], axis=-1)
    return k, kv[..., MLA_NOPE:]


def mla_attend(q, k, v, w_o):
    B, L = q.shape[:2]
    o = dense_attention((q * MLA_SCALE)[:, :, :, None, :], k, v, None)
    return o.reshape(B, L, -1) @ w_o


def mla_context(h, w_down, q_norm, w_uq, kv_norm, w_ukv, w_o):
    q, ckv, k_rope = mla_down(h, w_down, q_norm, kv_norm, w_uq)
    k, v = mla_expand(ckv, k_rope, w_ukv)
    return mla_attend(q, k, v, w_o), ckv, k_rope


def mla_latent(h, ckv_ctx, krope_ctx, w_down, q_norm, w_uq, kv_norm, w_ukv, w_o):
    q, ckv, k_rope = mla_down(h, w_down, q_norm, kv_norm, w_uq)
    q = jnp.concatenate([q[..., :MLA_NOPE], axial_rope(q[..., MLA_NOPE:])], axis=-1)
    k_rope = axial_rope(k_rope[:, :, None, :])[:, :, 0, :]
    k_c, v_c = mla_expand(ckv_ctx, krope_ctx, w_ukv)
    k_l, v_l = mla_expand(ckv, k_rope, w_ukv)
    return mla_attend(q, jnp.concatenate([k_c, k_l], axis=1), jnp.concatenate([v_c, v_l], axis=1), w_o)


def gla_log_gate(h, wa1, wa2, ba):
    z = (h @ wa1) @ wa2 + ba
    return jax.nn.log_sigmoid(z.astype(jnp.float32)) / GLA_TAU


def gla_chunk_scan(q, k, v, g, s0):
    B, H, L, _ = q.shape
    n = L // GLA_CHUNK

    def to_chunks(t):
        return jnp.moveaxis(t.reshape(B, H, n, GLA_CHUNK, t.shape[-1]), 2, 0)

    tri = jnp.tril(jnp.ones((GLA_CHUNK, GLA_CHUNK), dtype=bool))

    def step(s, inp):
        qc, kc, vc, gc = inp
        qc, kc, vc = qc.astype(jnp.float32), kc.astype(jnp.float32), vc.astype(jnp.float32)
        b = lax.cumsum(gc.astype(jnp.float32), axis=2)
        b_last = b[:, :, -1:, :]
        q_t = qc * jnp.exp(b)
        k_t = kc * jnp.exp(-b)
        a = jnp.where(tri, jnp.einsum('bhid,bhjd->bhij', q_t, k_t), 0.0)
        o = jnp.einsum('bhij,bhje->bhie', a, vc) + jnp.einsum('bhid,bhde->bhie', q_t, s)
        k_dec = kc * jnp.exp(b_last - b)
        s_new = jnp.exp(b_last)[:, :, 0, :, None] * s + jnp.einsum('bhjd,bhje->bhde', k_dec, vc)
        return s_new, o

    s_fin, o = lax.scan(step, s0.astype(jnp.float32), (to_chunks(q), to_chunks(k), to_chunks(v), to_chunks(g)))
    o = jnp.moveaxis(o, 0, 2).reshape(B, H, L, v.shape[-1])
    return o.astype(v.dtype), s_fin.astype(v.dtype)


def gla_mixer(h, s_f0, s_b0, w_in, wa1, wa2, ba, norm_g, w_o):
    B, L, _ = h.shape
    p = h @ w_in
    nk = GLA_HEADS * GLA_DK
    nv = GLA_HEADS * GLA_DV

    def heads(t, d):
        return t.reshape(B, L, GLA_HEADS, d).transpose(0, 2, 1, 3)

    q = heads(p[..., :nk], GLA_DK) * GLA_DK ** -0.5
    k = heads(p[..., nk:2 * nk], GLA_DK)
    v = heads(p[..., 2 * nk:2 * nk + nv], GLA_DV)
    r = p[..., 2 * nk + nv:]
    g_f = heads(gla_log_gate(h, wa1[0], wa2[0], ba[0]), GLA_DK)
    g_b = heads(gla_log_gate(h, wa1[1], wa2[1], ba[1]), GLA_DK)
    o_f, s_f = gla_chunk_scan(q, k, v, g_f, s_f0)
    flip = lambda t: jnp.flip(t, axis=2)
    o_b, s_b = gla_chunk_scan(flip(q), flip(k), flip(v), flip(g_b), s_b0)
    o = (o_f + flip(o_b)).transpose(0, 2, 1, 3)
    o = rmsnorm(o, norm_g).reshape(B, L, nv) * jax.nn.silu(r)
    return o @ w_o, s_f, s_b


def sqrelu_ffn(h, w1, w2):
    return jnp.square(jax.nn.relu(h @ w1)) @ w2


def setup_inputs(seed: int = 0) -> dict:
    key = jax.random.key(seed)
    ks = jax.random.split(key, 32)

    def nrm(k, shape, s):
        return jax.random.normal(k, shape, jnp.float32) * s

    def gain(k, shape):
        return 1.0 + nrm(k, shape, 0.02)

    D = D_MODEL
    return {
        'x_prompt': nrm(ks[0], (BATCH, SEQ, D), 1.0),
        'x_sample': nrm(ks[1], (DEC_BATCH, DEC_SEQ, D), 1.0),
        'c': nrm(ks[2], (DEC_BATCH, D), 1.0),
        'cache_win_k': nrm(ks[3], (DEC_BATCH, N_WIN, PAST_LEN, WIN_KV_HEADS, WIN_HEAD_DIM), 1.0),
        'cache_win_v': nrm(ks[4], (DEC_BATCH, N_WIN, PAST_LEN, WIN_KV_HEADS, WIN_HEAD_DIM), 1.0),
        'cache_mla_ckv': nrm(ks[5], (DEC_BATCH, N_MLA, PAST_LEN, MLA_KV_RANK), 1.0),
        'cache_mla_krope': nrm(ks[6], (DEC_BATCH, N_MLA, PAST_LEN, MLA_ROPE), 1.0),
        'state_gla_fwd': nrm(ks[7], (DEC_BATCH, N_GLA, GLA_HEADS, GLA_DK, GLA_DV), 1.0),
        'state_gla_bwd': nrm(ks[8], (DEC_BATCH, N_GLA, GLA_HEADS, GLA_DK, GLA_DV), 1.0),
        'c_ctx': nrm(ks[9], (D,), 1.0),
        'ada_w': nrm(ks[10], (DEPTH, D, 6 * D), 0.5 * D ** -0.5),
        'ada_b': nrm(ks[11], (DEPTH, 6 * D), 0.02),
        'norm_g': gain(ks[12], (DEPTH, 2, D)),
        'win_wqkv': nrm(ks[13], (N_WIN, D, (WIN_HEADS + 2 * WIN_KV_HEADS) * WIN_HEAD_DIM), D ** -0.5),
        'win_sink': nrm(ks[14], (N_WIN, WIN_HEADS), 0.5),
        'win_wo': nrm(ks[15], (N_WIN, WIN_HEADS * WIN_HEAD_DIM, D), (WIN_HEADS * WIN_HEAD_DIM) ** -0.5),
        'mla_wdown': nrm(ks[16], (N_MLA, D, MLA_Q_RANK + MLA_KV_RANK + MLA_ROPE), D ** -0.5),
        'mla_q_norm': gain(ks[17], (N_MLA, MLA_Q_RANK)),
        'mla_wuq': nrm(ks[18], (N_MLA, MLA_Q_RANK, MLA_HEADS * (MLA_NOPE + MLA_ROPE)), MLA_Q_RANK ** -0.5),
        'mla_kv_norm': gain(ks[19], (N_MLA, MLA_KV_RANK)),
        'mla_wukv': nrm(ks[20], (N_MLA, MLA_KV_RANK, MLA_HEADS * (MLA_NOPE + MLA_V)), MLA_KV_RANK ** -0.5),
        'mla_wo': nrm(ks[21], (N_MLA, MLA_HEADS * MLA_V, D), (MLA_HEADS * MLA_V) ** -0.5),
        'gla_win': nrm(ks[22], (N_GLA, D, 2 * GLA_HEADS * GLA_DK + 2 * GLA_HEADS * GLA_DV), D ** -0.5),
        'gla_wa1': nrm(ks[23], (N_GLA, 2, D, GLA_GATE_RANK), D ** -0.5),
        'gla_wa2': nrm(ks[24], (N_GLA, 2, GLA_GATE_RANK, GLA_HEADS * GLA_DK), GLA_GATE_RANK ** -0.5),
        'gla_ba': nrm(ks[25], (N_GLA, 2, GLA_HEADS * GLA_DK), 0.1),
        'gla_norm': gain(ks[26], (N_GLA, GLA_DV)),
        'gla_wo': nrm(ks[27], (N_GLA, GLA_HEADS * GLA_DV, D), (GLA_HEADS * GLA_DV) ** -0.5),
        'ffn_w1': nrm(ks[28], (DEPTH, D, FFN_HIDDEN), D ** -0.5),
        'ffn_w2': nrm(ks[29], (DEPTH, FFN_HIDDEN, D), FFN_HIDDEN ** -0.5),
        'final_norm': gain(ks[30], (D,)),
    }


def reference(x_prompt, x_sample, c, cache_win_k, cache_win_v, cache_mla_ckv, cache_mla_krope,
              state_gla_fwd, state_gla_bwd, c_ctx, ada_w, ada_b, norm_g, win_wqkv, win_sink, win_wo,
              mla_wdown, mla_q_norm, mla_wuq, mla_kv_norm, mla_wukv, mla_wo, gla_win, gla_wa1,
              gla_wa2, gla_ba, gla_norm, gla_wo, ffn_w1, ffn_w2, final_norm):
    xp, xs = x_prompt, x_sample
    wk, wv, mc, mr, gf, gb = [], [], [], [], [], []
    for i in range(DEPTH):
        kind, j = i % N_MIXERS, i // N_MIXERS
        p_sh1, p_sc1, p_g1, p_sh2, p_sc2, p_g2 = modulation(c_ctx, ada_w[i], ada_b[i])
        s_sh1, s_sc1, s_g1, s_sh2, s_sc2, s_g2 = modulation(c, ada_w[i], ada_b[i])
        hp = modulate(xp, norm_g[i, 0], p_sh1, p_sc1)
        hs = modulate(xs, norm_g[i, 0], s_sh1, s_sc1)
        if kind == 0:
            yp, kc, vc = win_context(hp, win_wqkv[j], win_sink[j], win_wo[j])
            ys = win_latent(hs, cache_win_k[:, j], cache_win_v[:, j], win_wqkv[j], win_sink[j], win_wo[j])
            wk.append(kc)
            wv.append(vc)
        elif kind == 1:
            yp, ckv, kr = mla_context(hp, mla_wdown[j], mla_q_norm[j], mla_wuq[j], mla_kv_norm[j],
                                      mla_wukv[j], mla_wo[j])
            ys = mla_latent(hs, cache_mla_ckv[:, j], cache_mla_krope[:, j], mla_wdown[j], mla_q_norm[j],
                            mla_wuq[j], mla_kv_norm[j], mla_wukv[j], mla_wo[j])
            mc.append(ckv)
            mr.append(kr)
        else:
            zeros = jnp.zeros((xp.shape[0], GLA_HEADS, GLA_DK, GLA_DV), jnp.float32)
            yp, sf, sb = gla_mixer(hp, zeros, zeros, gla_win[j], gla_wa1[j], gla_wa2[j], gla_ba[j],
                                   gla_norm[j], gla_wo[j])
            ys, _, _ = gla_mixer(hs, state_gla_fwd[:, j], state_gla_bwd[:, j], gla_win[j], gla_wa1[j],
                                 gla_wa2[j], gla_ba[j], gla_norm[j], gla_wo[j])
            gf.append(sf)
            gb.append(sb)
        xp = xp + p_g1 * yp
        xs = xs + s_g1 * ys
        xp = xp + p_g2 * sqrelu_ffn(modulate(xp, norm_g[i, 1], p_sh2, p_sc2), ffn_w1[i], ffn_w2[i])
        xs = xs + s_g2 * sqrelu_ffn(modulate(xs, norm_g[i, 1], s_sh2, s_sc2), ffn_w1[i], ffn_w2[i])
    y_prompt = rmsnorm(xp, final_norm)
    y_sample = rmsnorm(xs, final_norm)
    new_win_k = jnp.stack(wk, axis=1)
    new_win_v = jnp.stack(wv, axis=1)
    new_mla_ckv = jnp.stack(mc, axis=1)
    new_mla_krope = jnp.stack(mr, axis=1)
    new_gla_fwd = jnp.stack(gf, axis=1)
    new_gla_bwd = jnp.stack(gb, axis=1)
    return (y_prompt, y_sample, new_win_k, new_win_v, new_mla_ckv, new_mla_krope, new_gla_fwd, new_gla_bwd)
```

```cpp
#include <hip/hip_runtime.h>
#include <cstdio>
#include <cstdint>
namespace pg8 {
#define PG8_LAS __attribute__((address_space(3)))
typedef unsigned short bf16_t;
typedef short bf16x8 __attribute__((ext_vector_type(8)));
typedef float f32x4 __attribute__((ext_vector_type(4)));
typedef unsigned u32x4 __attribute__((ext_vector_type(4)));
constexpr int BM = 256, BK = 64, HALF = 128, HTB = HALF * BK * 2  , STAGE_BYTES = 8 * HTB, NXCD = 8, WGM = 8;

__host__ __device__ __forceinline__ int lds_byte(int r, int c) { const int st = (r >> 4) * 2 + (c >> 5), rr = r & 15, cc = c & 31, ob = rr * 64 + cc * 2; return st * 1024 + (ob ^ (((ob >> 9) & 1) << 5)); }
__host__ __device__ __forceinline__ void stage_rc(int b, int& R, int& C) { const int st = b / 1024, sb = b % 1024, swz = sb ^ (((sb >> 9) & 1) << 5); R = (st >> 1) * 16 + swz / 64; C = (st & 1) * 32 + (swz % 64) / 2; }
__host__ __device__ __forceinline__ int perm32(int rho) { const int n = rho >> 4, i = rho & 15; return 8 * (i >> 2) + 4 * n + (i & 3); }

struct Unit { int pm, pn; };
struct Gemm { const bf16_t* A; const bf16_t* Bt; int M, N, K; };

struct StaticOrder {
    int nM, nN, nwg, G, c;
    __host__ __device__ void init(int M, int N, int G_, int c_) { nM = M / BM; nN = N / BM; nwg = nM * nN; G = G_; c = c_; }
    __host__ __device__ bool next(int i, Unit& u) const {
        const long L = (long)i * G + c; if (L >= nwg) return false;
        int wgid = (int)L; { const int q = nwg / NXCD, r = nwg % NXCD, xcd = wgid % NXCD, off = wgid / NXCD; wgid = (xcd < r ? xcd * (q + 1) : r * (q + 1) + (xcd - r) * q) + off; }
        const int nig = WGM * nN, gid = wgid / nig, fm = gid * WGM, gsz = (nM - fm) < WGM ? (nM - fm) : WGM;
        u.pm = fm + ((wgid % nig) % gsz); u.pn = (wgid % nig) / gsz; return true;
    }
    __device__ __forceinline__ void a_ready(const Unit&) const {}
    __device__ __forceinline__ void done(const Unit&) const {}
};
__device__ __forceinline__ unsigned cvt_pk_bf16(float lo, float hi) { unsigned r; asm volatile("v_cvt_pk_bf16_f32 %0, %1, %2" : "=v"(r) : "v"(lo), "v"(hi)); return r; }
typedef float f32x2 __attribute__((ext_vector_type(2)));
template <class Epi, class Sched, bool ALIGN_EPI = false, bool SP2 = false>
__device__ __forceinline__ void gemm_phase(PG8_LAS unsigned char* lds, const Gemm g, const Sched& S, const Epi& E) {
    const int tid = threadIdx.x, wid = __builtin_amdgcn_readfirstlane(tid >> 6), lane = tid & 63, wr = wid >> 2, wc = wid & 3, fr = lane & 15, fq = lane >> 4;
    const int K = g.K, nt = K / BK;
    unsigned voffA[2], voffB[2];
#pragma unroll
    for (int i = 0; i < 2; ++i) { int R, C; stage_rc(tid * 16 + i * 8192, R, C); const int Rb = Epi::PERM ? ((R & ~31) + perm32(R & 31)) : R;
        voffA[i] = (unsigned)(R * K + C) * 2u; voffB[i] = (unsigned)(Rb * K + C) * 2u; }
    const size_t kstep = (size_t)(BK * 2);
    const size_t hstep = (size_t)HALF * K * 2;
    const size_t tstep = 2 * hstep;
    const unsigned ldsw = (unsigned)wid * 1024u;
    const int aoff = lds_byte(wr * 64 + fr, fq * 8), boff = lds_byte(wc * 32 + fr, fq * 8);
#define PG8_SA(b, h) (((b) * 2 + (h)) * HTB)
#define PG8_SB(b, h) ((4 + (b) * 2 + (h)) * HTB)
#define PG8_STAGE(bufoff, gbase, voff) do { _Pragma("unroll") for (int _i = 0; _i < 2; ++_i) \
        __builtin_amdgcn_global_load_lds((const unsigned*)((const char*)(gbase) + (voff)[_i]), (PG8_LAS unsigned*)(lds + (bufoff) + ldsw + _i * 8192), 16, 0, 0); } while (0)
#define PG8_LDA(dst, b, h) do { _Pragma("unroll") for (int m = 0; m < 4; ++m) _Pragma("unroll") for (int k = 0; k < 2; ++k) dst[m][k] = *(const PG8_LAS bf16x8*)(lds + PG8_SA(b, h) + aoff + m * 2048 + k * 1024); } while (0)
#define PG8_LDB(dst, b, h) do { _Pragma("unroll") for (int n = 0; n < 2; ++n) _Pragma("unroll") for (int k = 0; k < 2; ++k) dst[n][k] = *(const PG8_LAS bf16x8*)(lds + PG8_SB(b, h) + boff + n * 2048 + k * 1024); } while (0)
#define PG8_MMA(ai, bj, At, Bt) do { __builtin_amdgcn_s_setprio(1); _Pragma("unroll") for (int m = 0; m < 4; ++m) _Pragma("unroll") for (int n = 0; n < 2; ++n) _Pragma("unroll") for (int k = 0; k < 2; ++k) \
        acc[ai][bj][m][n] = __builtin_amdgcn_mfma_f32_16x16x32_bf16(Bt[n][k], At[m][k], acc[ai][bj][m][n], 0, 0, 0); __builtin_amdgcn_s_setprio(0); } while (0)
#define PG8_WAIT_V(n) asm volatile("s_waitcnt vmcnt(" #n ")" ::: "memory")
#define PG8_WAIT_L(n) asm volatile("s_waitcnt lgkmcnt(" #n ")" ::: "memory")
#define PG8_BAR __builtin_amdgcn_s_barrier()
#define PG8_SCHED __builtin_amdgcn_sched_barrier(0)
    Unit cur, nxt; int ui = 0;
    if (!S.next(0, cur)) return;
    f32x4 acc[2][2][4][2];
#pragma unroll
    for (int a = 0; a < 2; ++a)
#pragma unroll
        for (int b = 0; b < 2; ++b)
#pragma unroll
            for (int m = 0; m < 4; ++m)
#pragma unroll
                for (int n = 0; n < 2; ++n) acc[a][b][m][n] = (f32x4){0.f, 0.f, 0.f, 0.f};
    bf16x8 At[4][2], B0[2][2], B1[2][2];
    const char* cA = (const char*)g.A + (size_t)cur.pm * tstep; const char* cB = (const char*)g.Bt + (size_t)cur.pn * tstep;
    S.a_ready(cur);
    if constexpr (SP2) {
        PG8_STAGE(PG8_SB(0, 0), cB, voffB); PG8_STAGE(PG8_SB(0, 1), cB + hstep, voffB); PG8_STAGE(PG8_SA(0, 0), cA, voffA); PG8_STAGE(PG8_SA(0, 1), cA + hstep, voffA);
        if (wr == 1) PG8_BAR;
        PG8_WAIT_V(2); PG8_BAR;
        PG8_STAGE(PG8_SB(1, 0), cB + kstep, voffB); PG8_STAGE(PG8_SA(1, 0), cA + kstep, voffA); PG8_STAGE(PG8_SB(1, 1), cB + hstep + kstep, voffB);
        PG8_WAIT_V(6); PG8_BAR;
    } else {
        PG8_STAGE(PG8_SB(0, 0), cB, voffB); PG8_STAGE(PG8_SA(0, 0), cA, voffA); PG8_STAGE(PG8_SB(0, 1), cB + hstep, voffB); PG8_STAGE(PG8_SA(0, 1), cA + hstep, voffA);
        if (wr == 1) PG8_BAR;
        PG8_WAIT_V(4); PG8_BAR;
        PG8_STAGE(PG8_SB(1, 0), cB + kstep, voffB); PG8_STAGE(PG8_SA(1, 0), cA + kstep, voffA); PG8_STAGE(PG8_SB(1, 1), cB + hstep + kstep, voffB);
        PG8_WAIT_V(6); PG8_BAR;
    }
    for (;;) {
        const bool has_next = S.next(ui + 1, nxt);
        const char* nA = has_next ? (const char*)g.A + (size_t)nxt.pm * tstep : cA; const char* nB = has_next ? (const char*)g.Bt + (size_t)nxt.pn * tstep : cB;
        for (int t = 0; t < nt; t += 2) {
            const bool last = (t == nt - 2);
            const char* a1 = cA + (size_t)(t + 1) * kstep;
            const char* a2 = last ? nA : cA + (size_t)(t + 2) * kstep; const char* b2 = last ? nB : cB + (size_t)(t + 2) * kstep;
            const char* a3 = a2 + kstep; const char* b3 = b2 + kstep;
            if (last && has_next) S.a_ready(nxt);
            if constexpr (SP2) {
            PG8_LDB(B0, 0, 0); PG8_LDB(B1, 0, 1); PG8_SCHED; PG8_LDA(At, 0, 0); PG8_STAGE(PG8_SA(1, 1), a1 + hstep, voffA);
            PG8_WAIT_V(8); PG8_WAIT_L(0); PG8_BAR; PG8_MMA(0, 0, At, B0); PG8_MMA(0, 1, At, B1); PG8_BAR; PG8_SCHED;
            PG8_LDA(At, 0, 1); PG8_STAGE(PG8_SB(0, 0), b2, voffB); PG8_STAGE(PG8_SB(0, 1), b2 + hstep, voffB); PG8_STAGE(PG8_SA(0, 0), a2, voffA);
            PG8_WAIT_V(8); PG8_WAIT_L(0); PG8_BAR; PG8_MMA(1, 0, At, B0); PG8_MMA(1, 1, At, B1); PG8_BAR; PG8_SCHED;
            PG8_LDB(B0, 1, 0); PG8_LDB(B1, 1, 1); PG8_SCHED; PG8_LDA(At, 1, 0); PG8_STAGE(PG8_SA(0, 1), a2 + hstep, voffA);
            PG8_WAIT_V(8); PG8_WAIT_L(0); PG8_BAR; PG8_MMA(0, 0, At, B0); PG8_MMA(0, 1, At, B1); PG8_BAR; PG8_SCHED;
            PG8_LDA(At, 1, 1); PG8_STAGE(PG8_SB(1, 0), b3, voffB); PG8_STAGE(PG8_SB(1, 1), b3 + hstep, voffB); PG8_STAGE(PG8_SA(1, 0), a3, voffA);
            PG8_WAIT_V(8); PG8_WAIT_L(0); PG8_BAR; PG8_MMA(1, 0, At, B0); PG8_MMA(1, 1, At, B1); PG8_BAR; PG8_SCHED;
            } else {
            PG8_LDB(B0, 0, 0); PG8_SCHED; PG8_LDA(At, 0, 0); PG8_STAGE(PG8_SA(1, 1), a1 + hstep, voffA);
            PG8_WAIT_L(8); PG8_BAR; PG8_WAIT_L(0); PG8_MMA(0, 0, At, B0); PG8_BAR; PG8_SCHED;
            PG8_LDB(B1, 0, 1); PG8_STAGE(PG8_SB(0, 0), b2, voffB);
            PG8_BAR; PG8_WAIT_L(0); PG8_MMA(0, 1, At, B1); PG8_BAR;
            PG8_LDA(At, 0, 1); PG8_STAGE(PG8_SA(0, 0), a2, voffA);
            PG8_BAR; PG8_WAIT_L(0); PG8_MMA(1, 0, At, B0); PG8_BAR; PG8_SCHED;
            PG8_STAGE(PG8_SB(0, 1), b2 + hstep, voffB);
            PG8_WAIT_V(6); PG8_BAR; PG8_MMA(1, 1, At, B1); PG8_BAR;
            PG8_LDB(B0, 1, 0); PG8_SCHED; PG8_LDA(At, 1, 0); PG8_STAGE(PG8_SA(0, 1), a2 + hstep, voffA);
            PG8_WAIT_L(8); PG8_BAR; PG8_WAIT_L(0); PG8_MMA(0, 0, At, B0); PG8_BAR; PG8_SCHED;
            PG8_LDB(B1, 1, 1); PG8_STAGE(PG8_SB(1, 0), b3, voffB);
            PG8_BAR; PG8_WAIT_L(0); PG8_MMA(0, 1, At, B1); PG8_BAR;
            PG8_LDA(At, 1, 1); PG8_STAGE(PG8_SA(1, 0), a3, voffA);
            PG8_BAR; PG8_WAIT_L(0); PG8_MMA(1, 0, At, B0); PG8_BAR; PG8_SCHED;
            PG8_STAGE(PG8_SB(1, 1), b3 + hstep, voffB);
            PG8_WAIT_V(6); PG8_BAR; PG8_MMA(1, 1, At, B1); PG8_BAR;
            }
        }
        if constexpr (ALIGN_EPI) { if (wr == 0) PG8_BAR; }
        if constexpr (!Epi::AFTER_DRAIN) { E(acc, cur, wr, wc, fr, fq); S.done(cur); }
        if (!has_next) break;
#pragma unroll
        for (int a = 0; a < 2; ++a)
#pragma unroll
            for (int b = 0; b < 2; ++b)
#pragma unroll
                for (int m = 0; m < 4; ++m)
#pragma unroll
                    for (int n = 0; n < 2; ++n) acc[a][b][m][n] = (f32x4){0.f, 0.f, 0.f, 0.f};
        cur = nxt; cA = nA; cB = nB; ++ui;
        if constexpr (ALIGN_EPI) { if (wr == 1) PG8_BAR; }
    }
    PG8_WAIT_V(0);
    if constexpr (!ALIGN_EPI) { if (wr == 0) PG8_BAR; }
    PG8_BAR;
    if constexpr (Epi::AFTER_DRAIN) { E.fused(acc, cur, wr, wc, fr, fq, lds, wid, lane); S.done(cur); }
#undef PG8_SA
#undef PG8_SB
#undef PG8_STAGE
#undef PG8_LDA
#undef PG8_LDB
#undef PG8_MMA
#undef PG8_WAIT_V
#undef PG8_WAIT_L
#undef PG8_BAR
#undef PG8_SCHED
}
}

#define GAS __attribute__((address_space(1)))
#define LAS __attribute__((address_space(3)))
typedef unsigned short bf16;
typedef unsigned v4u __attribute__((ext_vector_type(4)));
typedef unsigned v2u __attribute__((ext_vector_type(2)));
typedef float f32x4 __attribute__((ext_vector_type(4)));
typedef float f32x2 __attribute__((ext_vector_type(2)));
typedef float f32x16 __attribute__((ext_vector_type(16)));
typedef short bf16x8 __attribute__((ext_vector_type(8)));
typedef short s16x4 __attribute__((ext_vector_type(4)));
typedef GAS unsigned gu32;
#define RLX_AGENT __ATOMIC_RELAXED, __HIP_MEMORY_SCOPE_AGENT
#define LDS_WAIT() asm volatile("s_waitcnt lgkmcnt(0)" ::: "memory")
#define VM_WAIT() asm volatile("s_waitcnt vmcnt(0)" ::: "memory")
#define SBAR() __builtin_amdgcn_sched_barrier(0)
__device__ __forceinline__ unsigned f2bf(float f) { unsigned u = __builtin_bit_cast(unsigned, f); return (u + 0x7fffu + ((u >> 16) & 1u)) >> 16; }
__device__ __forceinline__ unsigned pk2(float lo, float hi) { return f2bf(lo) | (f2bf(hi) << 16); }
__device__ __forceinline__ float bf2f(unsigned short b) { return __builtin_bit_cast(float, (unsigned)b << 16); }
__device__ __forceinline__ unsigned cvtpk(float lo, float hi) { unsigned r; asm volatile("v_cvt_pk_bf16_f32 %0, %1, %2" : "=v"(r) : "v"(lo), "v"(hi)); return r; }
__device__ __forceinline__ float wave_sum(float v) {
#pragma unroll
    for (int o = 1; o < 64; o <<= 1) v += __shfl_xor(v, o);
    return v;
}
#define XB_TMO      128
#define XB_XCNT(j)  (256  + 64 * (j))
#define XB_XSUB(j)  (1280 + 64 * (j))
#define XB_XGEN(j)  (2304 + 64 * (j))
#define XB_TOP      3328
#define XB_TOPGEN   3392
#define XCD_BAR_WORDS 3456
#define XB_SPIN_CAP (1u << 18)

__device__ __forceinline__ unsigned xb_ld(unsigned* p)              { return __hip_atomic_load(p, __ATOMIC_RELAXED, __HIP_MEMORY_SCOPE_AGENT); }
__device__ __forceinline__ unsigned xb_add(unsigned* p, unsigned v) { return __hip_atomic_fetch_add(p, v, __ATOMIC_RELAXED, __HIP_MEMORY_SCOPE_AGENT); }
__device__ __forceinline__ unsigned xb_xcc_id() { return (unsigned)__builtin_amdgcn_s_getreg((3 << 11) | 20) & 0xFu; }
#define XB_SPIN(cond, bar) do { unsigned _sp = 0; while (cond) { __builtin_amdgcn_s_sleep(1); \
    if ((++_sp & 255u) == 0u) { if (xb_ld(&(bar)[XB_TMO])) break; if (_sp > XB_SPIN_CAP) { atomicAdd(&(bar)[XB_TMO], 1u); break; } } } } while (0)

struct XcdBarrier {
    unsigned* bar; unsigned x;
    volatile LAS unsigned* st;
};

__device__ __forceinline__ XcdBarrier xcd_barrier_post(unsigned* bar, volatile LAS unsigned* st) {
    XcdBarrier b; b.bar = bar; b.x = xb_xcc_id(); b.st = st;
    if (threadIdx.x == 0) (void)xb_add(&bar[XB_XCNT(b.x)], 1u);
    return b;
}
__device__ __forceinline__ void xcd_barrier_complete(unsigned* bar, unsigned x, unsigned& nloc, unsigned& nx) {
    const unsigned G = gridDim.x * gridDim.y * gridDim.z;
    unsigned sum, cnt, mine, sp = 0u;
    for (;;) {
        sum = 0u; cnt = 0u; mine = 0u;
#pragma unroll
        for (unsigned j = 0; j < 16; ++j) { const unsigned c = xb_ld(&bar[XB_XCNT(j)]); sum += c; cnt += (c > 0u) ? 1u : 0u; mine = (j == x) ? c : mine; }
        if (sum == G) break;
        __builtin_amdgcn_s_sleep(1);
        if ((++sp & 255u) == 0u) { if (xb_ld(&bar[XB_TMO])) break; if (sp > XB_SPIN_CAP) { atomicAdd(&bar[XB_TMO], 1u); break; } }
    }
    nloc = mine > 0u ? mine : 1u; nx = cnt > 0u ? cnt : 1u;
}

__device__ __forceinline__ void xcd_barrier(const XcdBarrier& b) {
    asm volatile("s_waitcnt vmcnt(0)" ::: "memory");
    __syncthreads();
    if (threadIdx.x == 0) {
        unsigned* bar = b.bar;
        __builtin_amdgcn_s_waitcnt(0);
        unsigned nloc = b.st[0], nx = b.st[1];
        if (nloc == 0u) { xcd_barrier_complete(bar, b.x, nloc, nx); b.st[0] = nloc; b.st[1] = nx; }
        const unsigned old = xb_add(&bar[XB_XSUB(b.x)], 1u);
        const unsigned gen = old / nloc;
        if (old + 1u == (gen + 1u) * nloc) {
            __builtin_amdgcn_fence(__ATOMIC_RELEASE, "agent");
            asm volatile("s_waitcnt vmcnt(0)" ::: "memory");
            const unsigned og = xb_add(&bar[XB_TOP], 1u);
            const unsigned tg = og / nx;
            if (og + 1u == (tg + 1u) * nx) xb_add(&bar[XB_TOPGEN], 1u);
            else XB_SPIN(xb_ld(&bar[XB_TOPGEN]) == tg, bar);
            __builtin_amdgcn_fence(__ATOMIC_ACQUIRE, "agent");
            xb_add(&bar[XB_XGEN(b.x)], 1u);
            asm volatile("s_waitcnt vmcnt(0)" ::: "memory");
        } else {
            XB_SPIN(xb_ld(&bar[XB_XGEN(b.x)]) == gen, bar);
            __builtin_amdgcn_fence(__ATOMIC_ACQUIRE, "agent");
            asm volatile("s_waitcnt vmcnt(0)" ::: "memory");
        }
    }
    __syncthreads();
}

constexpr int NWAVES = 8;
constexpr int DM = 2048, MTOK = 16384, MP = 8192, FFH = 8192;
constexpr float EPS = 1e-6f;
constexpr size_t MiB = 1u << 20;
constexpr size_t WS_CTL = 0, CTL_ZERO_BYTES = 1 * MiB;
constexpr size_t WS_MOD = 1 * MiB;
constexpr size_t WS_TABW = 2 * MiB;
constexpr size_t WS_TABM = 2 * MiB + 65536;
constexpr size_t WS_W1T = 4 * MiB;
constexpr size_t WS_W2T = 132 * MiB;
constexpr size_t WS_WQKVT = 260 * MiB;
constexpr size_t WS_WWOT = 284 * MiB;
constexpr size_t WS_MWDT = 300 * MiB;
constexpr size_t WS_MWUQT = 304 * MiB;
constexpr size_t WS_MWUKVT = 307 * MiB;
constexpr size_t WS_MWOT = 309 * MiB;
constexpr size_t WS_GWINT = 317 * MiB;
constexpr size_t WS_GWOT = 342 * MiB;
constexpr size_t WS_CTXK = 350 * MiB;
constexpr size_t WS_CTXV = 352 * MiB;
constexpr size_t WS_X = 354 * MiB;
constexpr size_t WS_H = 482 * MiB;
constexpr size_t WS_AO = 546 * MiB;
constexpr size_t WS_SCR = 610 * MiB;
constexpr size_t WS_HID = WS_SCR;
constexpr size_t WS_WQ = WS_SCR, WS_WK = WS_SCR + 64 * MiB, WS_WV = WS_SCR + 80 * MiB;
constexpr size_t WS_MD = WS_SCR, WS_MCQ = WS_SCR + 64 * MiB, WS_MCKV = WS_SCR + 80 * MiB, WS_MKR = WS_SCR + 89 * MiB, WS_MQ = WS_SCR + 92 * MiB, WS_MKN = WS_SCR + 188 * MiB, WS_MV = WS_SCR + 256 * MiB;
constexpr size_t WS_GQ = WS_SCR, WS_GK = WS_SCR + 32 * MiB, WS_GV = WS_SCR + 64 * MiB, WS_GR = WS_SCR + 128 * MiB, WS_GU = WS_SCR + 192 * MiB,
                 WS_GQT = WS_SCR + 194 * MiB, WS_GKD = WS_SCR + 258 * MiB, WS_GAM = WS_SCR + 322 * MiB, WS_GDEC = WS_SCR + 338 * MiB, WS_GOF = WS_SCR + 340 * MiB, WS_GOB = WS_SCR + 468 * MiB;
constexpr size_t WS_END = WS_SCR + 596 * MiB;
constexpr size_t O_YP = 0, O_YS = 16777216, O_WK = 33554432, O_WV = 41943040, O_CKV = 50331648, O_KR = 52428800, O_GF = 52953088, O_GB = 69730304, O_END = 86507520;
constexpr int CW_BAR = 4096;
constexpr int RING_BYTES = 131072, MISC_OFF = RING_BYTES + 320, LDS_BYTES = 147456;

struct Args {
    const float* in[32]; float* out; unsigned char* ws; int ph_lo, ph_hi, li, pad;
};
enum { I_XP = 0, I_XS, I_C, I_CWK, I_CWV, I_CCKV, I_CKR, I_SGF, I_SGB, I_CCTX, I_ADAW, I_ADAB, I_NORMG, I_WQKV, I_SINK, I_WWO, I_MWD, I_MQN, I_MWUQ, I_MKVN, I_MWUKV, I_MWO,
       I_GWIN, I_GWA1, I_GWA2, I_GBA, I_GNORM, I_GWO, I_W1, I_W2, I_FNORM };

__device__ __forceinline__ int cond_of_pm(int pm) { return pm < 32 ? 0 : (pm >> 4) - 1; }

struct EpiResid {
    static constexpr bool PERM = true, AFTER_DRAIN = false;
    const float* xp; const float* xs; float* X; const float* gate; int first;
    __device__ __forceinline__ void operator()(const pg8::f32x4 (&acc)[2][2][4][2], const pg8::Unit& u, int wr, int wc, int fr, int fq) const {
        const int row0 = u.pm * 256 + wr * 64 + fr, col0 = u.pn * 256 + wc * 32 + 8 * fq;
        const float* gp = gate + (size_t)cond_of_pm(u.pm) * 12288 + col0;
        f32x4 gv[2][2];
#pragma unroll
        for (int bj = 0; bj < 2; ++bj)
#pragma unroll
            for (int n = 0; n < 2; ++n) gv[bj][n] = *(const f32x4*)(gp + bj * 128 + 4 * n);
#pragma unroll
        for (int ai = 0; ai < 2; ++ai)
#pragma unroll
            for (int m = 0; m < 4; ++m) {
                const int row = row0 + ai * 128 + m * 16;
                const float* sp = first ? (row < MP ? xp + (size_t)row * DM : xs + (size_t)(row - MP) * DM) : X + (size_t)row * DM;
                float* dp = X + (size_t)row * DM;
#pragma unroll
                for (int bj = 0; bj < 2; ++bj)
#pragma unroll
                    for (int n = 0; n < 2; ++n) {
                        const int c = col0 + bj * 128 + 4 * n;
                        const f32x4 xv = *(const f32x4*)(sp + c);
                        *(f32x4*)(dp + c) = xv + gv[bj][n] * acc[ai][bj][m][n];
                    }
            }
    }
};

struct EpiRelu2 {
    static constexpr bool PERM = true, AFTER_DRAIN = false;
    bf16* O; int ldc;
    __device__ __forceinline__ void operator()(const pg8::f32x4 (&acc)[2][2][4][2], const pg8::Unit& u, int wr, int wc, int fr, int fq) const {
        const int row0 = u.pm * 256 + wr * 64 + fr, col0 = u.pn * 256 + wc * 32 + 8 * fq;
#pragma unroll
        for (int ai = 0; ai < 2; ++ai)
#pragma unroll
            for (int m = 0; m < 4; ++m) {
                bf16* rp = O + (size_t)(row0 + ai * 128 + m * 16) * ldc + col0;
#pragma unroll
                for (int bj = 0; bj < 2; ++bj) {
                    f32x4 a = acc[ai][bj][m][0], b = acc[ai][bj][m][1];
                    a = __builtin_elementwise_max(a, (f32x4){0.f, 0.f, 0.f, 0.f}); b = __builtin_elementwise_max(b, (f32x4){0.f, 0.f, 0.f, 0.f});
                    a = a * a; b = b * b;
                    v4u w; w.x = cvtpk(a[0], a[1]); w.y = cvtpk(a[2], a[3]); w.z = cvtpk(b[0], b[1]); w.w = cvtpk(b[2], b[3]);
                    *(v4u*)(rp + bj * 128) = w;
                }
            }
    }
};

struct EpiF32 {
    static constexpr bool PERM = true, AFTER_DRAIN = false;
    float* O; int ldc;
    __device__ __forceinline__ void operator()(const pg8::f32x4 (&acc)[2][2][4][2], const pg8::Unit& u, int wr, int wc, int fr, int fq) const {
        const int row0 = u.pm * 256 + wr * 64 + fr, col0 = u.pn * 256 + wc * 32 + 8 * fq;
#pragma unroll
        for (int ai = 0; ai < 2; ++ai)
#pragma unroll
            for (int m = 0; m < 4; ++m) {
                float* rp = O + (size_t)(row0 + ai * 128 + m * 16) * ldc + col0;
#pragma unroll
                for (int bj = 0; bj < 2; ++bj) { *(f32x4*)(rp + bj * 128) = acc[ai][bj][m][0]; *(f32x4*)(rp + bj * 128 + 4) = acc[ai][bj][m][1]; }
            }
    }
};

__device__ __forceinline__ v4u pack8(const f32x4& a, const f32x4& b) { v4u w; w.x = cvtpk(a[0], a[1]); w.y = cvtpk(a[2], a[3]); w.z = cvtpk(b[0], b[1]); w.w = cvtpk(b[2], b[3]); return w; }

struct EpiQkvWin {
    static constexpr bool PERM = true, AFTER_DRAIN = false;
    bf16 *Q, *K, *V; float* outk; float* outv; int j; const f32x2* tab;
    __device__ __forceinline__ void operator()(const pg8::f32x4 (&acc)[2][2][4][2], const pg8::Unit& u, int wr, int wc, int fr, int fq) const {
        const int row0 = u.pm * 256 + wr * 64 + fr, cl = wc * 32 + 8 * fq;
        const int pn = u.pn; const bool sample = u.pm >= 32;
        const int ug = 4 * wc + fq, idx0 = (ug & 7) * 4, d1 = (ug < 8 ? 0 : 64) + idx0;
#pragma unroll
        for (int ai = 0; ai < 2; ++ai)
#pragma unroll
            for (int m = 0; m < 4; ++m) {
                const int row = row0 + ai * 128 + m * 16;
                f32x4 cs0 = {1.f, 0.f, 1.f, 0.f}, cs1 = {1.f, 0.f, 1.f, 0.f};
                if (sample && pn < 10) { const int t = row & 4095, pos = (ug < 8) ? (t >> 6) : (t & 63); const f32x4* tp = (const f32x4*)(tab + pos * 32 + idx0); cs0 = tp[0]; cs1 = tp[1]; }
#pragma unroll
                for (int bj = 0; bj < 2; ++bj) {
                    f32x4 a = acc[ai][bj][m][0], b = acc[ai][bj][m][1];
                    if (pn < 10) {
                        if (sample) {
                            const f32x4 co = {cs0[0], cs0[2], cs1[0], cs1[2]}, si = {cs0[1], cs0[3], cs1[1], cs1[3]};
                            const f32x4 na = a * co - b * si, nb = b * co + a * si; a = na; b = nb;
                        }
                        if (pn < 8) { *(v4u*)(Q + (size_t)row * 2048 + pn * 256 + bj * 128 + cl) = pack8(a, b); }
                        else {
                            const int kvh = (pn - 8) * 2 + bj;
                            *(v4u*)(K + (size_t)row * 512 + kvh * 128 + cl) = pack8(a, b);
                            if (!sample) { float* op = outk + ((size_t)(u.pm * 2 + j) * 256 + (row & 255)) * 512 + kvh * 128 + d1; *(f32x4*)op = a; *(f32x4*)(op + 32) = b; }
                        }
                    } else {
                        const int kvh = (pn - 10) * 2 + bj;
                        *(v4u*)(V + (size_t)row * 512 + kvh * 128 + cl) = pack8(a, b);
                        if (!sample) { float* op = outv + ((size_t)(u.pm * 2 + j) * 256 + (row & 255)) * 512 + kvh * 128 + cl; *(f32x4*)op = a; *(f32x4*)(op + 4) = b; }
                    }
                }
            }
    }
};

struct EpiMlaQ {
    static constexpr bool PERM = true, AFTER_DRAIN = false;
    bf16* Q; const f32x2* tab;
    __device__ __forceinline__ void operator()(const pg8::f32x4 (&acc)[2][2][4][2], const pg8::Unit& u, int wr, int wc, int fr, int fq) const {
        const int row0 = u.pm * 256 + wr * 64 + fr, col0 = u.pn * 256 + wc * 32 + 8 * fq;
        const bool sample = u.pm >= 32;
#pragma unroll
        for (int bj = 0; bj < 2; ++bj) {
            const int c0 = col0 + bj * 128, p0 = c0 % 192; const bool isr = p0 >= 128; const int ug = isr ? ((p0 - 128) >> 3) : 0, idx0 = (ug & 3) * 4;
#pragma unroll
            for (int ai = 0; ai < 2; ++ai)
#pragma unroll
                for (int m = 0; m < 4; ++m) {
                    const int row = row0 + ai * 128 + m * 16;
                    f32x4 a = acc[ai][bj][m][0], b = acc[ai][bj][m][1];
                    if (sample) {
                        const int t = row & 4095, pos = (ug < 4) ? (t >> 6) : (t & 63); const f32x4* tp = (const f32x4*)(tab + pos * 16 + idx0); const f32x4 cs0 = tp[0], cs1 = tp[1];
                        const f32x4 co = {cs0[0], cs0[2], cs1[0], cs1[2]}, si = {cs0[1], cs0[3], cs1[1], cs1[3]};
                        const f32x4 na = a * co - b * si, nb = b * co + a * si;
                        if (isr) { a = na; b = nb; }
                    }
                    *(v4u*)(Q + (size_t)row * 3072 + c0) = pack8(a, b);
                }
        }
    }
};

struct EpiMlaKV {
    static constexpr bool PERM = true, AFTER_DRAIN = false;
    bf16 *KN, *V;
    __device__ __forceinline__ void operator()(const pg8::f32x4 (&acc)[2][2][4][2], const pg8::Unit& u, int wr, int wc, int fr, int fq) const {
        const int row0 = u.pm * 256 + wr * 64 + fr, cl = u.pn * 128 + wc * 32 + 8 * fq;
#pragma unroll
        for (int ai = 0; ai < 2; ++ai)
#pragma unroll
            for (int m = 0; m < 4; ++m) {
                const size_t ro = (size_t)(row0 + ai * 128 + m * 16) * 2048 + cl;
                *(v4u*)(KN + ro) = pack8(acc[ai][0][m][0], acc[ai][0][m][1]);
                *(v4u*)(V + ro) = pack8(acc[ai][1][m][0], acc[ai][1][m][1]);
            }
    }
};

struct EpiGlaIn {
    static constexpr bool PERM = true, AFTER_DRAIN = false;
    bf16 *q, *k, *v, *r; float* uo;
    __device__ __forceinline__ void operator()(const pg8::f32x4 (&acc)[2][2][4][2], const pg8::Unit& u, int wr, int wc, int fr, int fq) const {
        const int row0 = u.pm * 256 + wr * 64 + fr, cl = wc * 32 + 8 * fq; const int pn = u.pn;
#pragma unroll
        for (int ai = 0; ai < 2; ++ai)
#pragma unroll
            for (int m = 0; m < 4; ++m) {
                const int row = row0 + ai * 128 + m * 16;
#pragma unroll
                for (int bj = 0; bj < 2; ++bj) {
                    f32x4 a = acc[ai][bj][m][0], b = acc[ai][bj][m][1];
                    const int c = pn * 256 + bj * 128 + cl;
                    if (pn < 4) { a = a * 0.0625f; b = b * 0.0625f; *(v4u*)(q + (size_t)row * 1024 + c) = pack8(a, b); }
                    else if (pn < 8) { *(v4u*)(k + (size_t)row * 1024 + (c - 1024)) = pack8(a, b); }
                    else if (pn < 16) { *(v4u*)(v + (size_t)row * 2048 + (c - 2048)) = pack8(a, b); }
                    else if (pn < 24) { *(v4u*)(r + (size_t)row * 2048 + (c - 4096)) = pack8(a, b); }
                    else if (bj == 0 && wc == 0) { float* op = uo + (size_t)row * 32 + 8 * fq; *(f32x4*)op = a; *(f32x4*)(op + 4) = b; }
                }
            }
    }
};

struct Frame {
    LAS unsigned char* lds; unsigned char* ldsg;
    int tid, lane, wave, G, bx;
    const float* const* in; float* out; unsigned char* ws;
};
#define WSP(T, off) ((T*)(F.ws + (off)))

__device__ __forceinline__ int perm_win(int p) { const int u = p >> 3, v = p & 7; return (u < 8 ? 0 : 64) + (u & 7) * 4 + (v & 3) + ((v & 4) ? 32 : 0); }
__device__ __forceinline__ int perm_mla(int p) { const int u = p >> 3, v = p & 7; return (u < 4 ? 0 : 32) + (u & 3) * 4 + (v & 3) + ((v & 4) ? 16 : 0); }
__device__ __forceinline__ int srcmap(int mode, int n) {
    if (mode == 1) { if (n >= 2560) return n; return (n & ~127) + perm_win(n & 127); }
    if (mode == 2) { if (n < 768) return n; if (n >= 832) return -1; return 768 + perm_mla(n - 768); }
    if (mode == 3) { const int hh = n / 192, p = n - hh * 192; if (p < 128) return n; return hh * 192 + 128 + perm_mla(p - 128); }
    return n;
}
__device__ __forceinline__ void tr_item(const float* W, int K, int Nsrc, int nblk, bf16* WT, int mode, LAS float* scr, int item, int lane) {
    const int kb = item / nblk, nb = item - kb * nblk, k0 = 64 * kb, n0 = 32 * nb;
    const int sc = srcmap(mode, n0 + (lane & 31));
#pragma unroll 8
    for (int i = 0; i < 32; ++i) { const int kk = 2 * i + (lane >> 5); scr[kk * 33 + (lane & 31)] = sc >= 0 ? W[(size_t)(k0 + kk) * Nsrc + sc] : 0.f; }
    LDS_WAIT(); asm volatile("" ::: "memory");
    const int c = lane & 7;
#pragma unroll
    for (int jj = 0; jj < 4; ++jj) { const int n = (lane >> 3) + 8 * jj; const LAS float* s = scr + (8 * c) * 33 + n;
        v4u o; o.x = pk2(s[0 * 33], s[1 * 33]); o.y = pk2(s[2 * 33], s[3 * 33]); o.z = pk2(s[4 * 33], s[5 * 33]); o.w = pk2(s[6 * 33], s[7 * 33]);
        *(GAS v4u*)(WT + (size_t)(n0 + n) * K + k0 + 8 * c) = o; }
    LDS_WAIT(); asm volatile("" ::: "memory");
}

__device__ __forceinline__ void p0_prologue(Frame& F) {
    const int tid = F.tid, lane = F.lane, wave = F.wave;
    for (int it = F.bx; it < 192; it += F.G) {
        const int l = it / 48, nb = it - l * 48;
        LAS float* sl = (LAS float*)F.lds; LAS float* red = sl + 3 * 2048;
        for (int e = tid; e < 3 * 2048; e += 512) { const int c = e >> 11, k = e & 2047; const float v = (c == 0) ? F.in[I_CCTX][k] : F.in[I_C][(c - 1) * 2048 + k]; sl[e] = v / (1.f + __expf(-v)); }
        __syncthreads();
        const float* Wp = F.in[I_ADAW] + ((size_t)l * 2048 + wave * 256) * 12288 + nb * 256 + lane * 4;
        f32x4 a0 = {0.f, 0.f, 0.f, 0.f}, a1 = a0, a2 = a0;
        for (int k = 0; k < 256; k += 8) {
            f32x4 w[8];
#pragma unroll
            for (int jj = 0; jj < 8; ++jj) w[jj] = *(const f32x4*)(Wp + (size_t)(k + jj) * 12288);
#pragma unroll
            for (int jj = 0; jj < 8; ++jj) { const int kk = wave * 256 + k + jj; a0 += w[jj] * sl[kk]; a1 += w[jj] * sl[2048 + kk]; a2 += w[jj] * sl[4096 + kk]; }
        }
        *(LAS f32x4*)(red + (wave * 3 + 0) * 256 + lane * 4) = a0; *(LAS f32x4*)(red + (wave * 3 + 1) * 256 + lane * 4) = a1; *(LAS f32x4*)(red + (wave * 3 + 2) * 256 + lane * 4) = a2;
        __syncthreads();
        for (int e = tid; e < 768; e += 512) { const int c = e >> 8, n = e & 255; float s = F.in[I_ADAB][l * 12288 + nb * 256 + n];
#pragma unroll
            for (int w8 = 0; w8 < 8; ++w8) s += red[(w8 * 3 + c) * 256 + n];
            WSP(float, WS_MOD)[(size_t)(l * 3 + c) * 12288 + nb * 256 + n] = s; }
        __syncthreads();
    }
    if (F.bx == F.G - 1) {
        for (int e = tid; e < 64 * 32; e += 512) { const int pos = e >> 5, i = e & 31; const float inv = exp2f(-(float)i * (13.287712379549449f / 32.f)); const float ang = (float)pos * inv;
            WSP(f32x2, WS_TABW)[e] = (f32x2){cosf(ang), sinf(ang)}; }
        for (int e = tid; e < 64 * 16; e += 512) { const int pos = e >> 4, i = e & 15; const float inv = exp2f(-(float)i * (13.287712379549449f / 16.f)); const float ang = (float)pos * inv;
            WSP(f32x2, WS_TABM)[e] = (f32x2){cosf(ang), sinf(ang)}; }
    }
    const int gt = F.bx * 512 + tid, NGT = F.G * 512;
    for (int e = gt; e < 2 * 2 * 512 * 512; e += NGT) {
        const int c = e & 511, pos = (e >> 9) & 511, b = (e >> 18) & 1, jj = e >> 19;
        const size_t sbase = (((size_t)b * 2 + jj) * 512 + pos) * 512;
        WSP(bf16, WS_CTXK)[e] = (bf16)f2bf(F.in[I_CWK][sbase + (c & ~127) + perm_win(c & 127)]);
        WSP(bf16, WS_CTXV)[e] = (bf16)f2bf(F.in[I_CWV][sbase + c]);
    }
    for (int e = gt; e < 256 * 2048; e += NGT) { const int n = e >> 11, k = e & 2047; float v = 0.f; if (n < 32) v = F.in[I_GWA1][((size_t)(n >> 4) * 2048 + k) * 16 + (n & 15)];
        WSP(bf16, WS_GWINT)[(size_t)(6144 + n) * 2048 + k] = (bf16)f2bf(v); }
    LAS float* scr = (LAS float*)(F.lds + wave * 16384);
    const int gw = F.bx * NWAVES + wave, NGW = F.G * NWAVES;
    constexpr int C_W1 = 32 * 256, C_W2 = 128 * 64, C_QKV = 32 * 96, C_WO = 32 * 64, C_MWD = 32 * 32, C_MUQ = 8 * 96, C_MUKV = 4 * 128, C_GWIN = 32 * 192;
    constexpr int NITEMS = 4 * C_W1 + 4 * C_W2 + 2 * C_QKV + 2 * C_WO + C_MWD + C_MUQ + C_MUKV + C_WO + C_GWIN + C_WO;
    for (int it = gw; it < NITEMS; it += NGW) {
        int r = it;
        if (r < 4 * C_W1) { const int l = r / C_W1; r -= l * C_W1; tr_item(F.in[I_W1] + (size_t)l * 2048 * 8192, 2048, 8192, 256, WSP(bf16, WS_W1T) + (size_t)l * 8192 * 2048, 0, scr, r, lane); continue; } r -= 4 * C_W1;
        if (r < 4 * C_W2) { const int l = r / C_W2; r -= l * C_W2; tr_item(F.in[I_W2] + (size_t)l * 8192 * 2048, 8192, 2048, 64, WSP(bf16, WS_W2T) + (size_t)l * 2048 * 8192, 0, scr, r, lane); continue; } r -= 4 * C_W2;
        if (r < 2 * C_QKV) { const int l = r / C_QKV; r -= l * C_QKV; tr_item(F.in[I_WQKV] + (size_t)l * 2048 * 3072, 2048, 3072, 96, WSP(bf16, WS_WQKVT) + (size_t)l * 3072 * 2048, 1, scr, r, lane); continue; } r -= 2 * C_QKV;
        if (r < 2 * C_WO) { const int l = r / C_WO; r -= l * C_WO; tr_item(F.in[I_WWO] + (size_t)l * 2048 * 2048, 2048, 2048, 64, WSP(bf16, WS_WWOT) + (size_t)l * 2048 * 2048, 0, scr, r, lane); continue; } r -= 2 * C_WO;
        if (r < C_MWD) { tr_item(F.in[I_MWD], 2048, 832, 32, WSP(bf16, WS_MWDT), 2, scr, r, lane); continue; } r -= C_MWD;
        if (r < C_MUQ) { tr_item(F.in[I_MWUQ], 512, 3072, 96, WSP(bf16, WS_MWUQT), 3, scr, r, lane); continue; } r -= C_MUQ;
        if (r < C_MUKV) { tr_item(F.in[I_MWUKV], 256, 4096, 128, WSP(bf16, WS_MWUKVT), 0, scr, r, lane); continue; } r -= C_MUKV;
        if (r < C_WO) { tr_item(F.in[I_MWO], 2048, 2048, 64, WSP(bf16, WS_MWOT), 0, scr, r, lane); continue; } r -= C_WO;
        if (r < C_GWIN) { tr_item(F.in[I_GWIN], 2048, 6144, 192, WSP(bf16, WS_GWINT), 0, scr, r, lane); continue; } r -= C_GWIN;
        tr_item(F.in[I_GWO], 2048, 2048, 64, WSP(bf16, WS_GWOT), 0, scr, r, lane);
    }
}

__device__ __forceinline__ const float* x_row(Frame& F, int L, int row) {
    return L == 0 ? (row < MP ? F.in[I_XP] + (size_t)row * DM : F.in[I_XS] + (size_t)(row - MP) * DM) : WSP(float, WS_X) + (size_t)row * DM;
}
__device__ __forceinline__ void mod_phase(Frame& F, int L, int which, int first) {
    const int gw = F.bx * NWAVES + F.wave, NGW = F.G * NWAVES, lane = F.lane;
    for (int rb = gw; rb < MTOK / 8; rb += NGW) {
        const int row0 = rb * 8, cond = row0 < MP ? 0 : (row0 >> 12) - 1;
        const float* mv = WSP(float, WS_MOD) + (size_t)(L * 3 + cond) * 12288 + (which ? 3 * 2048 : 0);
        const float* g = F.in[I_NORMG] + (size_t)(L * 2 + which) * 2048;
        f32x4 a[8], s[8];
#pragma unroll
        for (int jj = 0; jj < 8; ++jj) { const int col = 4 * lane + 256 * jj; const f32x4 gv = *(const f32x4*)(g + col), sc = *(const f32x4*)(mv + 2048 + col); s[jj] = *(const f32x4*)(mv + col); a[jj] = gv * (sc + 1.f); }
        for (int r = 0; r < 8; ++r) {
            const int row = row0 + r; const float* xr = x_row(F, first ? 0 : 1, row);
            f32x4 v[8]; float ss = 0.f;
#pragma unroll
            for (int jj = 0; jj < 8; ++jj) { v[jj] = *(const f32x4*)(xr + 4 * lane + 256 * jj); ss += (v[jj][0] * v[jj][0] + v[jj][1] * v[jj][1]) + (v[jj][2] * v[jj][2] + v[jj][3] * v[jj][3]); }
            const float rstd = rsqrtf(wave_sum(ss) * (1.f / 2048.f) + EPS);
            bf16* hr = WSP(bf16, WS_H) + (size_t)row * DM;
#pragma unroll
            for (int jj = 0; jj < 8; ++jj) { const f32x4 y = v[jj] * rstd * a[jj] + s[jj]; v2u w; w.x = cvtpk(y[0], y[1]); w.y = cvtpk(y[2], y[3]); *(v2u*)(hr + 4 * lane + 256 * jj) = w; }
        }
    }
}
__device__ __forceinline__ void final_phase(Frame& F) {
    const int gw = F.bx * NWAVES + F.wave, NGW = F.G * NWAVES, lane = F.lane;
    const float* g = F.in[I_FNORM];
    for (int row = gw; row < MTOK; row += NGW) {
        const float* xr = WSP(float, WS_X) + (size_t)row * DM;
        f32x4 v[8]; float ss = 0.f;
#pragma unroll
        for (int jj = 0; jj < 8; ++jj) { v[jj] = *(const f32x4*)(xr + 4 * lane + 256 * jj); ss += (v[jj][0] * v[jj][0] + v[jj][1] * v[jj][1]) + (v[jj][2] * v[jj][2] + v[jj][3] * v[jj][3]); }
        const float rstd = rsqrtf(wave_sum(ss) * (1.f / 2048.f) + EPS);
        float* orow = F.out + (size_t)row * DM;
#pragma unroll
        for (int jj = 0; jj < 8; ++jj) { const int col = 4 * lane + 256 * jj; *(f32x4*)(orow + col) = v[jj] * rstd * *(const f32x4*)(g + col); }
    }
}

namespace att {
constexpr int QBLK = 32, KVBLK = 64;
constexpr int SHM_V = 16384, SHM_K = 16384, SHM_KR = 8192;
constexpr int OFF_V = 0, OFF_K = 2 * SHM_V, OFF_KR = 2 * SHM_V + 2 * SHM_K, OFF_WS = OFF_KR + 2 * SHM_KR, OFF_QR = OFF_WS + NWAVES * 64 * 4, LDS_ATT = OFF_QR + NWAVES * 4096;
#define KSWZ(row, colB) ((row) * 256 + ((colB) ^ (((row) & 7) << 4)))
#define KRSWZ(row, chunk) ((row) * 128 + ((((chunk) ^ ((row) >> 1)) & 7) << 4))
__device__ __forceinline__ int crow(int r, int hi) { return (r & 3) + 8 * (r >> 2) + 4 * hi; }
template <int DQK> struct Cst { static constexpr float SCALE = DQK == 128 ? 0.088388347648318440f : 0.072168783648703220f; static constexpr float C = SCALE * 1.4426950408889634f; };
constexpr float THR = 8.f;

template <int DQK>
__device__ __forceinline__ void partialSM(f32x16& p0, f32x16& p1, float& m_reg, float& mn, float& alpha) {
    constexpr float C = Cst<DQK>::C, SCALE = Cst<DQK>::SCALE;
    float pmax = p0[0];
#pragma unroll
    for (int r = 1; r < 16; ++r) pmax = fmaxf(pmax, p0[r]);
#pragma unroll
    for (int r = 0; r < 16; ++r) pmax = fmaxf(pmax, p1[r]);
    { auto rr = __builtin_amdgcn_permlane32_swap(__float_as_uint(pmax), __float_as_uint(pmax), false, false);
      pmax = fmaxf(__uint_as_float(rr[0]), __uint_as_float(rr[1])); }
    if (__builtin_expect(__all(pmax - m_reg <= THR / SCALE), 1)) { mn = m_reg; alpha = 1.f; }
    else { mn = fmaxf(m_reg, pmax); alpha = __builtin_amdgcn_exp2f((m_reg - mn) * C); m_reg = mn; }
    const float mnC = -mn * C;
#pragma unroll
    for (int r = 0; r < 16; ++r) p0[r] = __builtin_amdgcn_exp2f(fmaf(p0[r], C, mnC));
#pragma unroll
    for (int r = 0; r < 16; ++r) p1[r] = __builtin_amdgcn_exp2f(fmaf(p1[r], C, mnC));
}
__device__ __forceinline__ void finishSM(f32x16& p0, f32x16& p1, float alpha, float& l_reg, bf16x8& pa0, bf16x8& pa1, bf16x8& pa2, bf16x8& pa3) {
    float ps = 0;
#pragma unroll
    for (int r = 0; r < 16; ++r) ps += p0[r];
#pragma unroll
    for (int r = 0; r < 16; ++r) ps += p1[r];
    { auto rr = __builtin_amdgcn_permlane32_swap(__float_as_uint(ps), __float_as_uint(ps), false, false);
      ps = __uint_as_float(rr[0]) + __uint_as_float(rr[1]); }
    l_reg = l_reg * alpha + ps;
#define PK4(P, BASE, OUT) do { unsigned a0 = cvtpk(P[BASE + 0], P[BASE + 1]), a1 = cvtpk(P[BASE + 2], P[BASE + 3]);   \
    unsigned b0 = cvtpk(P[BASE + 4], P[BASE + 5]), b1 = cvtpk(P[BASE + 6], P[BASE + 7]);                              \
    auto r0 = __builtin_amdgcn_permlane32_swap(a0, b0, false, false); auto r1 = __builtin_amdgcn_permlane32_swap(a1, b1, false, false); \
    v4u w = {r0[0], r1[0], r0[1], r1[1]}; OUT = *reinterpret_cast<bf16x8*>(&w); } while (0)
    PK4(p0, 0, pa0); PK4(p0, 8, pa1); PK4(p1, 0, pa2); PK4(p1, 8, pa3);
#undef PK4
}
__device__ __forceinline__ int v_st(int k, int c) { const int kk = (k & ~0xC) | ((k & 4) << 1) | ((k & 8) >> 1); return ((kk >> 3) * 4 + (c >> 5)) * 512 + ((kk & 7) * 32 + (c & 31)) * 2; }
__device__ __forceinline__ int v_rd_base(int lane) { return ((lane & 3) << 3) | (((lane >> 2) & 3) << 6) | (((lane >> 4) & 1) << 5) | (((lane >> 5) & 1) << 8); }
constexpr int v_rd_off(int d0, int ks, int half) { return d0 * 512 + ks * 4096 + half * 2048; }
template <int OFF> __device__ __forceinline__ s16x4 tr_read(int vb) {
    s16x4 r; asm volatile("ds_read_b64_tr_b16 %0, %1 offset:%2" : "=&v"(r) : "v"(vb), "i"(OFF) : "memory"); return r;
}
template <int D0> __device__ __forceinline__ void pv_one(f32x16& od, int vb, bf16x8 pa0, bf16x8 pa1, bf16x8 pa2, bf16x8 pa3) {
    const s16x4 l0 = tr_read<v_rd_off(D0, 0, 0)>(vb), h0 = tr_read<v_rd_off(D0, 0, 1)>(vb), l1 = tr_read<v_rd_off(D0, 1, 0)>(vb), h1 = tr_read<v_rd_off(D0, 1, 1)>(vb);
    const s16x4 l2 = tr_read<v_rd_off(D0, 2, 0)>(vb), h2 = tr_read<v_rd_off(D0, 2, 1)>(vb), l3 = tr_read<v_rd_off(D0, 3, 0)>(vb), h3 = tr_read<v_rd_off(D0, 3, 1)>(vb);
    asm volatile("s_waitcnt lgkmcnt(0)" ::: "memory"); SBAR();
#define PKV(L, H) (bf16x8){L[0], L[1], L[2], L[3], H[0], H[1], H[2], H[3]}
    od = __builtin_amdgcn_mfma_f32_32x32x16_bf16(pa0, PKV(l0, h0), od, 0, 0, 0);
    od = __builtin_amdgcn_mfma_f32_32x32x16_bf16(pa1, PKV(l1, h1), od, 0, 0, 0);
    od = __builtin_amdgcn_mfma_f32_32x32x16_bf16(pa2, PKV(l2, h2), od, 0, 0, 0);
    od = __builtin_amdgcn_mfma_f32_32x32x16_bf16(pa3, PKV(l3, h3), od, 0, 0, 0);
#undef PKV
}

template <int DQK, bool MASKED>
__device__ __forceinline__ void attn_unit(const bf16* __restrict__ Qb, int ldq,
                                          const bf16* __restrict__ KA, const bf16* __restrict__ VA, const bf16* __restrict__ KRA, int nA,
                                          const bf16* __restrict__ KB, const bf16* __restrict__ VB, const bf16* __restrict__ KRB, int nB,
                                          int ldk, int qpos0, int kposB0, float sink_l2, bf16* __restrict__ Ob, char* lds) {
    constexpr int ND = 8;
    constexpr float C = Cst<DQK>::C;
    const int tid = threadIdx.x, wid = tid >> 6, lane = tid & 63, r32 = lane & 31, hi = lane >> 5;
    char* V_lds = lds + OFF_V; char* K_lds = lds + OFF_K; char* KR_lds = lds + OFF_KR;
    float* wsf = (float*)(lds + OFF_WS) + wid * 64; float* li_l = wsf; float* al_l = wsf + 32;
    float m_reg = -1e30f, l_reg = 0.f; f32x16 o[4] = {}; bf16x8 qr[ND];
    const bf16* Qw = Qb + (size_t)(wid * QBLK + r32) * ldq + hi * 8;
#pragma unroll
    for (int d0 = 0; d0 < ND; ++d0) qr[d0] = *reinterpret_cast<const bf16x8*>(Qw + d0 * 16);
    char* QR_lds = lds + OFF_QR;
    if constexpr (DQK == 192) {
#pragma unroll
        for (int dd = 0; dd < 4; ++dd) { const bf16x8 qv = *reinterpret_cast<const bf16x8*>(Qw + 128 + dd * 16); *(bf16x8*)(QR_lds + wid * 4096 + KRSWZ(r32, dd * 2 + hi)) = qv; }
    }
    const int sr = tid >> 4, sc = (tid & 15) * 8, vst0 = v_st(sr, sc), vst1 = v_st(32 + sr, sc);
    const int krr = tid >> 3, krc = tid & 7;
    const int vb0 = (int)(uintptr_t)(LAS char*)V_lds + v_rd_base(lane);
    const int NT = nA + nB;
    bf16x8 sv0, sv1, sk0, sk1, skr;
    const unsigned go0 = (unsigned)(sr * ldk + sc) * 2u, go1 = (unsigned)((32 + sr) * ldk + sc) * 2u, gor = (unsigned)(krr * 64 + krc * 8) * 2u;
#define SLOAD(t) do { const bool inA_ = (t) < nA; const int tt_ = inA_ ? (t) : (t) - nA; const char* Kt_ = (const char*)((inA_ ? KA : KB) + (size_t)tt_ * 64 * ldk); const char* Vt_ = (const char*)((inA_ ? VA : VB) + (size_t)tt_ * 64 * ldk); \
    sv0 = *reinterpret_cast<const bf16x8*>(Vt_ + go0); sv1 = *reinterpret_cast<const bf16x8*>(Vt_ + go1); \
    sk0 = *reinterpret_cast<const bf16x8*>(Kt_ + go0); sk1 = *reinterpret_cast<const bf16x8*>(Kt_ + go1); \
    if constexpr (DQK == 192) { const char* Rt_ = (const char*)((inA_ ? KRA : KRB) + (size_t)tt_ * 64 * 64); skr = *reinterpret_cast<const bf16x8*>(Rt_ + gor); } } while (0)
#define SWRITE(b) do { *(bf16x8*)(V_lds + (b) * SHM_V + vst0) = sv0; *(bf16x8*)(V_lds + (b) * SHM_V + vst1) = sv1; const int kc_ = sc * 2; \
    *(bf16x8*)(K_lds + (b) * SHM_K + KSWZ(sr, kc_)) = sk0; *(bf16x8*)(K_lds + (b) * SHM_K + KSWZ(32 + sr, kc_)) = sk1; \
    if constexpr (DQK == 192) { *(bf16x8*)(KR_lds + (b) * SHM_KR + KRSWZ(krr, krc)) = skr; } } while (0)
    SLOAD(0); VM_WAIT(); SWRITE(0); __syncthreads();
    for (int t = 0; t < NT; ++t) {
        const int cur = t & 1;
        if (t + 1 < NT) SLOAD(t + 1);
        f32x16 p0 = {}, p1 = {};
        { const char* Ks = K_lds + cur * SHM_K;
#pragma unroll
          for (int dg = 0; dg < 2; ++dg) {
            bf16x8 kf0[4], kf1[4];
#pragma unroll
            for (int dd = 0; dd < 4; ++dd) { const int cb = ((dg * 4 + dd) * 16 + hi * 8) * 2;
              kf0[dd] = *reinterpret_cast<const bf16x8*>(Ks + KSWZ(r32, cb)); kf1[dd] = *reinterpret_cast<const bf16x8*>(Ks + KSWZ(32 + r32, cb)); }
#pragma unroll
            for (int dd = 0; dd < 4; ++dd) {
              p0 = __builtin_amdgcn_mfma_f32_32x32x16_bf16(kf0[dd], qr[dg * 4 + dd], p0, 0, 0, 0);
              p1 = __builtin_amdgcn_mfma_f32_32x32x16_bf16(kf1[dd], qr[dg * 4 + dd], p1, 0, 0, 0); }
            SBAR();
          }
          if constexpr (DQK == 192) { const char* Rs = KR_lds + cur * SHM_KR; const char* Qs = QR_lds + wid * 4096;
            bf16x8 kf0[4], kf1[4], qf[4];
#pragma unroll
            for (int dd = 0; dd < 4; ++dd) { const int ch = dd * 2 + hi;
              kf0[dd] = *reinterpret_cast<const bf16x8*>(Rs + KRSWZ(r32, ch)); kf1[dd] = *reinterpret_cast<const bf16x8*>(Rs + KRSWZ(32 + r32, ch)); qf[dd] = *reinterpret_cast<const bf16x8*>(Qs + KRSWZ(r32, ch)); }
#pragma unroll
            for (int dd = 0; dd < 4; ++dd) {
              p0 = __builtin_amdgcn_mfma_f32_32x32x16_bf16(kf0[dd], qf[dd], p0, 0, 0, 0);
              p1 = __builtin_amdgcn_mfma_f32_32x32x16_bf16(kf1[dd], qf[dd], p1, 0, 0, 0); }
            SBAR();
          }
        }
        if constexpr (MASKED) { if (t >= nA) { const int qp = qpos0 + wid * QBLK + r32, kb = kposB0 + (t - nA) * 64;
#pragma unroll
            for (int r = 0; r < 16; ++r) { const int d = qp - (kb + crow(r, hi)); if (d > 128 || d < -128) p0[r] = -1e30f; const int d2 = d - 32; if (d2 > 128 || d2 < -128) p1[r] = -1e30f; } } }
        float mn, alpha; bf16x8 pa0, pa1, pa2, pa3;
        partialSM<DQK>(p0, p1, m_reg, mn, alpha);
        if (__any(alpha < 1.f)) { if (hi == 0) al_l[r32] = alpha; LDS_WAIT();
#pragma unroll
            for (int r = 0; r < 16; ++r) { const float al = al_l[crow(r, hi)];
#pragma unroll
                for (int d = 0; d < 4; ++d) o[d][r] *= al; } }
        finishSM(p0, p1, alpha, l_reg, pa0, pa1, pa2, pa3); SBAR();
        { const int vb = vb0 + cur * SHM_V;
          pv_one<0>(o[0], vb, pa0, pa1, pa2, pa3); pv_one<1>(o[1], vb, pa0, pa1, pa2, pa3); pv_one<2>(o[2], vb, pa0, pa1, pa2, pa3); pv_one<3>(o[3], vb, pa0, pa1, pa2, pa3); }
        if (t + 1 < NT) { VM_WAIT(); SWRITE(cur ^ 1); }
        __syncthreads();
    }
    l_reg += __builtin_amdgcn_exp2f(sink_l2 - m_reg * C);
    if (hi == 0) li_l[r32] = l_reg; LDS_WAIT();
    int obase = (wid * QBLK + 4 * hi) * 2048 + r32; asm volatile("" : "+v"(obase));
#pragma unroll
    for (int r = 0; r < 16; ++r) { const float rl = __builtin_amdgcn_rcpf(li_l[crow(r, hi)]); const int ro = ((r & 3) + 8 * (r >> 2)) * 2048;
#pragma unroll
        for (int d0 = 0; d0 < 4; ++d0) *(bf16*)((char*)Ob + (unsigned)(obase + ro + d0 * 32) * 2u) = (bf16)f2bf(o[d0][r] * rl); }
    LDS_WAIT();
#undef SLOAD
#undef SWRITE
}
}

__device__ __forceinline__ void attn_win_phase(Frame& F, int j) {
    const bf16* Q = WSP(bf16, WS_WQ); const bf16* K = WSP(bf16, WS_WK); const bf16* V = WSP(bf16, WS_WV); bf16* O = WSP(bf16, WS_AO);
    const bf16* CK = WSP(bf16, WS_CTXK) + (size_t)j * 2 * 512 * 512; const bf16* CV = WSP(bf16, WS_CTXV) + (size_t)j * 2 * 512 * 512;
    for (int un = F.bx; un < 1024; un += F.G) {
        const int h = un & 15, kvh = h >> 2; const float sink = F.in[I_SINK][j * 16 + h] * 1.4426950408889634f;
        if (un < 512) {
            const int qb = un >> 4, bs = qb >> 4, t0 = (qb & 15) * 256, row0 = MP + qb * 256;
            int kt0 = (t0 >> 6) - 2, kt1 = (t0 >> 6) + 5; if (kt0 < 0) kt0 = 0; if (kt1 > 63) kt1 = 63;
            const size_t kb = (size_t)(MP + bs * 4096 + kt0 * 64) * 512 + kvh * 128;
            att::attn_unit<128, true>(Q + (size_t)row0 * 2048 + h * 128, 2048, CK + (size_t)bs * 512 * 512 + kvh * 128, CV + (size_t)bs * 512 * 512 + kvh * 128, nullptr, 8,
                                     K + kb, V + kb, nullptr, kt1 - kt0 + 1, 512, t0, kt0 * 64, sink, O + (size_t)row0 * 2048 + h * 128, (char*)F.ldsg);
        } else {
            const int b = (un - 512) >> 4, row0 = b * 256; const size_t kb = (size_t)row0 * 512 + kvh * 128;
            att::attn_unit<128, false>(Q + (size_t)row0 * 2048 + h * 128, 2048, nullptr, nullptr, nullptr, 0,
                                      K + kb, V + kb, nullptr, 4, 512, 0, 0, sink, O + (size_t)row0 * 2048 + h * 128, (char*)F.ldsg);
        }
    }
}
__device__ __forceinline__ void attn_mla_phase(Frame& F) {
    const bf16* Q = WSP(bf16, WS_MQ); const bf16* KN = WSP(bf16, WS_MKN); const bf16* V = WSP(bf16, WS_MV); const bf16* KR = WSP(bf16, WS_MKR); bf16* O = WSP(bf16, WS_AO);
    for (int un = F.bx; un < 1024; un += F.G) {
        const int h = un & 15;
        if (un < 512) {
            const int qb = un >> 4, bs = qb >> 4, row0 = MP + qb * 256;
            const size_t ra = (size_t)bs * 512, rb = (size_t)1024 + MP + bs * 4096;
            att::attn_unit<192, false>(Q + (size_t)row0 * 3072 + h * 192, 3072, KN + ra * 2048 + h * 128, V + ra * 2048 + h * 128, KR + ra * 64, 8,
                                      KN + rb * 2048 + h * 128, V + rb * 2048 + h * 128, KR + rb * 64, 64, 2048, 0, 0, -1e30f, O + (size_t)row0 * 2048 + h * 128, (char*)F.ldsg);
        } else {
            const int b = (un - 512) >> 4, row0 = b * 256; const size_t rb = (size_t)1024 + row0;
            att::attn_unit<192, false>(Q + (size_t)row0 * 3072 + h * 192, 3072, nullptr, nullptr, nullptr, 0,
                                      KN + rb * 2048 + h * 128, V + rb * 2048 + h * 128, KR + rb * 64, 4, 2048, 0, 0, -1e30f, O + (size_t)row0 * 2048 + h * 128, (char*)F.ldsg);
        }
    }
}

__device__ __forceinline__ void mla_norm_phase(Frame& F) {
    const int gw = F.bx * NWAVES + F.wave, NGW = F.G * NWAVES, lane = F.lane;
    const float* D = WSP(float, WS_MD); bf16* CQ = WSP(bf16, WS_MCQ); bf16* CKV = WSP(bf16, WS_MCKV); bf16* KR = WSP(bf16, WS_MKR);
    const f32x2* tab = WSP(f32x2, WS_TABM);
    const float* qn = F.in[I_MQN]; const float* kvn = F.in[I_MKVN];
    for (int row = gw; row < MTOK; row += NGW) {
        const float* d = D + (size_t)row * 1024;
        {
            const f32x4 v0 = *(const f32x4*)(d + 4 * lane), v1 = *(const f32x4*)(d + 256 + 4 * lane);
            float ss = (v0[0] * v0[0] + v0[1] * v0[1]) + (v0[2] * v0[2] + v0[3] * v0[3]) + (v1[0] * v1[0] + v1[1] * v1[1]) + (v1[2] * v1[2] + v1[3] * v1[3]);
            const float rstd = rsqrtf(wave_sum(ss) * (1.f / 512.f) + EPS);
            const f32x4 y0 = v0 * rstd * *(const f32x4*)(qn + 4 * lane), y1 = v1 * rstd * *(const f32x4*)(qn + 256 + 4 * lane);
            v2u w; w.x = cvtpk(y0[0], y0[1]); w.y = cvtpk(y0[2], y0[3]); *(v2u*)(CQ + (size_t)row * 512 + 4 * lane) = w;
            w.x = cvtpk(y1[0], y1[1]); w.y = cvtpk(y1[2], y1[3]); *(v2u*)(CQ + (size_t)row * 512 + 256 + 4 * lane) = w;
        }
        {
            const f32x4 v0 = *(const f32x4*)(d + 512 + 4 * lane);
            float ss = (v0[0] * v0[0] + v0[1] * v0[1]) + (v0[2] * v0[2] + v0[3] * v0[3]);
            const float rstd = rsqrtf(wave_sum(ss) * (1.f / 256.f) + EPS);
            const f32x4 y0 = v0 * rstd * *(const f32x4*)(kvn + 4 * lane);
            v2u w; w.x = cvtpk(y0[0], y0[1]); w.y = cvtpk(y0[2], y0[3]); *(v2u*)(CKV + (size_t)(1024 + row) * 256 + 4 * lane) = w;
            if (row < MP) *(f32x4*)(F.out + O_CKV + (size_t)row * 256 + 4 * lane) = y0;
        }
        if (lane < 8) {
            const int ug = lane, idx0 = (ug & 3) * 4, d1 = (ug < 4 ? 0 : 32) + idx0;
            f32x4 a = *(const f32x4*)(d + 768 + 8 * ug), b = *(const f32x4*)(d + 768 + 8 * ug + 4);
            if (row < MP) { float* op = F.out + O_KR + (size_t)row * 64 + d1; *(f32x4*)op = a; *(f32x4*)(op + 16) = b; }
            else { const int t = row & 4095, pos = (ug < 4) ? (t >> 6) : (t & 63); const f32x4* tp = (const f32x4*)(tab + pos * 16 + idx0); const f32x4 cs0 = tp[0], cs1 = tp[1];
                const f32x4 co = {cs0[0], cs0[2], cs1[0], cs1[2]}, si = {cs0[1], cs0[3], cs1[1], cs1[3]};
                const f32x4 na = a * co - b * si, nb = b * co + a * si; a = na; b = nb; }
            *(v4u*)(KR + (size_t)(1024 + row) * 64 + 8 * ug) = pack8(a, b);
        }
    }
    const int gt = F.bx * 512 + F.tid, NGT = F.G * 512;
    for (int e = gt; e < 1024 * 256; e += NGT) CKV[e] = (bf16)f2bf(F.in[I_CCKV][e]);
    for (int e = gt; e < 1024 * 64; e += NGT) KR[e] = (bf16)f2bf(F.in[I_CKR][(e & ~63) + perm_mla(e & 63)]);
}

typedef short v4i16_t __attribute__((ext_vector_type(4)));
__device__ __forceinline__ s16x4 vtr(const LAS char* p) { return __builtin_bit_cast(s16x4, __builtin_amdgcn_ds_read_tr16_b64_v4i16((LAS v4i16_t*)p)); }
#define MFMA16(a, b, c) __builtin_amdgcn_mfma_f32_16x16x32_bf16((a), (b), (c), 0, 0, 0)
#define CAT8(L, H) (bf16x8){L[0], L[1], L[2], L[3], H[0], H[1], H[2], H[3]}

__device__ __forceinline__ void gla_prep_phase(Frame& F) {
    constexpr int PQ = 528, OQ = 0, OK_ = 64 * PQ, OKT = 2 * 64 * PQ, OUB = 3 * 64 * PQ, OHT = OUB + 4096, OAT = OHT + 2048;
    LAS char* L = (LAS char*)F.lds; const int tid = F.tid, lane = F.lane, wave = F.wave;
    const bf16* GQ = WSP(bf16, WS_GQ); const bf16* GK = WSP(bf16, WS_GK); const float* GU = WSP(float, WS_GU);
    for (int un = F.bx; un < 2048; un += F.G) {
        const int d = un & 1, ch = un >> 1, c = ch >> 2, h = ch & 3, row0 = c * 64;
        bf16* QT = WSP(bf16, WS_GQT) + (size_t)d * MTOK * 1024; bf16* KD = WSP(bf16, WS_GKD) + (size_t)d * MTOK * 1024;
        bf16* AM = WSP(bf16, WS_GAM) + ((size_t)d * 1024 + ch) * 4096; float* DEC = WSP(float, WS_GDEC) + ((size_t)d * 1024 + ch) * 256;
#pragma unroll
        for (int i = 0; i < 4; ++i) { const int e = tid + 512 * i, row = e >> 5, cc = e & 31; const size_t go = (size_t)(row0 + row) * 1024 + h * 256 + cc * 8;
            *(LAS v4u*)(L + OQ + row * PQ + cc * 16) = *(const v4u*)(GQ + go); *(LAS v4u*)(L + OK_ + row * PQ + cc * 16) = *(const v4u*)(GK + go); }
        if (tid < 256) { const int row = tid >> 2, q4 = tid & 3; *(LAS f32x4*)(L + OUB + (row * 16 + q4 * 4) * 4) = *(const f32x4*)(GU + (size_t)(row0 + row) * 32 + d * 16 + q4 * 4); }
        __syncthreads();
        {
            const int hf = tid >> 8, col = tid & 255;
            float w[16];
#pragma unroll
            for (int r = 0; r < 16; ++r) w[r] = F.in[I_GWA2][((size_t)d * 16 + r) * 1024 + h * 256 + col];
            const float bias = F.in[I_GBA][d * 1024 + h * 256 + col];
            float g[32]; float tot = 0.f;
#pragma unroll
            for (int ii = 0; ii < 32; ++ii) { const int i = hf * 32 + ii; float z = bias;
#pragma unroll
                for (int q4 = 0; q4 < 4; ++q4) { const f32x4 uv = *(const LAS f32x4*)(L + OUB + (i * 16 + q4 * 4) * 4); z += uv[0] * w[4 * q4] + uv[1] * w[4 * q4 + 1] + uv[2] * w[4 * q4 + 2] + uv[3] * w[4 * q4 + 3]; }
                const float ls = fminf(z, 0.f) - __logf(1.f + __expf(-fabsf(z)));
                g[ii] = ls * 0.0625f; tot += g[ii]; }
            ((LAS float*)(L + OHT))[hf * 256 + col] = tot;
            __syncthreads();
            const float other = ((const LAS float*)(L + OHT))[(1 - hf) * 256 + col];
            const float T = tot + other;
            float run = (d == 0) ? (hf == 1 ? other : 0.f) : (hf == 0 ? other : 0.f);
            if (hf == 0) DEC[col] = __expf(T);
#pragma unroll
            for (int s = 0; s < 32; ++s) {
                const int ii = (d == 0) ? s : 31 - s;
                run += (d == 0) ? g[s] : g[31 - s];
                const int i = hf * 32 + ii;
                LAS bf16* qp = (LAS bf16*)(L + OQ + i * PQ) + col; LAS bf16* kp = (LAS bf16*)(L + OK_ + i * PQ) + col; LAS bf16* ktp = (LAS bf16*)(L + OKT + i * PQ) + col;
                const float qv = bf2f(*qp), kv = bf2f(*kp);
                *qp = (bf16)f2bf(qv * __expf(run)); *ktp = (bf16)f2bf(kv * __expf(-run)); *kp = (bf16)f2bf(kv * __expf(T - run));
            }
        }
        __syncthreads();
        {
            const int gq = lane >> 4, cl = lane & 15;
#pragma unroll
            for (int s2 = 0; s2 < 2; ++s2) {
                const int T16 = 2 * wave + s2, ti = T16 >> 2, tj = T16 & 3;
                f32x4 acc = {0.f, 0.f, 0.f, 0.f};
#pragma unroll
                for (int ks = 0; ks < 8; ++ks) {
                    const bf16x8 a = *(const LAS bf16x8*)(L + OQ + (16 * ti + cl) * PQ + (32 * ks + 8 * gq) * 2);
                    const bf16x8 b = *(const LAS bf16x8*)(L + OKT + (16 * tj + cl) * PQ + (32 * ks + 8 * gq) * 2);
                    acc = MFMA16(a, b, acc);
                }
                const int jcol = 16 * tj + cl;
#pragma unroll
                for (int r = 0; r < 4; ++r) { const int i = 16 * ti + 4 * gq + r; const bool keep = (d == 0) ? (jcol <= i) : (jcol >= i);
                    ((LAS bf16*)(L + OAT))[i * 64 + jcol] = (bf16)f2bf(keep ? acc[r] : 0.f); }
            }
        }
        __syncthreads();
#pragma unroll
        for (int i = 0; i < 4; ++i) { const int e = tid + 512 * i, row = e >> 5, cc = e & 31; const size_t go = (size_t)(row0 + row) * 1024 + h * 256 + cc * 8;
            *(v4u*)(QT + go) = *(const LAS v4u*)(L + OQ + row * PQ + cc * 16); *(v4u*)(KD + go) = *(const LAS v4u*)(L + OK_ + row * PQ + cc * 16); }
        *(v4u*)(AM + tid * 8) = *(const LAS v4u*)(L + OAT + tid * 16);
        __syncthreads();
    }
}

__device__ __forceinline__ void gla_scan_item(Frame& F, int seq, int h, int d, int sl) {
    constexpr int PQ = 528, PK = 544, PA = 136, PV = 288;
    constexpr int OQ = 0, OK_ = 64 * PQ, OA = OK_ + 64 * PK, OV = OA + 64 * PA, ODEC = OV + 64 * PV;
    LAS char* L = (LAS char*)F.lds; const int tid = F.tid, lane = F.lane, wave = F.wave, gq = lane >> 4, cl = lane & 15;
    const bool sample = seq >= 32; const int base = sample ? MP + (seq - 32) * 4096 : seq * 256, nch = sample ? 64 : 4;
    const bf16* QT = WSP(bf16, WS_GQT) + (size_t)d * MTOK * 1024; const bf16* KD = WSP(bf16, WS_GKD) + (size_t)d * MTOK * 1024;
    const bf16* AM = WSP(bf16, WS_GAM) + (size_t)d * 1024 * 4096; const float* DEC = WSP(float, WS_GDEC) + (size_t)d * 1024 * 256;
    const bf16* GV = WSP(bf16, WS_GV); float* OD = WSP(float, d == 0 ? WS_GOF : WS_GOB);
    const int dvc = h * 512 + sl * 128;
    f32x4 S[16];
    if (sample) { const float* s0 = F.in[d == 0 ? I_SGF : I_SGB] + ((size_t)((seq - 32) * 4 + h) * 256) * 512 + sl * 128 + 16 * wave + cl;
#pragma unroll
        for (int t = 0; t < 16; ++t)
#pragma unroll
            for (int r = 0; r < 4; ++r) S[t][r] = s0[(size_t)(16 * t + 4 * gq + r) * 512];
    } else {
#pragma unroll
        for (int t = 0; t < 16; ++t) S[t] = (f32x4){0.f, 0.f, 0.f, 0.f};
    }
    v4u rq[4], rk[4], rv[2], ra; float rdec = 0.f;
#define GLOAD(ci) do { const int r0_ = base + 64 * (ci); const int chx_ = (r0_ >> 6) * 4 + h; \
    _Pragma("unroll") for (int i = 0; i < 4; ++i) { const int e = tid + 512 * i, row = e >> 5, cc = e & 31; const size_t go = (size_t)(r0_ + row) * 1024 + h * 256 + cc * 8; rq[i] = *(const v4u*)(QT + go); rk[i] = *(const v4u*)(KD + go); } \
    _Pragma("unroll") for (int i = 0; i < 2; ++i) { const int e = tid + 512 * i, row = e >> 4, cc = e & 15; rv[i] = *(const v4u*)(GV + (size_t)(r0_ + row) * 2048 + dvc + cc * 8); } \
    ra = *(const v4u*)(AM + (size_t)chx_ * 4096 + tid * 8); if (tid < 256) rdec = DEC[(size_t)chx_ * 256 + tid]; } while (0)
#define LWRITE() do { \
    _Pragma("unroll") for (int i = 0; i < 4; ++i) { const int e = tid + 512 * i, row = e >> 5, cc = e & 31; *(LAS v4u*)(L + OQ + row * PQ + cc * 16) = rq[i]; *(LAS v4u*)(L + OK_ + row * PK + cc * 16) = rk[i]; } \
    _Pragma("unroll") for (int i = 0; i < 2; ++i) { const int e = tid + 512 * i, row = e >> 4, cc = e & 15; *(LAS v4u*)(L + OV + row * PV + cc * 16) = rv[i]; } \
    { const int row = tid >> 3, cc = tid & 7; *(LAS v2u*)(L + OA + row * PA + cc * 16) = (v2u){ra.x, ra.y}; *(LAS v2u*)(L + OA + row * PA + cc * 16 + 8) = (v2u){ra.z, ra.w}; } \
    if (tid < 256) ((LAS float*)(L + ODEC))[tid] = rdec; } while (0)
    GLOAD(d == 0 ? 0 : nch - 1);
    LWRITE();
    __syncthreads();
    for (int s = 0; s < nch; ++s) {
        const int ci = d == 0 ? s : nch - 1 - s, row0 = base + 64 * ci;
        if (s + 1 < nch) GLOAD(d == 0 ? s + 1 : nch - 2 - s);
        f32x4 o[4];
#pragma unroll
        for (int ti = 0; ti < 4; ++ti) o[ti] = (f32x4){0.f, 0.f, 0.f, 0.f};
#pragma unroll
        for (int ks = 0; ks < 8; ++ks) {
            v4u bw; bw.x = cvtpk(S[2 * ks][0], S[2 * ks][1]); bw.y = cvtpk(S[2 * ks][2], S[2 * ks][3]); bw.z = cvtpk(S[2 * ks + 1][0], S[2 * ks + 1][1]); bw.w = cvtpk(S[2 * ks + 1][2], S[2 * ks + 1][3]);
            const bf16x8 bfr = __builtin_bit_cast(bf16x8, bw);
#pragma unroll
            for (int ti = 0; ti < 4; ++ti) {
                const LAS char* ap = L + OQ + (16 * ti + cl) * PQ + (32 * ks + 4 * gq) * 2;
                const s16x4 lo = *(const LAS s16x4*)ap, hi = *(const LAS s16x4*)(ap + 32);
                o[ti] = MFMA16(CAT8(lo, hi), bfr, o[ti]);
            }
        }
        bf16x8 vb[2];
#pragma unroll
        for (int ks = 0; ks < 2; ++ks) { const LAS char* vp = L + OV + (32 * ks + 4 * gq + (cl >> 2)) * PV + 32 * wave + 8 * (cl & 3);
            const s16x4 lo = vtr(vp), hi = vtr(vp + 16 * PV); vb[ks] = CAT8(lo, hi); }
#pragma unroll
        for (int ks = 0; ks < 2; ++ks)
#pragma unroll
            for (int ti = 0; ti < 4; ++ti) {
                const LAS char* ap = L + OA + (16 * ti + cl) * PA + (32 * ks + 4 * gq) * 2;
                const s16x4 lo = *(const LAS s16x4*)ap, hi = *(const LAS s16x4*)(ap + 32);
                o[ti] = MFMA16(CAT8(lo, hi), vb[ks], o[ti]);
            }
#pragma unroll
        for (int ti = 0; ti < 4; ++ti)
#pragma unroll
            for (int r = 0; r < 4; ++r) OD[(size_t)(row0 + 16 * ti + 4 * gq + r) * 2048 + dvc + 16 * wave + cl] = o[ti][r];
#pragma unroll
        for (int t = 0; t < 16; ++t) {
            const f32x4 dc = *(const LAS f32x4*)(L + ODEC + (16 * t + 4 * gq) * 4);
            S[t] = S[t] * dc;
#pragma unroll
            for (int ks = 0; ks < 2; ++ks) { const LAS char* kp = L + OK_ + (32 * ks + 4 * gq + (cl >> 2)) * PK + 32 * t + 8 * (cl & 3);
                const s16x4 lo = vtr(kp), hi = vtr(kp + 16 * PK); S[t] = MFMA16(CAT8(lo, hi), vb[ks], S[t]); }
        }
        __syncthreads();
        if (s + 1 < nch) { LWRITE(); }
        __syncthreads();
    }
    if (!sample) { float* so = F.out + (d == 0 ? O_GF : O_GB) + ((size_t)(seq * 4 + h) * 256) * 512 + sl * 128 + 16 * wave + cl;
#pragma unroll
        for (int t = 0; t < 16; ++t)
#pragma unroll
            for (int r = 0; r < 4; ++r) so[(size_t)(16 * t + 4 * gq + r) * 512] = S[t][r];
    }
#undef GLOAD
#undef LWRITE
}
__device__ __forceinline__ void gla_scan_phase(Frame& F) {
    const int NS = 64;
    if (F.G > 2 * NS) {
        if (F.bx < NS) { const int c = F.bx; gla_scan_item(F, 32 + (c >> 5), (c >> 3) & 3, (c >> 2) & 1, c & 3); }
        else for (int it = F.bx - NS; it < 1024; it += F.G - NS) gla_scan_item(F, it >> 5, (it >> 3) & 3, (it >> 2) & 1, it & 3);
    } else {
        for (int it = F.bx; it < 1024 + NS; it += F.G) { if (it < NS) gla_scan_item(F, 32 + (it >> 5), (it >> 3) & 3, (it >> 2) & 1, it & 3); else { const int i2 = it - NS; gla_scan_item(F, i2 >> 5, (i2 >> 3) & 3, (i2 >> 2) & 1, i2 & 3); } }
    }
}
__device__ __forceinline__ void gla_post_phase(Frame& F) {
    const int gw = F.bx * NWAVES + F.wave, NGW = F.G * NWAVES, lane = F.lane;
    const float* OFp = WSP(float, WS_GOF); const float* OBp = WSP(float, WS_GOB); const bf16* GR = WSP(bf16, WS_GR); bf16* AO = WSP(bf16, WS_AO); const float* gn = F.in[I_GNORM];
    for (int row = gw; row < MTOK; row += NGW) {
#pragma unroll
        for (int hh = 0; hh < 4; ++hh) {
            const size_t o0 = (size_t)row * 2048 + hh * 512 + 4 * lane;
            const f32x4 v0 = *(const f32x4*)(OFp + o0) + *(const f32x4*)(OBp + o0), v1 = *(const f32x4*)(OFp + o0 + 256) + *(const f32x4*)(OBp + o0 + 256);
            float ss = (v0[0] * v0[0] + v0[1] * v0[1]) + (v0[2] * v0[2] + v0[3] * v0[3]) + (v1[0] * v1[0] + v1[1] * v1[1]) + (v1[2] * v1[2] + v1[3] * v1[3]);
            const float rstd = rsqrtf(wave_sum(ss) * (1.f / 512.f) + EPS);
            const v2u r0 = *(const v2u*)(GR + o0), r1 = *(const v2u*)(GR + o0 + 256);
            f32x4 ra = {bf2f((unsigned short)(r0.x & 0xffff)), bf2f((unsigned short)(r0.x >> 16)), bf2f((unsigned short)(r0.y & 0xffff)), bf2f((unsigned short)(r0.y >> 16))};
            f32x4 rb = {bf2f((unsigned short)(r1.x & 0xffff)), bf2f((unsigned short)(r1.x >> 16)), bf2f((unsigned short)(r1.y & 0xffff)), bf2f((unsigned short)(r1.y >> 16))};
#pragma unroll
            for (int i = 0; i < 4; ++i) { ra[i] = ra[i] / (1.f + __expf(-ra[i])); rb[i] = rb[i] / (1.f + __expf(-rb[i])); }
            const f32x4 y0 = v0 * rstd * *(const f32x4*)(gn + 4 * lane) * ra, y1 = v1 * rstd * *(const f32x4*)(gn + 256 + 4 * lane) * rb;
            v2u w; w.x = cvtpk(y0[0], y0[1]); w.y = cvtpk(y0[2], y0[3]); *(v2u*)(AO + o0) = w;
            w.x = cvtpk(y1[0], y1[1]); w.y = cvtpk(y1[2], y1[3]); *(v2u*)(AO + o0 + 256) = w;
        }
    }
}

#ifndef MK_N_LAUNCHES
#define MK_N_LAUNCHES 0
#endif
constexpr int N_PHASES = 34;
__global__ void __launch_bounds__(NWAVES * 64, 2) mk_fwd(Args args) {
    extern __shared__ __attribute__((aligned(16))) unsigned char lds[];
    Frame F;
    F.lds = (LAS unsigned char*)lds; F.ldsg = lds;
    F.tid = threadIdx.x; F.lane = F.tid & 63; F.wave = __builtin_amdgcn_readfirstlane(F.tid >> 6);
    F.G = gridDim.x; F.bx = blockIdx.x;
    F.in = args.in; F.out = args.out; F.ws = args.ws;
    volatile LAS unsigned* MISC = (volatile LAS unsigned*)(F.lds + MISC_OFF);
    if (F.tid < 32) MISC[F.tid] = 0u;
    __syncthreads();
    const int lo = args.ph_lo, hi = args.ph_hi;
    const bool use_bar = (hi - lo) > 1;
    XcdBarrier bar; bar.bar = (unsigned*)(F.ws + WS_CTL) + CW_BAR + args.li * XCD_BAR_WORDS; bar.x = 0; bar.st = nullptr;
    if (use_bar) bar = xcd_barrier_post((unsigned*)(F.ws + WS_CTL) + CW_BAR + args.li * XCD_BAR_WORDS, MISC + 8);
#ifdef PH_ONLY
#define IN(k) ((k) == PH_ONLY && lo <= (k) && (k) < hi)
#else
#define IN(k) (lo <= (k) && (k) < hi)
#endif
#define SEAM(k) do { if (IN(k) && IN((k) + 1)) xcd_barrier(bar); } while (0)
    LAS unsigned char* ring = F.lds;

    if (IN(0)) { p0_prologue(F); } SEAM(0);

#define GEMM_PHASE(EpiT, epi, Aptr, Bptr, M_, N_, K_) do { pg8::Gemm g{(const pg8::bf16_t*)(Aptr), (const pg8::bf16_t*)(Bptr), (M_), (N_), (K_)}; pg8::StaticOrder S; S.init((M_), (N_), F.G, F.bx); \
        pg8::gemm_phase<EpiT, pg8::StaticOrder, true, true>(ring, g, S, epi); } while (0)

#define LAYER_TAIL(P, L, WOT) \
    if (IN((P))) { EpiResid E{F.in[I_XP], F.in[I_XS], WSP(float, WS_X), WSP(float, WS_MOD) + (size_t)((L) * 3) * 12288 + 2 * 2048, (L) == 0 ? 1 : 0}; \
        GEMM_PHASE(EpiResid, E, WSP(bf16, WS_AO), (WOT), MTOK, DM, DM); } SEAM((P)); \
    if (IN((P) + 1)) { mod_phase(F, (L), 1, 0); } SEAM((P) + 1); \
    if (IN((P) + 2)) { EpiRelu2 E{WSP(bf16, WS_HID), FFH}; GEMM_PHASE(EpiRelu2, E, WSP(bf16, WS_H), WSP(bf16, WS_W1T) + (size_t)(L) * FFH * DM, MTOK, FFH, DM); } SEAM((P) + 2); \
    if (IN((P) + 3)) { EpiResid E{F.in[I_XP], F.in[I_XS], WSP(float, WS_X), WSP(float, WS_MOD) + (size_t)((L) * 3) * 12288 + 5 * 2048, 0}; \
        GEMM_PHASE(EpiResid, E, WSP(bf16, WS_HID), WSP(bf16, WS_W2T) + (size_t)(L) * DM * FFH, MTOK, DM, FFH); } SEAM((P) + 3);

#define WIN_LAYER(P, L, J) \
    if (IN((P))) { mod_phase(F, (L), 0, (L) == 0 ? 1 : 0); } SEAM((P)); \
    if (IN((P) + 1)) { EpiQkvWin E{WSP(bf16, WS_WQ), WSP(bf16, WS_WK), WSP(bf16, WS_WV), F.out + O_WK, F.out + O_WV, (J), WSP(f32x2, WS_TABW)}; \
        GEMM_PHASE(EpiQkvWin, E, WSP(bf16, WS_H), WSP(bf16, WS_WQKVT) + (size_t)(J) * 3072 * DM, MTOK, 3072, DM); } SEAM((P) + 1); \
    if (IN((P) + 2)) { attn_win_phase(F, (J)); } SEAM((P) + 2); \
    LAYER_TAIL((P) + 3, (L), WSP(bf16, WS_WWOT) + (size_t)(J) * DM * DM)

    WIN_LAYER(1, 0, 0)
    if (IN(8)) { mod_phase(F, 1, 0, 0); } SEAM(8);
    if (IN(9)) { EpiF32 E{WSP(float, WS_MD), 1024}; GEMM_PHASE(EpiF32, E, WSP(bf16, WS_H), WSP(bf16, WS_MWDT), MTOK, 1024, DM); } SEAM(9);
    if (IN(10)) { mla_norm_phase(F); } SEAM(10);
    if (IN(11)) {
        { EpiMlaQ E{WSP(bf16, WS_MQ), WSP(f32x2, WS_TABM)}; GEMM_PHASE(EpiMlaQ, E, WSP(bf16, WS_MCQ), WSP(bf16, WS_MWUQT), MTOK, 3072, 512); }
        { EpiMlaKV E{WSP(bf16, WS_MKN), WSP(bf16, WS_MV)}; GEMM_PHASE(EpiMlaKV, E, WSP(bf16, WS_MCKV), WSP(bf16, WS_MWUKVT), MTOK + 1024, 4096, 256); }
    } SEAM(11);
    if (IN(12)) { attn_mla_phase(F); } SEAM(12);
    LAYER_TAIL(13, 1, WSP(bf16, WS_MWOT))
    if (IN(17)) { mod_phase(F, 2, 0, 0); } SEAM(17);
    if (IN(18)) { EpiGlaIn E{WSP(bf16, WS_GQ), WSP(bf16, WS_GK), WSP(bf16, WS_GV), WSP(bf16, WS_GR), WSP(float, WS_GU)}; GEMM_PHASE(EpiGlaIn, E, WSP(bf16, WS_H), WSP(bf16, WS_GWINT), MTOK, 6400, DM); } SEAM(18);
    if (IN(19)) { gla_prep_phase(F); } SEAM(19);
    if (IN(20)) { gla_scan_phase(F); } SEAM(20);
    if (IN(21)) { gla_post_phase(F); } SEAM(21);
    LAYER_TAIL(22, 2, WSP(bf16, WS_GWOT))
    WIN_LAYER(26, 3, 1)
    if (IN(33)) { final_phase(F); }
#undef IN
#undef SEAM
}

extern "C" void kernel_launch(void* const* d_in, const int* in_sizes, int n_in, void* d_out, int out_size, void* d_ws, size_t ws_size, hipStream_t stream) {
    static int grid = 0;
    if (grid == 0) {
        if (n_in != 31 || (size_t)out_size != O_END || ws_size < WS_END) { fprintf(stderr, "kernel_launch: shape mismatch n_in %d out %d ws %zu (need %zu)\n", n_in, out_size, ws_size, (size_t)WS_END); grid = -1; return; }
        int dev = 0, cus = 0, per_cu = 0;
        if (hipGetDevice(&dev) != hipSuccess || hipDeviceGetAttribute(&cus, hipDeviceAttributeMultiprocessorCount, dev) != hipSuccess) { grid = -1; return; }
        if (hipFuncSetAttribute((const void*)mk_fwd, hipFuncAttributeMaxDynamicSharedMemorySize, LDS_BYTES) != hipSuccess) { fprintf(stderr, "kernel_launch: hipFuncSetAttribute failed\n"); grid = -1; return; }
        if (hipOccupancyMaxActiveBlocksPerMultiprocessor(&per_cu, (const void*)mk_fwd, NWAVES * 64, LDS_BYTES) != hipSuccess || per_cu < 1) fprintf(stderr, "kernel_launch: occupancy query says %d\n", per_cu);
        (void)hipGetLastError();
        grid = cus;
    }
    if (grid < 0) return;
    if (hipMemsetAsync((char*)d_ws + WS_CTL, 0, CTL_ZERO_BYTES, stream) != hipSuccess) return;
    Args a{};
    for (int i = 0; i < 31; ++i) a.in[i] = (const float*)d_in[i];
    a.in[31] = nullptr;
    a.out = (float*)d_out; a.ws = (unsigned char*)d_ws; a.pad = 0;
#if MK_N_LAUNCHES == 1
    a.ph_lo = 0; a.ph_hi = N_PHASES; a.li = 0;
    hipLaunchKernelGGL(mk_fwd, dim3(grid), dim3(NWAVES * 64), LDS_BYTES, stream, a);
#else
    for (int p = 0; p < N_PHASES; ++p) { a.ph_lo = p; a.ph_hi = p + 1; a.li = 0; hipLaunchKernelGGL(mk_fwd, dim3(grid), dim3(NWAVES * 64), LDS_BYTES, stream, a); }
#endif
}
```

```cpp
#include <hip/hip_runtime.h>
#include <cstdio>
#include <cstdint>
namespace pg8 {
#define PG8_LAS __attribute__((address_space(3)))
typedef unsigned short bf16_t;
typedef short bf16x8 __attribute__((ext_vector_type(8)));
typedef float f32x4 __attribute__((ext_vector_type(4)));
typedef unsigned u32x4 __attribute__((ext_vector_type(4)));
constexpr int BM = 256, BK = 64, HALF = 128, HTB = HALF * BK * 2  , STAGE_BYTES = 8 * HTB, NXCD = 8, WGM = 8;

__host__ __device__ __forceinline__ int lds_byte(int r, int c) { const int st = (r >> 4) * 2 + (c >> 5), rr = r & 15, cc = c & 31, ob = rr * 64 + cc * 2; return st * 1024 + (ob ^ (((ob >> 9) & 1) << 5)); }
__host__ __device__ __forceinline__ void stage_rc(int b, int& R, int& C) { const int st = b / 1024, sb = b % 1024, swz = sb ^ (((sb >> 9) & 1) << 5); R = (st >> 1) * 16 + swz / 64; C = (st & 1) * 32 + (swz % 64) / 2; }
__host__ __device__ __forceinline__ int perm32(int rho) { const int n = rho >> 4, i = rho & 15; return 8 * (i >> 2) + 4 * n + (i & 3); }

struct Unit { int pm, pn; };
struct Gemm { const bf16_t* A; const bf16_t* Bt; int M, N, K; };

struct StaticOrder {
    int nM, nN, nwg, G, c;
    __host__ __device__ void init(int M, int N, int G_, int c_) { nM = M / BM; nN = N / BM; nwg = nM * nN; G = G_; c = c_; }
    __host__ __device__ bool next(int i, Unit& u) const {
        const long L = (long)i * G + c; if (L >= nwg) return false;
        int wgid = (int)L; { const int q = nwg / NXCD, r = nwg % NXCD, xcd = wgid % NXCD, off = wgid / NXCD; wgid = (xcd < r ? xcd * (q + 1) : r * (q + 1) + (xcd - r) * q) + off; }
        const int nig = WGM * nN, gid = wgid / nig, fm = gid * WGM, gsz = (nM - fm) < WGM ? (nM - fm) : WGM;
        u.pm = fm + ((wgid % nig) % gsz); u.pn = (wgid % nig) / gsz; return true;
    }
    __device__ __forceinline__ void a_ready(const Unit&) const {}
    __device__ __forceinline__ void done(const Unit&) const {}
};
__device__ __forceinline__ unsigned cvt_pk_bf16(float lo, float hi) { unsigned r; asm volatile("v_cvt_pk_bf16_f32 %0, %1, %2" : "=v"(r) : "v"(lo), "v"(hi)); return r; }
typedef float f32x2 __attribute__((ext_vector_type(2)));
template <class Epi, class Sched, bool ALIGN_EPI = false, bool SP2 = false>
__device__ __forceinline__ void gemm_phase(PG8_LAS unsigned char* lds, const Gemm g, const Sched& S, const Epi& E) {
    const int tid = threadIdx.x, wid = __builtin_amdgcn_readfirstlane(tid >> 6), lane = tid & 63, wr = wid >> 2, wc = wid & 3, fr = lane & 15, fq = lane >> 4;
    const int K = g.K, nt = K / BK;
    unsigned voffA[2], voffB[2];
#pragma unroll
    for (int i = 0; i < 2; ++i) { int R, C; stage_rc(tid * 16 + i * 8192, R, C); const int Rb = Epi::PERM ? ((R & ~31) + perm32(R & 31)) : R;
        voffA[i] = (unsigned)(R * K + C) * 2u; voffB[i] = (unsigned)(Rb * K + C) * 2u; }
    const size_t kstep = (size_t)(BK * 2);
    const size_t hstep = (size_t)HALF * K * 2;
    const size_t tstep = 2 * hstep;
    const unsigned ldsw = (unsigned)wid * 1024u;
    const int aoff = lds_byte(wr * 64 + fr, fq * 8), boff = lds_byte(wc * 32 + fr, fq * 8);
#define PG8_SA(b, h) (((b) * 2 + (h)) * HTB)
#define PG8_SB(b, h) ((4 + (b) * 2 + (h)) * HTB)
#define PG8_STAGE(bufoff, gbase, voff) do { _Pragma("unroll") for (int _i = 0; _i < 2; ++_i) \
        __builtin_amdgcn_global_load_lds((const unsigned*)((const char*)(gbase) + (voff)[_i]), (PG8_LAS unsigned*)(lds + (bufoff) + ldsw + _i * 8192), 16, 0, 0); } while (0)
#define PG8_LDA(dst, b, h) do { _Pragma("unroll") for (int m = 0; m < 4; ++m) _Pragma("unroll") for (int k = 0; k < 2; ++k) dst[m][k] = *(const PG8_LAS bf16x8*)(lds + PG8_SA(b, h) + aoff + m * 2048 + k * 1024); } while (0)
#define PG8_LDB(dst, b, h) do { _Pragma("unroll") for (int n = 0; n < 2; ++n) _Pragma("unroll") for (int k = 0; k < 2; ++k) dst[n][k] = *(const PG8_LAS bf16x8*)(lds + PG8_SB(b, h) + boff + n * 2048 + k * 1024); } while (0)
#define PG8_MMA(ai, bj, At, Bt) do { __builtin_amdgcn_s_setprio(1); _Pragma("unroll") for (int m = 0; m < 4; ++m) _Pragma("unroll") for (int n = 0; n < 2; ++n) _Pragma("unroll") for (int k = 0; k < 2; ++k) \
        acc[ai][bj][m][n] = __builtin_amdgcn_mfma_f32_16x16x32_bf16(Bt[n][k], At[m][k], acc[ai][bj][m][n], 0, 0, 0); __builtin_amdgcn_s_setprio(0); } while (0)
#define PG8_WAIT_V(n) asm volatile("s_waitcnt vmcnt(" #n ")" ::: "memory")
#define PG8_WAIT_L(n) asm volatile("s_waitcnt lgkmcnt(" #n ")" ::: "memory")
#define PG8_BAR __builtin_amdgcn_s_barrier()
#define PG8_SCHED __builtin_amdgcn_sched_barrier(0)
    Unit cur, nxt; int ui = 0;
    if (!S.next(0, cur)) return;
    f32x4 acc[2][2][4][2];
#pragma unroll
    for (int a = 0; a < 2; ++a)
#pragma unroll
        for (int b = 0; b < 2; ++b)
#pragma unroll
            for (int m = 0; m < 4; ++m)
#pragma unroll
                for (int n = 0; n < 2; ++n) acc[a][b][m][n] = (f32x4){0.f, 0.f, 0.f, 0.f};
    bf16x8 At[4][2], B0[2][2], B1[2][2];
    const char* cA = (const char*)g.A + (size_t)cur.pm * tstep; const char* cB = (const char*)g.Bt + (size_t)cur.pn * tstep;
    S.a_ready(cur);
    if constexpr (SP2) {
        PG8_STAGE(PG8_SB(0, 0), cB, voffB); PG8_STAGE(PG8_SB(0, 1), cB + hstep, voffB); PG8_STAGE(PG8_SA(0, 0), cA, voffA); PG8_STAGE(PG8_SA(0, 1), cA + hstep, voffA);
        if (wr == 1) PG8_BAR;
        PG8_WAIT_V(2); PG8_BAR;
        PG8_STAGE(PG8_SB(1, 0), cB + kstep, voffB); PG8_STAGE(PG8_SA(1, 0), cA + kstep, voffA); PG8_STAGE(PG8_SB(1, 1), cB + hstep + kstep, voffB);
        PG8_WAIT_V(6); PG8_BAR;
    } else {
        PG8_STAGE(PG8_SB(0, 0), cB, voffB); PG8_STAGE(PG8_SA(0, 0), cA, voffA); PG8_STAGE(PG8_SB(0, 1), cB + hstep, voffB); PG8_STAGE(PG8_SA(0, 1), cA + hstep, voffA);
        if (wr == 1) PG8_BAR;
        PG8_WAIT_V(4); PG8_BAR;
        PG8_STAGE(PG8_SB(1, 0), cB + kstep, voffB); PG8_STAGE(PG8_SA(1, 0), cA + kstep, voffA); PG8_STAGE(PG8_SB(1, 1), cB + hstep + kstep, voffB);
        PG8_WAIT_V(6); PG8_BAR;
    }
    for (;;) {
        const bool has_next = S.next(ui + 1, nxt);
        const char* nA = has_next ? (const char*)g.A + (size_t)nxt.pm * tstep : cA; const char* nB = has_next ? (const char*)g.Bt + (size_t)nxt.pn * tstep : cB;
        for (int t = 0; t < nt; t += 2) {
            const bool last = (t == nt - 2);
            const char* a1 = cA + (size_t)(t + 1) * kstep;
            const char* a2 = last ? nA : cA + (size_t)(t + 2) * kstep; const char* b2 = last ? nB : cB + (size_t)(t + 2) * kstep;
            const char* a3 = a2 + kstep; const char* b3 = b2 + kstep;
            if (last && has_next) S.a_ready(nxt);
            if constexpr (SP2) {
            PG8_LDB(B0, 0, 0); PG8_LDB(B1, 0, 1); PG8_SCHED; PG8_LDA(At, 0, 0); PG8_STAGE(PG8_SA(1, 1), a1 + hstep, voffA);
            PG8_WAIT_V(8); PG8_WAIT_L(0); PG8_BAR; PG8_MMA(0, 0, At, B0); PG8_MMA(0, 1, At, B1); PG8_BAR; PG8_SCHED;
            PG8_LDA(At, 0, 1); PG8_STAGE(PG8_SB(0, 0), b2, voffB); PG8_STAGE(PG8_SB(0, 1), b2 + hstep, voffB); PG8_STAGE(PG8_SA(0, 0), a2, voffA);
            PG8_WAIT_V(8); PG8_WAIT_L(0); PG8_BAR; PG8_MMA(1, 0, At, B0); PG8_MMA(1, 1, At, B1); PG8_BAR; PG8_SCHED;
            PG8_LDB(B0, 1, 0); PG8_LDB(B1, 1, 1); PG8_SCHED; PG8_LDA(At, 1, 0); PG8_STAGE(PG8_SA(0, 1), a2 + hstep, voffA);
            PG8_WAIT_V(8); PG8_WAIT_L(0); PG8_BAR; PG8_MMA(0, 0, At, B0); PG8_MMA(0, 1, At, B1); PG8_BAR; PG8_SCHED;
            PG8_LDA(At, 1, 1); PG8_STAGE(PG8_SB(1, 0), b3, voffB); PG8_STAGE(PG8_SB(1, 1), b3 + hstep, voffB); PG8_STAGE(PG8_SA(1, 0), a3, voffA);
            PG8_WAIT_V(8); PG8_WAIT_L(0); PG8_BAR; PG8_MMA(1, 0, At, B0); PG8_MMA(1, 1, At, B1); PG8_BAR; PG8_SCHED;
            } else {
            PG8_LDB(B0, 0, 0); PG8_SCHED; PG8_LDA(At, 0, 0); PG8_STAGE(PG8_SA(1, 1), a1 + hstep, voffA);
            PG8_WAIT_L(8); PG8_BAR; PG8_WAIT_L(0); PG8_MMA(0, 0, At, B0); PG8_BAR; PG8_SCHED;
            PG8_LDB(B1, 0, 1); PG8_STAGE(PG8_SB(0, 0), b2, voffB);
            PG8_BAR; PG8_WAIT_L(0); PG8_MMA(0, 1, At, B1); PG8_BAR;
            PG8_LDA(At, 0, 1); PG8_STAGE(PG8_SA(0, 0), a2, voffA);
            PG8_BAR; PG8_WAIT_L(0); PG8_MMA(1, 0, At, B0); PG8_BAR; PG8_SCHED;
            PG8_STAGE(PG8_SB(0, 1), b2 + hstep, voffB);
            PG8_WAIT_V(6); PG8_BAR; PG8_MMA(1, 1, At, B1); PG8_BAR;
            PG8_LDB(B0, 1, 0); PG8_SCHED; PG8_LDA(At, 1, 0); PG8_STAGE(PG8_SA(0, 1), a2 + hstep, voffA);
            PG8_WAIT_L(8); PG8_BAR; PG8_WAIT_L(0); PG8_MMA(0, 0, At, B0); PG8_BAR; PG8_SCHED;
            PG8_LDB(B1, 1, 1); PG8_STAGE(PG8_SB(1, 0), b3, voffB);
            PG8_BAR; PG8_WAIT_L(0); PG8_MMA(0, 1, At, B1); PG8_BAR;
            PG8_LDA(At, 1, 1); PG8_STAGE(PG8_SA(1, 0), a3, voffA);
            PG8_BAR; PG8_WAIT_L(0); PG8_MMA(1, 0, At, B0); PG8_BAR; PG8_SCHED;
            PG8_STAGE(PG8_SB(1, 1), b3 + hstep, voffB);
            PG8_WAIT_V(6); PG8_BAR; PG8_MMA(1, 1, At, B1); PG8_BAR;
            }
        }
        if constexpr (ALIGN_EPI) { if (wr == 0) PG8_BAR; }
        if constexpr (!Epi::AFTER_DRAIN) { E(acc, cur, wr, wc, fr, fq); S.done(cur); }
        if (!has_next) break;
#pragma unroll
        for (int a = 0; a < 2; ++a)
#pragma unroll
            for (int b = 0; b < 2; ++b)
#pragma unroll
                for (int m = 0; m < 4; ++m)
#pragma unroll
                    for (int n = 0; n < 2; ++n) acc[a][b][m][n] = (f32x4){0.f, 0.f, 0.f, 0.f};
        cur = nxt; cA = nA; cB = nB; ++ui;
        if constexpr (ALIGN_EPI) { if (wr == 1) PG8_BAR; }
    }
    PG8_WAIT_V(0);
    if constexpr (!ALIGN_EPI) { if (wr == 0) PG8_BAR; }
    PG8_BAR;
    if constexpr (Epi::AFTER_DRAIN) { E.fused(acc, cur, wr, wc, fr, fq, lds, wid, lane); S.done(cur); }
#undef PG8_SA
#undef PG8_SB
#undef PG8_STAGE
#undef PG8_LDA
#undef PG8_LDB
#undef PG8_MMA
#undef PG8_WAIT_V
#undef PG8_WAIT_L
#undef PG8_BAR
#undef PG8_SCHED
}
}

#define GAS __attribute__((address_space(1)))
#define LAS __attribute__((address_space(3)))
typedef unsigned short bf16;
typedef unsigned v4u __attribute__((ext_vector_type(4)));
typedef unsigned v2u __attribute__((ext_vector_type(2)));
typedef float f32x4 __attribute__((ext_vector_type(4)));
typedef float f32x2 __attribute__((ext_vector_type(2)));
typedef float f32x16 __attribute__((ext_vector_type(16)));
typedef short bf16x8 __attribute__((ext_vector_type(8)));
typedef short s16x4 __attribute__((ext_vector_type(4)));
typedef GAS unsigned gu32;
#define RLX_AGENT __ATOMIC_RELAXED, __HIP_MEMORY_SCOPE_AGENT
#define LDS_WAIT() asm volatile("s_waitcnt lgkmcnt(0)" ::: "memory")
#define VM_WAIT() asm volatile("s_waitcnt vmcnt(0)" ::: "memory")
#define SBAR() __builtin_amdgcn_sched_barrier(0)
__device__ __forceinline__ unsigned f2bf(float f) { unsigned u = __builtin_bit_cast(unsigned, f); return (u + 0x7fffu + ((u >> 16) & 1u)) >> 16; }
__device__ __forceinline__ unsigned pk2(float lo, float hi) { return f2bf(lo) | (f2bf(hi) << 16); }
__device__ __forceinline__ float bf2f(unsigned short b) { return __builtin_bit_cast(float, (unsigned)b << 16); }
__device__ __forceinline__ unsigned cvtpk(float lo, float hi) { unsigned r; asm volatile("v_cvt_pk_bf16_f32 %0, %1, %2" : "=v"(r) : "v"(lo), "v"(hi)); return r; }
__device__ __forceinline__ float wave_sum(float v) {
#pragma unroll
    for (int o = 1; o < 64; o <<= 1) v += __shfl_xor(v, o);
    return v;
}
#define XB_TMO      128
#define XB_XCNT(j)  (256  + 64 * (j))
#define XB_XSUB(j)  (1280 + 64 * (j))
#define XB_XGEN(j)  (2304 + 64 * (j))
#define XB_TOP      3328
#define XB_TOPGEN   3392
#define XCD_BAR_WORDS 3456
#define XB_SPIN_CAP (1u << 18)

__device__ __forceinline__ unsigned xb_ld(unsigned* p)              { return __hip_atomic_load(p, __ATOMIC_RELAXED, __HIP_MEMORY_SCOPE_AGENT); }
__device__ __forceinline__ unsigned xb_add(unsigned* p, unsigned v) { return __hip_atomic_fetch_add(p, v, __ATOMIC_RELAXED, __HIP_MEMORY_SCOPE_AGENT); }
__device__ __forceinline__ unsigned xb_xcc_id() { return (unsigned)__builtin_amdgcn_s_getreg((3 << 11) | 20) & 0xFu; }
#define XB_SPIN(cond, bar) do { unsigned _sp = 0; while (cond) { __builtin_amdgcn_s_sleep(1); \
    if ((++_sp & 255u) == 0u) { if (xb_ld(&(bar)[XB_TMO])) break; if (_sp > XB_SPIN_CAP) { atomicAdd(&(bar)[XB_TMO], 1u); break; } } } } while (0)

struct XcdBarrier {
    unsigned* bar; unsigned x;
    volatile LAS unsigned* st;
};

__device__ __forceinline__ XcdBarrier xcd_barrier_post(unsigned* bar, volatile LAS unsigned* st) {
    XcdBarrier b; b.bar = bar; b.x = xb_xcc_id(); b.st = st;
    if (threadIdx.x == 0) (void)xb_add(&bar[XB_XCNT(b.x)], 1u);
    return b;
}
__device__ __forceinline__ void xcd_barrier_complete(unsigned* bar, unsigned x, unsigned& nloc, unsigned& nx) {
    const unsigned G = gridDim.x * gridDim.y * gridDim.z;
    unsigned sum, cnt, mine, sp = 0u;
    for (;;) {
        sum = 0u; cnt = 0u; mine = 0u;
#pragma unroll
        for (unsigned j = 0; j < 16; ++j) { const unsigned c = xb_ld(&bar[XB_XCNT(j)]); sum += c; cnt += (c > 0u) ? 1u : 0u; mine = (j == x) ? c : mine; }
        if (sum == G) break;
        __builtin_amdgcn_s_sleep(1);
        if ((++sp & 255u) == 0u) { if (xb_ld(&bar[XB_TMO])) break; if (sp > XB_SPIN_CAP) { atomicAdd(&bar[XB_TMO], 1u); break; } }
    }
    nloc = mine > 0u ? mine : 1u; nx = cnt > 0u ? cnt : 1u;
}

__device__ __forceinline__ void xcd_barrier(const XcdBarrier& b) {
    asm volatile("s_waitcnt vmcnt(0)" ::: "memory");
    __syncthreads();
    if (threadIdx.x == 0) {
        unsigned* bar = b.bar;
        __builtin_amdgcn_s_waitcnt(0);
        unsigned nloc = b.st[0], nx = b.st[1];
        if (nloc == 0u) { xcd_barrier_complete(bar, b.x, nloc, nx); b.st[0] = nloc; b.st[1] = nx; }
        const unsigned old = xb_add(&bar[XB_XSUB(b.x)], 1u);
        const unsigned gen = old / nloc;
        if (old + 1u == (gen + 1u) * nloc) {
            __builtin_amdgcn_fence(__ATOMIC_RELEASE, "agent");
            asm volatile("s_waitcnt vmcnt(0)" ::: "memory");
            const unsigned og = xb_add(&bar[XB_TOP], 1u);
            const unsigned tg = og / nx;
            if (og + 1u == (tg + 1u) * nx) xb_add(&bar[XB_TOPGEN], 1u);
            else XB_SPIN(xb_ld(&bar[XB_TOPGEN]) == tg, bar);
            __builtin_amdgcn_fence(__ATOMIC_ACQUIRE, "agent");
            xb_add(&bar[XB_XGEN(b.x)], 1u);
            asm volatile("s_waitcnt vmcnt(0)" ::: "memory");
        } else {
            XB_SPIN(xb_ld(&bar[XB_XGEN(b.x)]) == gen, bar);
            __builtin_amdgcn_fence(__ATOMIC_ACQUIRE, "agent");
            asm volatile("s_waitcnt vmcnt(0)" ::: "memory");
        }
    }
    __syncthreads();
}

constexpr int NWAVES = 8;
constexpr int DM = 2048, MTOK = 16384, MP = 8192, FFH = 8192;
constexpr float EPS = 1e-6f;
constexpr size_t MiB = 1u << 20;
constexpr size_t WS_CTL = 0, CTL_ZERO_BYTES = 1 * MiB;
constexpr size_t WS_MOD = 1 * MiB;
constexpr size_t WS_TABW = 2 * MiB;
constexpr size_t WS_TABM = 2 * MiB + 65536;
constexpr size_t WS_W1T = 4 * MiB;
constexpr size_t WS_W2T = 132 * MiB;
constexpr size_t WS_WQKVT = 260 * MiB;
constexpr size_t WS_WWOT = 284 * MiB;
constexpr size_t WS_MWDT = 300 * MiB;
constexpr size_t WS_MWUQT = 304 * MiB;
constexpr size_t WS_MWUKVT = 307 * MiB;
constexpr size_t WS_MWOT = 309 * MiB;
constexpr size_t WS_GWINT = 317 * MiB;
constexpr size_t WS_GWOT = 342 * MiB;
constexpr size_t WS_CTXK = 350 * MiB;
constexpr size_t WS_CTXV = 352 * MiB;
constexpr size_t WS_X = 354 * MiB;
constexpr size_t WS_H = 482 * MiB;
constexpr size_t WS_AO = 546 * MiB;
constexpr size_t WS_SCR = 610 * MiB;
constexpr size_t WS_HID = WS_SCR;
constexpr size_t WS_WQ = WS_SCR, WS_WK = WS_SCR + 64 * MiB, WS_WV = WS_SCR + 80 * MiB;
constexpr size_t WS_MD = WS_SCR, WS_MCQ = WS_SCR + 64 * MiB, WS_MCKV = WS_SCR + 80 * MiB, WS_MKR = WS_SCR + 89 * MiB, WS_MQ = WS_SCR + 92 * MiB, WS_MKN = WS_SCR + 188 * MiB, WS_MV = WS_SCR + 256 * MiB;
constexpr size_t WS_GQ = WS_SCR, WS_GK = WS_SCR + 32 * MiB, WS_GV = WS_SCR + 64 * MiB, WS_GR = WS_SCR + 128 * MiB, WS_GU = WS_SCR + 192 * MiB,
                 WS_GQT = WS_SCR + 194 * MiB, WS_GKD = WS_SCR + 258 * MiB, WS_GAM = WS_SCR + 322 * MiB, WS_GDEC = WS_SCR + 338 * MiB, WS_GOF = WS_SCR + 340 * MiB, WS_GOB = WS_SCR + 468 * MiB;
constexpr size_t WS_END = WS_SCR + 596 * MiB;
constexpr size_t O_YP = 0, O_YS = 16777216, O_WK = 33554432, O_WV = 41943040, O_CKV = 50331648, O_KR = 52428800, O_GF = 52953088, O_GB = 69730304, O_END = 86507520;
constexpr int CW_BAR = 4096;
constexpr int RING_BYTES = 131072, MISC_OFF = RING_BYTES + 320, LDS_BYTES = 147456;

struct Args {
    const float* in[32]; float* out; unsigned char* ws; int ph_lo, ph_hi, li, pad;
};
enum { I_XP = 0, I_XS, I_C, I_CWK, I_CWV, I_CCKV, I_CKR, I_SGF, I_SGB, I_CCTX, I_ADAW, I_ADAB, I_NORMG, I_WQKV, I_SINK, I_WWO, I_MWD, I_MQN, I_MWUQ, I_MKVN, I_MWUKV, I_MWO,
       I_GWIN, I_GWA1, I_GWA2, I_GBA, I_GNORM, I_GWO, I_W1, I_W2, I_FNORM };

__device__ __forceinline__ int cond_of_pm(int pm) { return pm < 32 ? 0 : (pm >> 4) - 1; }

struct EpiResid {
    static constexpr bool PERM = true, AFTER_DRAIN = false;
    const float* xp; const float* xs; float* X; const float* gate; int first;
    __device__ __forceinline__ void operator()(const pg8::f32x4 (&acc)[2][2][4][2], const pg8::Unit& u, int wr, int wc, int fr, int fq) const {
        const int row0 = u.pm * 256 + wr * 64 + fr, col0 = u.pn * 256 + wc * 32 + 8 * fq;
        const float* gp = gate + (size_t)cond_of_pm(u.pm) * 12288 + col0;
        f32x4 gv[2][2];
#pragma unroll
        for (int bj = 0; bj < 2; ++bj)
#pragma unroll
            for (int n = 0; n < 2; ++n) gv[bj][n] = *(const f32x4*)(gp + bj * 128 + 4 * n);
#pragma unroll
        for (int ai = 0; ai < 2; ++ai)
#pragma unroll
            for (int m = 0; m < 4; ++m) {
                const int row = row0 + ai * 128 + m * 16;
                const float* sp = first ? (row < MP ? xp + (size_t)row * DM : xs + (size_t)(row - MP) * DM) : X + (size_t)row * DM;
                float* dp = X + (size_t)row * DM;
#pragma unroll
                for (int bj = 0; bj < 2; ++bj)
#pragma unroll
                    for (int n = 0; n < 2; ++n) {
                        const int c = col0 + bj * 128 + 4 * n;
                        const f32x4 xv = *(const f32x4*)(sp + c);
                        *(f32x4*)(dp + c) = xv + gv[bj][n] * acc[ai][bj][m][n];
                    }
            }
    }
};

struct EpiRelu2 {
    static constexpr bool PERM = true, AFTER_DRAIN = false;
    bf16* O; int ldc;
    __device__ __forceinline__ void operator()(const pg8::f32x4 (&acc)[2][2][4][2], const pg8::Unit& u, int wr, int wc, int fr, int fq) const {
        const int row0 = u.pm * 256 + wr * 64 + fr, col0 = u.pn * 256 + wc * 32 + 8 * fq;
#pragma unroll
        for (int ai = 0; ai < 2; ++ai)
#pragma unroll
            for (int m = 0; m < 4; ++m) {
                bf16* rp = O + (size_t)(row0 + ai * 128 + m * 16) * ldc + col0;
#pragma unroll
                for (int bj = 0; bj < 2; ++bj) {
                    f32x4 a = acc[ai][bj][m][0], b = acc[ai][bj][m][1];
                    a = __builtin_elementwise_max(a, (f32x4){0.f, 0.f, 0.f, 0.f}); b = __builtin_elementwise_max(b, (f32x4){0.f, 0.f, 0.f, 0.f});
                    a = a * a; b = b * b;
                    v4u w; w.x = cvtpk(a[0], a[1]); w.y = cvtpk(a[2], a[3]); w.z = cvtpk(b[0], b[1]); w.w = cvtpk(b[2], b[3]);
                    *(v4u*)(rp + bj * 128) = w;
                }
            }
    }
};

struct EpiF32 {
    static constexpr bool PERM = true, AFTER_DRAIN = false;
    float* O; int ldc;
    __device__ __forceinline__ void operator()(const pg8::f32x4 (&acc)[2][2][4][2], const pg8::Unit& u, int wr, int wc, int fr, int fq) const {
        const int row0 = u.pm * 256 + wr * 64 + fr, col0 = u.pn * 256 + wc * 32 + 8 * fq;
#pragma unroll
        for (int ai = 0; ai < 2; ++ai)
#pragma unroll
            for (int m = 0; m < 4; ++m) {
                float* rp = O + (size_t)(row0 + ai * 128 + m * 16) * ldc + col0;
#pragma unroll
                for (int bj = 0; bj < 2; ++bj) { *(f32x4*)(rp + bj * 128) = acc[ai][bj][m][0]; *(f32x4*)(rp + bj * 128 + 4) = acc[ai][bj][m][1]; }
            }
    }
};

__device__ __forceinline__ v4u pack8(const f32x4& a, const f32x4& b) { v4u w; w.x = cvtpk(a[0], a[1]); w.y = cvtpk(a[2], a[3]); w.z = cvtpk(b[0], b[1]); w.w = cvtpk(b[2], b[3]); return w; }

struct EpiQkvWin {
    static constexpr bool PERM = true, AFTER_DRAIN = false;
    bf16 *Q, *K, *V; float* outk; float* outv; int j; const f32x2* tab;
    __device__ __forceinline__ void operator()(const pg8::f32x4 (&acc)[2][2][4][2], const pg8::Unit& u, int wr, int wc, int fr, int fq) const {
        const int row0 = u.pm * 256 + wr * 64 + fr, cl = wc * 32 + 8 * fq;
        const int pn = u.pn; const bool sample = u.pm >= 32;
        const int ug = 4 * wc + fq, idx0 = (ug & 7) * 4, d1 = (ug < 8 ? 0 : 64) + idx0;
#pragma unroll
        for (int ai = 0; ai < 2; ++ai)
#pragma unroll
            for (int m = 0; m < 4; ++m) {
                const int row = row0 + ai * 128 + m * 16;
                f32x4 cs0 = {1.f, 0.f, 1.f, 0.f}, cs1 = {1.f, 0.f, 1.f, 0.f};
                if (sample && pn < 10) { const int t = row & 4095, pos = (ug < 8) ? (t >> 6) : (t & 63); const f32x4* tp = (const f32x4*)(tab + pos * 32 + idx0); cs0 = tp[0]; cs1 = tp[1]; }
#pragma unroll
                for (int bj = 0; bj < 2; ++bj) {
                    f32x4 a = acc[ai][bj][m][0], b = acc[ai][bj][m][1];
                    if (pn < 10) {
                        if (sample) {
                            const f32x4 co = {cs0[0], cs0[2], cs1[0], cs1[2]}, si = {cs0[1], cs0[3], cs1[1], cs1[3]};
                            const f32x4 na = a * co - b * si, nb = b * co + a * si; a = na; b = nb;
                        }
                        if (pn < 8) { *(v4u*)(Q + (size_t)row * 2048 + pn * 256 + bj * 128 + cl) = pack8(a, b); }
                        else {
                            const int kvh = (pn - 8) * 2 + bj;
                            *(v4u*)(K + (size_t)row * 512 + kvh * 128 + cl) = pack8(a, b);
                            if (!sample) { float* op = outk + ((size_t)(u.pm * 2 + j) * 256 + (row & 255)) * 512 + kvh * 128 + d1; *(f32x4*)op = a; *(f32x4*)(op + 32) = b; }
                        }
                    } else {
                        const int kvh = (pn - 10) * 2 + bj;
                        *(v4u*)(V + (size_t)row * 512 + kvh * 128 + cl) = pack8(a, b);
                        if (!sample) { float* op = outv + ((size_t)(u.pm * 2 + j) * 256 + (row & 255)) * 512 + kvh * 128 + cl; *(f32x4*)op = a; *(f32x4*)(op + 4) = b; }
                    }
                }
            }
    }
};

struct EpiMlaQ {
    static constexpr bool PERM = true, AFTER_DRAIN = false;
    bf16* Q; const f32x2* tab;
    __device__ __forceinline__ void operator()(const pg8::f32x4 (&acc)[2][2][4][2], const pg8::Unit& u, int wr, int wc, int fr, int fq) const {
        const int row0 = u.pm * 256 + wr * 64 + fr, col0 = u.pn * 256 + wc * 32 + 8 * fq;
        const bool sample = u.pm >= 32;
#pragma unroll
        for (int bj = 0; bj < 2; ++bj) {
            const int c0 = col0 + bj * 128, p0 = c0 % 192; const bool isr = p0 >= 128; const int ug = isr ? ((p0 - 128) >> 3) : 0, idx0 = (ug & 3) * 4;
#pragma unroll
            for (int ai = 0; ai < 2; ++ai)
#pragma unroll
                for (int m = 0; m < 4; ++m) {
                    const int row = row0 + ai * 128 + m * 16;
                    f32x4 a = acc[ai][bj][m][0], b = acc[ai][bj][m][1];
                    if (sample) {
                        const int t = row & 4095, pos = (ug < 4) ? (t >> 6) : (t & 63); const f32x4* tp = (const f32x4*)(tab + pos * 16 + idx0); const f32x4 cs0 = tp[0], cs1 = tp[1];
                        const f32x4 co = {cs0[0], cs0[2], cs1[0], cs1[2]}, si = {cs0[1], cs0[3], cs1[1], cs1[3]};
                        const f32x4 na = a * co - b * si, nb = b * co + a * si;
                        if (isr) { a = na; b = nb; }
                    }
                    *(v4u*)(Q + (size_t)row * 3072 + c0) = pack8(a, b);
                }
        }
    }
};

struct EpiMlaKV {
    static constexpr bool PERM = true, AFTER_DRAIN = false;
    bf16 *KN, *V;
    __device__ __forceinline__ void operator()(const pg8::f32x4 (&acc)[2][2][4][2], const pg8::Unit& u, int wr, int wc, int fr, int fq) const {
        const int row0 = u.pm * 256 + wr * 64 + fr, cl = u.pn * 128 + wc * 32 + 8 * fq;
#pragma unroll
        for (int ai = 0; ai < 2; ++ai)
#pragma unroll
            for (int m = 0; m < 4; ++m) {
                const size_t ro = (size_t)(row0 + ai * 128 + m * 16) * 2048 + cl;
                *(v4u*)(KN + ro) = pack8(acc[ai][0][m][0], acc[ai][0][m][1]);
                *(v4u*)(V + ro) = pack8(acc[ai][1][m][0], acc[ai][1][m][1]);
            }
    }
};

struct EpiGlaIn {
    static constexpr bool PERM = true, AFTER_DRAIN = false;
    bf16 *q, *k, *v, *r; float* uo;
    __device__ __forceinline__ void operator()(const pg8::f32x4 (&acc)[2][2][4][2], const pg8::Unit& u, int wr, int wc, int fr, int fq) const {
        const int row0 = u.pm * 256 + wr * 64 + fr, cl = wc * 32 + 8 * fq; const int pn = u.pn;
#pragma unroll
        for (int ai = 0; ai < 2; ++ai)
#pragma unroll
            for (int m = 0; m < 4; ++m) {
                const int row = row0 + ai * 128 + m * 16;
#pragma unroll
                for (int bj = 0; bj < 2; ++bj) {
                    f32x4 a = acc[ai][bj][m][0], b = acc[ai][bj][m][1];
                    const int c = pn * 256 + bj * 128 + cl;
                    if (pn < 4) { a = a * 0.0625f; b = b * 0.0625f; *(v4u*)(q + (size_t)row * 1024 + c) = pack8(a, b); }
                    else if (pn < 8) { *(v4u*)(k + (size_t)row * 1024 + (c - 1024)) = pack8(a, b); }
                    else if (pn < 16) { *(v4u*)(v + (size_t)row * 2048 + (c - 2048)) = pack8(a, b); }
                    else if (pn < 24) { *(v4u*)(r + (size_t)row * 2048 + (c - 4096)) = pack8(a, b); }
                    else if (bj == 0 && wc == 0) { float* op = uo + (size_t)row * 32 + 8 * fq; *(f32x4*)op = a; *(f32x4*)(op + 4) = b; }
                }
            }
    }
};

struct Frame {
    LAS unsigned char* lds; unsigned char* ldsg;
    int tid, lane, wave, G, bx;
    const float* const* in; float* out; unsigned char* ws;
};
#define WSP(T, off) ((T*)(F.ws + (off)))

__device__ __forceinline__ int perm_win(int p) { const int u = p >> 3, v = p & 7; return (u < 8 ? 0 : 64) + (u & 7) * 4 + (v & 3) + ((v & 4) ? 32 : 0); }
__device__ __forceinline__ int perm_mla(int p) { const int u = p >> 3, v = p & 7; return (u < 4 ? 0 : 32) + (u & 3) * 4 + (v & 3) + ((v & 4) ? 16 : 0); }
__device__ __forceinline__ int srcmap(int mode, int n) {
    if (mode == 1) { if (n >= 2560) return n; return (n & ~127) + perm_win(n & 127); }
    if (mode == 2) { if (n < 768) return n; if (n >= 832) return -1; return 768 + perm_mla(n - 768); }
    if (mode == 3) { const int hh = n / 192, p = n - hh * 192; if (p < 128) return n; return hh * 192 + 128 + perm_mla(p - 128); }
    return n;
}
__device__ __forceinline__ void tr_item(const float* W, int K, int Nsrc, int nblk, bf16* WT, int mode, LAS float* scr, int item, int lane) {
    const int kb = item / nblk, nb = item - kb * nblk, k0 = 64 * kb, n0 = 32 * nb;
    const int sc = srcmap(mode, n0 + (lane & 31));
#pragma unroll 8
    for (int i = 0; i < 32; ++i) { const int kk = 2 * i + (lane >> 5); scr[kk * 33 + (lane & 31)] = sc >= 0 ? W[(size_t)(k0 + kk) * Nsrc + sc] : 0.f; }
    LDS_WAIT(); asm volatile("" ::: "memory");
    const int c = lane & 7;
#pragma unroll
    for (int jj = 0; jj < 4; ++jj) { const int n = (lane >> 3) + 8 * jj; const LAS float* s = scr + (8 * c) * 33 + n;
        v4u o; o.x = pk2(s[0 * 33], s[1 * 33]); o.y = pk2(s[2 * 33], s[3 * 33]); o.z = pk2(s[4 * 33], s[5 * 33]); o.w = pk2(s[6 * 33], s[7 * 33]);
        *(GAS v4u*)(WT + (size_t)(n0 + n) * K + k0 + 8 * c) = o; }
    LDS_WAIT(); asm volatile("" ::: "memory");
}

__device__ __forceinline__ void p0_prologue(Frame& F) {
    const int tid = F.tid, lane = F.lane, wave = F.wave;
    for (int it = F.bx; it < 192; it += F.G) {
        const int l = it / 48, nb = it - l * 48;
        LAS float* sl = (LAS float*)F.lds; LAS float* red = sl + 3 * 2048;
        for (int e = tid; e < 3 * 2048; e += 512) { const int c = e >> 11, k = e & 2047; const float v = (c == 0) ? F.in[I_CCTX][k] : F.in[I_C][(c - 1) * 2048 + k]; sl[e] = v / (1.f + __expf(-v)); }
        __syncthreads();
        const float* Wp = F.in[I_ADAW] + ((size_t)l * 2048 + wave * 256) * 12288 + nb * 256 + lane * 4;
        f32x4 a0 = {0.f, 0.f, 0.f, 0.f}, a1 = a0, a2 = a0;
        for (int k = 0; k < 256; k += 8) {
            f32x4 w[8];
#pragma unroll
            for (int jj = 0; jj < 8; ++jj) w[jj] = *(const f32x4*)(Wp + (size_t)(k + jj) * 12288);
#pragma unroll
            for (int jj = 0; jj < 8; ++jj) { const int kk = wave * 256 + k + jj; a0 += w[jj] * sl[kk]; a1 += w[jj] * sl[2048 + kk]; a2 += w[jj] * sl[4096 + kk]; }
        }
        *(LAS f32x4*)(red + (wave * 3 + 0) * 256 + lane * 4) = a0; *(LAS f32x4*)(red + (wave * 3 + 1) * 256 + lane * 4) = a1; *(LAS f32x4*)(red + (wave * 3 + 2) * 256 + lane * 4) = a2;
        __syncthreads();
        for (int e = tid; e < 768; e += 512) { const int c = e >> 8, n = e & 255; float s = F.in[I_ADAB][l * 12288 + nb * 256 + n];
#pragma unroll
            for (int w8 = 0; w8 < 8; ++w8) s += red[(w8 * 3 + c) * 256 + n];
            WSP(float, WS_MOD)[(size_t)(l * 3 + c) * 12288 + nb * 256 + n] = s; }
        __syncthreads();
    }
    if (F.bx == F.G - 1) {
        for (int e = tid; e < 64 * 32; e += 512) { const int pos = e >> 5, i = e & 31; const float inv = exp2f(-(float)i * (13.287712379549449f / 32.f)); const float ang = (float)pos * inv;
            WSP(f32x2, WS_TABW)[e] = (f32x2){cosf(ang), sinf(ang)}; }
        for (int e = tid; e < 64 * 16; e += 512) { const int pos = e >> 4, i = e & 15; const float inv = exp2f(-(float)i * (13.287712379549449f / 16.f)); const float ang = (float)pos * inv;
            WSP(f32x2, WS_TABM)[e] = (f32x2){cosf(ang), sinf(ang)}; }
    }
    const int gt = F.bx * 512 + tid, NGT = F.G * 512;
    for (int e = gt; e < 2 * 2 * 512 * 512; e += NGT) {
        const int c = e & 511, pos = (e >> 9) & 511, b = (e >> 18) & 1, jj = e >> 19;
        const size_t sbase = (((size_t)b * 2 + jj) * 512 + pos) * 512;
        WSP(bf16, WS_CTXK)[e] = (bf16)f2bf(F.in[I_CWK][sbase + (c & ~127) + perm_win(c & 127)]);
        WSP(bf16, WS_CTXV)[e] = (bf16)f2bf(F.in[I_CWV][sbase + c]);
    }
    for (int e = gt; e < 256 * 2048; e += NGT) { const int n = e >> 11, k = e & 2047; float v = 0.f; if (n < 32) v = F.in[I_GWA1][((size_t)(n >> 4) * 2048 + k) * 16 + (n & 15)];
        WSP(bf16, WS_GWINT)[(size_t)(6144 + n) * 2048 + k] = (bf16)f2bf(v); }
    LAS float* scr = (LAS float*)(F.lds + wave * 16384);
    const int gw = F.bx * NWAVES + wave, NGW = F.G * NWAVES;
    constexpr int C_W1 = 32 * 256, C_W2 = 128 * 64, C_QKV = 32 * 96, C_WO = 32 * 64, C_MWD = 32 * 32, C_MUQ = 8 * 96, C_MUKV = 4 * 128, C_GWIN = 32 * 192;
    constexpr int NITEMS = 4 * C_W1 + 4 * C_W2 + 2 * C_QKV + 2 * C_WO + C_MWD + C_MUQ + C_MUKV + C_WO + C_GWIN + C_WO;
    for (int it = gw; it < NITEMS; it += NGW) {
        int r = it;
        if (r < 4 * C_W1) { const int l = r / C_W1; r -= l * C_W1; tr_item(F.in[I_W1] + (size_t)l * 2048 * 8192, 2048, 8192, 256, WSP(bf16, WS_W1T) + (size_t)l * 8192 * 2048, 0, scr, r, lane); continue; } r -= 4 * C_W1;
        if (r < 4 * C_W2) { const int l = r / C_W2; r -= l * C_W2; tr_item(F.in[I_W2] + (size_t)l * 8192 * 2048, 8192, 2048, 64, WSP(bf16, WS_W2T) + (size_t)l * 2048 * 8192, 0, scr, r, lane); continue; } r -= 4 * C_W2;
        if (r < 2 * C_QKV) { const int l = r / C_QKV; r -= l * C_QKV; tr_item(F.in[I_WQKV] + (size_t)l * 2048 * 3072, 2048, 3072, 96, WSP(bf16, WS_WQKVT) + (size_t)l * 3072 * 2048, 1, scr, r, lane); continue; } r -= 2 * C_QKV;
        if (r < 2 * C_WO) { const int l = r / C_WO; r -= l * C_WO; tr_item(F.in[I_WWO] + (size_t)l * 2048 * 2048, 2048, 2048, 64, WSP(bf16, WS_WWOT) + (size_t)l * 2048 * 2048, 0, scr, r, lane); continue; } r -= 2 * C_WO;
        if (r < C_MWD) { tr_item(F.in[I_MWD], 2048, 832, 32, WSP(bf16, WS_MWDT), 2, scr, r, lane); continue; } r -= C_MWD;
        if (r < C_MUQ) { tr_item(F.in[I_MWUQ], 512, 3072, 96, WSP(bf16, WS_MWUQT), 3, scr, r, lane); continue; } r -= C_MUQ;
        if (r < C_MUKV) { tr_item(F.in[I_MWUKV], 256, 4096, 128, WSP(bf16, WS_MWUKVT), 0, scr, r, lane); continue; } r -= C_MUKV;
        if (r < C_WO) { tr_item(F.in[I_MWO], 2048, 2048, 64, WSP(bf16, WS_MWOT), 0, scr, r, lane); continue; } r -= C_WO;
        if (r < C_GWIN) { tr_item(F.in[I_GWIN], 2048, 6144, 192, WSP(bf16, WS_GWINT), 0, scr, r, lane); continue; } r -= C_GWIN;
        tr_item(F.in[I_GWO], 2048, 2048, 64, WSP(bf16, WS_GWOT), 0, scr, r, lane);
    }
}

__device__ __forceinline__ const float* x_row(Frame& F, int L, int row) {
    return L == 0 ? (row < MP ? F.in[I_XP] + (size_t)row * DM : F.in[I_XS] + (size_t)(row - MP) * DM) : WSP(float, WS_X) + (size_t)row * DM;
}
__device__ __forceinline__ void mod_phase(Frame& F, int L, int which, int first) {
    const int gw = F.bx * NWAVES + F.wave, NGW = F.G * NWAVES, lane = F.lane;
    for (int rb = gw; rb < MTOK / 8; rb += NGW) {
        const int row0 = rb * 8, cond = row0 < MP ? 0 : (row0 >> 12) - 1;
        const float* mv = WSP(float, WS_MOD) + (size_t)(L * 3 + cond) * 12288 + (which ? 3 * 2048 : 0);
        const float* g = F.in[I_NORMG] + (size_t)(L * 2 + which) * 2048;
        f32x4 a[8], s[8];
#pragma unroll
        for (int jj = 0; jj < 8; ++jj) { const int col = 4 * lane + 256 * jj; const f32x4 gv = *(const f32x4*)(g + col), sc = *(const f32x4*)(mv + 2048 + col); s[jj] = *(const f32x4*)(mv + col); a[jj] = gv * (sc + 1.f); }
        for (int r = 0; r < 8; ++r) {
            const int row = row0 + r; const float* xr = x_row(F, first ? 0 : 1, row);
            f32x4 v[8]; float ss = 0.f;
#pragma unroll
            for (int jj = 0; jj < 8; ++jj) { v[jj] = *(const f32x4*)(xr + 4 * lane + 256 * jj); ss += (v[jj][0] * v[jj][0] + v[jj][1] * v[jj][1]) + (v[jj][2] * v[jj][2] + v[jj][3] * v[jj][3]); }
            const float rstd = rsqrtf(wave_sum(ss) * (1.f / 2048.f) + EPS);
            bf16* hr = WSP(bf16, WS_H) + (size_t)row * DM;
#pragma unroll
            for (int jj = 0; jj < 8; ++jj) { const f32x4 y = v[jj] * rstd * a[jj] + s[jj]; v2u w; w.x = cvtpk(y[0], y[1]); w.y = cvtpk(y[2], y[3]); *(v2u*)(hr + 4 * lane + 256 * jj) = w; }
        }
    }
}
__device__ __forceinline__ void final_phase(Frame& F) {
    const int gw = F.bx * NWAVES + F.wave, NGW = F.G * NWAVES, lane = F.lane;
    const float* g = F.in[I_FNORM];
    for (int row = gw; row < MTOK; row += NGW) {
        const float* xr = WSP(float, WS_X) + (size_t)row * DM;
        f32x4 v[8]; float ss = 0.f;
#pragma unroll
        for (int jj = 0; jj < 8; ++jj) { v[jj] = *(const f32x4*)(xr + 4 * lane + 256 * jj); ss += (v[jj][0] * v[jj][0] + v[jj][1] * v[jj][1]) + (v[jj][2] * v[jj][2] + v[jj][3] * v[jj][3]); }
        const float rstd = rsqrtf(wave_sum(ss) * (1.f / 2048.f) + EPS);
        float* orow = F.out + (size_t)row * DM;
#pragma unroll
        for (int jj = 0; jj < 8; ++jj) { const int col = 4 * lane + 256 * jj; *(f32x4*)(orow + col) = v[jj] * rstd * *(const f32x4*)(g + col); }
    }
}

namespace att {
constexpr int QBLK = 32, KVBLK = 64;
constexpr int SHM_V = 16384, SHM_K = 16384, SHM_KR = 8192;
constexpr int OFF_V = 0, OFF_K = 2 * SHM_V, OFF_KR = 2 * SHM_V + 2 * SHM_K, OFF_WS = OFF_KR + 2 * SHM_KR, OFF_QR = OFF_WS + NWAVES * 64 * 4, LDS_ATT = OFF_QR + NWAVES * 4096;
#define KSWZ(row, colB) ((row) * 256 + ((colB) ^ (((row) & 7) << 4)))
#define KRSWZ(row, chunk) ((row) * 128 + ((((chunk) ^ ((row) >> 1)) & 7) << 4))
__device__ __forceinline__ int crow(int r, int hi) { return (r & 3) + 8 * (r >> 2) + 4 * hi; }
template <int DQK> struct Cst { static constexpr float SCALE = DQK == 128 ? 0.088388347648318440f : 0.072168783648703220f; static constexpr float C = SCALE * 1.4426950408889634f; };
constexpr float THR = 8.f;

template <int DQK>
__device__ __forceinline__ void partialSM(f32x16& p0, f32x16& p1, float& m_reg, float& mn, float& alpha) {
    constexpr float C = Cst<DQK>::C, SCALE = Cst<DQK>::SCALE;
    float pmax = p0[0];
#pragma unroll
    for (int r = 1; r < 16; ++r) pmax = fmaxf(pmax, p0[r]);
#pragma unroll
    for (int r = 0; r < 16; ++r) pmax = fmaxf(pmax, p1[r]);
    { auto rr = __builtin_amdgcn_permlane32_swap(__float_as_uint(pmax), __float_as_uint(pmax), false, false);
      pmax = fmaxf(__uint_as_float(rr[0]), __uint_as_float(rr[1])); }
    if (__builtin_expect(__all(pmax - m_reg <= THR / SCALE), 1)) { mn = m_reg; alpha = 1.f; }
    else { mn = fmaxf(m_reg, pmax); alpha = __builtin_amdgcn_exp2f((m_reg - mn) * C); m_reg = mn; }
    const float mnC = -mn * C;
#pragma unroll
    for (int r = 0; r < 16; ++r) p0[r] = __builtin_amdgcn_exp2f(fmaf(p0[r], C, mnC));
#pragma unroll
    for (int r = 0; r < 16; ++r) p1[r] = __builtin_amdgcn_exp2f(fmaf(p1[r], C, mnC));
}
__device__ __forceinline__ void finishSM(f32x16& p0, f32x16& p1, float alpha, float& l_reg, bf16x8& pa0, bf16x8& pa1, bf16x8& pa2, bf16x8& pa3) {
    float ps = 0;
#pragma unroll
    for (int r = 0; r < 16; ++r) ps += p0[r];
#pragma unroll
    for (int r = 0; r < 16; ++r) ps += p1[r];
    { auto rr = __builtin_amdgcn_permlane32_swap(__float_as_uint(ps), __float_as_uint(ps), false, false);
      ps = __uint_as_float(rr[0]) + __uint_as_float(rr[1]); }
    l_reg = l_reg * alpha + ps;
#define PK4(P, BASE, OUT) do { unsigned a0 = cvtpk(P[BASE + 0], P[BASE + 1]), a1 = cvtpk(P[BASE + 2], P[BASE + 3]);   \
    unsigned b0 = cvtpk(P[BASE + 4], P[BASE + 5]), b1 = cvtpk(P[BASE + 6], P[BASE + 7]);                              \
    auto r0 = __builtin_amdgcn_permlane32_swap(a0, b0, false, false); auto r1 = __builtin_amdgcn_permlane32_swap(a1, b1, false, false); \
    v4u w = {r0[0], r1[0], r0[1], r1[1]}; OUT = *reinterpret_cast<bf16x8*>(&w); } while (0)
    PK4(p0, 0, pa0); PK4(p0, 8, pa1); PK4(p1, 0, pa2); PK4(p1, 8, pa3);
#undef PK4
}
__device__ __forceinline__ int v_st(int k, int c) { const int kk = (k & ~0xC) | ((k & 4) << 1) | ((k & 8) >> 1); return ((kk >> 3) * 4 + (c >> 5)) * 512 + ((kk & 7) * 32 + (c & 31)) * 2; }
__device__ __forceinline__ int v_rd_base(int lane) { return ((lane & 3) << 3) | (((lane >> 2) & 3) << 6) | (((lane >> 4) & 1) << 5) | (((lane >> 5) & 1) << 8); }
constexpr int v_rd_off(int d0, int ks, int half) { return d0 * 512 + ks * 4096 + half * 2048; }
template <int OFF> __device__ __forceinline__ s16x4 tr_read(int vb) {
    s16x4 r; asm volatile("ds_read_b64_tr_b16 %0, %1 offset:%2" : "=&v"(r) : "v"(vb), "i"(OFF) : "memory"); return r;
}
template <int D0> __device__ __forceinline__ void pv_one(f32x16& od, int vb, bf16x8 pa0, bf16x8 pa1, bf16x8 pa2, bf16x8 pa3) {
    const s16x4 l0 = tr_read<v_rd_off(D0, 0, 0)>(vb), h0 = tr_read<v_rd_off(D0, 0, 1)>(vb), l1 = tr_read<v_rd_off(D0, 1, 0)>(vb), h1 = tr_read<v_rd_off(D0, 1, 1)>(vb);
    const s16x4 l2 = tr_read<v_rd_off(D0, 2, 0)>(vb), h2 = tr_read<v_rd_off(D0, 2, 1)>(vb), l3 = tr_read<v_rd_off(D0, 3, 0)>(vb), h3 = tr_read<v_rd_off(D0, 3, 1)>(vb);
    asm volatile("s_waitcnt lgkmcnt(0)" ::: "memory"); SBAR();
#define PKV(L, H) (bf16x8){L[0], L[1], L[2], L[3], H[0], H[1], H[2], H[3]}
    od = __builtin_amdgcn_mfma_f32_32x32x16_bf16(pa0, PKV(l0, h0), od, 0, 0, 0);
    od = __builtin_amdgcn_mfma_f32_32x32x16_bf16(pa1, PKV(l1, h1), od, 0, 0, 0);
    od = __builtin_amdgcn_mfma_f32_32x32x16_bf16(pa2, PKV(l2, h2), od, 0, 0, 0);
    od = __builtin_amdgcn_mfma_f32_32x32x16_bf16(pa3, PKV(l3, h3), od, 0, 0, 0);
#undef PKV
}

template <int DQK, bool MASKED>
__device__ __forceinline__ void attn_unit(const bf16* __restrict__ Qb, int ldq,
                                          const bf16* __restrict__ KA, const bf16* __restrict__ VA, const bf16* __restrict__ KRA, int nA,
                                          const bf16* __restrict__ KB, const bf16* __restrict__ VB, const bf16* __restrict__ KRB, int nB,
                                          int ldk, int qpos0, int kposB0, float sink_l2, bf16* __restrict__ Ob, char* lds) {
    constexpr int ND = 8;
    constexpr float C = Cst<DQK>::C;
    const int tid = threadIdx.x, wid = tid >> 6, lane = tid & 63, r32 = lane & 31, hi = lane >> 5;
    char* V_lds = lds + OFF_V; char* K_lds = lds + OFF_K; char* KR_lds = lds + OFF_KR;
    float* wsf = (float*)(lds + OFF_WS) + wid * 64; float* li_l = wsf; float* al_l = wsf + 32;
    float m_reg = -1e30f, l_reg = 0.f; f32x16 o[4] = {}; bf16x8 qr[ND];
    const bf16* Qw = Qb + (size_t)(wid * QBLK + r32) * ldq + hi * 8;
#pragma unroll
    for (int d0 = 0; d0 < ND; ++d0) qr[d0] = *reinterpret_cast<const bf16x8*>(Qw + d0 * 16);
    char* QR_lds = lds + OFF_QR;
    if constexpr (DQK == 192) {
#pragma unroll
        for (int dd = 0; dd < 4; ++dd) { const bf16x8 qv = *reinterpret_cast<const bf16x8*>(Qw + 128 + dd * 16); *(bf16x8*)(QR_lds + wid * 4096 + KRSWZ(r32, dd * 2 + hi)) = qv; }
    }
    const int sr = tid >> 4, sc = (tid & 15) * 8, vst0 = v_st(sr, sc), vst1 = v_st(32 + sr, sc);
    const int krr = tid >> 3, krc = tid & 7;
    const int vb0 = (int)(uintptr_t)(LAS char*)V_lds + v_rd_base(lane);
    const int NT = nA + nB;
    bf16x8 sv0, sv1, sk0, sk1, skr;
    const unsigned go0 = (unsigned)(sr * ldk + sc) * 2u, go1 = (unsigned)((32 + sr) * ldk + sc) * 2u, gor = (unsigned)(krr * 64 + krc * 8) * 2u;
#define SLOAD(t) do { const bool inA_ = (t) < nA; const int tt_ = inA_ ? (t) : (t) - nA; const char* Kt_ = (const char*)((inA_ ? KA : KB) + (size_t)tt_ * 64 * ldk); const char* Vt_ = (const char*)((inA_ ? VA : VB) + (size_t)tt_ * 64 * ldk); \
    sv0 = *reinterpret_cast<const bf16x8*>(Vt_ + go0); sv1 = *reinterpret_cast<const bf16x8*>(Vt_ + go1); \
    sk0 = *reinterpret_cast<const bf16x8*>(Kt_ + go0); sk1 = *reinterpret_cast<const bf16x8*>(Kt_ + go1); \
    if constexpr (DQK == 192) { const char* Rt_ = (const char*)((inA_ ? KRA : KRB) + (size_t)tt_ * 64 * 64); skr = *reinterpret_cast<const bf16x8*>(Rt_ + gor); } } while (0)
#define SWRITE(b) do { *(bf16x8*)(V_lds + (b) * SHM_V + vst0) = sv0; *(bf16x8*)(V_lds + (b) * SHM_V + vst1) = sv1; const int kc_ = sc * 2; \
    *(bf16x8*)(K_lds + (b) * SHM_K + KSWZ(sr, kc_)) = sk0; *(bf16x8*)(K_lds + (b) * SHM_K + KSWZ(32 + sr, kc_)) = sk1; \
    if constexpr (DQK == 192) { *(bf16x8*)(KR_lds + (b) * SHM_KR + KRSWZ(krr, krc)) = skr; } } while (0)
    SLOAD(0); VM_WAIT(); SWRITE(0); __syncthreads();
    for (int t = 0; t < NT; ++t) {
        const int cur = t & 1;
        if (t + 1 < NT) SLOAD(t + 1);
        f32x16 p0 = {}, p1 = {};
        { const char* Ks = K_lds + cur * SHM_K;
#pragma unroll
          for (int dg = 0; dg < 2; ++dg) {
            bf16x8 kf0[4], kf1[4];
#pragma unroll
            for (int dd = 0; dd < 4; ++dd) { const int cb = ((dg * 4 + dd) * 16 + hi * 8) * 2;
              kf0[dd] = *reinterpret_cast<const bf16x8*>(Ks + KSWZ(r32, cb)); kf1[dd] = *reinterpret_cast<const bf16x8*>(Ks + KSWZ(32 + r32, cb)); }
#pragma unroll
            for (int dd = 0; dd < 4; ++dd) {
              p0 = __builtin_amdgcn_mfma_f32_32x32x16_bf16(kf0[dd], qr[dg * 4 + dd], p0, 0, 0, 0);
              p1 = __builtin_amdgcn_mfma_f32_32x32x16_bf16(kf1[dd], qr[dg * 4 + dd], p1, 0, 0, 0); }
            SBAR();
          }
          if constexpr (DQK == 192) { const char* Rs = KR_lds + cur * SHM_KR; const char* Qs = QR_lds + wid * 4096;
            bf16x8 kf0[4], kf1[4], qf[4];
#pragma unroll
            for (int dd = 0; dd < 4; ++dd) { const int ch = dd * 2 + hi;
              kf0[dd] = *reinterpret_cast<const bf16x8*>(Rs + KRSWZ(r32, ch)); kf1[dd] = *reinterpret_cast<const bf16x8*>(Rs + KRSWZ(32 + r32, ch)); qf[dd] = *reinterpret_cast<const bf16x8*>(Qs + KRSWZ(r32, ch)); }
#pragma unroll
            for (int dd = 0; dd < 4; ++dd) {
              p0 = __builtin_amdgcn_mfma_f32_32x32x16_bf16(kf0[dd], qf[dd], p0, 0, 0, 0);
              p1 = __builtin_amdgcn_mfma_f32_32x32x16_bf16(kf1[dd], qf[dd], p1, 0, 0, 0); }
            SBAR();
          }
        }
        if constexpr (MASKED) { if (t >= nA) { const int qp = qpos0 + wid * QBLK + r32, kb = kposB0 + (t - nA) * 64;
#pragma unroll
            for (int r = 0; r < 16; ++r) { const int d = qp - (kb + crow(r, hi)); if (d > 128 || d < -128) p0[r] = -1e30f; const int d2 = d - 32; if (d2 > 128 || d2 < -128) p1[r] = -1e30f; } } }
        float mn, alpha; bf16x8 pa0, pa1, pa2, pa3;
        partialSM<DQK>(p0, p1, m_reg, mn, alpha);
        if (__any(alpha < 1.f)) { if (hi == 0) al_l[r32] = alpha; LDS_WAIT();
#pragma unroll
            for (int r = 0; r < 16; ++r) { const float al = al_l[crow(r, hi)];
#pragma unroll
                for (int d = 0; d < 4; ++d) o[d][r] *= al; } }
        finishSM(p0, p1, alpha, l_reg, pa0, pa1, pa2, pa3); SBAR();
        { const int vb = vb0 + cur * SHM_V;
          pv_one<0>(o[0], vb, pa0, pa1, pa2, pa3); pv_one<1>(o[1], vb, pa0, pa1, pa2, pa3); pv_one<2>(o[2], vb, pa0, pa1, pa2, pa3); pv_one<3>(o[3], vb, pa0, pa1, pa2, pa3); }
        if (t + 1 < NT) { VM_WAIT(); SWRITE(cur ^ 1); }
        __syncthreads();
    }
    l_reg += __builtin_amdgcn_exp2f(sink_l2 - m_reg * C);
    if (hi == 0) li_l[r32] = l_reg; LDS_WAIT();
    int obase = (wid * QBLK + 4 * hi) * 2048 + r32; asm volatile("" : "+v"(obase));
#pragma unroll
    for (int r = 0; r < 16; ++r) { const float rl = __builtin_amdgcn_rcpf(li_l[crow(r, hi)]); const int ro = ((r & 3) + 8 * (r >> 2)) * 2048;
#pragma unroll
        for (int d0 = 0; d0 < 4; ++d0) *(bf16*)((char*)Ob + (unsigned)(obase + ro + d0 * 32) * 2u) = (bf16)f2bf(o[d0][r] * rl); }
    LDS_WAIT();
#undef SLOAD
#undef SWRITE
}
}

__device__ __forceinline__ void attn_win_phase(Frame& F, int j) {
    const bf16* Q = WSP(bf16, WS_WQ); const bf16* K = WSP(bf16, WS_WK); const bf16* V = WSP(bf16, WS_WV); bf16* O = WSP(bf16, WS_AO);
    const bf16* CK = WSP(bf16, WS_CTXK) + (size_t)j * 2 * 512 * 512; const bf16* CV = WSP(bf16, WS_CTXV) + (size_t)j * 2 * 512 * 512;
    for (int un = F.bx; un < 1024; un += F.G) {
        const int h = un & 15, kvh = h >> 2; const float sink = F.in[I_SINK][j * 16 + h] * 1.4426950408889634f;
        if (un < 512) {
            const int qb = un >> 4, bs = qb >> 4, t0 = (qb & 15) * 256, row0 = MP + qb * 256;
            int kt0 = (t0 >> 6) - 2, kt1 = (t0 >> 6) + 5; if (kt0 < 0) kt0 = 0; if (kt1 > 63) kt1 = 63;
            const size_t kb = (size_t)(MP + bs * 4096 + kt0 * 64) * 512 + kvh * 128;
            att::attn_unit<128, true>(Q + (size_t)row0 * 2048 + h * 128, 2048, CK + (size_t)bs * 512 * 512 + kvh * 128, CV + (size_t)bs * 512 * 512 + kvh * 128, nullptr, 8,
                                     K + kb, V + kb, nullptr, kt1 - kt0 + 1, 512, t0, kt0 * 64, sink, O + (size_t)row0 * 2048 + h * 128, (char*)F.ldsg);
        } else {
            const int b = (un - 512) >> 4, row0 = b * 256; const size_t kb = (size_t)row0 * 512 + kvh * 128;
            att::attn_unit<128, false>(Q + (size_t)row0 * 2048 + h * 128, 2048, nullptr, nullptr, nullptr, 0,
                                      K + kb, V + kb, nullptr, 4, 512, 0, 0, sink, O + (size_t)row0 * 2048 + h * 128, (char*)F.ldsg);
        }
    }
}
__device__ __forceinline__ void attn_mla_phase(Frame& F) {
    const bf16* Q = WSP(bf16, WS_MQ); const bf16* KN = WSP(bf16, WS_MKN); const bf16* V = WSP(bf16, WS_MV); const bf16* KR = WSP(bf16, WS_MKR); bf16* O = WSP(bf16, WS_AO);
    for (int un = F.bx; un < 1024; un += F.G) {
        const int h = un & 15;
        if (un < 512) {
            const int qb = un >> 4, bs = qb >> 4, row0 = MP + qb * 256;
            const size_t ra = (size_t)bs * 512, rb = (size_t)1024 + MP + bs * 4096;
            att::attn_unit<192, false>(Q + (size_t)row0 * 3072 + h * 192, 3072, KN + ra * 2048 + h * 128, V + ra * 2048 + h * 128, KR + ra * 64, 8,
                                      KN + rb * 2048 + h * 128, V + rb * 2048 + h * 128, KR + rb * 64, 64, 2048, 0, 0, -1e30f, O + (size_t)row0 * 2048 + h * 128, (char*)F.ldsg);
        } else {
            const int b = (un - 512) >> 4, row0 = b * 256; const size_t rb = (size_t)1024 + row0;
            att::attn_unit<192, false>(Q + (size_t)row0 * 3072 + h * 192, 3072, nullptr, nullptr, nullptr, 0,
                                      KN + rb * 2048 + h * 128, V + rb * 2048 + h * 128, KR + rb * 64, 4, 2048, 0, 0, -1e30f, O + (size_t)row0 * 2048 + h * 128, (char*)F.ldsg);
        }
    }
}

__device__ __forceinline__ void mla_norm_phase(Frame& F) {
    const int gw = F.bx * NWAVES + F.wave, NGW = F.G * NWAVES, lane = F.lane;
    const float* D = WSP(float, WS_MD); bf16* CQ = WSP(bf16, WS_MCQ); bf16* CKV = WSP(bf16, WS_MCKV); bf16* KR = WSP(bf16, WS_MKR);
    const f32x2* tab = WSP(f32x2, WS_TABM);
    const float* qn = F.in[I_MQN]; const float* kvn = F.in[I_MKVN];
    for (int row = gw; row < MTOK; row += NGW) {
        const float* d = D + (size_t)row * 1024;
        {
            const f32x4 v0 = *(const f32x4*)(d + 4 * lane), v1 = *(const f32x4*)(d + 256 + 4 * lane);
            float ss = (v0[0] * v0[0] + v0[1] * v0[1]) + (v0[2] * v0[2] + v0[3] * v0[3]) + (v1[0] * v1[0] + v1[1] * v1[1]) + (v1[2] * v1[2] + v1[3] * v1[3]);
            const float rstd = rsqrtf(wave_sum(ss) * (1.f / 512.f) + EPS);
            const f32x4 y0 = v0 * rstd * *(const f32x4*)(qn + 4 * lane), y1 = v1 * rstd * *(const f32x4*)(qn + 256 + 4 * lane);
            v2u w; w.x = cvtpk(y0[0], y0[1]); w.y = cvtpk(y0[2], y0[3]); *(v2u*)(CQ + (size_t)row * 512 + 4 * lane) = w;
            w.x = cvtpk(y1[0], y1[1]); w.y = cvtpk(y1[2], y1[3]); *(v2u*)(CQ + (size_t)row * 512 + 256 + 4 * lane) = w;
        }
        {
            const f32x4 v0 = *(const f32x4*)(d + 512 + 4 * lane);
            float ss = (v0[0] * v0[0] + v0[1] * v0[1]) + (v0[2] * v0[2] + v0[3] * v0[3]);
            const float rstd = rsqrtf(wave_sum(ss) * (1.f / 256.f) + EPS);
            const f32x4 y0 = v0 * rstd * *(const f32x4*)(kvn + 4 * lane);
            v2u w; w.x = cvtpk(y0[0], y0[1]); w.y = cvtpk(y0[2], y0[3]); *(v2u*)(CKV + (size_t)(1024 + row) * 256 + 4 * lane) = w;
            if (row < MP) *(f32x4*)(F.out + O_CKV + (size_t)row * 256 + 4 * lane) = y0;
        }
        if (lane < 8) {
            const int ug = lane, idx0 = (ug & 3) * 4, d1 = (ug < 4 ? 0 : 32) + idx0;
            f32x4 a = *(const f32x4*)(d + 768 + 8 * ug), b = *(const f32x4*)(d + 768 + 8 * ug + 4);
            if (row < MP) { float* op = F.out + O_KR + (size_t)row * 64 + d1; *(f32x4*)op = a; *(f32x4*)(op + 16) = b; }
            else { const int t = row & 4095, pos = (ug < 4) ? (t >> 6) : (t & 63); const f32x4* tp = (const f32x4*)(tab + pos * 16 + idx0); const f32x4 cs0 = tp[0], cs1 = tp[1];
                const f32x4 co = {cs0[0], cs0[2], cs1[0], cs1[2]}, si = {cs0[1], cs0[3], cs1[1], cs1[3]};
                const f32x4 na = a * co - b * si, nb = b * co + a * si; a = na; b = nb; }
            *(v4u*)(KR + (size_t)(1024 + row) * 64 + 8 * ug) = pack8(a, b);
        }
    }
    const int gt = F.bx * 512 + F.tid, NGT = F.G * 512;
    for (int e = gt; e < 1024 * 256; e += NGT) CKV[e] = (bf16)f2bf(F.in[I_CCKV][e]);
    for (int e = gt; e < 1024 * 64; e += NGT) KR[e] = (bf16)f2bf(F.in[I_CKR][(e & ~63) + perm_mla(e & 63)]);
}

typedef short v4i16_t __attribute__((ext_vector_type(4)));
__device__ __forceinline__ s16x4 vtr(const LAS char* p) { return __builtin_bit_cast(s16x4, __builtin_amdgcn_ds_read_tr16_b64_v4i16((LAS v4i16_t*)p)); }
#define MFMA16(a, b, c) __builtin_amdgcn_mfma_f32_16x16x32_bf16((a), (b), (c), 0, 0, 0)
#define CAT8(L, H) (bf16x8){L[0], L[1], L[2], L[3], H[0], H[1], H[2], H[3]}

__device__ __forceinline__ void gla_prep_phase(Frame& F) {
    constexpr int PQ = 528, OQ = 0, OK_ = 64 * PQ, OKT = 2 * 64 * PQ, OUB = 3 * 64 * PQ, OHT = OUB + 4096, OAT = OHT + 2048;
    LAS char* L = (LAS char*)F.lds; const int tid = F.tid, lane = F.lane, wave = F.wave;
    const bf16* GQ = WSP(bf16, WS_GQ); const bf16* GK = WSP(bf16, WS_GK); const float* GU = WSP(float, WS_GU);
    for (int un = F.bx; un < 2048; un += F.G) {
        const int d = un & 1, ch = un >> 1, c = ch >> 2, h = ch & 3, row0 = c * 64;
        bf16* QT = WSP(bf16, WS_GQT) + (size_t)d * MTOK * 1024; bf16* KD = WSP(bf16, WS_GKD) + (size_t)d * MTOK * 1024;
        bf16* AM = WSP(bf16, WS_GAM) + ((size_t)d * 1024 + ch) * 4096; float* DEC = WSP(float, WS_GDEC) + ((size_t)d * 1024 + ch) * 256;
#pragma unroll
        for (int i = 0; i < 4; ++i) { const int e = tid + 512 * i, row = e >> 5, cc = e & 31; const size_t go = (size_t)(row0 + row) * 1024 + h * 256 + cc * 8;
            *(LAS v4u*)(L + OQ + row * PQ + cc * 16) = *(const v4u*)(GQ + go); *(LAS v4u*)(L + OK_ + row * PQ + cc * 16) = *(const v4u*)(GK + go); }
        if (tid < 256) { const int row = tid >> 2, q4 = tid & 3; *(LAS f32x4*)(L + OUB + (row * 16 + q4 * 4) * 4) = *(const f32x4*)(GU + (size_t)(row0 + row) * 32 + d * 16 + q4 * 4); }
        __syncthreads();
        {
            const int hf = tid >> 8, col = tid & 255;
            float w[16];
#pragma unroll
            for (int r = 0; r < 16; ++r) w[r] = F.in[I_GWA2][((size_t)d * 16 + r) * 1024 + h * 256 + col];
            const float bias = F.in[I_GBA][d * 1024 + h * 256 + col];
            float g[32]; float tot = 0.f;
#pragma unroll
            for (int ii = 0; ii < 32; ++ii) { const int i = hf * 32 + ii; float z = bias;
#pragma unroll
                for (int q4 = 0; q4 < 4; ++q4) { const f32x4 uv = *(const LAS f32x4*)(L + OUB + (i * 16 + q4 * 4) * 4); z += uv[0] * w[4 * q4] + uv[1] * w[4 * q4 + 1] + uv[2] * w[4 * q4 + 2] + uv[3] * w[4 * q4 + 3]; }
                const float ls = fminf(z, 0.f) - __logf(1.f + __expf(-fabsf(z)));
                g[ii] = ls * 0.0625f; tot += g[ii]; }
            ((LAS float*)(L + OHT))[hf * 256 + col] = tot;
            __syncthreads();
            const float other = ((const LAS float*)(L + OHT))[(1 - hf) * 256 + col];
            const float T = tot + other;
            float run = (d == 0) ? (hf == 1 ? other : 0.f) : (hf == 0 ? other : 0.f);
            if (hf == 0) DEC[col] = __expf(T);
#pragma unroll
            for (int s = 0; s < 32; ++s) {
                const int ii = (d == 0) ? s : 31 - s;
                run += (d == 0) ? g[s] : g[31 - s];
                const int i = hf * 32 + ii;
                LAS bf16* qp = (LAS bf16*)(L + OQ + i * PQ) + col; LAS bf16* kp = (LAS bf16*)(L + OK_ + i * PQ) + col; LAS bf16* ktp = (LAS bf16*)(L + OKT + i * PQ) + col;
                const float qv = bf2f(*qp), kv = bf2f(*kp);
                *qp = (bf16)f2bf(qv * __expf(run)); *ktp = (bf16)f2bf(kv * __expf(-run)); *kp = (bf16)f2bf(kv * __expf(T - run));
            }
        }
        __syncthreads();
        {
            const int gq = lane >> 4, cl = lane & 15;
#pragma unroll
            for (int s2 = 0; s2 < 2; ++s2) {
                const int T16 = 2 * wave + s2, ti = T16 >> 2, tj = T16 & 3;
                f32x4 acc = {0.f, 0.f, 0.f, 0.f};
#pragma unroll
                for (int ks = 0; ks < 8; ++ks) {
                    const bf16x8 a = *(const LAS bf16x8*)(L + OQ + (16 * ti + cl) * PQ + (32 * ks + 8 * gq) * 2);
                    const bf16x8 b = *(const LAS bf16x8*)(L + OKT + (16 * tj + cl) * PQ + (32 * ks + 8 * gq) * 2);
                    acc = MFMA16(a, b, acc);
                }
                const int jcol = 16 * tj + cl;
#pragma unroll
                for (int r = 0; r < 4; ++r) { const int i = 16 * ti + 4 * gq + r; const bool keep = (d == 0) ? (jcol <= i) : (jcol >= i);
                    ((LAS bf16*)(L + OAT))[i * 64 + jcol] = (bf16)f2bf(keep ? acc[r] : 0.f); }
            }
        }
        __syncthreads();
#pragma unroll
        for (int i = 0; i < 4; ++i) { const int e = tid + 512 * i, row = e >> 5, cc = e & 31; const size_t go = (size_t)(row0 + row) * 1024 + h * 256 + cc * 8;
            *(v4u*)(QT + go) = *(const LAS v4u*)(L + OQ + row * PQ + cc * 16); *(v4u*)(KD + go) = *(const LAS v4u*)(L + OK_ + row * PQ + cc * 16); }
        *(v4u*)(AM + tid * 8) = *(const LAS v4u*)(L + OAT + tid * 16);
        __syncthreads();
    }
}

__device__ __forceinline__ void gla_scan_item(Frame& F, int seq, int h, int d, int sl) {
    constexpr int PQ = 528, PK = 544, PA = 136, PV = 288;
    constexpr int OQ = 0, OK_ = 64 * PQ, OA = OK_ + 64 * PK, OV = OA + 64 * PA, ODEC = OV + 64 * PV;
    LAS char* L = (LAS char*)F.lds; const int tid = F.tid, lane = F.lane, wave = F.wave, gq = lane >> 4, cl = lane & 15;
    const bool sample = seq >= 32; const int base = sample ? MP + (seq - 32) * 4096 : seq * 256, nch = sample ? 64 : 4;
    const bf16* QT = WSP(bf16, WS_GQT) + (size_t)d * MTOK * 1024; const bf16* KD = WSP(bf16, WS_GKD) + (size_t)d * MTOK * 1024;
    const bf16* AM = WSP(bf16, WS_GAM) + (size_t)d * 1024 * 4096; const float* DEC = WSP(float, WS_GDEC) + (size_t)d * 1024 * 256;
    const bf16* GV = WSP(bf16, WS_GV); float* OD = WSP(float, d == 0 ? WS_GOF : WS_GOB);
    const int dvc = h * 512 + sl * 128;
    f32x4 S[16];
    if (sample) { const float* s0 = F.in[d == 0 ? I_SGF : I_SGB] + ((size_t)((seq - 32) * 4 + h) * 256) * 512 + sl * 128 + 16 * wave + cl;
#pragma unroll
        for (int t = 0; t < 16; ++t)
#pragma unroll
            for (int r = 0; r < 4; ++r) S[t][r] = s0[(size_t)(16 * t + 4 * gq + r) * 512];
    } else {
#pragma unroll
        for (int t = 0; t < 16; ++t) S[t] = (f32x4){0.f, 0.f, 0.f, 0.f};
    }
    v4u rq[4], rk[4], rv[2], ra; float rdec = 0.f;
#define GLOAD(ci) do { const int r0_ = base + 64 * (ci); const int chx_ = (r0_ >> 6) * 4 + h; \
    _Pragma("unroll") for (int i = 0; i < 4; ++i) { const int e = tid + 512 * i, row = e >> 5, cc = e & 31; const size_t go = (size_t)(r0_ + row) * 1024 + h * 256 + cc * 8; rq[i] = *(const v4u*)(QT + go); rk[i] = *(const v4u*)(KD + go); } \
    _Pragma("unroll") for (int i = 0; i < 2; ++i) { const int e = tid + 512 * i, row = e >> 4, cc = e & 15; rv[i] = *(const v4u*)(GV + (size_t)(r0_ + row) * 2048 + dvc + cc * 8); } \
    ra = *(const v4u*)(AM + (size_t)chx_ * 4096 + tid * 8); if (tid < 256) rdec = DEC[(size_t)chx_ * 256 + tid]; } while (0)
#define LWRITE() do { \
    _Pragma("unroll") for (int i = 0; i < 4; ++i) { const int e = tid + 512 * i, row = e >> 5, cc = e & 31; *(LAS v4u*)(L + OQ + row * PQ + cc * 16) = rq[i]; *(LAS v4u*)(L + OK_ + row * PK + cc * 16) = rk[i]; } \
    _Pragma("unroll") for (int i = 0; i < 2; ++i) { const int e = tid + 512 * i, row = e >> 4, cc = e & 15; *(LAS v4u*)(L + OV + row * PV + cc * 16) = rv[i]; } \
    { const int row = tid >> 3, cc = tid & 7; *(LAS v2u*)(L + OA + row * PA + cc * 16) = (v2u){ra.x, ra.y}; *(LAS v2u*)(L + OA + row * PA + cc * 16 + 8) = (v2u){ra.z, ra.w}; } \
    if (tid < 256) ((LAS float*)(L + ODEC))[tid] = rdec; } while (0)
    GLOAD(d == 0 ? 0 : nch - 1);
    LWRITE();
    __syncthreads();
    for (int s = 0; s < nch; ++s) {
        const int ci = d == 0 ? s : nch - 1 - s, row0 = base + 64 * ci;
        if (s + 1 < nch) GLOAD(d == 0 ? s + 1 : nch - 2 - s);
        f32x4 o[4];
#pragma unroll
        for (int ti = 0; ti < 4; ++ti) o[ti] = (f32x4){0.f, 0.f, 0.f, 0.f};
#pragma unroll
        for (int ks = 0; ks < 8; ++ks) {
            v4u bw; bw.x = cvtpk(S[2 * ks][0], S[2 * ks][1]); bw.y = cvtpk(S[2 * ks][2], S[2 * ks][3]); bw.z = cvtpk(S[2 * ks + 1][0], S[2 * ks + 1][1]); bw.w = cvtpk(S[2 * ks + 1][2], S[2 * ks + 1][3]);
            const bf16x8 bfr = __builtin_bit_cast(bf16x8, bw);
#pragma unroll
            for (int ti = 0; ti < 4; ++ti) {
                const LAS char* ap = L + OQ + (16 * ti + cl) * PQ + (32 * ks + 4 * gq) * 2;
                const s16x4 lo = *(const LAS s16x4*)ap, hi = *(const LAS s16x4*)(ap + 32);
                o[ti] = MFMA16(CAT8(lo, hi), bfr, o[ti]);
            }
        }
        bf16x8 vb[2];
#pragma unroll
        for (int ks = 0; ks < 2; ++ks) { const LAS char* vp = L + OV + (32 * ks + 4 * gq + (cl >> 2)) * PV + 32 * wave + 8 * (cl & 3);
            const s16x4 lo = vtr(vp), hi = vtr(vp + 16 * PV); vb[ks] = CAT8(lo, hi); }
#pragma unroll
        for (int ks = 0; ks < 2; ++ks)
#pragma unroll
            for (int ti = 0; ti < 4; ++ti) {
                const LAS char* ap = L + OA + (16 * ti + cl) * PA + (32 * ks + 4 * gq) * 2;
                const s16x4 lo = *(const LAS s16x4*)ap, hi = *(const LAS s16x4*)(ap + 32);
                o[ti] = MFMA16(CAT8(lo, hi), vb[ks], o[ti]);
            }
#pragma unroll
        for (int ti = 0; ti < 4; ++ti)
#pragma unroll
            for (int r = 0; r < 4; ++r) OD[(size_t)(row0 + 16 * ti + 4 * gq + r) * 2048 + dvc + 16 * wave + cl] = o[ti][r];
#pragma unroll
        for (int t = 0; t < 16; ++t) {
            const f32x4 dc = *(const LAS f32x4*)(L + ODEC + (16 * t + 4 * gq) * 4);
            S[t] = S[t] * dc;
#pragma unroll
            for (int ks = 0; ks < 2; ++ks) { const LAS char* kp = L + OK_ + (32 * ks + 4 * gq + (cl >> 2)) * PK + 32 * t + 8 * (cl & 3);
                const s16x4 lo = vtr(kp), hi = vtr(kp + 16 * PK); S[t] = MFMA16(CAT8(lo, hi), vb[ks], S[t]); }
        }
        __syncthreads();
        if (s + 1 < nch) { LWRITE(); }
        __syncthreads();
    }
    if (!sample) { float* so = F.out + (d == 0 ? O_GF : O_GB) + ((size_t)(seq * 4 + h) * 256) * 512 + sl * 128 + 16 * wave + cl;
#pragma unroll
        for (int t = 0; t < 16; ++t)
#pragma unroll
            for (int r = 0; r < 4; ++r) so[(size_t)(16 * t + 4 * gq + r) * 512] = S[t][r];
    }
#undef GLOAD
#undef LWRITE
}
__device__ __forceinline__ void gla_scan_phase(Frame& F) {
    const int NS = 64;
    if (F.G > 2 * NS) {
        if (F.bx < NS) { const int c = F.bx; gla_scan_item(F, 32 + (c >> 5), (c >> 3) & 3, (c >> 2) & 1, c & 3); }
        else for (int it = F.bx - NS; it < 1024; it += F.G - NS) gla_scan_item(F, it >> 5, (it >> 3) & 3, (it >> 2) & 1, it & 3);
    } else {
        for (int it = F.bx; it < 1024 + NS; it += F.G) { if (it < NS) gla_scan_item(F, 32 + (it >> 5), (it >> 3) & 3, (it >> 2) & 1, it & 3); else { const int i2 = it - NS; gla_scan_item(F, i2 >> 5, (i2 >> 3) & 3, (i2 >> 2) & 1, i2 & 3); } }
    }
}
__device__ __forceinline__ void gla_post_phase(Frame& F) {
    const int gw = F.bx * NWAVES + F.wave, NGW = F.G * NWAVES, lane = F.lane;
    const float* OFp = WSP(float, WS_GOF); const float* OBp = WSP(float, WS_GOB); const bf16* GR = WSP(bf16, WS_GR); bf16* AO = WSP(bf16, WS_AO); const float* gn = F.in[I_GNORM];
    for (int row = gw; row < MTOK; row += NGW) {
#pragma unroll
        for (int hh = 0; hh < 4; ++hh) {
            const size_t o0 = (size_t)row * 2048 + hh * 512 + 4 * lane;
            const f32x4 v0 = *(const f32x4*)(OFp + o0) + *(const f32x4*)(OBp + o0), v1 = *(const f32x4*)(OFp + o0 + 256) + *(const f32x4*)(OBp + o0 + 256);
            float ss = (v0[0] * v0[0] + v0[1] * v0[1]) + (v0[2] * v0[2] + v0[3] * v0[3]) + (v1[0] * v1[0] + v1[1] * v1[1]) + (v1[2] * v1[2] + v1[3] * v1[3]);
            const float rstd = rsqrtf(wave_sum(ss) * (1.f / 512.f) + EPS);
            const v2u r0 = *(const v2u*)(GR + o0), r1 = *(const v2u*)(GR + o0 + 256);
            f32x4 ra = {bf2f((unsigned short)(r0.x & 0xffff)), bf2f((unsigned short)(r0.x >> 16)), bf2f((unsigned short)(r0.y & 0xffff)), bf2f((unsigned short)(r0.y >> 16))};
            f32x4 rb = {bf2f((unsigned short)(r1.x & 0xffff)), bf2f((unsigned short)(r1.x >> 16)), bf2f((unsigned short)(r1.y & 0xffff)), bf2f((unsigned short)(r1.y >> 16))};
#pragma unroll
            for (int i = 0; i < 4; ++i) { ra[i] = ra[i] / (1.f + __expf(-ra[i])); rb[i] = rb[i] / (1.f + __expf(-rb[i])); }
            const f32x4 y0 = v0 * rstd * *(const f32x4*)(gn + 4 * lane) * ra, y1 = v1 * rstd * *(const f32x4*)(gn + 256 + 4 * lane) * rb;
            v2u w; w.x = cvtpk(y0[0], y0[1]); w.y = cvtpk(y0[2], y0[3]); *(v2u*)(AO + o0) = w;
            w.x = cvtpk(y1[0], y1[1]); w.y = cvtpk(y1[2], y1[3]); *(v2u*)(AO + o0 + 256) = w;
        }
    }
}

#ifndef MK_N_LAUNCHES
#define MK_N_LAUNCHES 1
#endif
constexpr int N_PHASES = 34;
__global__ void __launch_bounds__(NWAVES * 64, 2) mk_fwd(Args args) {
    extern __shared__ __attribute__((aligned(16))) unsigned char lds[];
    Frame F;
    F.lds = (LAS unsigned char*)lds; F.ldsg = lds;
    F.tid = threadIdx.x; F.lane = F.tid & 63; F.wave = __builtin_amdgcn_readfirstlane(F.tid >> 6);
    F.G = gridDim.x; F.bx = blockIdx.x;
    F.in = args.in; F.out = args.out; F.ws = args.ws;
    volatile LAS unsigned* MISC = (volatile LAS unsigned*)(F.lds + MISC_OFF);
    if (F.tid < 32) MISC[F.tid] = 0u;
    __syncthreads();
    const int lo = args.ph_lo, hi = args.ph_hi;
    const bool use_bar = (hi - lo) > 1;
    XcdBarrier bar; bar.bar = (unsigned*)(F.ws + WS_CTL) + CW_BAR + args.li * XCD_BAR_WORDS; bar.x = 0; bar.st = nullptr;
    if (use_bar) bar = xcd_barrier_post((unsigned*)(F.ws + WS_CTL) + CW_BAR + args.li * XCD_BAR_WORDS, MISC + 8);
#ifdef PH_ONLY
#define IN(k) ((k) == PH_ONLY && lo <= (k) && (k) < hi)
#else
#define IN(k) (lo <= (k) && (k) < hi)
#endif
#define SEAM(k) do { if (IN(k) && IN((k) + 1)) xcd_barrier(bar); } while (0)
    LAS unsigned char* ring = F.lds;

    if (IN(0)) { p0_prologue(F); } SEAM(0);

#define GEMM_PHASE(EpiT, epi, Aptr, Bptr, M_, N_, K_) do { pg8::Gemm g{(const pg8::bf16_t*)(Aptr), (const pg8::bf16_t*)(Bptr), (M_), (N_), (K_)}; pg8::StaticOrder S; S.init((M_), (N_), F.G, F.bx); \
        pg8::gemm_phase<EpiT, pg8::StaticOrder, true, true>(ring, g, S, epi); } while (0)

#define LAYER_TAIL(P, L, WOT) \
    if (IN((P))) { EpiResid E{F.in[I_XP], F.in[I_XS], WSP(float, WS_X), WSP(float, WS_MOD) + (size_t)((L) * 3) * 12288 + 2 * 2048, (L) == 0 ? 1 : 0}; \
        GEMM_PHASE(EpiResid, E, WSP(bf16, WS_AO), (WOT), MTOK, DM, DM); } SEAM((P)); \
    if (IN((P) + 1)) { mod_phase(F, (L), 1, 0); } SEAM((P) + 1); \
    if (IN((P) + 2)) { EpiRelu2 E{WSP(bf16, WS_HID), FFH}; GEMM_PHASE(EpiRelu2, E, WSP(bf16, WS_H), WSP(bf16, WS_W1T) + (size_t)(L) * FFH * DM, MTOK, FFH, DM); } SEAM((P) + 2); \
    if (IN((P) + 3)) { EpiResid E{F.in[I_XP], F.in[I_XS], WSP(float, WS_X), WSP(float, WS_MOD) + (size_t)((L) * 3) * 12288 + 5 * 2048, 0}; \
        GEMM_PHASE(EpiResid, E, WSP(bf16, WS_HID), WSP(bf16, WS_W2T) + (size_t)(L) * DM * FFH, MTOK, DM, FFH); } SEAM((P) + 3);

#define WIN_LAYER(P, L, J) \
    if (IN((P))) { mod_phase(F, (L), 0, (L) == 0 ? 1 : 0); } SEAM((P)); \
    if (IN((P) + 1)) { EpiQkvWin E{WSP(bf16, WS_WQ), WSP(bf16, WS_WK), WSP(bf16, WS_WV), F.out + O_WK, F.out + O_WV, (J), WSP(f32x2, WS_TABW)}; \
        GEMM_PHASE(EpiQkvWin, E, WSP(bf16, WS_H), WSP(bf16, WS_WQKVT) + (size_t)(J) * 3072 * DM, MTOK, 3072, DM); } SEAM((P) + 1); \
    if (IN((P) + 2)) { attn_win_phase(F, (J)); } SEAM((P) + 2); \
    LAYER_TAIL((P) + 3, (L), WSP(bf16, WS_WWOT) + (size_t)(J) * DM * DM)

    WIN_LAYER(1, 0, 0)
    if (IN(8)) { mod_phase(F, 1, 0, 0); } SEAM(8);
    if (IN(9)) { EpiF32 E{WSP(float, WS_MD), 1024}; GEMM_PHASE(EpiF32, E, WSP(bf16, WS_H), WSP(bf16, WS_MWDT), MTOK, 1024, DM); } SEAM(9);
    if (IN(10)) { mla_norm_phase(F); } SEAM(10);
    if (IN(11)) {
        { EpiMlaQ E{WSP(bf16, WS_MQ), WSP(f32x2, WS_TABM)}; GEMM_PHASE(EpiMlaQ, E, WSP(bf16, WS_MCQ), WSP(bf16, WS_MWUQT), MTOK, 3072, 512); }
        { EpiMlaKV E{WSP(bf16, WS_MKN), WSP(bf16, WS_MV)}; GEMM_PHASE(EpiMlaKV, E, WSP(bf16, WS_MCKV), WSP(bf16, WS_MWUKVT), MTOK + 1024, 4096, 256); }
    } SEAM(11);
    if (IN(12)) { attn_mla_phase(F); } SEAM(12);
    LAYER_TAIL(13, 1, WSP(bf16, WS_MWOT))
    if (IN(17)) { mod_phase(F, 2, 0, 0); } SEAM(17);
    if (IN(18)) { EpiGlaIn E{WSP(bf16, WS_GQ), WSP(bf16, WS_GK), WSP(bf16, WS_GV), WSP(bf16, WS_GR), WSP(float, WS_GU)}; GEMM_PHASE(EpiGlaIn, E, WSP(bf16, WS_H), WSP(bf16, WS_GWINT), MTOK, 6400, DM); } SEAM(18);
    if (IN(19)) { gla_prep_phase(F); } SEAM(19);
    if (IN(20)) { gla_scan_phase(F); } SEAM(20);
    if (IN(21)) { gla_post_phase(F); } SEAM(21);
    LAYER_TAIL(22, 2, WSP(bf16, WS_GWOT))
    WIN_LAYER(26, 3, 1)
    if (IN(33)) { final_phase(F); }
#undef IN
#undef SEAM
}

extern "C" void kernel_launch(void* const* d_in, const int* in_sizes, int n_in, void* d_out, int out_size, void* d_ws, size_t ws_size, hipStream_t stream) {
    static int grid = 0;
    if (grid == 0) {
        if (n_in != 31 || (size_t)out_size != O_END || ws_size < WS_END) { fprintf(stderr, "kernel_launch: shape mismatch n_in %d out %d ws %zu (need %zu)\n", n_in, out_size, ws_size, (size_t)WS_END); grid = -1; return; }
        int dev = 0, cus = 0, per_cu = 0;
        if (hipGetDevice(&dev) != hipSuccess || hipDeviceGetAttribute(&cus, hipDeviceAttributeMultiprocessorCount, dev) != hipSuccess) { grid = -1; return; }
        if (hipFuncSetAttribute((const void*)mk_fwd, hipFuncAttributeMaxDynamicSharedMemorySize, LDS_BYTES) != hipSuccess) { fprintf(stderr, "kernel_launch: hipFuncSetAttribute failed\n"); grid = -1; return; }
        if (hipOccupancyMaxActiveBlocksPerMultiprocessor(&per_cu, (const void*)mk_fwd, NWAVES * 64, LDS_BYTES) != hipSuccess || per_cu < 1) fprintf(stderr, "kernel_launch: occupancy query says %d\n", per_cu);
        (void)hipGetLastError();
        grid = cus;
    }
    if (grid < 0) return;
    if (hipMemsetAsync((char*)d_ws + WS_CTL, 0, CTL_ZERO_BYTES, stream) != hipSuccess) return;
    Args a{};
    for (int i = 0; i < 31; ++i) a.in[i] = (const float*)d_in[i];
    a.in[31] = nullptr;
    a.out = (float*)d_out; a.ws = (unsigned char*)d_ws; a.pad = 0;
#if MK_N_LAUNCHES == 1
    a.ph_lo = 0; a.ph_hi = N_PHASES; a.li = 0;
    hipLaunchKernelGGL(mk_fwd, dim3(grid), dim3(NWAVES * 64), LDS_BYTES, stream, a);
#else
    for (int p = 0; p < N_PHASES; ++p) { a.ph_lo = p; a.ph_hi = p + 1; a.li = 0; hipLaunchKernelGGL(mk_fwd, dim3(grid), dim3(NWAVES * 64), LDS_BYTES, stream, a); }
#endif
}
```

```cpp
#include <hip/hip_runtime.h>
#include <cstdio>
#include <cstdint>
namespace pg8 {
#define PG8_LAS __attribute__((address_space(3)))
typedef unsigned short bf16_t;
typedef short bf16x8 __attribute__((ext_vector_type(8)));
typedef float f32x4 __attribute__((ext_vector_type(4)));
typedef unsigned u32x4 __attribute__((ext_vector_type(4)));
constexpr int BM = 256, BK = 64, HALF = 128, HTB = HALF * BK * 2  , STAGE_BYTES = 8 * HTB, NXCD = 8, WGM = 8;

__host__ __device__ __forceinline__ int lds_byte(int r, int c) { const int st = (r >> 4) * 2 + (c >> 5), rr = r & 15, cc = c & 31, ob = rr * 64 + cc * 2; return st * 1024 + (ob ^ (((ob >> 9) & 1) << 5)); }
__host__ __device__ __forceinline__ void stage_rc(int b, int& R, int& C) { const int st = b / 1024, sb = b % 1024, swz = sb ^ (((sb >> 9) & 1) << 5); R = (st >> 1) * 16 + swz / 64; C = (st & 1) * 32 + (swz % 64) / 2; }
__host__ __device__ __forceinline__ int perm32(int rho) { const int n = rho >> 4, i = rho & 15; return 8 * (i >> 2) + 4 * n + (i & 3); }

struct Unit { int pm, pn; };
struct Gemm { const bf16_t* A; const bf16_t* Bt; int M, N, K; };

struct StaticOrder {
    int nM, nN, nwg, G, c;
    __host__ __device__ void init(int M, int N, int G_, int c_) { nM = M / BM; nN = N / BM; nwg = nM * nN; G = G_; c = c_; }
    __host__ __device__ bool next(int i, Unit& u) const {
        const long L = (long)i * G + c; if (L >= nwg) return false;
        int wgid = (int)L; { const int q = nwg / NXCD, r = nwg % NXCD, xcd = wgid % NXCD, off = wgid / NXCD; wgid = (xcd < r ? xcd * (q + 1) : r * (q + 1) + (xcd - r) * q) + off; }
        const int nig = WGM * nN, gid = wgid / nig, fm = gid * WGM, gsz = (nM - fm) < WGM ? (nM - fm) : WGM;
        u.pm = fm + ((wgid % nig) % gsz); u.pn = (wgid % nig) / gsz; return true;
    }
    __device__ __forceinline__ void a_ready(const Unit&) const {}
    __device__ __forceinline__ void done(const Unit&) const {}
};
__device__ __forceinline__ unsigned cvt_pk_bf16(float lo, float hi) { unsigned r; asm volatile("v_cvt_pk_bf16_f32 %0, %1, %2" : "=v"(r) : "v"(lo), "v"(hi)); return r; }
typedef float f32x2 __attribute__((ext_vector_type(2)));
template <class Epi, class Sched, bool ALIGN_EPI = false, bool SP2 = false>
__device__ __forceinline__ void gemm_phase(PG8_LAS unsigned char* lds, const Gemm g, const Sched& S, const Epi& E) {
    const int tid = threadIdx.x, wid = __builtin_amdgcn_readfirstlane(tid >> 6), lane = tid & 63, wr = wid >> 2, wc = wid & 3, fr = lane & 15, fq = lane >> 4;
    const int K = g.K, nt = K / BK;
    unsigned voffA[2], voffB[2];
#pragma unroll
    for (int i = 0; i < 2; ++i) { int R, C; stage_rc(tid * 16 + i * 8192, R, C); const int Rb = Epi::PERM ? ((R & ~31) + perm32(R & 31)) : R;
        voffA[i] = (unsigned)(R * K + C) * 2u; voffB[i] = (unsigned)(Rb * K + C) * 2u; }
    const size_t kstep = (size_t)(BK * 2);
    const size_t hstep = (size_t)HALF * K * 2;
    const size_t tstep = 2 * hstep;
    const unsigned ldsw = (unsigned)wid * 1024u;
    const int aoff = lds_byte(wr * 64 + fr, fq * 8), boff = lds_byte(wc * 32 + fr, fq * 8);
#define PG8_SA(b, h) (((b) * 2 + (h)) * HTB)
#define PG8_SB(b, h) ((4 + (b) * 2 + (h)) * HTB)
#define PG8_STAGE(bufoff, gbase, voff) do { _Pragma("unroll") for (int _i = 0; _i < 2; ++_i) \
        __builtin_amdgcn_global_load_lds((const unsigned*)((const char*)(gbase) + (voff)[_i]), (PG8_LAS unsigned*)(lds + (bufoff) + ldsw + _i * 8192), 16, 0, 0); } while (0)
#define PG8_LDA(dst, b, h) do { _Pragma("unroll") for (int m = 0; m < 4; ++m) _Pragma("unroll") for (int k = 0; k < 2; ++k) dst[m][k] = *(const PG8_LAS bf16x8*)(lds + PG8_SA(b, h) + aoff + m * 2048 + k * 1024); } while (0)
#define PG8_LDB(dst, b, h) do { _Pragma("unroll") for (int n = 0; n < 2; ++n) _Pragma("unroll") for (int k = 0; k < 2; ++k) dst[n][k] = *(const PG8_LAS bf16x8*)(lds + PG8_SB(b, h) + boff + n * 2048 + k * 1024); } while (0)
#define PG8_MMA(ai, bj, At, Bt) do { __builtin_amdgcn_s_setprio(1); _Pragma("unroll") for (int m = 0; m < 4; ++m) _Pragma("unroll") for (int n = 0; n < 2; ++n) _Pragma("unroll") for (int k = 0; k < 2; ++k) \
        acc[ai][bj][m][n] = __builtin_amdgcn_mfma_f32_16x16x32_bf16(Bt[n][k], At[m][k], acc[ai][bj][m][n], 0, 0, 0); __builtin_amdgcn_s_setprio(0); } while (0)
#define PG8_WAIT_V(n) asm volatile("s_waitcnt vmcnt(" #n ")" ::: "memory")
#define PG8_WAIT_L(n) asm volatile("s_waitcnt lgkmcnt(" #n ")" ::: "memory")
#define PG8_BAR __builtin_amdgcn_s_barrier()
#define PG8_SCHED __builtin_amdgcn_sched_barrier(0)
    Unit cur, nxt; int ui = 0;
    if (!S.next(0, cur)) return;
    f32x4 acc[2][2][4][2];
#pragma unroll
    for (int a = 0; a < 2; ++a)
#pragma unroll
        for (int b = 0; b < 2; ++b)
#pragma unroll
            for (int m = 0; m < 4; ++m)
#pragma unroll
                for (int n = 0; n < 2; ++n) acc[a][b][m][n] = (f32x4){0.f, 0.f, 0.f, 0.f};
    bf16x8 At[4][2], B0[2][2], B1[2][2];
    const char* cA = (const char*)g.A + (size_t)cur.pm * tstep; const char* cB = (const char*)g.Bt + (size_t)cur.pn * tstep;
    S.a_ready(cur);
    if constexpr (SP2) {
        PG8_STAGE(PG8_SB(0, 0), cB, voffB); PG8_STAGE(PG8_SB(0, 1), cB + hstep, voffB); PG8_STAGE(PG8_SA(0, 0), cA, voffA); PG8_STAGE(PG8_SA(0, 1), cA + hstep, voffA);
        if (wr == 1) PG8_BAR;
        PG8_WAIT_V(2); PG8_BAR;
        PG8_STAGE(PG8_SB(1, 0), cB + kstep, voffB); PG8_STAGE(PG8_SA(1, 0), cA + kstep, voffA); PG8_STAGE(PG8_SB(1, 1), cB + hstep + kstep, voffB);
        PG8_WAIT_V(6); PG8_BAR;
    } else {
        PG8_STAGE(PG8_SB(0, 0), cB, voffB); PG8_STAGE(PG8_SA(0, 0), cA, voffA); PG8_STAGE(PG8_SB(0, 1), cB + hstep, voffB); PG8_STAGE(PG8_SA(0, 1), cA + hstep, voffA);
        if (wr == 1) PG8_BAR;
        PG8_WAIT_V(4); PG8_BAR;
        PG8_STAGE(PG8_SB(1, 0), cB + kstep, voffB); PG8_STAGE(PG8_SA(1, 0), cA + kstep, voffA); PG8_STAGE(PG8_SB(1, 1), cB + hstep + kstep, voffB);
        PG8_WAIT_V(6); PG8_BAR;
    }
    for (;;) {
        const bool has_next = S.next(ui + 1, nxt);
        const char* nA = has_next ? (const char*)g.A + (size_t)nxt.pm * tstep : cA; const char* nB = has_next ? (const char*)g.Bt + (size_t)nxt.pn * tstep : cB;
        for (int t = 0; t < nt; t += 2) {
            const bool last = (t == nt - 2);
            const char* a1 = cA + (size_t)(t + 1) * kstep;
            const char* a2 = last ? nA : cA + (size_t)(t + 2) * kstep; const char* b2 = last ? nB : cB + (size_t)(t + 2) * kstep;
            const char* a3 = a2 + kstep; const char* b3 = b2 + kstep;
            if (last && has_next) S.a_ready(nxt);
            if constexpr (SP2) {
            PG8_LDB(B0, 0, 0); PG8_LDB(B1, 0, 1); PG8_SCHED; PG8_LDA(At, 0, 0); PG8_STAGE(PG8_SA(1, 1), a1 + hstep, voffA);
            PG8_WAIT_V(8); PG8_WAIT_L(0); PG8_BAR; PG8_MMA(0, 0, At, B0); PG8_MMA(0, 1, At, B1); PG8_BAR; PG8_SCHED;
            PG8_LDA(At, 0, 1); PG8_STAGE(PG8_SB(0, 0), b2, voffB); PG8_STAGE(PG8_SB(0, 1), b2 + hstep, voffB); PG8_STAGE(PG8_SA(0, 0), a2, voffA);
            PG8_WAIT_V(8); PG8_WAIT_L(0); PG8_BAR; PG8_MMA(1, 0, At, B0); PG8_MMA(1, 1, At, B1); PG8_BAR; PG8_SCHED;
            PG8_LDB(B0, 1, 0); PG8_LDB(B1, 1, 1); PG8_SCHED; PG8_LDA(At, 1, 0); PG8_STAGE(PG8_SA(0, 1), a2 + hstep, voffA);
            PG8_WAIT_V(8); PG8_WAIT_L(0); PG8_BAR; PG8_MMA(0, 0, At, B0); PG8_MMA(0, 1, At, B1); PG8_BAR; PG8_SCHED;
            PG8_LDA(At, 1, 1); PG8_STAGE(PG8_SB(1, 0), b3, voffB); PG8_STAGE(PG8_SB(1, 1), b3 + hstep, voffB); PG8_STAGE(PG8_SA(1, 0), a3, voffA);
            PG8_WAIT_V(8); PG8_WAIT_L(0); PG8_BAR; PG8_MMA(1, 0, At, B0); PG8_MMA(1, 1, At, B1); PG8_BAR; PG8_SCHED;
            } else {
            PG8_LDB(B0, 0, 0); PG8_SCHED; PG8_LDA(At, 0, 0); PG8_STAGE(PG8_SA(1, 1), a1 + hstep, voffA);
            PG8_WAIT_L(8); PG8_BAR; PG8_WAIT_L(0); PG8_MMA(0, 0, At, B0); PG8_BAR; PG8_SCHED;
            PG8_LDB(B1, 0, 1); PG8_STAGE(PG8_SB(0, 0), b2, voffB);
            PG8_BAR; PG8_WAIT_L(0); PG8_MMA(0, 1, At, B1); PG8_BAR;
            PG8_LDA(At, 0, 1); PG8_STAGE(PG8_SA(0, 0), a2, voffA);
            PG8_BAR; PG8_WAIT_L(0); PG8_MMA(1, 0, At, B0); PG8_BAR; PG8_SCHED;
            PG8_STAGE(PG8_SB(0, 1), b2 + hstep, voffB);
            PG8_WAIT_V(6); PG8_BAR; PG8_MMA(1, 1, At, B1); PG8_BAR;
            PG8_LDB(B0, 1, 0); PG8_SCHED; PG8_LDA(At, 1, 0); PG8_STAGE(PG8_SA(0, 1), a2 + hstep, voffA);
            PG8_WAIT_L(8); PG8_BAR; PG8_WAIT_L(0); PG8_MMA(0, 0, At, B0); PG8_BAR; PG8_SCHED;
            PG8_LDB(B1, 1, 1); PG8_STAGE(PG8_SB(1, 0), b3, voffB);
            PG8_BAR; PG8_WAIT_L(0); PG8_MMA(0, 1, At, B1); PG8_BAR;
            PG8_LDA(At, 1, 1); PG8_STAGE(PG8_SA(1, 0), a3, voffA);
            PG8_BAR; PG8_WAIT_L(0); PG8_MMA(1, 0, At, B0); PG8_BAR; PG8_SCHED;
            PG8_STAGE(PG8_SB(1, 1), b3 + hstep, voffB);
            PG8_WAIT_V(6); PG8_BAR; PG8_MMA(1, 1, At, B1); PG8_BAR;
            }
        }
        if constexpr (ALIGN_EPI) { if (wr == 0) PG8_BAR; }
        if constexpr (!Epi::AFTER_DRAIN) { E(acc, cur, wr, wc, fr, fq); S.done(cur); }
        if (!has_next) break;
#pragma unroll
        for (int a = 0; a < 2; ++a)
#pragma unroll
            for (int b = 0; b < 2; ++b)
#pragma unroll
                for (int m = 0; m < 4; ++m)
#pragma unroll
                    for (int n = 0; n < 2; ++n) acc[a][b][m][n] = (f32x4){0.f, 0.f, 0.f, 0.f};
        cur = nxt; cA = nA; cB = nB; ++ui;
        if constexpr (ALIGN_EPI) { if (wr == 1) PG8_BAR; }
    }
    PG8_WAIT_V(0);
    if constexpr (!ALIGN_EPI) { if (wr == 0) PG8_BAR; }
    PG8_BAR;
    if constexpr (Epi::AFTER_DRAIN) { E.fused(acc, cur, wr, wc, fr, fq, lds, wid, lane); S.done(cur); }
#undef PG8_SA
#undef PG8_SB
#undef PG8_STAGE
#undef PG8_LDA
#undef PG8_LDB
#undef PG8_MMA
#undef PG8_WAIT_V
#undef PG8_WAIT_L
#undef PG8_BAR
#undef PG8_SCHED
}
}

#define GAS __attribute__((address_space(1)))
#define LAS __attribute__((address_space(3)))
typedef unsigned short bf16;
typedef unsigned v4u __attribute__((ext_vector_type(4)));
typedef unsigned v2u __attribute__((ext_vector_type(2)));
typedef float f32x4 __attribute__((ext_vector_type(4)));
typedef float f32x2 __attribute__((ext_vector_type(2)));
typedef float f32x16 __attribute__((ext_vector_type(16)));
typedef short bf16x8 __attribute__((ext_vector_type(8)));
typedef short s16x4 __attribute__((ext_vector_type(4)));
typedef GAS unsigned gu32;
#define RLX_AGENT __ATOMIC_RELAXED, __HIP_MEMORY_SCOPE_AGENT
#define LDS_WAIT() asm volatile("s_waitcnt lgkmcnt(0)" ::: "memory")
#define VM_WAIT() asm volatile("s_waitcnt vmcnt(0)" ::: "memory")
#define SBAR() __builtin_amdgcn_sched_barrier(0)
__device__ __forceinline__ unsigned f2bf(float f) { unsigned u = __builtin_bit_cast(unsigned, f); return (u + 0x7fffu + ((u >> 16) & 1u)) >> 16; }
__device__ __forceinline__ unsigned pk2(float lo, float hi) { return f2bf(lo) | (f2bf(hi) << 16); }
__device__ __forceinline__ float bf2f(unsigned short b) { return __builtin_bit_cast(float, (unsigned)b << 16); }
__device__ __forceinline__ unsigned cvtpk(float lo, float hi) { unsigned r; asm volatile("v_cvt_pk_bf16_f32 %0, %1, %2" : "=v"(r) : "v"(lo), "v"(hi)); return r; }
__device__ __forceinline__ float wave_sum(float v) {
#pragma unroll
    for (int o = 1; o < 64; o <<= 1) v += __shfl_xor(v, o);
    return v;
}
#define XB_TMO      128
#define XB_XCNT(j)  (256  + 64 * (j))
#define XB_XSUB(j)  (1280 + 64 * (j))
#define XB_XGEN(j)  (2304 + 64 * (j))
#define XB_TOP      3328
#define XB_TOPGEN   3392
#define XCD_BAR_WORDS 3456
#define XB_SPIN_CAP (1u << 18)

__device__ __forceinline__ unsigned xb_ld(unsigned* p)              { return __hip_atomic_load(p, __ATOMIC_RELAXED, __HIP_MEMORY_SCOPE_AGENT); }
__device__ __forceinline__ unsigned xb_add(unsigned* p, unsigned v) { return __hip_atomic_fetch_add(p, v, __ATOMIC_RELAXED, __HIP_MEMORY_SCOPE_AGENT); }
__device__ __forceinline__ unsigned xb_xcc_id() { return (unsigned)__builtin_amdgcn_s_getreg((3 << 11) | 20) & 0xFu; }
#define XB_SPIN(cond, bar) do { unsigned _sp = 0; while (cond) { __builtin_amdgcn_s_sleep(1); \
    if ((++_sp & 255u) == 0u) { if (xb_ld(&(bar)[XB_TMO])) break; if (_sp > XB_SPIN_CAP) { atomicAdd(&(bar)[XB_TMO], 1u); break; } } } } while (0)

struct XcdBarrier {
    unsigned* bar; unsigned x;
    volatile LAS unsigned* st;
};

__device__ __forceinline__ XcdBarrier xcd_barrier_post(unsigned* bar, volatile LAS unsigned* st) {
    XcdBarrier b; b.bar = bar; b.x = xb_xcc_id(); b.st = st;
    if (threadIdx.x == 0) (void)xb_add(&bar[XB_XCNT(b.x)], 1u);
    return b;
}
__device__ __forceinline__ void xcd_barrier_complete(unsigned* bar, unsigned x, unsigned& nloc, unsigned& nx) {
    const unsigned G = gridDim.x * gridDim.y * gridDim.z;
    unsigned sum, cnt, mine, sp = 0u;
    for (;;) {
        sum = 0u; cnt = 0u; mine = 0u;
#pragma unroll
        for (unsigned j = 0; j < 16; ++j) { const unsigned c = xb_ld(&bar[XB_XCNT(j)]); sum += c; cnt += (c > 0u) ? 1u : 0u; mine = (j == x) ? c : mine; }
        if (sum == G) break;
        __builtin_amdgcn_s_sleep(1);
        if ((++sp & 255u) == 0u) { if (xb_ld(&bar[XB_TMO])) break; if (sp > XB_SPIN_CAP) { atomicAdd(&bar[XB_TMO], 1u); break; } }
    }
    nloc = mine > 0u ? mine : 1u; nx = cnt > 0u ? cnt : 1u;
}

__device__ __forceinline__ void xcd_barrier(const XcdBarrier& b) {
    asm volatile("s_waitcnt vmcnt(0)" ::: "memory");
    __syncthreads();
    if (threadIdx.x == 0) {
        unsigned* bar = b.bar;
        __builtin_amdgcn_s_waitcnt(0);
        unsigned nloc = b.st[0], nx = b.st[1];
        if (nloc == 0u) { xcd_barrier_complete(bar, b.x, nloc, nx); b.st[0] = nloc; b.st[1] = nx; }
        const unsigned old = xb_add(&bar[XB_XSUB(b.x)], 1u);
        const unsigned gen = old / nloc;
        if (old + 1u == (gen + 1u) * nloc) {
            __builtin_amdgcn_fence(__ATOMIC_RELEASE, "agent");
            asm volatile("s_waitcnt vmcnt(0)" ::: "memory");
            const unsigned og = xb_add(&bar[XB_TOP], 1u);
            const unsigned tg = og / nx;
            if (og + 1u == (tg + 1u) * nx) xb_add(&bar[XB_TOPGEN], 1u);
            else XB_SPIN(xb_ld(&bar[XB_TOPGEN]) == tg, bar);
            __builtin_amdgcn_fence(__ATOMIC_ACQUIRE, "agent");
            xb_add(&bar[XB_XGEN(b.x)], 1u);
            asm volatile("s_waitcnt vmcnt(0)" ::: "memory");
        } else {
            XB_SPIN(xb_ld(&bar[XB_XGEN(b.x)]) == gen, bar);
            __builtin_amdgcn_fence(__ATOMIC_ACQUIRE, "agent");
            asm volatile("s_waitcnt vmcnt(0)" ::: "memory");
        }
    }
    __syncthreads();
}

constexpr int NWAVES = 8;
constexpr int DM = 2048, MTOK = 16384, MP = 8192, FFH = 8192;
constexpr float EPS = 1e-6f;
constexpr size_t MiB = 1u << 20;
constexpr size_t WS_CTL = 0, CTL_ZERO_BYTES = 1 * MiB;
constexpr size_t WS_MOD = 1 * MiB;
constexpr size_t WS_TABW = 2 * MiB;
constexpr size_t WS_TABM = 2 * MiB + 65536;
constexpr size_t WS_W1T = 4 * MiB;
constexpr size_t WS_W2T = 132 * MiB;
constexpr size_t WS_WQKVT = 260 * MiB;
constexpr size_t WS_WWOT = 284 * MiB;
constexpr size_t WS_MWDT = 300 * MiB;
constexpr size_t WS_MWUQT = 304 * MiB;
constexpr size_t WS_MWUKVT = 307 * MiB;
constexpr size_t WS_MWOT = 309 * MiB;
constexpr size_t WS_GWINT = 317 * MiB;
constexpr size_t WS_GWOT = 342 * MiB;
constexpr size_t WS_CTXK = 350 * MiB;
constexpr size_t WS_CTXV = 352 * MiB;
constexpr size_t WS_X = 354 * MiB;
constexpr size_t WS_H = 482 * MiB;
constexpr size_t WS_AO = 546 * MiB;
constexpr size_t WS_SCR = 610 * MiB;
constexpr size_t WS_HID = WS_SCR;
constexpr size_t WS_WQ = WS_SCR, WS_WK = WS_SCR + 64 * MiB, WS_WV = WS_SCR + 80 * MiB;
constexpr size_t WS_MD = WS_SCR, WS_MCQ = WS_SCR + 64 * MiB, WS_MCKV = WS_SCR + 80 * MiB, WS_MKR = WS_SCR + 89 * MiB, WS_MQ = WS_SCR + 92 * MiB, WS_MKN = WS_SCR + 188 * MiB, WS_MV = WS_SCR + 256 * MiB;
constexpr size_t WS_GQ = WS_SCR, WS_GK = WS_SCR + 32 * MiB, WS_GV = WS_SCR + 64 * MiB, WS_GR = WS_SCR + 128 * MiB, WS_GU = WS_SCR + 192 * MiB,
                 WS_GQT = WS_SCR + 194 * MiB, WS_GKD = WS_SCR + 258 * MiB, WS_GAM = WS_SCR + 322 * MiB, WS_GDEC = WS_SCR + 338 * MiB, WS_GOF = WS_SCR + 340 * MiB, WS_GOB = WS_SCR + 468 * MiB;
constexpr size_t WS_END = WS_SCR + 596 * MiB;
constexpr size_t O_YP = 0, O_YS = 16777216, O_WK = 33554432, O_WV = 41943040, O_CKV = 50331648, O_KR = 52428800, O_GF = 52953088, O_GB = 69730304, O_END = 86507520;
constexpr int CW_BAR = 4096;
constexpr int RING_BYTES = 131072, MISC_OFF = 135168 + 320, LDS_BYTES = 147456;

struct Args {
    const float* in[32]; float* out; unsigned char* ws; int ph_lo, ph_hi, li, pad; unsigned long long rep_mask; int rep_n, pad2;
};
enum { I_XP = 0, I_XS, I_C, I_CWK, I_CWV, I_CCKV, I_CKR, I_SGF, I_SGB, I_CCTX, I_ADAW, I_ADAB, I_NORMG, I_WQKV, I_SINK, I_WWO, I_MWD, I_MQN, I_MWUQ, I_MKVN, I_MWUKV, I_MWO,
       I_GWIN, I_GWA1, I_GWA2, I_GBA, I_GNORM, I_GWO, I_W1, I_W2, I_FNORM };

__device__ __forceinline__ int cond_of_pm(int pm) { return pm < 32 ? 0 : (pm >> 4) - 1; }

struct EpiResid {
    static constexpr bool PERM = true, AFTER_DRAIN = false;
    const float* xp; const float* xs; float* X; const float* gate; int first;
    __device__ __forceinline__ void operator()(const pg8::f32x4 (&acc)[2][2][4][2], const pg8::Unit& u, int wr, int wc, int fr, int fq) const {
        const int row0 = u.pm * 256 + wr * 64 + fr, col0 = u.pn * 256 + wc * 32 + 8 * fq;
        const float* gp = gate + (size_t)cond_of_pm(u.pm) * 12288 + col0;
        f32x4 gv[2][2];
#pragma unroll
        for (int bj = 0; bj < 2; ++bj)
#pragma unroll
            for (int n = 0; n < 2; ++n) gv[bj][n] = *(const f32x4*)(gp + bj * 128 + 4 * n);
#pragma unroll
        for (int ai = 0; ai < 2; ++ai)
#pragma unroll
            for (int m = 0; m < 4; ++m) {
                const int row = row0 + ai * 128 + m * 16;
                const float* sp = first ? (row < MP ? xp + (size_t)row * DM : xs + (size_t)(row - MP) * DM) : X + (size_t)row * DM;
                float* dp = X + (size_t)row * DM;
#pragma unroll
                for (int bj = 0; bj < 2; ++bj)
#pragma unroll
                    for (int n = 0; n < 2; ++n) {
                        const int c = col0 + bj * 128 + 4 * n;
                        const f32x4 xv = *(const f32x4*)(sp + c);
                        *(f32x4*)(dp + c) = xv + gv[bj][n] * acc[ai][bj][m][n];
                    }
            }
    }
};

struct EpiRelu2 {
    static constexpr bool PERM = true, AFTER_DRAIN = false;
    bf16* O; int ldc;
    __device__ __forceinline__ void operator()(const pg8::f32x4 (&acc)[2][2][4][2], const pg8::Unit& u, int wr, int wc, int fr, int fq) const {
        const int row0 = u.pm * 256 + wr * 64 + fr, col0 = u.pn * 256 + wc * 32 + 8 * fq;
#pragma unroll
        for (int ai = 0; ai < 2; ++ai)
#pragma unroll
            for (int m = 0; m < 4; ++m) {
                bf16* rp = O + (size_t)(row0 + ai * 128 + m * 16) * ldc + col0;
#pragma unroll
                for (int bj = 0; bj < 2; ++bj) {
                    f32x4 a = acc[ai][bj][m][0], b = acc[ai][bj][m][1];
                    a = __builtin_elementwise_max(a, (f32x4){0.f, 0.f, 0.f, 0.f}); b = __builtin_elementwise_max(b, (f32x4){0.f, 0.f, 0.f, 0.f});
                    a = a * a; b = b * b;
                    v4u w; w.x = cvtpk(a[0], a[1]); w.y = cvtpk(a[2], a[3]); w.z = cvtpk(b[0], b[1]); w.w = cvtpk(b[2], b[3]);
                    *(v4u*)(rp + bj * 128) = w;
                }
            }
    }
};

struct EpiF32 {
    static constexpr bool PERM = true, AFTER_DRAIN = false;
    float* O; int ldc;
    __device__ __forceinline__ void operator()(const pg8::f32x4 (&acc)[2][2][4][2], const pg8::Unit& u, int wr, int wc, int fr, int fq) const {
        const int row0 = u.pm * 256 + wr * 64 + fr, col0 = u.pn * 256 + wc * 32 + 8 * fq;
#pragma unroll
        for (int ai = 0; ai < 2; ++ai)
#pragma unroll
            for (int m = 0; m < 4; ++m) {
                float* rp = O + (size_t)(row0 + ai * 128 + m * 16) * ldc + col0;
#pragma unroll
                for (int bj = 0; bj < 2; ++bj) { *(f32x4*)(rp + bj * 128) = acc[ai][bj][m][0]; *(f32x4*)(rp + bj * 128 + 4) = acc[ai][bj][m][1]; }
            }
    }
};

__device__ __forceinline__ v4u pack8(const f32x4& a, const f32x4& b) { v4u w; w.x = cvtpk(a[0], a[1]); w.y = cvtpk(a[2], a[3]); w.z = cvtpk(b[0], b[1]); w.w = cvtpk(b[2], b[3]); return w; }

struct EpiQkvWin {
    static constexpr bool PERM = true, AFTER_DRAIN = false;
    bf16 *Q, *K, *V; float* outk; float* outv; int j; const f32x2* tab;
    __device__ __forceinline__ void operator()(const pg8::f32x4 (&acc)[2][2][4][2], const pg8::Unit& u, int wr, int wc, int fr, int fq) const {
        const int row0 = u.pm * 256 + wr * 64 + fr, cl = wc * 32 + 8 * fq;
        const int pn = u.pn; const bool sample = u.pm >= 32;
        const int ug = 4 * wc + fq, idx0 = (ug & 7) * 4, d1 = (ug < 8 ? 0 : 64) + idx0;
#pragma unroll
        for (int ai = 0; ai < 2; ++ai)
#pragma unroll
            for (int m = 0; m < 4; ++m) {
                const int row = row0 + ai * 128 + m * 16;
                f32x4 cs0 = {1.f, 0.f, 1.f, 0.f}, cs1 = {1.f, 0.f, 1.f, 0.f};
                if (sample && pn < 10) { const int t = row & 4095, pos = (ug < 8) ? (t >> 6) : (t & 63); const f32x4* tp = (const f32x4*)(tab + pos * 32 + idx0); cs0 = tp[0]; cs1 = tp[1]; }
#pragma unroll
                for (int bj = 0; bj < 2; ++bj) {
                    f32x4 a = acc[ai][bj][m][0], b = acc[ai][bj][m][1];
                    if (pn < 10) {
                        if (sample) {
                            const f32x4 co = {cs0[0], cs0[2], cs1[0], cs1[2]}, si = {cs0[1], cs0[3], cs1[1], cs1[3]};
                            const f32x4 na = a * co - b * si, nb = b * co + a * si; a = na; b = nb;
                        }
                        if (pn < 8) { *(v4u*)(Q + (size_t)row * 2048 + pn * 256 + bj * 128 + cl) = pack8(a, b); }
                        else {
                            const int kvh = (pn - 8) * 2 + bj;
                            *(v4u*)(K + (size_t)row * 512 + kvh * 128 + cl) = pack8(a, b);
                            if (!sample) { float* op = outk + ((size_t)(u.pm * 2 + j) * 256 + (row & 255)) * 512 + kvh * 128 + d1; *(f32x4*)op = a; *(f32x4*)(op + 32) = b; }
                        }
                    } else {
                        const int kvh = (pn - 10) * 2 + bj;
                        *(v4u*)(V + (size_t)row * 512 + kvh * 128 + cl) = pack8(a, b);
                        if (!sample) { float* op = outv + ((size_t)(u.pm * 2 + j) * 256 + (row & 255)) * 512 + kvh * 128 + cl; *(f32x4*)op = a; *(f32x4*)(op + 4) = b; }
                    }
                }
            }
    }
};

struct EpiMlaQ {
    static constexpr bool PERM = true, AFTER_DRAIN = false;
    bf16* Q; const f32x2* tab;
    __device__ __forceinline__ void operator()(const pg8::f32x4 (&acc)[2][2][4][2], const pg8::Unit& u, int wr, int wc, int fr, int fq) const {
        const int row0 = u.pm * 256 + wr * 64 + fr, col0 = u.pn * 256 + wc * 32 + 8 * fq;
        const bool sample = u.pm >= 32;
#pragma unroll
        for (int bj = 0; bj < 2; ++bj) {
            const int c0 = col0 + bj * 128, p0 = c0 % 192; const bool isr = p0 >= 128; const int ug = isr ? ((p0 - 128) >> 3) : 0, idx0 = (ug & 3) * 4;
#pragma unroll
            for (int ai = 0; ai < 2; ++ai)
#pragma unroll
                for (int m = 0; m < 4; ++m) {
                    const int row = row0 + ai * 128 + m * 16;
                    f32x4 a = acc[ai][bj][m][0], b = acc[ai][bj][m][1];
                    if (sample) {
                        const int t = row & 4095, pos = (ug < 4) ? (t >> 6) : (t & 63); const f32x4* tp = (const f32x4*)(tab + pos * 16 + idx0); const f32x4 cs0 = tp[0], cs1 = tp[1];
                        const f32x4 co = {cs0[0], cs0[2], cs1[0], cs1[2]}, si = {cs0[1], cs0[3], cs1[1], cs1[3]};
                        const f32x4 na = a * co - b * si, nb = b * co + a * si;
                        if (isr) { a = na; b = nb; }
                    }
                    *(v4u*)(Q + (size_t)row * 3072 + c0) = pack8(a, b);
                }
        }
    }
};

struct EpiMlaKV {
    static constexpr bool PERM = true, AFTER_DRAIN = false;
    bf16 *KN, *V;
    __device__ __forceinline__ void operator()(const pg8::f32x4 (&acc)[2][2][4][2], const pg8::Unit& u, int wr, int wc, int fr, int fq) const {
        const int row0 = u.pm * 256 + wr * 64 + fr, cl = u.pn * 128 + wc * 32 + 8 * fq;
#pragma unroll
        for (int ai = 0; ai < 2; ++ai)
#pragma unroll
            for (int m = 0; m < 4; ++m) {
                const size_t ro = (size_t)(row0 + ai * 128 + m * 16) * 2048 + cl;
                *(v4u*)(KN + ro) = pack8(acc[ai][0][m][0], acc[ai][0][m][1]);
                *(v4u*)(V + ro) = pack8(acc[ai][1][m][0], acc[ai][1][m][1]);
            }
    }
};

struct EpiGlaIn {
    static constexpr bool PERM = true, AFTER_DRAIN = false;
    bf16 *q, *k, *v, *r; float* uo;
    __device__ __forceinline__ void operator()(const pg8::f32x4 (&acc)[2][2][4][2], const pg8::Unit& u, int wr, int wc, int fr, int fq) const {
        const int row0 = u.pm * 256 + wr * 64 + fr, cl = wc * 32 + 8 * fq; const int pn = u.pn;
#pragma unroll
        for (int ai = 0; ai < 2; ++ai)
#pragma unroll
            for (int m = 0; m < 4; ++m) {
                const int row = row0 + ai * 128 + m * 16;
#pragma unroll
                for (int bj = 0; bj < 2; ++bj) {
                    f32x4 a = acc[ai][bj][m][0], b = acc[ai][bj][m][1];
                    const int c = pn * 256 + bj * 128 + cl;
                    if (pn < 4) { a = a * 0.0625f; b = b * 0.0625f; *(v4u*)(q + (size_t)row * 1024 + c) = pack8(a, b); }
                    else if (pn < 8) { *(v4u*)(k + (size_t)row * 1024 + (c - 1024)) = pack8(a, b); }
                    else if (pn < 16) { *(v4u*)(v + (size_t)row * 2048 + (c - 2048)) = pack8(a, b); }
                    else if (pn < 24) { *(v4u*)(r + (size_t)row * 2048 + (c - 4096)) = pack8(a, b); }
                    else if (bj == 0 && wc == 0) { float* op = uo + (size_t)row * 32 + 8 * fq; *(f32x4*)op = a; *(f32x4*)(op + 4) = b; }
                }
            }
    }
};

struct Frame {
    LAS unsigned char* lds; unsigned char* ldsg;
    int tid, lane, wave, G, bx;
    const float* const* in; float* out; unsigned char* ws;
};
#define WSP(T, off) ((T*)(F.ws + (off)))

__device__ __forceinline__ int perm_win(int p) { const int u = p >> 3, v = p & 7; return (u < 8 ? 0 : 64) + (u & 7) * 4 + (v & 3) + ((v & 4) ? 32 : 0); }
__device__ __forceinline__ int perm_mla(int p) { const int u = p >> 3, v = p & 7; return (u < 4 ? 0 : 32) + (u & 3) * 4 + (v & 3) + ((v & 4) ? 16 : 0); }
__device__ __forceinline__ int srcmap(int mode, int n) {
    if (mode == 1) { if (n >= 2560) return n; return (n & ~127) + perm_win(n & 127); }
    if (mode == 2) { if (n < 768) return n; if (n >= 832) return -1; return 768 + perm_mla(n - 768); }
    if (mode == 3) { const int hh = n / 192, p = n - hh * 192; if (p < 128) return n; return hh * 192 + 128 + perm_mla(p - 128); }
    return n;
}
__device__ __forceinline__ void tr_item(const float* W, int K, int Nsrc, int nblk, bf16* WT, int mode, LAS float* scr, int item, int lane) {
    const int kb = item / nblk, nb = item - kb * nblk, k0 = 64 * kb, n0 = 64 * nb;
    const int ln = (lane & 15) * 4, lk = lane >> 4;
    const int sc = srcmap(mode, n0 + ln);
    f32x4 v[16];
    const float* Wp = W + (size_t)(k0 + lk) * Nsrc + (sc >= 0 ? sc : 0);
#pragma unroll
    for (int i = 0; i < 16; ++i) v[i] = sc >= 0 ? *(const f32x4*)(Wp + (size_t)(4 * i) * Nsrc) : (f32x4){0.f, 0.f, 0.f, 0.f};
#pragma unroll
    for (int i = 0; i < 16; ++i) { LAS float* d = scr + (4 * i + lk) * 65 + ln; d[0] = v[i][0]; d[1] = v[i][1]; d[2] = v[i][2]; d[3] = v[i][3]; }
    LDS_WAIT(); asm volatile("" ::: "memory");
    const int c = lane & 7;
#pragma unroll
    for (int jj = 0; jj < 8; ++jj) { const int n = (lane >> 3) + 8 * jj; const LAS float* s = scr + (8 * c) * 65 + n;
        v4u o; o.x = pk2(s[0 * 65], s[1 * 65]); o.y = pk2(s[2 * 65], s[3 * 65]); o.z = pk2(s[4 * 65], s[5 * 65]); o.w = pk2(s[6 * 65], s[7 * 65]);
        *(GAS v4u*)(WT + (size_t)(n0 + n) * K + k0 + 8 * c) = o; }
    LDS_WAIT(); asm volatile("" ::: "memory");
}

__device__ __forceinline__ void p0_prologue(Frame& F) {
    const int tid = F.tid, lane = F.lane, wave = F.wave;
    for (int it = F.bx; it < 192; it += F.G) {
        const int l = it / 48, nb = it - l * 48;
        LAS float* sl = (LAS float*)F.lds; LAS float* red = sl + 3 * 2048;
        for (int e = tid; e < 3 * 2048; e += 512) { const int c = e >> 11, k = e & 2047; const float v = (c == 0) ? F.in[I_CCTX][k] : F.in[I_C][(c - 1) * 2048 + k]; sl[e] = v / (1.f + __expf(-v)); }
        __syncthreads();
        const float* Wp = F.in[I_ADAW] + ((size_t)l * 2048 + wave * 256) * 12288 + nb * 256 + lane * 4;
        f32x4 a0 = {0.f, 0.f, 0.f, 0.f}, a1 = a0, a2 = a0;
        for (int k = 0; k < 256; k += 8) {
            f32x4 w[8];
#pragma unroll
            for (int jj = 0; jj < 8; ++jj) w[jj] = *(const f32x4*)(Wp + (size_t)(k + jj) * 12288);
#pragma unroll
            for (int jj = 0; jj < 8; ++jj) { const int kk = wave * 256 + k + jj; a0 += w[jj] * sl[kk]; a1 += w[jj] * sl[2048 + kk]; a2 += w[jj] * sl[4096 + kk]; }
        }
        *(LAS f32x4*)(red + (wave * 3 + 0) * 256 + lane * 4) = a0; *(LAS f32x4*)(red + (wave * 3 + 1) * 256 + lane * 4) = a1; *(LAS f32x4*)(red + (wave * 3 + 2) * 256 + lane * 4) = a2;
        __syncthreads();
        for (int e = tid; e < 768; e += 512) { const int c = e >> 8, n = e & 255; float s = F.in[I_ADAB][l * 12288 + nb * 256 + n];
#pragma unroll
            for (int w8 = 0; w8 < 8; ++w8) s += red[(w8 * 3 + c) * 256 + n];
            WSP(float, WS_MOD)[(size_t)(l * 3 + c) * 12288 + nb * 256 + n] = s; }
        __syncthreads();
    }
    if (F.bx == F.G - 1) {
        for (int e = tid; e < 64 * 32; e += 512) { const int pos = e >> 5, i = e & 31; const float inv = exp2f(-(float)i * (13.287712379549449f / 32.f)); const float ang = (float)pos * inv;
            WSP(f32x2, WS_TABW)[e] = (f32x2){cosf(ang), sinf(ang)}; }
        for (int e = tid; e < 64 * 16; e += 512) { const int pos = e >> 4, i = e & 15; const float inv = exp2f(-(float)i * (13.287712379549449f / 16.f)); const float ang = (float)pos * inv;
            WSP(f32x2, WS_TABM)[e] = (f32x2){cosf(ang), sinf(ang)}; }
    }
    const int gt = F.bx * 512 + tid, NGT = F.G * 512;
    for (int e = gt; e < 2 * 2 * 512 * 512; e += NGT) {
        const int c = e & 511, pos = (e >> 9) & 511, b = (e >> 18) & 1, jj = e >> 19;
        const size_t sbase = (((size_t)b * 2 + jj) * 512 + pos) * 512;
        WSP(bf16, WS_CTXK)[e] = (bf16)f2bf(F.in[I_CWK][sbase + (c & ~127) + perm_win(c & 127)]);
        WSP(bf16, WS_CTXV)[e] = (bf16)f2bf(F.in[I_CWV][sbase + c]);
    }
    for (int e = gt; e < 256 * 2048; e += NGT) { const int n = e >> 11, k = e & 2047; float v = 0.f; if (n < 32) v = F.in[I_GWA1][((size_t)(n >> 4) * 2048 + k) * 16 + (n & 15)];
        WSP(bf16, WS_GWINT)[(size_t)(6144 + n) * 2048 + k] = (bf16)f2bf(v); }
    LAS float* scr = (LAS float*)(F.lds + wave * 16640);
    constexpr int C_W1 = 32 * 128, C_W2 = 128 * 32, C_QKV = 32 * 48, C_WO = 32 * 32, C_MWD = 32 * 16, C_MUQ = 8 * 48, C_MUKV = 4 * 64, C_GWIN = 32 * 96;
    constexpr int NITEMS = 4 * C_W1 + 4 * C_W2 + 2 * C_QKV + 2 * C_WO + C_MWD + C_MUQ + C_MUKV + C_WO + C_GWIN + C_WO;
    const bool bal = (F.G == 256); constexpr int NA = 19, NITA = 256 * NWAVES * NA;
    const int gw = F.bx * NWAVES + wave, NGW = F.G * NWAVES;
    const int nmine = bal ? (NA + (F.bx >= 192 ? (NITEMS - NITA - ((F.bx - 192) * NWAVES + wave) + 511) / 512 : 0)) : (NITEMS - gw + NGW - 1) / NGW;
    for (int q = 0; q < nmine; ++q) {
        const int it = bal ? (q < NA ? gw + q * NGW : NITA + ((F.bx - 192) * NWAVES + wave) + (q - NA) * 512) : gw + q * NGW;
        int r = it;
        if (r < 4 * C_W1) { const int l = r / C_W1; r -= l * C_W1; tr_item(F.in[I_W1] + (size_t)l * 2048 * 8192, 2048, 8192, 128, WSP(bf16, WS_W1T) + (size_t)l * 8192 * 2048, 0, scr, r, lane); continue; } r -= 4 * C_W1;
        if (r < 4 * C_W2) { const int l = r / C_W2; r -= l * C_W2; tr_item(F.in[I_W2] + (size_t)l * 8192 * 2048, 8192, 2048, 32, WSP(bf16, WS_W2T) + (size_t)l * 2048 * 8192, 0, scr, r, lane); continue; } r -= 4 * C_W2;
        if (r < 2 * C_QKV) { const int l = r / C_QKV; r -= l * C_QKV; tr_item(F.in[I_WQKV] + (size_t)l * 2048 * 3072, 2048, 3072, 48, WSP(bf16, WS_WQKVT) + (size_t)l * 3072 * 2048, 1, scr, r, lane); continue; } r -= 2 * C_QKV;
        if (r < 2 * C_WO) { const int l = r / C_WO; r -= l * C_WO; tr_item(F.in[I_WWO] + (size_t)l * 2048 * 2048, 2048, 2048, 32, WSP(bf16, WS_WWOT) + (size_t)l * 2048 * 2048, 0, scr, r, lane); continue; } r -= 2 * C_WO;
        if (r < C_MWD) { tr_item(F.in[I_MWD], 2048, 832, 16, WSP(bf16, WS_MWDT), 2, scr, r, lane); continue; } r -= C_MWD;
        if (r < C_MUQ) { tr_item(F.in[I_MWUQ], 512, 3072, 48, WSP(bf16, WS_MWUQT), 3, scr, r, lane); continue; } r -= C_MUQ;
        if (r < C_MUKV) { tr_item(F.in[I_MWUKV], 256, 4096, 64, WSP(bf16, WS_MWUKVT), 0, scr, r, lane); continue; } r -= C_MUKV;
        if (r < C_WO) { tr_item(F.in[I_MWO], 2048, 2048, 32, WSP(bf16, WS_MWOT), 0, scr, r, lane); continue; } r -= C_WO;
        if (r < C_GWIN) { tr_item(F.in[I_GWIN], 2048, 6144, 96, WSP(bf16, WS_GWINT), 0, scr, r, lane); continue; } r -= C_GWIN;
        tr_item(F.in[I_GWO], 2048, 2048, 32, WSP(bf16, WS_GWOT), 0, scr, r, lane);
    }
}

__device__ __forceinline__ const float* x_row(Frame& F, int L, int row) {
    return L == 0 ? (row < MP ? F.in[I_XP] + (size_t)row * DM : F.in[I_XS] + (size_t)(row - MP) * DM) : WSP(float, WS_X) + (size_t)row * DM;
}
__device__ __forceinline__ void mod_phase(Frame& F, int L, int which, int first) {
    const int gw = F.bx * NWAVES + F.wave, NGW = F.G * NWAVES, lane = F.lane;
    for (int rb = gw; rb < MTOK / 8; rb += NGW) {
        const int row0 = rb * 8, cond = row0 < MP ? 0 : (row0 >> 12) - 1;
        const float* mv = WSP(float, WS_MOD) + (size_t)(L * 3 + cond) * 12288 + (which ? 3 * 2048 : 0);
        const float* g = F.in[I_NORMG] + (size_t)(L * 2 + which) * 2048;
        f32x4 a[8], s[8];
#pragma unroll
        for (int jj = 0; jj < 8; ++jj) { const int col = 4 * lane + 256 * jj; const f32x4 gv = *(const f32x4*)(g + col), sc = *(const f32x4*)(mv + 2048 + col); s[jj] = *(const f32x4*)(mv + col); a[jj] = gv * (sc + 1.f); }
        for (int r = 0; r < 8; ++r) {
            const int row = row0 + r; const float* xr = x_row(F, first ? 0 : 1, row);
            f32x4 v[8]; float ss = 0.f;
#pragma unroll
            for (int jj = 0; jj < 8; ++jj) { v[jj] = *(const f32x4*)(xr + 4 * lane + 256 * jj); ss += (v[jj][0] * v[jj][0] + v[jj][1] * v[jj][1]) + (v[jj][2] * v[jj][2] + v[jj][3] * v[jj][3]); }
            const float rstd = rsqrtf(wave_sum(ss) * (1.f / 2048.f) + EPS);
            bf16* hr = WSP(bf16, WS_H) + (size_t)row * DM;
#pragma unroll
            for (int jj = 0; jj < 8; ++jj) { const f32x4 y = v[jj] * rstd * a[jj] + s[jj]; v2u w; w.x = cvtpk(y[0], y[1]); w.y = cvtpk(y[2], y[3]); *(v2u*)(hr + 4 * lane + 256 * jj) = w; }
        }
    }
}
__device__ __forceinline__ void final_phase(Frame& F) {
    const int gw = F.bx * NWAVES + F.wave, NGW = F.G * NWAVES, lane = F.lane;
    const float* g = F.in[I_FNORM];
    for (int row = gw; row < MTOK; row += NGW) {
        const float* xr = WSP(float, WS_X) + (size_t)row * DM;
        f32x4 v[8]; float ss = 0.f;
#pragma unroll
        for (int jj = 0; jj < 8; ++jj) { v[jj] = *(const f32x4*)(xr + 4 * lane + 256 * jj); ss += (v[jj][0] * v[jj][0] + v[jj][1] * v[jj][1]) + (v[jj][2] * v[jj][2] + v[jj][3] * v[jj][3]); }
        const float rstd = rsqrtf(wave_sum(ss) * (1.f / 2048.f) + EPS);
        float* orow = F.out + (size_t)row * DM;
#pragma unroll
        for (int jj = 0; jj < 8; ++jj) { const int col = 4 * lane + 256 * jj; *(f32x4*)(orow + col) = v[jj] * rstd * *(const f32x4*)(g + col); }
    }
}

namespace att {
constexpr int QBLK = 32, KVBLK = 64;
constexpr int SHM_V = 16384, SHM_K = 16384, SHM_KR = 8192;
constexpr int OFF_V = 0, OFF_K = 2 * SHM_V, OFF_KR = 2 * SHM_V + 2 * SHM_K, OFF_WS = OFF_KR + 2 * SHM_KR, OFF_QR = OFF_WS + NWAVES * 64 * 4, LDS_ATT = OFF_QR + NWAVES * 4096;
#define KSWZ(row, colB) ((row) * 256 + ((colB) ^ (((row) & 7) << 4)))
#define KRSWZ(row, chunk) ((row) * 128 + ((((chunk) ^ ((row) >> 1)) & 7) << 4))
__device__ __forceinline__ int crow(int r, int hi) { return (r & 3) + 8 * (r >> 2) + 4 * hi; }
template <int DQK> struct Cst { static constexpr float SCALE = DQK == 128 ? 0.088388347648318440f : 0.072168783648703220f; static constexpr float C = SCALE * 1.4426950408889634f; };
constexpr float THR = 8.f;

template <int DQK>
__device__ __forceinline__ void partialSM(f32x16& p0, f32x16& p1, float& m_reg, float& mn, float& alpha) {
    constexpr float C = Cst<DQK>::C, SCALE = Cst<DQK>::SCALE;
    float pmax = p0[0];
#pragma unroll
    for (int r = 1; r < 16; ++r) pmax = fmaxf(pmax, p0[r]);
#pragma unroll
    for (int r = 0; r < 16; ++r) pmax = fmaxf(pmax, p1[r]);
    { auto rr = __builtin_amdgcn_permlane32_swap(__float_as_uint(pmax), __float_as_uint(pmax), false, false);
      pmax = fmaxf(__uint_as_float(rr[0]), __uint_as_float(rr[1])); }
    if (__builtin_expect(__all(pmax - m_reg <= THR / SCALE), 1)) { mn = m_reg; alpha = 1.f; }
    else { mn = fmaxf(m_reg, pmax); alpha = __builtin_amdgcn_exp2f((m_reg - mn) * C); m_reg = mn; }
    const float mnC = -mn * C;
#pragma unroll
    for (int r = 0; r < 16; ++r) p0[r] = __builtin_amdgcn_exp2f(fmaf(p0[r], C, mnC));
#pragma unroll
    for (int r = 0; r < 16; ++r) p1[r] = __builtin_amdgcn_exp2f(fmaf(p1[r], C, mnC));
}
__device__ __forceinline__ void finishSM(f32x16& p0, f32x16& p1, float alpha, float& l_reg, bf16x8& pa0, bf16x8& pa1, bf16x8& pa2, bf16x8& pa3) {
    float ps = 0;
#pragma unroll
    for (int r = 0; r < 16; ++r) ps += p0[r];
#pragma unroll
    for (int r = 0; r < 16; ++r) ps += p1[r];
    { auto rr = __builtin_amdgcn_permlane32_swap(__float_as_uint(ps), __float_as_uint(ps), false, false);
      ps = __uint_as_float(rr[0]) + __uint_as_float(rr[1]); }
    l_reg = l_reg * alpha + ps;
#define PK4(P, BASE, OUT) do { unsigned a0 = cvtpk(P[BASE + 0], P[BASE + 1]), a1 = cvtpk(P[BASE + 2], P[BASE + 3]);   \
    unsigned b0 = cvtpk(P[BASE + 4], P[BASE + 5]), b1 = cvtpk(P[BASE + 6], P[BASE + 7]);                              \
    auto r0 = __builtin_amdgcn_permlane32_swap(a0, b0, false, false); auto r1 = __builtin_amdgcn_permlane32_swap(a1, b1, false, false); \
    v4u w = {r0[0], r1[0], r0[1], r1[1]}; OUT = *reinterpret_cast<bf16x8*>(&w); } while (0)
    PK4(p0, 0, pa0); PK4(p0, 8, pa1); PK4(p1, 0, pa2); PK4(p1, 8, pa3);
#undef PK4
}
__device__ __forceinline__ int v_st(int k, int c) { const int kk = (k & ~0xC) | ((k & 4) << 1) | ((k & 8) >> 1); return ((kk >> 3) * 4 + (c >> 5)) * 512 + ((kk & 7) * 32 + (c & 31)) * 2; }
__device__ __forceinline__ int v_rd_base(int lane) { return ((lane & 3) << 3) | (((lane >> 2) & 3) << 6) | (((lane >> 4) & 1) << 5) | (((lane >> 5) & 1) << 8); }
constexpr int v_rd_off(int d0, int ks, int half) { return d0 * 512 + ks * 4096 + half * 2048; }
template <int OFF> __device__ __forceinline__ s16x4 tr_read(int vb) {
    s16x4 r; asm volatile("ds_read_b64_tr_b16 %0, %1 offset:%2" : "=&v"(r) : "v"(vb), "i"(OFF) : "memory"); return r;
}
template <int D0> __device__ __forceinline__ void pv_one(f32x16& od, int vb, bf16x8 pa0, bf16x8 pa1, bf16x8 pa2, bf16x8 pa3) {
    const s16x4 l0 = tr_read<v_rd_off(D0, 0, 0)>(vb), h0 = tr_read<v_rd_off(D0, 0, 1)>(vb), l1 = tr_read<v_rd_off(D0, 1, 0)>(vb), h1 = tr_read<v_rd_off(D0, 1, 1)>(vb);
    const s16x4 l2 = tr_read<v_rd_off(D0, 2, 0)>(vb), h2 = tr_read<v_rd_off(D0, 2, 1)>(vb), l3 = tr_read<v_rd_off(D0, 3, 0)>(vb), h3 = tr_read<v_rd_off(D0, 3, 1)>(vb);
    asm volatile("s_waitcnt lgkmcnt(0)" ::: "memory"); SBAR();
#define PKV(L, H) (bf16x8){L[0], L[1], L[2], L[3], H[0], H[1], H[2], H[3]}
    od = __builtin_amdgcn_mfma_f32_32x32x16_bf16(pa0, PKV(l0, h0), od, 0, 0, 0);
    od = __builtin_amdgcn_mfma_f32_32x32x16_bf16(pa1, PKV(l1, h1), od, 0, 0, 0);
    od = __builtin_amdgcn_mfma_f32_32x32x16_bf16(pa2, PKV(l2, h2), od, 0, 0, 0);
    od = __builtin_amdgcn_mfma_f32_32x32x16_bf16(pa3, PKV(l3, h3), od, 0, 0, 0);
#undef PKV
}

template <int DQK, bool MASKED>
__device__ __forceinline__ void attn_unit(const bf16* __restrict__ Qb, int ldq,
                                          const bf16* __restrict__ KA, const bf16* __restrict__ VA, const bf16* __restrict__ KRA, int nA,
                                          const bf16* __restrict__ KB, const bf16* __restrict__ VB, const bf16* __restrict__ KRB, int nB,
                                          int ldk, int qpos0, int kposB0, float sink_l2, bf16* __restrict__ Ob, char* lds) {
    constexpr int ND = 8;
    constexpr float C = Cst<DQK>::C;
    const int tid = threadIdx.x, wid = tid >> 6, lane = tid & 63, r32 = lane & 31, hi = lane >> 5;
    char* V_lds = lds + OFF_V; char* K_lds = lds + OFF_K; char* KR_lds = lds + OFF_KR;
    float* wsf = (float*)(lds + OFF_WS) + wid * 64; float* li_l = wsf; float* al_l = wsf + 32;
    float m_reg = -1e30f, l_reg = 0.f; f32x16 o[4] = {}; bf16x8 qr[ND];
    const bf16* Qw = Qb + (size_t)(wid * QBLK + r32) * ldq + hi * 8;
#pragma unroll
    for (int d0 = 0; d0 < ND; ++d0) qr[d0] = *reinterpret_cast<const bf16x8*>(Qw + d0 * 16);
    char* QR_lds = lds + OFF_QR;
    if constexpr (DQK == 192) {
#pragma unroll
        for (int dd = 0; dd < 4; ++dd) { const bf16x8 qv = *reinterpret_cast<const bf16x8*>(Qw + 128 + dd * 16); *(bf16x8*)(QR_lds + wid * 4096 + KRSWZ(r32, dd * 2 + hi)) = qv; }
    }
    const int sr = tid >> 4, sc = (tid & 15) * 8, vst0 = v_st(sr, sc), vst1 = v_st(32 + sr, sc);
    const int krr = tid >> 3, krc = tid & 7;
    const int vb0 = (int)(uintptr_t)(LAS char*)V_lds + v_rd_base(lane);
    const int NT = nA + nB;
    bf16x8 sv0, sv1, sk0, sk1, skr;
    const unsigned go0 = (unsigned)(sr * ldk + sc) * 2u, go1 = (unsigned)((32 + sr) * ldk + sc) * 2u, gor = (unsigned)(krr * 64 + krc * 8) * 2u;
#define SLOAD(t) do { const bool inA_ = (t) < nA; const int tt_ = inA_ ? (t) : (t) - nA; const char* Kt_ = (const char*)((inA_ ? KA : KB) + (size_t)tt_ * 64 * ldk); const char* Vt_ = (const char*)((inA_ ? VA : VB) + (size_t)tt_ * 64 * ldk); \
    sv0 = *reinterpret_cast<const bf16x8*>(Vt_ + go0); sv1 = *reinterpret_cast<const bf16x8*>(Vt_ + go1); \
    sk0 = *reinterpret_cast<const bf16x8*>(Kt_ + go0); sk1 = *reinterpret_cast<const bf16x8*>(Kt_ + go1); \
    if constexpr (DQK == 192) { const char* Rt_ = (const char*)((inA_ ? KRA : KRB) + (size_t)tt_ * 64 * 64); skr = *reinterpret_cast<const bf16x8*>(Rt_ + gor); } } while (0)
#define SWRITE(b) do { *(bf16x8*)(V_lds + (b) * SHM_V + vst0) = sv0; *(bf16x8*)(V_lds + (b) * SHM_V + vst1) = sv1; const int kc_ = sc * 2; \
    *(bf16x8*)(K_lds + (b) * SHM_K + KSWZ(sr, kc_)) = sk0; *(bf16x8*)(K_lds + (b) * SHM_K + KSWZ(32 + sr, kc_)) = sk1; \
    if constexpr (DQK == 192) { *(bf16x8*)(KR_lds + (b) * SHM_KR + KRSWZ(krr, krc)) = skr; } } while (0)
    SLOAD(0); VM_WAIT(); SWRITE(0); __syncthreads();
    for (int t = 0; t < NT; ++t) {
        const int cur = t & 1;
        if (t + 1 < NT) SLOAD(t + 1);
        f32x16 p0 = {}, p1 = {};
        { const char* Ks = K_lds + cur * SHM_K;
#pragma unroll
          for (int dg = 0; dg < 2; ++dg) {
            bf16x8 kf0[4], kf1[4];
#pragma unroll
            for (int dd = 0; dd < 4; ++dd) { const int cb = ((dg * 4 + dd) * 16 + hi * 8) * 2;
              kf0[dd] = *reinterpret_cast<const bf16x8*>(Ks + KSWZ(r32, cb)); kf1[dd] = *reinterpret_cast<const bf16x8*>(Ks + KSWZ(32 + r32, cb)); }
#pragma unroll
            for (int dd = 0; dd < 4; ++dd) {
              p0 = __builtin_amdgcn_mfma_f32_32x32x16_bf16(kf0[dd], qr[dg * 4 + dd], p0, 0, 0, 0);
              p1 = __builtin_amdgcn_mfma_f32_32x32x16_bf16(kf1[dd], qr[dg * 4 + dd], p1, 0, 0, 0); }
            SBAR();
          }
          if constexpr (DQK == 192) { const char* Rs = KR_lds + cur * SHM_KR; const char* Qs = QR_lds + wid * 4096;
            bf16x8 kf0[4], kf1[4], qf[4];
#pragma unroll
            for (int dd = 0; dd < 4; ++dd) { const int ch = dd * 2 + hi;
              kf0[dd] = *reinterpret_cast<const bf16x8*>(Rs + KRSWZ(r32, ch)); kf1[dd] = *reinterpret_cast<const bf16x8*>(Rs + KRSWZ(32 + r32, ch)); qf[dd] = *reinterpret_cast<const bf16x8*>(Qs + KRSWZ(r32, ch)); }
#pragma unroll
            for (int dd = 0; dd < 4; ++dd) {
              p0 = __builtin_amdgcn_mfma_f32_32x32x16_bf16(kf0[dd], qf[dd], p0, 0, 0, 0);
              p1 = __builtin_amdgcn_mfma_f32_32x32x16_bf16(kf1[dd], qf[dd], p1, 0, 0, 0); }
            SBAR();
          }
        }
        if constexpr (MASKED) { if (t >= nA) { const int qp = qpos0 + wid * QBLK + r32, kb = kposB0 + (t - nA) * 64;
#pragma unroll
            for (int r = 0; r < 16; ++r) { const int d = qp - (kb + crow(r, hi)); if (d > 128 || d < -128) p0[r] = -1e30f; const int d2 = d - 32; if (d2 > 128 || d2 < -128) p1[r] = -1e30f; } } }
        float mn, alpha; bf16x8 pa0, pa1, pa2, pa3;
        partialSM<DQK>(p0, p1, m_reg, mn, alpha);
        if (__any(alpha < 1.f)) { if (hi == 0) al_l[r32] = alpha; LDS_WAIT();
#pragma unroll
            for (int r = 0; r < 16; ++r) { const float al = al_l[crow(r, hi)];
#pragma unroll
                for (int d = 0; d < 4; ++d) o[d][r] *= al; } }
        finishSM(p0, p1, alpha, l_reg, pa0, pa1, pa2, pa3); SBAR();
        { const int vb = vb0 + cur * SHM_V;
          pv_one<0>(o[0], vb, pa0, pa1, pa2, pa3); pv_one<1>(o[1], vb, pa0, pa1, pa2, pa3); pv_one<2>(o[2], vb, pa0, pa1, pa2, pa3); pv_one<3>(o[3], vb, pa0, pa1, pa2, pa3); }
        if (t + 1 < NT) { VM_WAIT(); SWRITE(cur ^ 1); }
        __syncthreads();
    }
    l_reg += __builtin_amdgcn_exp2f(sink_l2 - m_reg * C);
    if (hi == 0) li_l[r32] = l_reg; LDS_WAIT();
    int obase = (wid * QBLK + 4 * hi) * 2048 + r32; asm volatile("" : "+v"(obase));
#pragma unroll
    for (int r = 0; r < 16; ++r) { const float rl = __builtin_amdgcn_rcpf(li_l[crow(r, hi)]); const int ro = ((r & 3) + 8 * (r >> 2)) * 2048;
#pragma unroll
        for (int d0 = 0; d0 < 4; ++d0) *(bf16*)((char*)Ob + (unsigned)(obase + ro + d0 * 32) * 2u) = (bf16)f2bf(o[d0][r] * rl); }
    LDS_WAIT();
#undef SLOAD
#undef SWRITE
}
}

__device__ __forceinline__ void attn_win_phase(Frame& F, int j) {
    const bf16* Q = WSP(bf16, WS_WQ); const bf16* K = WSP(bf16, WS_WK); const bf16* V = WSP(bf16, WS_WV); bf16* O = WSP(bf16, WS_AO);
    const bf16* CK = WSP(bf16, WS_CTXK) + (size_t)j * 2 * 512 * 512; const bf16* CV = WSP(bf16, WS_CTXV) + (size_t)j * 2 * 512 * 512;
    for (int un = F.bx; un < 1024; un += F.G) {
        const int h = un & 15, kvh = h >> 2; const float sink = F.in[I_SINK][j * 16 + h] * 1.4426950408889634f;
        if (un < 512) {
            const int qb = un >> 4, bs = qb >> 4, t0 = (qb & 15) * 256, row0 = MP + qb * 256;
            int kt0 = (t0 >> 6) - 2, kt1 = (t0 >> 6) + 5; if (kt0 < 0) kt0 = 0; if (kt1 > 63) kt1 = 63;
            const size_t kb = (size_t)(MP + bs * 4096 + kt0 * 64) * 512 + kvh * 128;
            att::attn_unit<128, true>(Q + (size_t)row0 * 2048 + h * 128, 2048, CK + (size_t)bs * 512 * 512 + kvh * 128, CV + (size_t)bs * 512 * 512 + kvh * 128, nullptr, 8,
                                     K + kb, V + kb, nullptr, kt1 - kt0 + 1, 512, t0, kt0 * 64, sink, O + (size_t)row0 * 2048 + h * 128, (char*)F.ldsg);
        } else {
            const int b = (un - 512) >> 4, row0 = b * 256; const size_t kb = (size_t)row0 * 512 + kvh * 128;
            att::attn_unit<128, false>(Q + (size_t)row0 * 2048 + h * 128, 2048, nullptr, nullptr, nullptr, 0,
                                      K + kb, V + kb, nullptr, 4, 512, 0, 0, sink, O + (size_t)row0 * 2048 + h * 128, (char*)F.ldsg);
        }
    }
}
__device__ __forceinline__ void attn_mla_phase(Frame& F) {
    const bf16* Q = WSP(bf16, WS_MQ); const bf16* KN = WSP(bf16, WS_MKN); const bf16* V = WSP(bf16, WS_MV); const bf16* KR = WSP(bf16, WS_MKR); bf16* O = WSP(bf16, WS_AO);
    for (int un = F.bx; un < 1024; un += F.G) {
        const int h = un & 15;
        if (un < 512) {
            const int qb = un >> 4, bs = qb >> 4, row0 = MP + qb * 256;
            const size_t ra = (size_t)bs * 512, rb = (size_t)1024 + MP + bs * 4096;
            att::attn_unit<192, false>(Q + (size_t)row0 * 3072 + h * 192, 3072, KN + ra * 2048 + h * 128, V + ra * 2048 + h * 128, KR + ra * 64, 8,
                                      KN + rb * 2048 + h * 128, V + rb * 2048 + h * 128, KR + rb * 64, 64, 2048, 0, 0, -1e30f, O + (size_t)row0 * 2048 + h * 128, (char*)F.ldsg);
        } else {
            const int b = (un - 512) >> 4, row0 = b * 256; const size_t rb = (size_t)1024 + row0;
            att::attn_unit<192, false>(Q + (size_t)row0 * 3072 + h * 192, 3072, nullptr, nullptr, nullptr, 0,
                                      KN + rb * 2048 + h * 128, V + rb * 2048 + h * 128, KR + rb * 64, 4, 2048, 0, 0, -1e30f, O + (size_t)row0 * 2048 + h * 128, (char*)F.ldsg);
        }
    }
}

__device__ __forceinline__ void mla_norm_phase(Frame& F) {
    const int gw = F.bx * NWAVES + F.wave, NGW = F.G * NWAVES, lane = F.lane;
    const float* D = WSP(float, WS_MD); bf16* CQ = WSP(bf16, WS_MCQ); bf16* CKV = WSP(bf16, WS_MCKV); bf16* KR = WSP(bf16, WS_MKR);
    const f32x2* tab = WSP(f32x2, WS_TABM);
    const float* qn = F.in[I_MQN]; const float* kvn = F.in[I_MKVN];
    for (int row = gw; row < MTOK; row += NGW) {
        const float* d = D + (size_t)row * 1024;
        {
            const f32x4 v0 = *(const f32x4*)(d + 4 * lane), v1 = *(const f32x4*)(d + 256 + 4 * lane);
            float ss = (v0[0] * v0[0] + v0[1] * v0[1]) + (v0[2] * v0[2] + v0[3] * v0[3]) + (v1[0] * v1[0] + v1[1] * v1[1]) + (v1[2] * v1[2] + v1[3] * v1[3]);
            const float rstd = rsqrtf(wave_sum(ss) * (1.f / 512.f) + EPS);
            const f32x4 y0 = v0 * rstd * *(const f32x4*)(qn + 4 * lane), y1 = v1 * rstd * *(const f32x4*)(qn + 256 + 4 * lane);
            v2u w; w.x = cvtpk(y0[0], y0[1]); w.y = cvtpk(y0[2], y0[3]); *(v2u*)(CQ + (size_t)row * 512 + 4 * lane) = w;
            w.x = cvtpk(y1[0], y1[1]); w.y = cvtpk(y1[2], y1[3]); *(v2u*)(CQ + (size_t)row * 512 + 256 + 4 * lane) = w;
        }
        {
            const f32x4 v0 = *(const f32x4*)(d + 512 + 4 * lane);
            float ss = (v0[0] * v0[0] + v0[1] * v0[1]) + (v0[2] * v0[2] + v0[3] * v0[3]);
            const float rstd = rsqrtf(wave_sum(ss) * (1.f / 256.f) + EPS);
            const f32x4 y0 = v0 * rstd * *(const f32x4*)(kvn + 4 * lane);
            v2u w; w.x = cvtpk(y0[0], y0[1]); w.y = cvtpk(y0[2], y0[3]); *(v2u*)(CKV + (size_t)(1024 + row) * 256 + 4 * lane) = w;
            if (row < MP) *(f32x4*)(F.out + O_CKV + (size_t)row * 256 + 4 * lane) = y0;
        }
        if (lane < 8) {
            const int ug = lane, idx0 = (ug & 3) * 4, d1 = (ug < 4 ? 0 : 32) + idx0;
            f32x4 a = *(const f32x4*)(d + 768 + 8 * ug), b = *(const f32x4*)(d + 768 + 8 * ug + 4);
            if (row < MP) { float* op = F.out + O_KR + (size_t)row * 64 + d1; *(f32x4*)op = a; *(f32x4*)(op + 16) = b; }
            else { const int t = row & 4095, pos = (ug < 4) ? (t >> 6) : (t & 63); const f32x4* tp = (const f32x4*)(tab + pos * 16 + idx0); const f32x4 cs0 = tp[0], cs1 = tp[1];
                const f32x4 co = {cs0[0], cs0[2], cs1[0], cs1[2]}, si = {cs0[1], cs0[3], cs1[1], cs1[3]};
                const f32x4 na = a * co - b * si, nb = b * co + a * si; a = na; b = nb; }
            *(v4u*)(KR + (size_t)(1024 + row) * 64 + 8 * ug) = pack8(a, b);
        }
    }
    const int gt = F.bx * 512 + F.tid, NGT = F.G * 512;
    for (int e = gt; e < 1024 * 256; e += NGT) CKV[e] = (bf16)f2bf(F.in[I_CCKV][e]);
    for (int e = gt; e < 1024 * 64; e += NGT) KR[e] = (bf16)f2bf(F.in[I_CKR][(e & ~63) + perm_mla(e & 63)]);
}

typedef short v4i16_t __attribute__((ext_vector_type(4)));
__device__ __forceinline__ s16x4 vtr(const LAS char* p) { return __builtin_bit_cast(s16x4, __builtin_amdgcn_ds_read_tr16_b64_v4i16((LAS v4i16_t*)p)); }
#define MFMA16(a, b, c) __builtin_amdgcn_mfma_f32_16x16x32_bf16((a), (b), (c), 0, 0, 0)
#define CAT8(L, H) (bf16x8){L[0], L[1], L[2], L[3], H[0], H[1], H[2], H[3]}

__device__ __forceinline__ void gla_prep_phase(Frame& F) {
    constexpr int PQ = 528, OQ = 0, OK_ = 64 * PQ, OKT = 2 * 64 * PQ, OUB = 3 * 64 * PQ, OHT = OUB + 4096, OAT = OHT + 2048;
    LAS char* L = (LAS char*)F.lds; const int tid = F.tid, lane = F.lane, wave = F.wave;
    const bf16* GQ = WSP(bf16, WS_GQ); const bf16* GK = WSP(bf16, WS_GK); const float* GU = WSP(float, WS_GU);
    for (int un = F.bx; un < 2048; un += F.G) {
        const int d = un & 1, ch = un >> 1, c = ch >> 2, h = ch & 3, row0 = c * 64;
        bf16* QT = WSP(bf16, WS_GQT) + (size_t)d * MTOK * 1024; bf16* KD = WSP(bf16, WS_GKD) + (size_t)d * MTOK * 1024;
        bf16* AM = WSP(bf16, WS_GAM) + ((size_t)d * 1024 + ch) * 4096; float* DEC = WSP(float, WS_GDEC) + ((size_t)d * 1024 + ch) * 256;
#pragma unroll
        for (int i = 0; i < 4; ++i) { const int e = tid + 512 * i, row = e >> 5, cc = e & 31; const size_t go = (size_t)(row0 + row) * 1024 + h * 256 + cc * 8;
            *(LAS v4u*)(L + OQ + row * PQ + cc * 16) = *(const v4u*)(GQ + go); *(LAS v4u*)(L + OK_ + row * PQ + cc * 16) = *(const v4u*)(GK + go); }
        if (tid < 256) { const int row = tid >> 2, q4 = tid & 3; *(LAS f32x4*)(L + OUB + (row * 16 + q4 * 4) * 4) = *(const f32x4*)(GU + (size_t)(row0 + row) * 32 + d * 16 + q4 * 4); }
        __syncthreads();
        {
            const int hf = tid >> 8, col = tid & 255;
            float w[16];
#pragma unroll
            for (int r = 0; r < 16; ++r) w[r] = F.in[I_GWA2][((size_t)d * 16 + r) * 1024 + h * 256 + col];
            const float bias = F.in[I_GBA][d * 1024 + h * 256 + col];
            float g[32]; float tot = 0.f;
#pragma unroll
            for (int ii = 0; ii < 32; ++ii) { const int i = hf * 32 + ii; float z = bias;
#pragma unroll
                for (int q4 = 0; q4 < 4; ++q4) { const f32x4 uv = *(const LAS f32x4*)(L + OUB + (i * 16 + q4 * 4) * 4); z += uv[0] * w[4 * q4] + uv[1] * w[4 * q4 + 1] + uv[2] * w[4 * q4 + 2] + uv[3] * w[4 * q4 + 3]; }
                const float ls = fminf(z, 0.f) - __logf(1.f + __expf(-fabsf(z)));
                g[ii] = ls * 0.0625f; tot += g[ii]; }
            ((LAS float*)(L + OHT))[hf * 256 + col] = tot;
            __syncthreads();
            const float other = ((const LAS float*)(L + OHT))[(1 - hf) * 256 + col];
            const float T = tot + other;
            float run = (d == 0) ? (hf == 1 ? other : 0.f) : (hf == 0 ? other : 0.f);
            if (hf == 0) DEC[col] = __expf(T);
#pragma unroll
            for (int s = 0; s < 32; ++s) {
                const int ii = (d == 0) ? s : 31 - s;
                run += (d == 0) ? g[s] : g[31 - s];
                const int i = hf * 32 + ii;
                LAS bf16* qp = (LAS bf16*)(L + OQ + i * PQ) + col; LAS bf16* kp = (LAS bf16*)(L + OK_ + i * PQ) + col; LAS bf16* ktp = (LAS bf16*)(L + OKT + i * PQ) + col;
                const float qv = bf2f(*qp), kv = bf2f(*kp);
                *qp = (bf16)f2bf(qv * __expf(run)); *ktp = (bf16)f2bf(kv * __expf(-run)); *kp = (bf16)f2bf(kv * __expf(T - run));
            }
        }
        __syncthreads();
        {
            const int gq = lane >> 4, cl = lane & 15;
#pragma unroll
            for (int s2 = 0; s2 < 2; ++s2) {
                const int T16 = 2 * wave + s2, ti = T16 >> 2, tj = T16 & 3;
                f32x4 acc = {0.f, 0.f, 0.f, 0.f};
#pragma unroll
                for (int ks = 0; ks < 8; ++ks) {
                    const bf16x8 a = *(const LAS bf16x8*)(L + OQ + (16 * ti + cl) * PQ + (32 * ks + 8 * gq) * 2);
                    const bf16x8 b = *(const LAS bf16x8*)(L + OKT + (16 * tj + cl) * PQ + (32 * ks + 8 * gq) * 2);
                    acc = MFMA16(a, b, acc);
                }
                const int jcol = 16 * tj + cl;
#pragma unroll
                for (int r = 0; r < 4; ++r) { const int i = 16 * ti + 4 * gq + r; const bool keep = (d == 0) ? (jcol <= i) : (jcol >= i);
                    ((LAS bf16*)(L + OAT))[i * 64 + jcol] = (bf16)f2bf(keep ? acc[r] : 0.f); }
            }
        }
        __syncthreads();
#pragma unroll
        for (int i = 0; i < 4; ++i) { const int e = tid + 512 * i, row = e >> 5, cc = e & 31; const size_t go = (size_t)(row0 + row) * 1024 + h * 256 + cc * 8;
            *(v4u*)(QT + go) = *(const LAS v4u*)(L + OQ + row * PQ + cc * 16); *(v4u*)(KD + go) = *(const LAS v4u*)(L + OK_ + row * PQ + cc * 16); }
        *(v4u*)(AM + tid * 8) = *(const LAS v4u*)(L + OAT + tid * 16);
        __syncthreads();
    }
}

__device__ __forceinline__ void gla_scan_item(Frame& F, int seq, int h, int d, int sl) {
    constexpr int PQ = 528, PK = 544, PA = 136, PV = 288;
    constexpr int OQ = 0, OK_ = 64 * PQ, OA = OK_ + 64 * PK, OV = OA + 64 * PA, ODEC = OV + 64 * PV;
    LAS char* L = (LAS char*)F.lds; const int tid = F.tid, lane = F.lane, wave = F.wave, gq = lane >> 4, cl = lane & 15;
    const bool sample = seq >= 32; const int base = sample ? MP + (seq - 32) * 4096 : seq * 256, nch = sample ? 64 : 4;
    const bf16* QT = WSP(bf16, WS_GQT) + (size_t)d * MTOK * 1024; const bf16* KD = WSP(bf16, WS_GKD) + (size_t)d * MTOK * 1024;
    const bf16* AM = WSP(bf16, WS_GAM) + (size_t)d * 1024 * 4096; const float* DEC = WSP(float, WS_GDEC) + (size_t)d * 1024 * 256;
    const bf16* GV = WSP(bf16, WS_GV); float* OD = WSP(float, d == 0 ? WS_GOF : WS_GOB);
    const int dvc = h * 512 + sl * 128;
    f32x4 S[16];
    if (sample) { const float* s0 = F.in[d == 0 ? I_SGF : I_SGB] + ((size_t)((seq - 32) * 4 + h) * 256) * 512 + sl * 128 + 16 * wave + cl;
#pragma unroll
        for (int t = 0; t < 16; ++t)
#pragma unroll
            for (int r = 0; r < 4; ++r) S[t][r] = s0[(size_t)(16 * t + 4 * gq + r) * 512];
    } else {
#pragma unroll
        for (int t = 0; t < 16; ++t) S[t] = (f32x4){0.f, 0.f, 0.f, 0.f};
    }
    v4u rq[4], rk[4], rv[2], ra; float rdec = 0.f;
#define GLOAD(ci) do { const int r0_ = base + 64 * (ci); const int chx_ = (r0_ >> 6) * 4 + h; \
    _Pragma("unroll") for (int i = 0; i < 4; ++i) { const int e = tid + 512 * i, row = e >> 5, cc = e & 31; const size_t go = (size_t)(r0_ + row) * 1024 + h * 256 + cc * 8; rq[i] = *(const v4u*)(QT + go); rk[i] = *(const v4u*)(KD + go); } \
    _Pragma("unroll") for (int i = 0; i < 2; ++i) { const int e = tid + 512 * i, row = e >> 4, cc = e & 15; rv[i] = *(const v4u*)(GV + (size_t)(r0_ + row) * 2048 + dvc + cc * 8); } \
    ra = *(const v4u*)(AM + (size_t)chx_ * 4096 + tid * 8); if (tid < 256) rdec = DEC[(size_t)chx_ * 256 + tid]; } while (0)
#define LWRITE() do { \
    _Pragma("unroll") for (int i = 0; i < 4; ++i) { const int e = tid + 512 * i, row = e >> 5, cc = e & 31; *(LAS v4u*)(L + OQ + row * PQ + cc * 16) = rq[i]; *(LAS v4u*)(L + OK_ + row * PK + cc * 16) = rk[i]; } \
    _Pragma("unroll") for (int i = 0; i < 2; ++i) { const int e = tid + 512 * i, row = e >> 4, cc = e & 15; *(LAS v4u*)(L + OV + row * PV + cc * 16) = rv[i]; } \
    { const int row = tid >> 3, cc = tid & 7; *(LAS v2u*)(L + OA + row * PA + cc * 16) = (v2u){ra.x, ra.y}; *(LAS v2u*)(L + OA + row * PA + cc * 16 + 8) = (v2u){ra.z, ra.w}; } \
    if (tid < 256) ((LAS float*)(L + ODEC))[tid] = rdec; } while (0)
    GLOAD(d == 0 ? 0 : nch - 1);
    LWRITE();
    __syncthreads();
    for (int s = 0; s < nch; ++s) {
        const int ci = d == 0 ? s : nch - 1 - s, row0 = base + 64 * ci;
        if (s + 1 < nch) GLOAD(d == 0 ? s + 1 : nch - 2 - s);
        f32x4 o[4];
#pragma unroll
        for (int ti = 0; ti < 4; ++ti) o[ti] = (f32x4){0.f, 0.f, 0.f, 0.f};
#pragma unroll
        for (int ks = 0; ks < 8; ++ks) {
            v4u bw; bw.x = cvtpk(S[2 * ks][0], S[2 * ks][1]); bw.y = cvtpk(S[2 * ks][2], S[2 * ks][3]); bw.z = cvtpk(S[2 * ks + 1][0], S[2 * ks + 1][1]); bw.w = cvtpk(S[2 * ks + 1][2], S[2 * ks + 1][3]);
            const bf16x8 bfr = __builtin_bit_cast(bf16x8, bw);
#pragma unroll
            for (int ti = 0; ti < 4; ++ti) {
                const LAS char* ap = L + OQ + (16 * ti + cl) * PQ + (32 * ks + 4 * gq) * 2;
                const s16x4 lo = *(const LAS s16x4*)ap, hi = *(const LAS s16x4*)(ap + 32);
                o[ti] = MFMA16(CAT8(lo, hi), bfr, o[ti]);
            }
        }
        bf16x8 vb[2];
#pragma unroll
        for (int ks = 0; ks < 2; ++ks) { const LAS char* vp = L + OV + (32 * ks + 4 * gq + (cl >> 2)) * PV + 32 * wave + 8 * (cl & 3);
            const s16x4 lo = vtr(vp), hi = vtr(vp + 16 * PV); vb[ks] = CAT8(lo, hi); }
#pragma unroll
        for (int ks = 0; ks < 2; ++ks)
#pragma unroll
            for (int ti = 0; ti < 4; ++ti) {
                const LAS char* ap = L + OA + (16 * ti + cl) * PA + (32 * ks + 4 * gq) * 2;
                const s16x4 lo = *(const LAS s16x4*)ap, hi = *(const LAS s16x4*)(ap + 32);
                o[ti] = MFMA16(CAT8(lo, hi), vb[ks], o[ti]);
            }
#pragma unroll
        for (int ti = 0; ti < 4; ++ti)
#pragma unroll
            for (int r = 0; r < 4; ++r) OD[(size_t)(row0 + 16 * ti + 4 * gq + r) * 2048 + dvc + 16 * wave + cl] = o[ti][r];
#pragma unroll
        for (int t = 0; t < 16; ++t) {
            const f32x4 dc = *(const LAS f32x4*)(L + ODEC + (16 * t + 4 * gq) * 4);
            S[t] = S[t] * dc;
#pragma unroll
            for (int ks = 0; ks < 2; ++ks) { const LAS char* kp = L + OK_ + (32 * ks + 4 * gq + (cl >> 2)) * PK + 32 * t + 8 * (cl & 3);
                const s16x4 lo = vtr(kp), hi = vtr(kp + 16 * PK); S[t] = MFMA16(CAT8(lo, hi), vb[ks], S[t]); }
        }
        __syncthreads();
        if (s + 1 < nch) { LWRITE(); }
        __syncthreads();
    }
    if (!sample) { float* so = F.out + (d == 0 ? O_GF : O_GB) + ((size_t)(seq * 4 + h) * 256) * 512 + sl * 128 + 16 * wave + cl;
#pragma unroll
        for (int t = 0; t < 16; ++t)
#pragma unroll
            for (int r = 0; r < 4; ++r) so[(size_t)(16 * t + 4 * gq + r) * 512] = S[t][r];
    }
#undef GLOAD
#undef LWRITE
}
__device__ __forceinline__ void gla_scan_phase(Frame& F) {
    const int NS = 64;
    if (F.G > 2 * NS) {
        if (F.bx < NS) { const int c = F.bx; gla_scan_item(F, 32 + (c >> 5), (c >> 3) & 3, (c >> 2) & 1, c & 3); }
        else for (int it = F.bx - NS; it < 1024; it += F.G - NS) gla_scan_item(F, it >> 5, (it >> 3) & 3, (it >> 2) & 1, it & 3);
    } else {
        for (int it = F.bx; it < 1024 + NS; it += F.G) { if (it < NS) gla_scan_item(F, 32 + (it >> 5), (it >> 3) & 3, (it >> 2) & 1, it & 3); else { const int i2 = it - NS; gla_scan_item(F, i2 >> 5, (i2 >> 3) & 3, (i2 >> 2) & 1, i2 & 3); } }
    }
}
__device__ __forceinline__ void gla_post_phase(Frame& F) {
    const int gw = F.bx * NWAVES + F.wave, NGW = F.G * NWAVES, lane = F.lane;
    const float* OFp = WSP(float, WS_GOF); const float* OBp = WSP(float, WS_GOB); const bf16* GR = WSP(bf16, WS_GR); bf16* AO = WSP(bf16, WS_AO); const float* gn = F.in[I_GNORM];
    for (int row = gw; row < MTOK; row += NGW) {
#pragma unroll
        for (int hh = 0; hh < 4; ++hh) {
            const size_t o0 = (size_t)row * 2048 + hh * 512 + 4 * lane;
            const f32x4 v0 = *(const f32x4*)(OFp + o0) + *(const f32x4*)(OBp + o0), v1 = *(const f32x4*)(OFp + o0 + 256) + *(const f32x4*)(OBp + o0 + 256);
            float ss = (v0[0] * v0[0] + v0[1] * v0[1]) + (v0[2] * v0[2] + v0[3] * v0[3]) + (v1[0] * v1[0] + v1[1] * v1[1]) + (v1[2] * v1[2] + v1[3] * v1[3]);
            const float rstd = rsqrtf(wave_sum(ss) * (1.f / 512.f) + EPS);
            const v2u r0 = *(const v2u*)(GR + o0), r1 = *(const v2u*)(GR + o0 + 256);
            f32x4 ra = {bf2f((unsigned short)(r0.x & 0xffff)), bf2f((unsigned short)(r0.x >> 16)), bf2f((unsigned short)(r0.y & 0xffff)), bf2f((unsigned short)(r0.y >> 16))};
            f32x4 rb = {bf2f((unsigned short)(r1.x & 0xffff)), bf2f((unsigned short)(r1.x >> 16)), bf2f((unsigned short)(r1.y & 0xffff)), bf2f((unsigned short)(r1.y >> 16))};
#pragma unroll
            for (int i = 0; i < 4; ++i) { ra[i] = ra[i] / (1.f + __expf(-ra[i])); rb[i] = rb[i] / (1.f + __expf(-rb[i])); }
            const f32x4 y0 = v0 * rstd * *(const f32x4*)(gn + 4 * lane) * ra, y1 = v1 * rstd * *(const f32x4*)(gn + 256 + 4 * lane) * rb;
            v2u w; w.x = cvtpk(y0[0], y0[1]); w.y = cvtpk(y0[2], y0[3]); *(v2u*)(AO + o0) = w;
            w.x = cvtpk(y1[0], y1[1]); w.y = cvtpk(y1[2], y1[3]); *(v2u*)(AO + o0 + 256) = w;
        }
    }
}

#ifndef MK_N_LAUNCHES
#define MK_N_LAUNCHES 1
#ifndef PG8_ALIGN
#define PG8_ALIGN true
#endif
#ifndef PG8_SP2
#define PG8_SP2 true
#endif
#endif
constexpr int N_PHASES = 35;
__global__ void __launch_bounds__(NWAVES * 64, 2) mk_fwd(Args args) {
    extern __shared__ __attribute__((aligned(16))) unsigned char lds[];
    Frame F;
    F.lds = (LAS unsigned char*)lds; F.ldsg = lds;
    F.tid = threadIdx.x; F.lane = F.tid & 63; F.wave = __builtin_amdgcn_readfirstlane(F.tid >> 6);
    F.G = gridDim.x; F.bx = blockIdx.x;
    F.in = args.in; F.out = args.out; F.ws = args.ws;
    volatile LAS unsigned* MISC = (volatile LAS unsigned*)(F.lds + MISC_OFF);
    if (F.tid < 32) MISC[F.tid] = 0u;
    __syncthreads();
    const int lo = args.ph_lo, hi = args.ph_hi;
    const bool use_bar = (hi - lo) > 1;
    XcdBarrier bar; bar.bar = (unsigned*)(F.ws + WS_CTL) + CW_BAR + args.li * XCD_BAR_WORDS; bar.x = 0; bar.st = nullptr;
    if (use_bar) bar = xcd_barrier_post((unsigned*)(F.ws + WS_CTL) + CW_BAR + args.li * XCD_BAR_WORDS, MISC + 8);
#ifdef PH_ONLY
#define IN(k) ((k) == PH_ONLY && lo <= (k) && (k) < hi)
#else
#define IN(k) (lo <= (k) && (k) < hi)
#endif
#define SEAM(k) do { if (IN(k) && IN((k) + 1)) xcd_barrier(bar); } while (0)
    LAS unsigned char* ring = F.lds;

#ifndef PROBE_MASK
#define PROBE_MASK 0ull
#endif
    constexpr unsigned long long REP_MASK = PROBE_MASK;
#define PHASE(k, ...) if (IN(k)) { if (((REP_MASK >> (k)) & 1ull) != 0ull) { const bool dry_ = true; (void)dry_; __VA_ARGS__ xcd_barrier(bar); } { const bool dry_ = false; (void)dry_; __VA_ARGS__ } } SEAM(k);
#define GATE(L, q) (dry_ ? (const float*)(F.ws + WS_CTL + 524288) : WSP(float, WS_MOD) + (size_t)((L) * 3) * 12288 + (q) * 2048)
    PHASE(0, p0_prologue(F);)

#define GEMM_PHASE(EpiT, epi, Aptr, Bptr, M_, N_, K_) do { int kk_ = (K_); asm volatile("" : "+s"(kk_)); pg8::Gemm g{(const pg8::bf16_t*)(Aptr), (const pg8::bf16_t*)(Bptr), (M_), (N_), kk_}; pg8::StaticOrder S; S.init((M_), (N_), F.G, F.bx); \
        pg8::gemm_phase<EpiT, pg8::StaticOrder, PG8_ALIGN, PG8_SP2>(ring, g, S, epi); } while (0)

#define LAYER_TAIL(P, L, WOT) \
    PHASE((P), EpiResid E{F.in[I_XP], F.in[I_XS], WSP(float, WS_X), GATE((L), 2), (L) == 0 ? 1 : 0}; GEMM_PHASE(EpiResid, E, WSP(bf16, WS_AO), (WOT), MTOK, DM, DM);) \
    PHASE((P) + 1, mod_phase(F, (L), 1, 0);) \
    PHASE((P) + 2, EpiRelu2 E{WSP(bf16, WS_HID), FFH}; GEMM_PHASE(EpiRelu2, E, WSP(bf16, WS_H), WSP(bf16, WS_W1T) + (size_t)(L) * FFH * DM, MTOK, FFH, DM);) \
    PHASE((P) + 3, EpiResid E{F.in[I_XP], F.in[I_XS], WSP(float, WS_X), GATE((L), 5), 0}; GEMM_PHASE(EpiResid, E, WSP(bf16, WS_HID), WSP(bf16, WS_W2T) + (size_t)(L) * DM * FFH, MTOK, DM, FFH);)

#define WIN_LAYER(P, L, J) \
    PHASE((P), mod_phase(F, (L), 0, (L) == 0 ? 1 : 0);) \
    PHASE((P) + 1, EpiQkvWin E{WSP(bf16, WS_WQ), WSP(bf16, WS_WK), WSP(bf16, WS_WV), F.out + O_WK, F.out + O_WV, (J), WSP(f32x2, WS_TABW)}; \
        GEMM_PHASE(EpiQkvWin, E, WSP(bf16, WS_H), WSP(bf16, WS_WQKVT) + (size_t)(J) * 3072 * DM, MTOK, 3072, DM);) \
    PHASE((P) + 2, attn_win_phase(F, (J));) \
    LAYER_TAIL((P) + 3, (L), WSP(bf16, WS_WWOT) + (size_t)(J) * DM * DM)

    WIN_LAYER(1, 0, 0)
    PHASE(8, mod_phase(F, 1, 0, 0);)
    PHASE(9, EpiF32 E{WSP(float, WS_MD), 1024}; GEMM_PHASE(EpiF32, E, WSP(bf16, WS_H), WSP(bf16, WS_MWDT), MTOK, 1024, DM);)
    PHASE(10, mla_norm_phase(F);)
    PHASE(11, EpiMlaQ E{WSP(bf16, WS_MQ), WSP(f32x2, WS_TABM)}; GEMM_PHASE(EpiMlaQ, E, WSP(bf16, WS_MCQ), WSP(bf16, WS_MWUQT), MTOK, 3072, 512);)
    PHASE(12, EpiMlaKV E{WSP(bf16, WS_MKN), WSP(bf16, WS_MV)}; GEMM_PHASE(EpiMlaKV, E, WSP(bf16, WS_MCKV), WSP(bf16, WS_MWUKVT), MTOK + 1024, 4096, 256);)
    PHASE(13, attn_mla_phase(F);)
    LAYER_TAIL(14, 1, WSP(bf16, WS_MWOT))
    PHASE(18, mod_phase(F, 2, 0, 0);)
    PHASE(19, EpiGlaIn E{WSP(bf16, WS_GQ), WSP(bf16, WS_GK), WSP(bf16, WS_GV), WSP(bf16, WS_GR), WSP(float, WS_GU)}; GEMM_PHASE(EpiGlaIn, E, WSP(bf16, WS_H), WSP(bf16, WS_GWINT), MTOK, 6400, DM);)
    PHASE(20, gla_prep_phase(F);)
    PHASE(21, gla_scan_phase(F);)
    PHASE(22, gla_post_phase(F);)
    LAYER_TAIL(23, 2, WSP(bf16, WS_GWOT))
    WIN_LAYER(27, 3, 1)
    PHASE(34, final_phase(F);)
#undef IN
#undef SEAM
}

extern "C" void kernel_launch(void* const* d_in, const int* in_sizes, int n_in, void* d_out, int out_size, void* d_ws, size_t ws_size, hipStream_t stream) {
    static int grid = 0;
    if (grid == 0) {
        if (n_in != 31 || (size_t)out_size != O_END || ws_size < WS_END) { fprintf(stderr, "kernel_launch: shape mismatch n_in %d out %d ws %zu (need %zu)\n", n_in, out_size, ws_size, (size_t)WS_END); grid = -1; return; }
        int dev = 0, cus = 0, per_cu = 0;
        if (hipGetDevice(&dev) != hipSuccess || hipDeviceGetAttribute(&cus, hipDeviceAttributeMultiprocessorCount, dev) != hipSuccess) { grid = -1; return; }
        if (hipFuncSetAttribute((const void*)mk_fwd, hipFuncAttributeMaxDynamicSharedMemorySize, LDS_BYTES) != hipSuccess) { fprintf(stderr, "kernel_launch: hipFuncSetAttribute failed\n"); grid = -1; return; }
        if (hipOccupancyMaxActiveBlocksPerMultiprocessor(&per_cu, (const void*)mk_fwd, NWAVES * 64, LDS_BYTES) != hipSuccess || per_cu < 1) fprintf(stderr, "kernel_launch: occupancy query says %d\n", per_cu);
        (void)hipGetLastError();
        grid = cus;
    }
    if (grid < 0) return;
    if (hipMemsetAsync((char*)d_ws + WS_CTL, 0, CTL_ZERO_BYTES, stream) != hipSuccess) return;
    Args a{};
    for (int i = 0; i < 31; ++i) a.in[i] = (const float*)d_in[i];
    a.in[31] = nullptr;
    a.out = (float*)d_out; a.ws = (unsigned char*)d_ws; a.pad = 0; a.rep_mask = 0ull; a.rep_n = 1; a.pad2 = 0;
#if MK_N_LAUNCHES == 1
    a.ph_lo = 0; a.ph_hi = N_PHASES; a.li = 0;
    hipLaunchKernelGGL(mk_fwd, dim3(grid), dim3(NWAVES * 64), LDS_BYTES, stream, a);
#else
    for (int p = 0; p < N_PHASES; ++p) { a.ph_lo = p; a.ph_hi = p + 1; a.li = 0; hipLaunchKernelGGL(mk_fwd, dim3(grid), dim3(NWAVES * 64), LDS_BYTES, stream, a); }
#endif
}
```

```cpp
#include <hip/hip_runtime.h>
#include <cstdio>
#include <cstdint>
namespace pg8 {
#define PG8_LAS __attribute__((address_space(3)))
typedef unsigned short bf16_t;
typedef short bf16x8 __attribute__((ext_vector_type(8)));
typedef float f32x4 __attribute__((ext_vector_type(4)));
typedef unsigned u32x4 __attribute__((ext_vector_type(4)));
constexpr int BM = 256, BK = 64, HALF = 128, HTB = HALF * BK * 2  , STAGE_BYTES = 8 * HTB, NXCD = 8, WGM = 8;

__host__ __device__ __forceinline__ int lds_byte(int r, int c) { const int st = (r >> 4) * 2 + (c >> 5), rr = r & 15, cc = c & 31, ob = rr * 64 + cc * 2; return st * 1024 + (ob ^ (((ob >> 9) & 1) << 5)); }
__host__ __device__ __forceinline__ void stage_rc(int b, int& R, int& C) { const int st = b / 1024, sb = b % 1024, swz = sb ^ (((sb >> 9) & 1) << 5); R = (st >> 1) * 16 + swz / 64; C = (st & 1) * 32 + (swz % 64) / 2; }
__host__ __device__ __forceinline__ int perm32(int rho) { const int n = rho >> 4, i = rho & 15; return 8 * (i >> 2) + 4 * n + (i & 3); }

struct Unit { int pm, pn; };
struct Gemm { const bf16_t* A; const bf16_t* Bt; int M, N, K; };

struct StaticOrder {
    int nM, nN, nwg, G, c;
    __host__ __device__ void init(int M, int N, int G_, int c_) { nM = M / BM; nN = N / BM; nwg = nM * nN; G = G_; c = c_; }
    __host__ __device__ bool next(int i, Unit& u) const {
        const long L = (long)i * G + c; if (L >= nwg) return false;
        int wgid = (int)L; { const int q = nwg / NXCD, r = nwg % NXCD, xcd = wgid % NXCD, off = wgid / NXCD; wgid = (xcd < r ? xcd * (q + 1) : r * (q + 1) + (xcd - r) * q) + off; }
        const int nig = WGM * nN, gid = wgid / nig, fm = gid * WGM, gsz = (nM - fm) < WGM ? (nM - fm) : WGM;
        u.pm = fm + ((wgid % nig) % gsz); u.pn = (wgid % nig) / gsz; return true;
    }
    __device__ __forceinline__ void a_ready(const Unit&) const {}
    __device__ __forceinline__ void done(const Unit&) const {}
};
__device__ __forceinline__ unsigned cvt_pk_bf16(float lo, float hi) { unsigned r; asm volatile("v_cvt_pk_bf16_f32 %0, %1, %2" : "=v"(r) : "v"(lo), "v"(hi)); return r; }
typedef float f32x2 __attribute__((ext_vector_type(2)));
template <class Epi, class Sched, bool ALIGN_EPI = false, bool SP2 = false>
__device__ __forceinline__ void gemm_phase(PG8_LAS unsigned char* lds, const Gemm g, const Sched& S, const Epi& E) {
    const int tid = threadIdx.x, wid = __builtin_amdgcn_readfirstlane(tid >> 6), lane = tid & 63, wr = wid >> 2, wc = wid & 3, fr = lane & 15, fq = lane >> 4;
    const int K = g.K, nt = K / BK;
    unsigned voffA[2], voffB[2];
#pragma unroll
    for (int i = 0; i < 2; ++i) { int R, C; stage_rc(tid * 16 + i * 8192, R, C); const int Rb = Epi::PERM ? ((R & ~31) + perm32(R & 31)) : R;
        voffA[i] = (unsigned)(R * K + C) * 2u; voffB[i] = (unsigned)(Rb * K + C) * 2u; }
    const size_t kstep = (size_t)(BK * 2);
    const size_t hstep = (size_t)HALF * K * 2;
    const size_t tstep = 2 * hstep;
    const unsigned ldsw = (unsigned)wid * 1024u;
    const int aoff = lds_byte(wr * 64 + fr, fq * 8), boff = lds_byte(wc * 32 + fr, fq * 8);
#define PG8_SA(b, h) (((b) * 2 + (h)) * HTB)
#define PG8_SB(b, h) ((4 + (b) * 2 + (h)) * HTB)
#define PG8_STAGE(bufoff, gbase, voff) do { _Pragma("unroll") for (int _i = 0; _i < 2; ++_i) \
        __builtin_amdgcn_global_load_lds((const unsigned*)((const char*)(gbase) + (voff)[_i]), (PG8_LAS unsigned*)(lds + (bufoff) + ldsw + _i * 8192), 16, 0, 0); } while (0)
#define PG8_LDA(dst, b, h) do { _Pragma("unroll") for (int m = 0; m < 4; ++m) _Pragma("unroll") for (int k = 0; k < 2; ++k) dst[m][k] = *(const PG8_LAS bf16x8*)(lds + PG8_SA(b, h) + aoff + m * 2048 + k * 1024); } while (0)
#define PG8_LDB(dst, b, h) do { _Pragma("unroll") for (int n = 0; n < 2; ++n) _Pragma("unroll") for (int k = 0; k < 2; ++k) dst[n][k] = *(const PG8_LAS bf16x8*)(lds + PG8_SB(b, h) + boff + n * 2048 + k * 1024); } while (0)
#define PG8_MMA(ai, bj, At, Bt) do { __builtin_amdgcn_s_setprio(1); _Pragma("unroll") for (int m = 0; m < 4; ++m) _Pragma("unroll") for (int n = 0; n < 2; ++n) _Pragma("unroll") for (int k = 0; k < 2; ++k) \
        acc[ai][bj][m][n] = __builtin_amdgcn_mfma_f32_16x16x32_bf16(Bt[n][k], At[m][k], acc[ai][bj][m][n], 0, 0, 0); __builtin_amdgcn_s_setprio(0); } while (0)
#define PG8_WAIT_V(n) asm volatile("s_waitcnt vmcnt(" #n ")" ::: "memory")
#define PG8_WAIT_L(n) asm volatile("s_waitcnt lgkmcnt(" #n ")" ::: "memory")
#define PG8_BAR __builtin_amdgcn_s_barrier()
#define PG8_SCHED __builtin_amdgcn_sched_barrier(0)
    Unit cur, nxt; int ui = 0;
    if (!S.next(0, cur)) return;
    f32x4 acc[2][2][4][2];
#pragma unroll
    for (int a = 0; a < 2; ++a)
#pragma unroll
        for (int b = 0; b < 2; ++b)
#pragma unroll
            for (int m = 0; m < 4; ++m)
#pragma unroll
                for (int n = 0; n < 2; ++n) acc[a][b][m][n] = (f32x4){0.f, 0.f, 0.f, 0.f};
    bf16x8 At[4][2], B0[2][2], B1[2][2];
    const char* cA = (const char*)g.A + (size_t)cur.pm * tstep; const char* cB = (const char*)g.Bt + (size_t)cur.pn * tstep;
    S.a_ready(cur);
    if constexpr (SP2) {
        PG8_STAGE(PG8_SB(0, 0), cB, voffB); PG8_STAGE(PG8_SB(0, 1), cB + hstep, voffB); PG8_STAGE(PG8_SA(0, 0), cA, voffA); PG8_STAGE(PG8_SA(0, 1), cA + hstep, voffA);
        if (wr == 1) PG8_BAR;
        PG8_WAIT_V(2); PG8_BAR;
        PG8_STAGE(PG8_SB(1, 0), cB + kstep, voffB); PG8_STAGE(PG8_SA(1, 0), cA + kstep, voffA); PG8_STAGE(PG8_SB(1, 1), cB + hstep + kstep, voffB);
        PG8_WAIT_V(6); PG8_BAR;
    } else {
        PG8_STAGE(PG8_SB(0, 0), cB, voffB); PG8_STAGE(PG8_SA(0, 0), cA, voffA); PG8_STAGE(PG8_SB(0, 1), cB + hstep, voffB); PG8_STAGE(PG8_SA(0, 1), cA + hstep, voffA);
        if (wr == 1) PG8_BAR;
        PG8_WAIT_V(4); PG8_BAR;
        PG8_STAGE(PG8_SB(1, 0), cB + kstep, voffB); PG8_STAGE(PG8_SA(1, 0), cA + kstep, voffA); PG8_STAGE(PG8_SB(1, 1), cB + hstep + kstep, voffB);
        PG8_WAIT_V(6); PG8_BAR;
    }
    for (;;) {
        const bool has_next = S.next(ui + 1, nxt);
        const char* nA = has_next ? (const char*)g.A + (size_t)nxt.pm * tstep : cA; const char* nB = has_next ? (const char*)g.Bt + (size_t)nxt.pn * tstep : cB;
        for (int t = 0; t < nt; t += 2) {
            const bool last = (t == nt - 2);
            const char* a1 = cA + (size_t)(t + 1) * kstep;
            const char* a2 = last ? nA : cA + (size_t)(t + 2) * kstep; const char* b2 = last ? nB : cB + (size_t)(t + 2) * kstep;
            const char* a3 = a2 + kstep; const char* b3 = b2 + kstep;
            if (last && has_next) S.a_ready(nxt);
            if constexpr (SP2) {
            PG8_LDB(B0, 0, 0); PG8_LDB(B1, 0, 1); PG8_SCHED; PG8_LDA(At, 0, 0); PG8_STAGE(PG8_SA(1, 1), a1 + hstep, voffA);
            PG8_WAIT_V(8); PG8_WAIT_L(0); PG8_BAR; PG8_MMA(0, 0, At, B0); PG8_MMA(0, 1, At, B1); PG8_BAR; PG8_SCHED;
            PG8_LDA(At, 0, 1); PG8_STAGE(PG8_SB(0, 0), b2, voffB); PG8_STAGE(PG8_SB(0, 1), b2 + hstep, voffB); PG8_STAGE(PG8_SA(0, 0), a2, voffA);
            PG8_WAIT_V(8); PG8_WAIT_L(0); PG8_BAR; PG8_MMA(1, 0, At, B0); PG8_MMA(1, 1, At, B1); PG8_BAR; PG8_SCHED;
            PG8_LDB(B0, 1, 0); PG8_LDB(B1, 1, 1); PG8_SCHED; PG8_LDA(At, 1, 0); PG8_STAGE(PG8_SA(0, 1), a2 + hstep, voffA);
            PG8_WAIT_V(8); PG8_WAIT_L(0); PG8_BAR; PG8_MMA(0, 0, At, B0); PG8_MMA(0, 1, At, B1); PG8_BAR; PG8_SCHED;
            PG8_LDA(At, 1, 1); PG8_STAGE(PG8_SB(1, 0), b3, voffB); PG8_STAGE(PG8_SB(1, 1), b3 + hstep, voffB); PG8_STAGE(PG8_SA(1, 0), a3, voffA);
            PG8_WAIT_V(8); PG8_WAIT_L(0); PG8_BAR; PG8_MMA(1, 0, At, B0); PG8_MMA(1, 1, At, B1); PG8_BAR; PG8_SCHED;
            } else {
            PG8_LDB(B0, 0, 0); PG8_SCHED; PG8_LDA(At, 0, 0); PG8_STAGE(PG8_SA(1, 1), a1 + hstep, voffA);
            PG8_WAIT_L(8); PG8_BAR; PG8_WAIT_L(0); PG8_MMA(0, 0, At, B0); PG8_BAR; PG8_SCHED;
            PG8_LDB(B1, 0, 1); PG8_STAGE(PG8_SB(0, 0), b2, voffB);
            PG8_BAR; PG8_WAIT_L(0); PG8_MMA(0, 1, At, B1); PG8_BAR;
            PG8_LDA(At, 0, 1); PG8_STAGE(PG8_SA(0, 0), a2, voffA);
            PG8_BAR; PG8_WAIT_L(0); PG8_MMA(1, 0, At, B0); PG8_BAR; PG8_SCHED;
            PG8_STAGE(PG8_SB(0, 1), b2 + hstep, voffB);
            PG8_WAIT_V(6); PG8_BAR; PG8_MMA(1, 1, At, B1); PG8_BAR;
            PG8_LDB(B0, 1, 0); PG8_SCHED; PG8_LDA(At, 1, 0); PG8_STAGE(PG8_SA(0, 1), a2 + hstep, voffA);
            PG8_WAIT_L(8); PG8_BAR; PG8_WAIT_L(0); PG8_MMA(0, 0, At, B0); PG8_BAR; PG8_SCHED;
            PG8_LDB(B1, 1, 1); PG8_STAGE(PG8_SB(1, 0), b3, voffB);
            PG8_BAR; PG8_WAIT_L(0); PG8_MMA(0, 1, At, B1); PG8_BAR;
            PG8_LDA(At, 1, 1); PG8_STAGE(PG8_SA(1, 0), a3, voffA);
            PG8_BAR; PG8_WAIT_L(0); PG8_MMA(1, 0, At, B0); PG8_BAR; PG8_SCHED;
            PG8_STAGE(PG8_SB(1, 1), b3 + hstep, voffB);
            PG8_WAIT_V(6); PG8_BAR; PG8_MMA(1, 1, At, B1); PG8_BAR;
            }
        }
        if constexpr (ALIGN_EPI) { if (wr == 0) PG8_BAR; }
        if constexpr (!Epi::AFTER_DRAIN) { E(acc, cur, wr, wc, fr, fq); S.done(cur); }
        if (!has_next) break;
#pragma unroll
        for (int a = 0; a < 2; ++a)
#pragma unroll
            for (int b = 0; b < 2; ++b)
#pragma unroll
                for (int m = 0; m < 4; ++m)
#pragma unroll
                    for (int n = 0; n < 2; ++n) acc[a][b][m][n] = (f32x4){0.f, 0.f, 0.f, 0.f};
        cur = nxt; cA = nA; cB = nB; ++ui;
        if constexpr (ALIGN_EPI) { if (wr == 1) PG8_BAR; }
    }
    PG8_WAIT_V(0);
    if constexpr (!ALIGN_EPI) { if (wr == 0) PG8_BAR; }
    PG8_BAR;
    if constexpr (Epi::AFTER_DRAIN) { E.fused(acc, cur, wr, wc, fr, fq, lds, wid, lane); S.done(cur); }
#undef PG8_SA
#undef PG8_SB
#undef PG8_STAGE
#undef PG8_LDA
#undef PG8_LDB
#undef PG8_MMA
#undef PG8_WAIT_V
#undef PG8_WAIT_L
#undef PG8_BAR
#undef PG8_SCHED
}
}

#define GAS __attribute__((address_space(1)))
#define LAS __attribute__((address_space(3)))
typedef unsigned short bf16;
typedef unsigned v4u __attribute__((ext_vector_type(4)));
typedef unsigned v2u __attribute__((ext_vector_type(2)));
typedef float f32x4 __attribute__((ext_vector_type(4)));
typedef float f32x2 __attribute__((ext_vector_type(2)));
typedef float f32x16 __attribute__((ext_vector_type(16)));
typedef short bf16x8 __attribute__((ext_vector_type(8)));
typedef short s16x4 __attribute__((ext_vector_type(4)));
typedef GAS unsigned gu32;
#define RLX_AGENT __ATOMIC_RELAXED, __HIP_MEMORY_SCOPE_AGENT
#define LDS_WAIT() asm volatile("s_waitcnt lgkmcnt(0)" ::: "memory")
#define VM_WAIT() asm volatile("s_waitcnt vmcnt(0)" ::: "memory")
#define SBAR() __builtin_amdgcn_sched_barrier(0)
__device__ __forceinline__ unsigned f2bf(float f) { unsigned u = __builtin_bit_cast(unsigned, f); return (u + 0x7fffu + ((u >> 16) & 1u)) >> 16; }
__device__ __forceinline__ unsigned pk2(float lo, float hi) { return f2bf(lo) | (f2bf(hi) << 16); }
__device__ __forceinline__ float bf2f(unsigned short b) { return __builtin_bit_cast(float, (unsigned)b << 16); }
__device__ __forceinline__ unsigned cvtpk(float lo, float hi) { unsigned r; asm volatile("v_cvt_pk_bf16_f32 %0, %1, %2" : "=v"(r) : "v"(lo), "v"(hi)); return r; }
__device__ __forceinline__ float wave_sum(float v) {
#pragma unroll
    for (int o = 1; o < 64; o <<= 1) v += __shfl_xor(v, o);
    return v;
}
#define XB_TMO      128
#define XB_XCNT(j)  (256  + 64 * (j))
#define XB_XSUB(j)  (1280 + 64 * (j))
#define XB_XGEN(j)  (2304 + 64 * (j))
#define XB_TOP      3328
#define XB_TOPGEN   3392
#define XCD_BAR_WORDS 3456
#define XB_SPIN_CAP (1u << 18)

__device__ __forceinline__ unsigned xb_ld(unsigned* p)              { return __hip_atomic_load(p, __ATOMIC_RELAXED, __HIP_MEMORY_SCOPE_AGENT); }
__device__ __forceinline__ unsigned xb_add(unsigned* p, unsigned v) { return __hip_atomic_fetch_add(p, v, __ATOMIC_RELAXED, __HIP_MEMORY_SCOPE_AGENT); }
__device__ __forceinline__ unsigned xb_xcc_id() { return (unsigned)__builtin_amdgcn_s_getreg((3 << 11) | 20) & 0xFu; }
#define XB_SPIN(cond, bar) do { unsigned _sp = 0; while (cond) { __builtin_amdgcn_s_sleep(1); \
    if ((++_sp & 255u) == 0u) { if (xb_ld(&(bar)[XB_TMO])) break; if (_sp > XB_SPIN_CAP) { atomicAdd(&(bar)[XB_TMO], 1u); break; } } } } while (0)

struct XcdBarrier {
    unsigned* bar; unsigned x;
    volatile LAS unsigned* st;
};

__device__ __forceinline__ XcdBarrier xcd_barrier_post(unsigned* bar, volatile LAS unsigned* st) {
    XcdBarrier b; b.bar = bar; b.x = xb_xcc_id(); b.st = st;
    if (threadIdx.x == 0) (void)xb_add(&bar[XB_XCNT(b.x)], 1u);
    return b;
}
__device__ __forceinline__ void xcd_barrier_complete(unsigned* bar, unsigned x, unsigned& nloc, unsigned& nx) {
    const unsigned G = gridDim.x * gridDim.y * gridDim.z;
    unsigned sum, cnt, mine, sp = 0u;
    for (;;) {
        sum = 0u; cnt = 0u; mine = 0u;
#pragma unroll
        for (unsigned j = 0; j < 16; ++j) { const unsigned c = xb_ld(&bar[XB_XCNT(j)]); sum += c; cnt += (c > 0u) ? 1u : 0u; mine = (j == x) ? c : mine; }
        if (sum == G) break;
        __builtin_amdgcn_s_sleep(1);
        if ((++sp & 255u) == 0u) { if (xb_ld(&bar[XB_TMO])) break; if (sp > XB_SPIN_CAP) { atomicAdd(&bar[XB_TMO], 1u); break; } }
    }
    nloc = mine > 0u ? mine : 1u; nx = cnt > 0u ? cnt : 1u;
}

__device__ __forceinline__ void xcd_barrier(const XcdBarrier& b) {
    asm volatile("s_waitcnt vmcnt(0)" ::: "memory");
    __syncthreads();
    if (threadIdx.x == 0) {
        unsigned* bar = b.bar;
        __builtin_amdgcn_s_waitcnt(0);
        unsigned nloc = b.st[0], nx = b.st[1];
        if (nloc == 0u) { xcd_barrier_complete(bar, b.x, nloc, nx); b.st[0] = nloc; b.st[1] = nx; }
        const unsigned old = xb_add(&bar[XB_XSUB(b.x)], 1u);
        const unsigned gen = old / nloc;
        if (old + 1u == (gen + 1u) * nloc) {
            __builtin_amdgcn_fence(__ATOMIC_RELEASE, "agent");
            asm volatile("s_waitcnt vmcnt(0)" ::: "memory");
            const unsigned og = xb_add(&bar[XB_TOP], 1u);
            const unsigned tg = og / nx;
            if (og + 1u == (tg + 1u) * nx) xb_add(&bar[XB_TOPGEN], 1u);
            else XB_SPIN(xb_ld(&bar[XB_TOPGEN]) == tg, bar);
            __builtin_amdgcn_fence(__ATOMIC_ACQUIRE, "agent");
            xb_add(&bar[XB_XGEN(b.x)], 1u);
            asm volatile("s_waitcnt vmcnt(0)" ::: "memory");
        } else {
            XB_SPIN(xb_ld(&bar[XB_XGEN(b.x)]) == gen, bar);
            __builtin_amdgcn_fence(__ATOMIC_ACQUIRE, "agent");
            asm volatile("s_waitcnt vmcnt(0)" ::: "memory");
        }
    }
    __syncthreads();
}

constexpr int NWAVES = 8;
constexpr int DM = 2048, MTOK = 16384, MP = 8192, FFH = 8192;
constexpr float EPS = 1e-6f;
constexpr size_t MiB = 1u << 20;
constexpr size_t WS_CTL = 0, CTL_ZERO_BYTES = 1 * MiB;
constexpr size_t WS_MOD = 2 * MiB;
constexpr size_t WS_TABW = 2 * MiB + 655360;
constexpr size_t WS_TABM = 2 * MiB + 720896;
constexpr size_t WS_SW = 3 * MiB;
constexpr size_t WS_W1T = 4 * MiB;
constexpr size_t WS_W2T = 132 * MiB;
constexpr size_t WS_WQKVT = 260 * MiB;
constexpr size_t WS_WWOT = 284 * MiB;
constexpr size_t WS_MWDT = 300 * MiB;
constexpr size_t WS_MWUQT = 304 * MiB;
constexpr size_t WS_MWUKVT = 307 * MiB;
constexpr size_t WS_MWOT = 309 * MiB;
constexpr size_t WS_GWINT = 317 * MiB;
constexpr size_t WS_GWOT = 342 * MiB;
constexpr size_t WS_CTXK = 350 * MiB;
constexpr size_t WS_CTXV = 352 * MiB;
constexpr size_t WS_X = 354 * MiB;
constexpr size_t WS_H = 482 * MiB;
constexpr size_t WS_AO = 546 * MiB;
constexpr size_t WS_SCR = 610 * MiB;
constexpr size_t WS_HID = WS_SCR;
constexpr size_t WS_WQ = WS_SCR, WS_WK = WS_SCR + 64 * MiB, WS_WV = WS_SCR + 80 * MiB;
constexpr size_t WS_MD = WS_SCR, WS_MCQ = WS_SCR + 64 * MiB, WS_MCKV = WS_SCR + 80 * MiB, WS_MKR = WS_SCR + 89 * MiB, WS_MQ = WS_SCR + 92 * MiB, WS_MKN = WS_SCR + 188 * MiB, WS_MV = WS_SCR + 256 * MiB;
constexpr size_t WS_GQ = WS_SCR, WS_GK = WS_SCR + 32 * MiB, WS_GV = WS_SCR + 64 * MiB, WS_GR = WS_SCR + 128 * MiB, WS_GU = WS_SCR + 192 * MiB,
                 WS_GQT = WS_SCR + 194 * MiB, WS_GKD = WS_SCR + 258 * MiB, WS_GAM = WS_SCR + 322 * MiB, WS_GDEC = WS_SCR + 338 * MiB, WS_GOF = WS_SCR + 340 * MiB, WS_GOB = WS_SCR + 468 * MiB;
constexpr size_t WS_PART = WS_SCR + 596 * MiB;
constexpr size_t WS_END = WS_PART + 16 * MiB;
constexpr size_t O_YP = 0, O_YS = 16777216, O_WK = 33554432, O_WV = 41943040, O_CKV = 50331648, O_KR = 52428800, O_GF = 52953088, O_GB = 69730304, O_END = 86507520;
constexpr int CW_BAR = 4096;
constexpr int RING_BYTES = 131072, MISC_OFF = 135168 + 320, LDS_BYTES = 147456;

struct Args {
    const float* in[32]; float* out; unsigned char* ws; int ph_lo, ph_hi, li, pad; unsigned long long rep_mask; int rep_n, pad2;
};
enum { I_XP = 0, I_XS, I_C, I_CWK, I_CWV, I_CCKV, I_CKR, I_SGF, I_SGB, I_CCTX, I_ADAW, I_ADAB, I_NORMG, I_WQKV, I_SINK, I_WWO, I_MWD, I_MQN, I_MWUQ, I_MKVN, I_MWUKV, I_MWO,
       I_GWIN, I_GWA1, I_GWA2, I_GBA, I_GNORM, I_GWO, I_W1, I_W2, I_FNORM };

__device__ __forceinline__ int cond_of_pm(int pm) { return pm < 32 ? 0 : (pm >> 4) - 1; }

__device__ __forceinline__ v4u pack8(const f32x4& a, const f32x4& b) { v4u w; w.x = cvtpk(a[0], a[1]); w.y = cvtpk(a[2], a[3]); w.z = cvtpk(b[0], b[1]); w.w = cvtpk(b[2], b[3]); return w; }

struct NormIn {
    const float* part; const float* sW; const LAS float* lrs; int pm0;
    __device__ __forceinline__ float rstd(int row, int pm) const {
        if (pm == pm0) return lrs[row & 255];
        const f32x4* pp = (const f32x4*)(part + (size_t)row * 32); f32x4 t = pp[0];
#pragma unroll
        for (int i = 1; i < 8; ++i) t += pp[i];
        return rsqrtf(((t[0] + t[1]) + (t[2] + t[3])) * (1.f / 2048.f) + EPS);
    }
    __device__ __forceinline__ const float* swp(int pm) const { return sW + (size_t)cond_of_pm(pm) * 8192; }
};

struct EpiResid {
    static constexpr bool PERM = true, AFTER_DRAIN = false;
    const float* xp; const float* xs; float* X; const float* gate; int first;
    bf16* H; const float* ng; const float* nsc; float* rss;
    __device__ __forceinline__ void operator()(const pg8::f32x4 (&acc)[2][2][4][2], const pg8::Unit& u, int wr, int wc, int fr, int fq) const {
        const int row0 = u.pm * 256 + wr * 64 + fr, col0 = u.pn * 256 + wc * 32 + 8 * fq, cond = cond_of_pm(u.pm);
        const float* gp = gate + (size_t)cond * 12288 + col0;
        f32x4 gv[2][2], av[2][2];
#pragma unroll
        for (int bj = 0; bj < 2; ++bj)
#pragma unroll
            for (int n = 0; n < 2; ++n) { gv[bj][n] = *(const f32x4*)(gp + bj * 128 + 4 * n);
                av[bj][n] = H ? *(const f32x4*)(ng + col0 + bj * 128 + 4 * n) * (*(const f32x4*)(nsc + (size_t)cond * 12288 + col0 + bj * 128 + 4 * n) + 1.f) : (f32x4){0.f, 0.f, 0.f, 0.f}; }
        f32x4 xv[2][2][2];
#define ER_LOAD(r, buf) do { const int row_ = row0 + ((r) >> 2) * 128 + ((r) & 3) * 16; const float* sp_ = first ? (row_ < MP ? xp + (size_t)row_ * DM : xs + (size_t)(row_ - MP) * DM) : X + (size_t)row_ * DM; \
        _Pragma("unroll") for (int bj = 0; bj < 2; ++bj) { xv[buf][bj][0] = *(const f32x4*)(sp_ + col0 + bj * 128); xv[buf][bj][1] = *(const f32x4*)(sp_ + col0 + bj * 128 + 4); } } while (0)
        ER_LOAD(0, 0);
#pragma unroll
        for (int r = 0; r < 8; ++r) {
            if (r + 1 < 8) ER_LOAD(r + 1, (r + 1) & 1);
            SBAR();
            const int ai = r >> 2, m = r & 3, row = row0 + ai * 128 + m * 16;
            float* dp = X + (size_t)row * DM;
            float ss = 0.f;
#pragma unroll
            for (int bj = 0; bj < 2; ++bj) {
                const int c = col0 + bj * 128;
                const f32x4 x0 = xv[r & 1][bj][0] + gv[bj][0] * acc[ai][bj][m][0], x1 = xv[r & 1][bj][1] + gv[bj][1] * acc[ai][bj][m][1];
                *(f32x4*)(dp + c) = x0; *(f32x4*)(dp + c + 4) = x1;
                if (H) { ss += (x0[0] * x0[0] + x0[1] * x0[1]) + (x0[2] * x0[2] + x0[3] * x0[3]) + (x1[0] * x1[0] + x1[1] * x1[1]) + (x1[2] * x1[2] + x1[3] * x1[3]);
                    *(v4u*)(H + (size_t)row * DM + c) = pack8(x0 * av[bj][0], x1 * av[bj][1]); }
            }
            if (H) { ss += __shfl_xor(ss, 16); ss += __shfl_xor(ss, 32);
                if (fq == 0) rss[(size_t)row * 32 + u.pn * 4 + wc] = ss; }
            SBAR();
        }
#undef ER_LOAD
    }
};

struct EpiRelu2 {
    static constexpr bool PERM = true, AFTER_DRAIN = false;
    bf16* O; int ldc; NormIn ni;
    __device__ __forceinline__ void operator()(const pg8::f32x4 (&acc)[2][2][4][2], const pg8::Unit& u, int wr, int wc, int fr, int fq) const {
        const int row0 = u.pm * 256 + wr * 64 + fr, col0 = u.pn * 256 + wc * 32 + 8 * fq;
        const float* swp = ni.swp(u.pm) + col0; f32x4 sw[2][2];
#pragma unroll
        for (int bj = 0; bj < 2; ++bj)
#pragma unroll
            for (int n = 0; n < 2; ++n) sw[bj][n] = *(const f32x4*)(swp + bj * 128 + 4 * n);
#pragma unroll
        for (int ai = 0; ai < 2; ++ai)
#pragma unroll
            for (int m = 0; m < 4; ++m) {
                const int row = row0 + ai * 128 + m * 16; const float rs = ni.rstd(row, u.pm);
                bf16* rp = O + (size_t)row * ldc + col0;
#pragma unroll
                for (int bj = 0; bj < 2; ++bj) {
                    f32x4 a = acc[ai][bj][m][0] * rs + sw[bj][0], b = acc[ai][bj][m][1] * rs + sw[bj][1];
                    a = __builtin_elementwise_max(a, (f32x4){0.f, 0.f, 0.f, 0.f}); b = __builtin_elementwise_max(b, (f32x4){0.f, 0.f, 0.f, 0.f});
                    a = a * a; b = b * b;
                    *(v4u*)(rp + bj * 128) = pack8(a, b);
                }
            }
    }
};

struct EpiF32 {
    static constexpr bool PERM = true, AFTER_DRAIN = false;
    float* O; int ldc; NormIn ni;
    __device__ __forceinline__ void operator()(const pg8::f32x4 (&acc)[2][2][4][2], const pg8::Unit& u, int wr, int wc, int fr, int fq) const {
        const int row0 = u.pm * 256 + wr * 64 + fr, col0 = u.pn * 256 + wc * 32 + 8 * fq;
        const float* swp = ni.swp(u.pm) + col0; f32x4 sw[2][2];
#pragma unroll
        for (int bj = 0; bj < 2; ++bj)
#pragma unroll
            for (int n = 0; n < 2; ++n) sw[bj][n] = *(const f32x4*)(swp + bj * 128 + 4 * n);
#pragma unroll
        for (int ai = 0; ai < 2; ++ai)
#pragma unroll
            for (int m = 0; m < 4; ++m) {
                const int row = row0 + ai * 128 + m * 16; const float rs = ni.rstd(row, u.pm);
                float* rp = O + (size_t)row * ldc + col0;
#pragma unroll
                for (int bj = 0; bj < 2; ++bj) { *(f32x4*)(rp + bj * 128) = acc[ai][bj][m][0] * rs + sw[bj][0]; *(f32x4*)(rp + bj * 128 + 4) = acc[ai][bj][m][1] * rs + sw[bj][1]; }
            }
    }
};

struct EpiQkvWin {
    static constexpr bool PERM = true, AFTER_DRAIN = false;
    bf16 *Q, *K, *V; float* outk; float* outv; int j; const f32x2* tab; NormIn ni;
    __device__ __forceinline__ void operator()(const pg8::f32x4 (&acc)[2][2][4][2], const pg8::Unit& u, int wr, int wc, int fr, int fq) const {
        const int row0 = u.pm * 256 + wr * 64 + fr, cl = wc * 32 + 8 * fq;
        const int pn = u.pn; const bool sample = u.pm >= 32;
        const int ug = 4 * wc + fq, idx0 = (ug & 7) * 4, d1 = (ug < 8 ? 0 : 64) + idx0;
        const float* swp = ni.swp(u.pm) + u.pn * 256 + cl; f32x4 sw[2][2];
#pragma unroll
        for (int bj = 0; bj < 2; ++bj)
#pragma unroll
            for (int n = 0; n < 2; ++n) sw[bj][n] = *(const f32x4*)(swp + bj * 128 + 4 * n);
#pragma unroll
        for (int ai = 0; ai < 2; ++ai)
#pragma unroll
            for (int m = 0; m < 4; ++m) {
                const int row = row0 + ai * 128 + m * 16; const float rs = ni.rstd(row, u.pm);
                f32x4 cs0 = {1.f, 0.f, 1.f, 0.f}, cs1 = {1.f, 0.f, 1.f, 0.f};
                if (sample && pn < 10) { const int t = row & 4095, pos = (ug < 8) ? (t >> 6) : (t & 63); const f32x4* tp = (const f32x4*)(tab + pos * 32 + idx0); cs0 = tp[0]; cs1 = tp[1]; }
#pragma unroll
                for (int bj = 0; bj < 2; ++bj) {
                    f32x4 a = acc[ai][bj][m][0] * rs + sw[bj][0], b = acc[ai][bj][m][1] * rs + sw[bj][1];
                    if (pn < 10) {
                        if (sample) {
                            const f32x4 co = {cs0[0], cs0[2], cs1[0], cs1[2]}, si = {cs0[1], cs0[3], cs1[1], cs1[3]};
                            const f32x4 na = a * co - b * si, nb = b * co + a * si; a = na; b = nb;
                        }
                        if (pn < 8) { *(v4u*)(Q + (size_t)row * 2048 + pn * 256 + bj * 128 + cl) = pack8(a, b); }
                        else {
                            const int kvh = (pn - 8) * 2 + bj;
                            *(v4u*)(K + (size_t)row * 512 + kvh * 128 + cl) = pack8(a, b);
                            if (!sample) { float* op = outk + ((size_t)(u.pm * 2 + j) * 256 + (row & 255)) * 512 + kvh * 128 + d1; *(f32x4*)op = a; *(f32x4*)(op + 32) = b; }
                        }
                    } else {
                        const int kvh = (pn - 10) * 2 + bj;
                        *(v4u*)(V + (size_t)row * 512 + kvh * 128 + cl) = pack8(a, b);
                        if (!sample) { float* op = outv + ((size_t)(u.pm * 2 + j) * 256 + (row & 255)) * 512 + kvh * 128 + cl; *(f32x4*)op = a; *(f32x4*)(op + 4) = b; }
                    }
                }
            }
    }
};

struct EpiMlaQ {
    static constexpr bool PERM = true, AFTER_DRAIN = false;
    bf16* Q; const f32x2* tab;
    __device__ __forceinline__ void operator()(const pg8::f32x4 (&acc)[2][2][4][2], const pg8::Unit& u, int wr, int wc, int fr, int fq) const {
        const int row0 = u.pm * 256 + wr * 64 + fr, col0 = u.pn * 256 + wc * 32 + 8 * fq;
        const bool sample = u.pm >= 32;
#pragma unroll
        for (int bj = 0; bj < 2; ++bj) {
            const int c0 = col0 + bj * 128, p0 = c0 % 192; const bool isr = p0 >= 128; const int ug = isr ? ((p0 - 128) >> 3) : 0, idx0 = (ug & 3) * 4;
#pragma unroll
            for (int ai = 0; ai < 2; ++ai)
#pragma unroll
                for (int m = 0; m < 4; ++m) {
                    const int row = row0 + ai * 128 + m * 16;
                    f32x4 a = acc[ai][bj][m][0], b = acc[ai][bj][m][1];
                    if (sample) {
                        const int t = row & 4095, pos = (ug < 4) ? (t >> 6) : (t & 63); const f32x4* tp = (const f32x4*)(tab + pos * 16 + idx0); const f32x4 cs0 = tp[0], cs1 = tp[1];
                        const f32x4 co = {cs0[0], cs0[2], cs1[0], cs1[2]}, si = {cs0[1], cs0[3], cs1[1], cs1[3]};
                        const f32x4 na = a * co - b * si, nb = b * co + a * si;
                        if (isr) { a = na; b = nb; }
                    }
                    *(v4u*)(Q + (size_t)row * 3072 + c0) = pack8(a, b);
                }
        }
    }
};

struct EpiMlaKV {
    static constexpr bool PERM = true, AFTER_DRAIN = false;
    bf16 *KN, *V;
    __device__ __forceinline__ void operator()(const pg8::f32x4 (&acc)[2][2][4][2], const pg8::Unit& u, int wr, int wc, int fr, int fq) const {
        const int row0 = u.pm * 256 + wr * 64 + fr, cl = u.pn * 128 + wc * 32 + 8 * fq;
#pragma unroll
        for (int ai = 0; ai < 2; ++ai)
#pragma unroll
            for (int m = 0; m < 4; ++m) {
                const size_t ro = (size_t)(row0 + ai * 128 + m * 16) * 2048 + cl;
                *(v4u*)(KN + ro) = pack8(acc[ai][0][m][0], acc[ai][0][m][1]);
                *(v4u*)(V + ro) = pack8(acc[ai][1][m][0], acc[ai][1][m][1]);
            }
    }
};

struct EpiGlaIn {
    static constexpr bool PERM = true, AFTER_DRAIN = false;
    bf16 *q, *k, *v, *r; float* uo; NormIn ni;
    __device__ __forceinline__ void operator()(const pg8::f32x4 (&acc)[2][2][4][2], const pg8::Unit& u, int wr, int wc, int fr, int fq) const {
        const int row0 = u.pm * 256 + wr * 64 + fr, cl = wc * 32 + 8 * fq; const int pn = u.pn;
        const float* swp = ni.swp(u.pm) + pn * 256 + cl; f32x4 sw[2][2];
#pragma unroll
        for (int bj = 0; bj < 2; ++bj)
#pragma unroll
            for (int n = 0; n < 2; ++n) sw[bj][n] = *(const f32x4*)(swp + bj * 128 + 4 * n);
#pragma unroll
        for (int ai = 0; ai < 2; ++ai)
#pragma unroll
            for (int m = 0; m < 4; ++m) {
                const int row = row0 + ai * 128 + m * 16; const float rs = ni.rstd(row, u.pm);
#pragma unroll
                for (int bj = 0; bj < 2; ++bj) {
                    f32x4 a = acc[ai][bj][m][0] * rs + sw[bj][0], b = acc[ai][bj][m][1] * rs + sw[bj][1];
                    const int c = pn * 256 + bj * 128 + cl;
                    if (pn < 4) { a = a * 0.0625f; b = b * 0.0625f; *(v4u*)(q + (size_t)row * 1024 + c) = pack8(a, b); }
                    else if (pn < 8) { *(v4u*)(k + (size_t)row * 1024 + (c - 1024)) = pack8(a, b); }
                    else if (pn < 16) { *(v4u*)(v + (size_t)row * 2048 + (c - 2048)) = pack8(a, b); }
                    else if (pn < 24) { *(v4u*)(r + (size_t)row * 2048 + (c - 4096)) = pack8(a, b); }
                    else if (bj == 0 && wc == 0) { float* op = uo + (size_t)row * 32 + 8 * fq; *(f32x4*)op = a; *(f32x4*)(op + 4) = b; }
                }
            }
    }
};

struct Frame {
    LAS unsigned char* lds; unsigned char* ldsg;
    int tid, lane, wave, G, bx;
    const float* const* in; float* out; unsigned char* ws;
};
#define WSP(T, off) ((T*)(F.ws + (off)))
constexpr int LDS_RSTD_OFF = 131072;
__device__ __forceinline__ int prep_rstd(Frame& F, const pg8::StaticOrder& S, int site) {
    pg8::Unit u0; int pm0 = -1; if (S.next(0, u0)) pm0 = u0.pm;
    LAS float* lrs = (LAS float*)(F.lds + LDS_RSTD_OFF);
    if (pm0 >= 0 && F.tid < 256) { const int row = pm0 * 256 + F.tid; const f32x4* pp = (const f32x4*)(WSP(float, WS_PART) + ((size_t)site * MTOK + row) * 32); f32x4 t = pp[0];
#pragma unroll
        for (int i = 1; i < 8; ++i) t += pp[i];
        lrs[F.tid] = rsqrtf(((t[0] + t[1]) + (t[2] + t[3])) * (1.f / 2048.f) + EPS); }
    __syncthreads();
    return pm0;
}

__device__ __forceinline__ int perm_win(int p) { const int u = p >> 3, v = p & 7; return (u < 8 ? 0 : 64) + (u & 7) * 4 + (v & 3) + ((v & 4) ? 32 : 0); }
__device__ __forceinline__ int perm_mla(int p) { const int u = p >> 3, v = p & 7; return (u < 4 ? 0 : 32) + (u & 3) * 4 + (v & 3) + ((v & 4) ? 16 : 0); }
__device__ __forceinline__ int srcmap(int mode, int n) {
    if (mode == 1) { if (n >= 2560) return n; return (n & ~127) + perm_win(n & 127); }
    if (mode == 2) { if (n < 768) return n; if (n >= 832) return -1; return 768 + perm_mla(n - 768); }
    if (mode == 3) { const int hh = n / 192, p = n - hh * 192; if (p < 128) return n; return hh * 192 + 128 + perm_mla(p - 128); }
    return n;
}
__device__ __forceinline__ void tr_item(const float* W, int K, int Nsrc, int nblk, bf16* WT, int mode, LAS float* scr, int item, int lane) {
    const int kb = item / nblk, nb = item - kb * nblk, k0 = 64 * kb, n0 = 64 * nb;
    const int ln = (lane & 15) * 4, lk = lane >> 4;
    const int sc = srcmap(mode, n0 + ln);
    f32x4 v[16];
    const float* Wp = W + (size_t)(k0 + lk) * Nsrc + (sc >= 0 ? sc : 0);
#pragma unroll
    for (int i = 0; i < 16; ++i) v[i] = sc >= 0 ? *(const f32x4*)(Wp + (size_t)(4 * i) * Nsrc) : (f32x4){0.f, 0.f, 0.f, 0.f};
#pragma unroll
    for (int i = 0; i < 16; ++i) { LAS float* d = scr + (4 * i + lk) * 65 + ln; d[0] = v[i][0]; d[1] = v[i][1]; d[2] = v[i][2]; d[3] = v[i][3]; }
    LDS_WAIT(); asm volatile("" ::: "memory");
    const int c = lane & 7;
#pragma unroll
    for (int jj = 0; jj < 8; ++jj) { const int n = (lane >> 3) + 8 * jj; const LAS float* s = scr + (8 * c) * 65 + n;
        v4u o; o.x = pk2(s[0 * 65], s[1 * 65]); o.y = pk2(s[2 * 65], s[3 * 65]); o.z = pk2(s[4 * 65], s[5 * 65]); o.w = pk2(s[6 * 65], s[7 * 65]);
        *(GAS v4u*)(WT + (size_t)(n0 + n) * K + k0 + 8 * c) = o; }
    LDS_WAIT(); asm volatile("" ::: "memory");
}

__device__ __forceinline__ void p0_prologue(Frame& F) {
    const int tid = F.tid, lane = F.lane, wave = F.wave;
    for (int it = F.bx; it < 192; it += F.G) {
        const int l = it / 48, nb = it - l * 48;
        LAS float* sl = (LAS float*)F.lds; LAS float* red = sl + 3 * 2048;
        for (int e = tid; e < 3 * 2048; e += 512) { const int c = e >> 11, k = e & 2047; const float v = (c == 0) ? F.in[I_CCTX][k] : F.in[I_C][(c - 1) * 2048 + k]; sl[e] = v / (1.f + __expf(-v)); }
        __syncthreads();
        const float* Wp = F.in[I_ADAW] + ((size_t)l * 2048 + wave * 256) * 12288 + nb * 256 + lane * 4;
        f32x4 a0 = {0.f, 0.f, 0.f, 0.f}, a1 = a0, a2 = a0;
        for (int k = 0; k < 256; k += 8) {
            f32x4 w[8];
#pragma unroll
            for (int jj = 0; jj < 8; ++jj) w[jj] = *(const f32x4*)(Wp + (size_t)(k + jj) * 12288);
#pragma unroll
            for (int jj = 0; jj < 8; ++jj) { const int kk = wave * 256 + k + jj; a0 += w[jj] * sl[kk]; a1 += w[jj] * sl[2048 + kk]; a2 += w[jj] * sl[4096 + kk]; }
        }
        *(LAS f32x4*)(red + (wave * 3 + 0) * 256 + lane * 4) = a0; *(LAS f32x4*)(red + (wave * 3 + 1) * 256 + lane * 4) = a1; *(LAS f32x4*)(red + (wave * 3 + 2) * 256 + lane * 4) = a2;
        __syncthreads();
        for (int e = tid; e < 768; e += 512) { const int c = e >> 8, n = e & 255; float s = F.in[I_ADAB][l * 12288 + nb * 256 + n];
#pragma unroll
            for (int w8 = 0; w8 < 8; ++w8) s += red[(w8 * 3 + c) * 256 + n];
            WSP(float, WS_MOD)[(size_t)(l * 3 + c) * 12288 + nb * 256 + n] = s; }
        __syncthreads();
    }
    if (F.bx == F.G - 1) {
        for (int e = tid; e < 64 * 32; e += 512) { const int pos = e >> 5, i = e & 31; const float inv = exp2f(-(float)i * (13.287712379549449f / 32.f)); const float ang = (float)pos * inv;
            WSP(f32x2, WS_TABW)[e] = (f32x2){cosf(ang), sinf(ang)}; }
        for (int e = tid; e < 64 * 16; e += 512) { const int pos = e >> 4, i = e & 15; const float inv = exp2f(-(float)i * (13.287712379549449f / 16.f)); const float ang = (float)pos * inv;
            WSP(f32x2, WS_TABM)[e] = (f32x2){cosf(ang), sinf(ang)}; }
    }
    const int gt = F.bx * 512 + tid, NGT = F.G * 512;
    for (int e = gt; e < 2 * 2 * 512 * 512; e += NGT) {
        const int c = e & 511, pos = (e >> 9) & 511, b = (e >> 18) & 1, jj = e >> 19;
        const size_t sbase = (((size_t)b * 2 + jj) * 512 + pos) * 512;
        WSP(bf16, WS_CTXK)[e] = (bf16)f2bf(F.in[I_CWK][sbase + (c & ~127) + perm_win(c & 127)]);
        WSP(bf16, WS_CTXV)[e] = (bf16)f2bf(F.in[I_CWV][sbase + c]);
    }
    for (int e = gt; e < 256 * 2048; e += NGT) { const int n = e >> 11, k = e & 2047; float v = 0.f; if (n < 32) v = F.in[I_GWA1][((size_t)(n >> 4) * 2048 + k) * 16 + (n & 15)];
        WSP(bf16, WS_GWINT)[(size_t)(6144 + n) * 2048 + k] = (bf16)f2bf(v); }
    LAS float* scr = (LAS float*)(F.lds + wave * 16640);
    constexpr int C_W1 = 32 * 128, C_W2 = 128 * 32, C_QKV = 32 * 48, C_WO = 32 * 32, C_MWD = 32 * 16, C_MUQ = 8 * 48, C_MUKV = 4 * 64, C_GWIN = 32 * 96;
    constexpr int NITEMS = 4 * C_W1 + 4 * C_W2 + 2 * C_QKV + 2 * C_WO + C_MWD + C_MUQ + C_MUKV + C_WO + C_GWIN + C_WO;
    const bool bal = (F.G == 256); constexpr int NA = 19, NITA = 256 * NWAVES * NA;
    const int gw = F.bx * NWAVES + wave, NGW = F.G * NWAVES;
    const int nmine = bal ? (NA + (F.bx >= 192 ? (NITEMS - NITA - ((F.bx - 192) * NWAVES + wave) + 511) / 512 : 0)) : (NITEMS - gw + NGW - 1) / NGW;
    for (int q = 0; q < nmine; ++q) {
        const int it = bal ? (q < NA ? gw + q * NGW : NITA + ((F.bx - 192) * NWAVES + wave) + (q - NA) * 512) : gw + q * NGW;
        int r = it;
        if (r < 4 * C_W1) { const int l = r / C_W1; r -= l * C_W1; tr_item(F.in[I_W1] + (size_t)l * 2048 * 8192, 2048, 8192, 128, WSP(bf16, WS_W1T) + (size_t)l * 8192 * 2048, 0, scr, r, lane); continue; } r -= 4 * C_W1;
        if (r < 4 * C_W2) { const int l = r / C_W2; r -= l * C_W2; tr_item(F.in[I_W2] + (size_t)l * 8192 * 2048, 8192, 2048, 32, WSP(bf16, WS_W2T) + (size_t)l * 2048 * 8192, 0, scr, r, lane); continue; } r -= 4 * C_W2;
        if (r < 2 * C_QKV) { const int l = r / C_QKV; r -= l * C_QKV; tr_item(F.in[I_WQKV] + (size_t)l * 2048 * 3072, 2048, 3072, 48, WSP(bf16, WS_WQKVT) + (size_t)l * 3072 * 2048, 1, scr, r, lane); continue; } r -= 2 * C_QKV;
        if (r < 2 * C_WO) { const int l = r / C_WO; r -= l * C_WO; tr_item(F.in[I_WWO] + (size_t)l * 2048 * 2048, 2048, 2048, 32, WSP(bf16, WS_WWOT) + (size_t)l * 2048 * 2048, 0, scr, r, lane); continue; } r -= 2 * C_WO;
        if (r < C_MWD) { tr_item(F.in[I_MWD], 2048, 832, 16, WSP(bf16, WS_MWDT), 2, scr, r, lane); continue; } r -= C_MWD;
        if (r < C_MUQ) { tr_item(F.in[I_MWUQ], 512, 3072, 48, WSP(bf16, WS_MWUQT), 3, scr, r, lane); continue; } r -= C_MUQ;
        if (r < C_MUKV) { tr_item(F.in[I_MWUKV], 256, 4096, 64, WSP(bf16, WS_MWUKVT), 0, scr, r, lane); continue; } r -= C_MUKV;
        if (r < C_WO) { tr_item(F.in[I_MWO], 2048, 2048, 32, WSP(bf16, WS_MWOT), 0, scr, r, lane); continue; } r -= C_WO;
        if (r < C_GWIN) { tr_item(F.in[I_GWIN], 2048, 6144, 96, WSP(bf16, WS_GWINT), 0, scr, r, lane); continue; } r -= C_GWIN;
        tr_item(F.in[I_GWO], 2048, 2048, 32, WSP(bf16, WS_GWOT), 0, scr, r, lane);
    }
}

__device__ __forceinline__ const float* x_row(Frame& F, int L, int row) {
    return L == 0 ? (row < MP ? F.in[I_XP] + (size_t)row * DM : F.in[I_XS] + (size_t)(row - MP) * DM) : WSP(float, WS_X) + (size_t)row * DM;
}
__device__ __forceinline__ void p1_phase(Frame& F) {
    const int gw = F.bx * NWAVES + F.wave, NGW = F.G * NWAVES, lane = F.lane;
    for (int rb = gw; rb < MTOK / 8; rb += NGW) {
        const int row0 = rb * 8, cond = row0 < MP ? 0 : (row0 >> 12) - 1;
        const float* mv = WSP(float, WS_MOD) + (size_t)cond * 12288;
        const float* g = F.in[I_NORMG];
        f32x4 a[8];
#pragma unroll
        for (int jj = 0; jj < 8; ++jj) { const int col = 4 * lane + 256 * jj; a[jj] = *(const f32x4*)(g + col) * (*(const f32x4*)(mv + 2048 + col) + 1.f); }
        for (int r = 0; r < 8; ++r) {
            const int row = row0 + r; const float* xr = x_row(F, 0, row);
            f32x4 v[8]; float ss = 0.f;
#pragma unroll
            for (int jj = 0; jj < 8; ++jj) { v[jj] = *(const f32x4*)(xr + 4 * lane + 256 * jj); ss += (v[jj][0] * v[jj][0] + v[jj][1] * v[jj][1]) + (v[jj][2] * v[jj][2] + v[jj][3] * v[jj][3]); }
            ss = wave_sum(ss);
            if (lane < 32) WSP(float, WS_PART)[(size_t)row * 32 + lane] = lane == 0 ? ss : 0.f;
            bf16* hr = WSP(bf16, WS_H) + (size_t)row * DM;
#pragma unroll
            for (int jj = 0; jj < 8; ++jj) { const f32x4 y = v[jj] * a[jj]; v2u w; w.x = cvtpk(y[0], y[1]); w.y = cvtpk(y[2], y[3]); *(v2u*)(hr + 4 * lane + 256 * jj) = w; }
        }
    }
    constexpr int NCH = 96 + 256 + 32 + 256 + 200 + 256 + 96 + 256;
    for (int ch = gw; ch < NCH; ch += NGW) {
        int c = ch, site = 0; const bf16* Wt = WSP(bf16, WS_WQKVT);
        if (c >= 96) { c -= 96; site = 1; Wt = WSP(bf16, WS_W1T);
          if (c >= 256) { c -= 256; site = 2; Wt = WSP(bf16, WS_MWDT);
            if (c >= 32) { c -= 32; site = 3; Wt = WSP(bf16, WS_W1T) + (size_t)1 * FFH * DM;
              if (c >= 256) { c -= 256; site = 4; Wt = WSP(bf16, WS_GWINT);
                if (c >= 200) { c -= 200; site = 5; Wt = WSP(bf16, WS_W1T) + (size_t)2 * FFH * DM;
                  if (c >= 256) { c -= 256; site = 6; Wt = WSP(bf16, WS_WQKVT) + (size_t)3072 * DM;
                    if (c >= 96) { c -= 96; site = 7; Wt = WSP(bf16, WS_W1T) + (size_t)3 * FFH * DM; } } } } } } }
        const int L = site >> 1, which = site & 1;
        const float* sv = WSP(float, WS_MOD) + (size_t)(L * 3) * 12288 + (which ? 3 * 2048 : 0);
        f32x4 s0[3][4], s1[3][4];
#pragma unroll
        for (int cc = 0; cc < 3; ++cc)
#pragma unroll
            for (int jj = 0; jj < 4; ++jj) { const float* sp = sv + (size_t)cc * 12288 + 8 * lane + 512 * jj; s0[cc][jj] = *(const f32x4*)sp; s1[cc][jj] = *(const f32x4*)(sp + 4); }
        float* so = WSP(float, WS_SW) + (size_t)site * 3 * 8192;
        for (int r = 0; r < 32; ++r) {
            const int n = c * 32 + r; const bf16* wr_ = Wt + (size_t)n * DM + 8 * lane;
            float d0 = 0.f, d1 = 0.f, d2 = 0.f;
#pragma unroll
            for (int jj = 0; jj < 4; ++jj) { const v4u w = *(const v4u*)(wr_ + 512 * jj);
                const f32x4 wa = {__builtin_bit_cast(float, w.x << 16), __builtin_bit_cast(float, w.x & 0xffff0000u), __builtin_bit_cast(float, w.y << 16), __builtin_bit_cast(float, w.y & 0xffff0000u)};
                const f32x4 wb = {__builtin_bit_cast(float, w.z << 16), __builtin_bit_cast(float, w.z & 0xffff0000u), __builtin_bit_cast(float, w.w << 16), __builtin_bit_cast(float, w.w & 0xffff0000u)};
                f32x4 t = wa * s0[0][jj] + wb * s1[0][jj]; d0 += (t[0] + t[1]) + (t[2] + t[3]);
                t = wa * s0[1][jj] + wb * s1[1][jj]; d1 += (t[0] + t[1]) + (t[2] + t[3]);
                t = wa * s0[2][jj] + wb * s1[2][jj]; d2 += (t[0] + t[1]) + (t[2] + t[3]); }
            d0 = wave_sum(d0); d1 = wave_sum(d1); d2 = wave_sum(d2);
            if (lane == 0) { so[n] = d0; so[8192 + n] = d1; so[2 * 8192 + n] = d2; }
        }
    }
}
__device__ __forceinline__ void final_phase(Frame& F) {
    const int gw = F.bx * NWAVES + F.wave, NGW = F.G * NWAVES, lane = F.lane;
    const float* g = F.in[I_FNORM];
    for (int row = gw; row < MTOK; row += NGW) {
        const float* xr = WSP(float, WS_X) + (size_t)row * DM;
        f32x4 v[8]; float ss = 0.f;
#pragma unroll
        for (int jj = 0; jj < 8; ++jj) { v[jj] = *(const f32x4*)(xr + 4 * lane + 256 * jj); ss += (v[jj][0] * v[jj][0] + v[jj][1] * v[jj][1]) + (v[jj][2] * v[jj][2] + v[jj][3] * v[jj][3]); }
        const float rstd = rsqrtf(wave_sum(ss) * (1.f / 2048.f) + EPS);
        float* orow = F.out + (size_t)row * DM;
#pragma unroll
        for (int jj = 0; jj < 8; ++jj) { const int col = 4 * lane + 256 * jj; *(f32x4*)(orow + col) = v[jj] * rstd * *(const f32x4*)(g + col); }
    }
}

namespace att {
constexpr int QBLK = 32, KVBLK = 64;
constexpr int SHM_V = 16384, SHM_K = 16384, SHM_KR = 8192;
constexpr int OFF_V = 0, OFF_K = 2 * SHM_V, OFF_KR = 2 * SHM_V + 2 * SHM_K, OFF_WS = OFF_KR + 2 * SHM_KR, OFF_QR = OFF_WS + NWAVES * 64 * 4, LDS_ATT = OFF_QR + NWAVES * 4096;
#define KSWZ(row, colB) ((row) * 256 + ((colB) ^ (((row) & 7) << 4)))
#define KRSWZ(row, chunk) ((row) * 128 + ((((chunk) ^ ((row) >> 1)) & 7) << 4))
__device__ __forceinline__ int crow(int r, int hi) { return (r & 3) + 8 * (r >> 2) + 4 * hi; }
template <int DQK> struct Cst { static constexpr float SCALE = DQK == 128 ? 0.088388347648318440f : 0.072168783648703220f; static constexpr float C = SCALE * 1.4426950408889634f; };
constexpr float THR = 8.f;

template <int DQK>
__device__ __forceinline__ void partialSM(f32x16& p0, f32x16& p1, float& m_reg, float& mn, float& alpha) {
    constexpr float C = Cst<DQK>::C, SCALE = Cst<DQK>::SCALE;
    float pmax = p0[0];
#pragma unroll
    for (int r = 1; r < 16; ++r) pmax = fmaxf(pmax, p0[r]);
#pragma unroll
    for (int r = 0; r < 16; ++r) pmax = fmaxf(pmax, p1[r]);
    { auto rr = __builtin_amdgcn_permlane32_swap(__float_as_uint(pmax), __float_as_uint(pmax), false, false);
      pmax = fmaxf(__uint_as_float(rr[0]), __uint_as_float(rr[1])); }
    if (__builtin_expect(__all(pmax - m_reg <= THR / SCALE), 1)) { mn = m_reg; alpha = 1.f; }
    else { mn = fmaxf(m_reg, pmax); alpha = __builtin_amdgcn_exp2f((m_reg - mn) * C); m_reg = mn; }
    const float mnC = -mn * C;
#pragma unroll
    for (int r = 0; r < 16; ++r) p0[r] = __builtin_amdgcn_exp2f(fmaf(p0[r], C, mnC));
#pragma unroll
    for (int r = 0; r < 16; ++r) p1[r] = __builtin_amdgcn_exp2f(fmaf(p1[r], C, mnC));
}
__device__ __forceinline__ void finishSM(f32x16& p0, f32x16& p1, float alpha, float& l_reg, bf16x8& pa0, bf16x8& pa1, bf16x8& pa2, bf16x8& pa3) {
    float ps = 0;
#pragma unroll
    for (int r = 0; r < 16; ++r) ps += p0[r];
#pragma unroll
    for (int r = 0; r < 16; ++r) ps += p1[r];
    { auto rr = __builtin_amdgcn_permlane32_swap(__float_as_uint(ps), __float_as_uint(ps), false, false);
      ps = __uint_as_float(rr[0]) + __uint_as_float(rr[1]); }
    l_reg = l_reg * alpha + ps;
#define PK4(P, BASE, OUT) do { unsigned a0 = cvtpk(P[BASE + 0], P[BASE + 1]), a1 = cvtpk(P[BASE + 2], P[BASE + 3]);   \
    unsigned b0 = cvtpk(P[BASE + 4], P[BASE + 5]), b1 = cvtpk(P[BASE + 6], P[BASE + 7]);                              \
    auto r0 = __builtin_amdgcn_permlane32_swap(a0, b0, false, false); auto r1 = __builtin_amdgcn_permlane32_swap(a1, b1, false, false); \
    v4u w = {r0[0], r1[0], r0[1], r1[1]}; OUT = *reinterpret_cast<bf16x8*>(&w); } while (0)
    PK4(p0, 0, pa0); PK4(p0, 8, pa1); PK4(p1, 0, pa2); PK4(p1, 8, pa3);
#undef PK4
}
__device__ __forceinline__ int v_st(int k, int c) { const int kk = (k & ~0xC) | ((k & 4) << 1) | ((k & 8) >> 1); return ((kk >> 3) * 4 + (c >> 5)) * 512 + ((kk & 7) * 32 + (c & 31)) * 2; }
__device__ __forceinline__ int v_rd_base(int lane) { return ((lane & 3) << 3) | (((lane >> 2) & 3) << 6) | (((lane >> 4) & 1) << 5) | (((lane >> 5) & 1) << 8); }
constexpr int v_rd_off(int d0, int ks, int half) { return d0 * 512 + ks * 4096 + half * 2048; }
template <int OFF> __device__ __forceinline__ s16x4 tr_read(int vb) {
    s16x4 r; asm volatile("ds_read_b64_tr_b16 %0, %1 offset:%2" : "=&v"(r) : "v"(vb), "i"(OFF) : "memory"); return r;
}
template <int D0> __device__ __forceinline__ void pv_one(f32x16& od, int vb, bf16x8 pa0, bf16x8 pa1, bf16x8 pa2, bf16x8 pa3) {
    const s16x4 l0 = tr_read<v_rd_off(D0, 0, 0)>(vb), h0 = tr_read<v_rd_off(D0, 0, 1)>(vb), l1 = tr_read<v_rd_off(D0, 1, 0)>(vb), h1 = tr_read<v_rd_off(D0, 1, 1)>(vb);
    const s16x4 l2 = tr_read<v_rd_off(D0, 2, 0)>(vb), h2 = tr_read<v_rd_off(D0, 2, 1)>(vb), l3 = tr_read<v_rd_off(D0, 3, 0)>(vb), h3 = tr_read<v_rd_off(D0, 3, 1)>(vb);
    asm volatile("s_waitcnt lgkmcnt(0)" ::: "memory"); SBAR();
#define PKV(L, H) (bf16x8){L[0], L[1], L[2], L[3], H[0], H[1], H[2], H[3]}
    od = __builtin_amdgcn_mfma_f32_32x32x16_bf16(pa0, PKV(l0, h0), od, 0, 0, 0);
    od = __builtin_amdgcn_mfma_f32_32x32x16_bf16(pa1, PKV(l1, h1), od, 0, 0, 0);
    od = __builtin_amdgcn_mfma_f32_32x32x16_bf16(pa2, PKV(l2, h2), od, 0, 0, 0);
    od = __builtin_amdgcn_mfma_f32_32x32x16_bf16(pa3, PKV(l3, h3), od, 0, 0, 0);
#undef PKV
}

template <int DQK, bool MASKED>
__device__ __forceinline__ void attn_unit(const bf16* __restrict__ Qb, int ldq,
                                          const bf16* __restrict__ KA, const bf16* __restrict__ VA, const bf16* __restrict__ KRA, int nA,
                                          const bf16* __restrict__ KB, const bf16* __restrict__ VB, const bf16* __restrict__ KRB, int nB,
                                          int ldk, int qpos0, int kposB0, float sink_l2, bf16* __restrict__ Ob, char* lds) {
    constexpr int ND = 8;
    constexpr float C = Cst<DQK>::C;
    const int tid = threadIdx.x, wid = tid >> 6, lane = tid & 63, r32 = lane & 31, hi = lane >> 5;
    char* V_lds = lds + OFF_V; char* K_lds = lds + OFF_K; char* KR_lds = lds + OFF_KR;
    float* wsf = (float*)(lds + OFF_WS) + wid * 64; float* li_l = wsf; float* al_l = wsf + 32;
    float m_reg = -1e30f, l_reg = 0.f; f32x16 o[4] = {}; bf16x8 qr[ND];
    const bf16* Qw = Qb + (size_t)(wid * QBLK + r32) * ldq + hi * 8;
#pragma unroll
    for (int d0 = 0; d0 < ND; ++d0) qr[d0] = *reinterpret_cast<const bf16x8*>(Qw + d0 * 16);
    char* QR_lds = lds + OFF_QR;
    if constexpr (DQK == 192) {
#pragma unroll
        for (int dd = 0; dd < 4; ++dd) { const bf16x8 qv = *reinterpret_cast<const bf16x8*>(Qw + 128 + dd * 16); *(bf16x8*)(QR_lds + wid * 4096 + KRSWZ(r32, dd * 2 + hi)) = qv; }
    }
    const int sr = tid >> 4, sc = (tid & 15) * 8, vst0 = v_st(sr, sc), vst1 = v_st(32 + sr, sc);
    const int krr = tid >> 3, krc = tid & 7;
    const int vb0 = (int)(uintptr_t)(LAS char*)V_lds + v_rd_base(lane);
    const int NT = nA + nB;
    bf16x8 sv0, sv1, sk0, sk1, skr;
    const unsigned go0 = (unsigned)(sr * ldk + sc) * 2u, go1 = (unsigned)((32 + sr) * ldk + sc) * 2u, gor = (unsigned)(krr * 64 + krc * 8) * 2u;
#define SLOAD(t) do { const bool inA_ = (t) < nA; const int tt_ = inA_ ? (t) : (t) - nA; const char* Kt_ = (const char*)((inA_ ? KA : KB) + (size_t)tt_ * 64 * ldk); const char* Vt_ = (const char*)((inA_ ? VA : VB) + (size_t)tt_ * 64 * ldk); \
    sv0 = *reinterpret_cast<const bf16x8*>(Vt_ + go0); sv1 = *reinterpret_cast<const bf16x8*>(Vt_ + go1); \
    sk0 = *reinterpret_cast<const bf16x8*>(Kt_ + go0); sk1 = *reinterpret_cast<const bf16x8*>(Kt_ + go1); \
    if constexpr (DQK == 192) { const char* Rt_ = (const char*)((inA_ ? KRA : KRB) + (size_t)tt_ * 64 * 64); skr = *reinterpret_cast<const bf16x8*>(Rt_ + gor); } } while (0)
#define SWRITE(b) do { *(bf16x8*)(V_lds + (b) * SHM_V + vst0) = sv0; *(bf16x8*)(V_lds + (b) * SHM_V + vst1) = sv1; const int kc_ = sc * 2; \
    *(bf16x8*)(K_lds + (b) * SHM_K + KSWZ(sr, kc_)) = sk0; *(bf16x8*)(K_lds + (b) * SHM_K + KSWZ(32 + sr, kc_)) = sk1; \
    if constexpr (DQK == 192) { *(bf16x8*)(KR_lds + (b) * SHM_KR + KRSWZ(krr, krc)) = skr; } } while (0)
    SLOAD(0); VM_WAIT(); SWRITE(0); __syncthreads();
    for (int t = 0; t < NT; ++t) {
        const int cur = t & 1;
        if (t + 1 < NT) SLOAD(t + 1);
        f32x16 p0 = {}, p1 = {};
        { const char* Ks = K_lds + cur * SHM_K;
#pragma unroll
          for (int dg = 0; dg < 2; ++dg) {
            bf16x8 kf0[4], kf1[4];
#pragma unroll
            for (int dd = 0; dd < 4; ++dd) { const int cb = ((dg * 4 + dd) * 16 + hi * 8) * 2;
              kf0[dd] = *reinterpret_cast<const bf16x8*>(Ks + KSWZ(r32, cb)); kf1[dd] = *reinterpret_cast<const bf16x8*>(Ks + KSWZ(32 + r32, cb)); }
#pragma unroll
            for (int dd = 0; dd < 4; ++dd) {
              p0 = __builtin_amdgcn_mfma_f32_32x32x16_bf16(kf0[dd], qr[dg * 4 + dd], p0, 0, 0, 0);
              p1 = __builtin_amdgcn_mfma_f32_32x32x16_bf16(kf1[dd], qr[dg * 4 + dd], p1, 0, 0, 0); }
            SBAR();
          }
          if constexpr (DQK == 192) { const char* Rs = KR_lds + cur * SHM_KR; const char* Qs = QR_lds + wid * 4096;
            bf16x8 kf0[4], kf1[4], qf[4];
#pragma unroll
            for (int dd = 0; dd < 4; ++dd) { const int ch = dd * 2 + hi;
              kf0[dd] = *reinterpret_cast<const bf16x8*>(Rs + KRSWZ(r32, ch)); kf1[dd] = *reinterpret_cast<const bf16x8*>(Rs + KRSWZ(32 + r32, ch)); qf[dd] = *reinterpret_cast<const bf16x8*>(Qs + KRSWZ(r32, ch)); }
#pragma unroll
            for (int dd = 0; dd < 4; ++dd) {
              p0 = __builtin_amdgcn_mfma_f32_32x32x16_bf16(kf0[dd], qf[dd], p0, 0, 0, 0);
              p1 = __builtin_amdgcn_mfma_f32_32x32x16_bf16(kf1[dd], qf[dd], p1, 0, 0, 0); }
            SBAR();
          }
        }
        if constexpr (MASKED) { if (t >= nA) { const int qp = qpos0 + wid * QBLK + r32, kb = kposB0 + (t - nA) * 64;
#pragma unroll
            for (int r = 0; r < 16; ++r) { const int d = qp - (kb + crow(r, hi)); if (d > 128 || d < -128) p0[r] = -1e30f; const int d2 = d - 32; if (d2 > 128 || d2 < -128) p1[r] = -1e30f; } } }
        float mn, alpha; bf16x8 pa0, pa1, pa2, pa3;
        partialSM<DQK>(p0, p1, m_reg, mn, alpha);
        if (__any(alpha < 1.f)) { if (hi == 0) al_l[r32] = alpha; LDS_WAIT();
#pragma unroll
            for (int r = 0; r < 16; ++r) { const float al = al_l[crow(r, hi)];
#pragma unroll
                for (int d = 0; d < 4; ++d) o[d][r] *= al; } }
        finishSM(p0, p1, alpha, l_reg, pa0, pa1, pa2, pa3); SBAR();
        { const int vb = vb0 + cur * SHM_V;
          pv_one<0>(o[0], vb, pa0, pa1, pa2, pa3); pv_one<1>(o[1], vb, pa0, pa1, pa2, pa3); pv_one<2>(o[2], vb, pa0, pa1, pa2, pa3); pv_one<3>(o[3], vb, pa0, pa1, pa2, pa3); }
        if (t + 1 < NT) { VM_WAIT(); SWRITE(cur ^ 1); }
        __syncthreads();
    }
    l_reg += __builtin_amdgcn_exp2f(sink_l2 - m_reg * C);
    if (hi == 0) li_l[r32] = l_reg; LDS_WAIT();
    int obase = (wid * QBLK + 4 * hi) * 2048 + r32; asm volatile("" : "+v"(obase));
#pragma unroll
    for (int r = 0; r < 16; ++r) { const float rl = __builtin_amdgcn_rcpf(li_l[crow(r, hi)]); const int ro = ((r & 3) + 8 * (r >> 2)) * 2048;
#pragma unroll
        for (int d0 = 0; d0 < 4; ++d0) *(bf16*)((char*)Ob + (unsigned)(obase + ro + d0 * 32) * 2u) = (bf16)f2bf(o[d0][r] * rl); }
    LDS_WAIT();
#undef SLOAD
#undef SWRITE
}
}

__device__ __forceinline__ void attn_win_phase(Frame& F, int j) {
    const bf16* Q = WSP(bf16, WS_WQ); const bf16* K = WSP(bf16, WS_WK); const bf16* V = WSP(bf16, WS_WV); bf16* O = WSP(bf16, WS_AO);
    const bf16* CK = WSP(bf16, WS_CTXK) + (size_t)j * 2 * 512 * 512; const bf16* CV = WSP(bf16, WS_CTXV) + (size_t)j * 2 * 512 * 512;
    for (int un = F.bx; un < 1024; un += F.G) {
        const int h = un & 15, kvh = h >> 2; const float sink = F.in[I_SINK][j * 16 + h] * 1.4426950408889634f;
        if (un < 512) {
            const int qb = un >> 4, bs = qb >> 4, t0 = (qb & 15) * 256, row0 = MP + qb * 256;
            int kt0 = (t0 >> 6) - 2, kt1 = (t0 >> 6) + 5; if (kt0 < 0) kt0 = 0; if (kt1 > 63) kt1 = 63;
            const size_t kb = (size_t)(MP + bs * 4096 + kt0 * 64) * 512 + kvh * 128;
            att::attn_unit<128, true>(Q + (size_t)row0 * 2048 + h * 128, 2048, CK + (size_t)bs * 512 * 512 + kvh * 128, CV + (size_t)bs * 512 * 512 + kvh * 128, nullptr, 8,
                                     K + kb, V + kb, nullptr, kt1 - kt0 + 1, 512, t0, kt0 * 64, sink, O + (size_t)row0 * 2048 + h * 128, (char*)F.ldsg);
        } else {
            const int b = (un - 512) >> 4, row0 = b * 256; const size_t kb = (size_t)row0 * 512 + kvh * 128;
            att::attn_unit<128, false>(Q + (size_t)row0 * 2048 + h * 128, 2048, nullptr, nullptr, nullptr, 0,
                                      K + kb, V + kb, nullptr, 4, 512, 0, 0, sink, O + (size_t)row0 * 2048 + h * 128, (char*)F.ldsg);
        }
    }
}
__device__ __forceinline__ void attn_mla_phase(Frame& F) {
    const bf16* Q = WSP(bf16, WS_MQ); const bf16* KN = WSP(bf16, WS_MKN); const bf16* V = WSP(bf16, WS_MV); const bf16* KR = WSP(bf16, WS_MKR); bf16* O = WSP(bf16, WS_AO);
    for (int un = F.bx; un < 1024; un += F.G) {
        const int h = un & 15;
        if (un < 512) {
            const int qb = un >> 4, bs = qb >> 4, row0 = MP + qb * 256;
            const size_t ra = (size_t)bs * 512, rb = (size_t)1024 + MP + bs * 4096;
            att::attn_unit<192, false>(Q + (size_t)row0 * 3072 + h * 192, 3072, KN + ra * 2048 + h * 128, V + ra * 2048 + h * 128, KR + ra * 64, 8,
                                      KN + rb * 2048 + h * 128, V + rb * 2048 + h * 128, KR + rb * 64, 64, 2048, 0, 0, -1e30f, O + (size_t)row0 * 2048 + h * 128, (char*)F.ldsg);
        } else {
            const int b = (un - 512) >> 4, row0 = b * 256; const size_t rb = (size_t)1024 + row0;
            att::attn_unit<192, false>(Q + (size_t)row0 * 3072 + h * 192, 3072, nullptr, nullptr, nullptr, 0,
                                      KN + rb * 2048 + h * 128, V + rb * 2048 + h * 128, KR + rb * 64, 4, 2048, 0, 0, -1e30f, O + (size_t)row0 * 2048 + h * 128, (char*)F.ldsg);
        }
    }
}

__device__ __forceinline__ void mla_norm_phase(Frame& F) {
    const int gw = F.bx * NWAVES + F.wave, NGW = F.G * NWAVES, lane = F.lane;
    const float* D = WSP(float, WS_MD); bf16* CQ = WSP(bf16, WS_MCQ); bf16* CKV = WSP(bf16, WS_MCKV); bf16* KR = WSP(bf16, WS_MKR);
    const f32x2* tab = WSP(f32x2, WS_TABM);
    const float* qn = F.in[I_MQN]; const float* kvn = F.in[I_MKVN];
    for (int row = gw; row < MTOK; row += NGW) {
        const float* d = D + (size_t)row * 1024;
        {
            const f32x4 v0 = *(const f32x4*)(d + 4 * lane), v1 = *(const f32x4*)(d + 256 + 4 * lane);
            float ss = (v0[0] * v0[0] + v0[1] * v0[1]) + (v0[2] * v0[2] + v0[3] * v0[3]) + (v1[0] * v1[0] + v1[1] * v1[1]) + (v1[2] * v1[2] + v1[3] * v1[3]);
            const float rstd = rsqrtf(wave_sum(ss) * (1.f / 512.f) + EPS);
            const f32x4 y0 = v0 * rstd * *(const f32x4*)(qn + 4 * lane), y1 = v1 * rstd * *(const f32x4*)(qn + 256 + 4 * lane);
            v2u w; w.x = cvtpk(y0[0], y0[1]); w.y = cvtpk(y0[2], y0[3]); *(v2u*)(CQ + (size_t)row * 512 + 4 * lane) = w;
            w.x = cvtpk(y1[0], y1[1]); w.y = cvtpk(y1[2], y1[3]); *(v2u*)(CQ + (size_t)row * 512 + 256 + 4 * lane) = w;
        }
        {
            const f32x4 v0 = *(const f32x4*)(d + 512 + 4 * lane);
            float ss = (v0[0] * v0[0] + v0[1] * v0[1]) + (v0[2] * v0[2] + v0[3] * v0[3]);
            const float rstd = rsqrtf(wave_sum(ss) * (1.f / 256.f) + EPS);
            const f32x4 y0 = v0 * rstd * *(const f32x4*)(kvn + 4 * lane);
            v2u w; w.x = cvtpk(y0[0], y0[1]); w.y = cvtpk(y0[2], y0[3]); *(v2u*)(CKV + (size_t)(1024 + row) * 256 + 4 * lane) = w;
            if (row < MP) *(f32x4*)(F.out + O_CKV + (size_t)row * 256 + 4 * lane) = y0;
        }
        if (lane < 8) {
            const int ug = lane, idx0 = (ug & 3) * 4, d1 = (ug < 4 ? 0 : 32) + idx0;
            f32x4 a = *(const f32x4*)(d + 768 + 8 * ug), b = *(const f32x4*)(d + 768 + 8 * ug + 4);
            if (row < MP) { float* op = F.out + O_KR + (size_t)row * 64 + d1; *(f32x4*)op = a; *(f32x4*)(op + 16) = b; }
            else { const int t = row & 4095, pos = (ug < 4) ? (t >> 6) : (t & 63); const f32x4* tp = (const f32x4*)(tab + pos * 16 + idx0); const f32x4 cs0 = tp[0], cs1 = tp[1];
                const f32x4 co = {cs0[0], cs0[2], cs1[0], cs1[2]}, si = {cs0[1], cs0[3], cs1[1], cs1[3]};
                const f32x4 na = a * co - b * si, nb = b * co + a * si; a = na; b = nb; }
            *(v4u*)(KR + (size_t)(1024 + row) * 64 + 8 * ug) = pack8(a, b);
        }
    }
    const int gt = F.bx * 512 + F.tid, NGT = F.G * 512;
    for (int e = gt; e < 1024 * 256; e += NGT) CKV[e] = (bf16)f2bf(F.in[I_CCKV][e]);
    for (int e = gt; e < 1024 * 64; e += NGT) KR[e] = (bf16)f2bf(F.in[I_CKR][(e & ~63) + perm_mla(e & 63)]);
}

typedef short v4i16_t __attribute__((ext_vector_type(4)));
__device__ __forceinline__ s16x4 vtr(const LAS char* p) { return __builtin_bit_cast(s16x4, __builtin_amdgcn_ds_read_tr16_b64_v4i16((LAS v4i16_t*)p)); }
#define MFMA16(a, b, c) __builtin_amdgcn_mfma_f32_16x16x32_bf16((a), (b), (c), 0, 0, 0)
#define CAT8(L, H) (bf16x8){L[0], L[1], L[2], L[3], H[0], H[1], H[2], H[3]}

__device__ __forceinline__ void gla_prep_phase(Frame& F) {
    constexpr int PQ = 528, OQ = 0, OK_ = 64 * PQ, OKT = 2 * 64 * PQ, OUB = 3 * 64 * PQ, OHT = OUB + 4096, OAT = OHT + 2048;
    LAS char* L = (LAS char*)F.lds; const int tid = F.tid, lane = F.lane, wave = F.wave;
    const bf16* GQ = WSP(bf16, WS_GQ); const bf16* GK = WSP(bf16, WS_GK); const float* GU = WSP(float, WS_GU);
    for (int un = F.bx; un < 2048; un += F.G) {
        const int d = un & 1, ch = un >> 1, c = ch >> 2, h = ch & 3, row0 = c * 64;
        bf16* QT = WSP(bf16, WS_GQT) + (size_t)d * MTOK * 1024; bf16* KD = WSP(bf16, WS_GKD) + (size_t)d * MTOK * 1024;
        bf16* AM = WSP(bf16, WS_GAM) + ((size_t)d * 1024 + ch) * 4096; float* DEC = WSP(float, WS_GDEC) + ((size_t)d * 1024 + ch) * 256;
#pragma unroll
        for (int i = 0; i < 4; ++i) { const int e = tid + 512 * i, row = e >> 5, cc = e & 31; const size_t go = (size_t)(row0 + row) * 1024 + h * 256 + cc * 8;
            *(LAS v4u*)(L + OQ + row * PQ + cc * 16) = *(const v4u*)(GQ + go); *(LAS v4u*)(L + OK_ + row * PQ + cc * 16) = *(const v4u*)(GK + go); }
        if (tid < 256) { const int row = tid >> 2, q4 = tid & 3; *(LAS f32x4*)(L + OUB + (row * 16 + q4 * 4) * 4) = *(const f32x4*)(GU + (size_t)(row0 + row) * 32 + d * 16 + q4 * 4); }
        __syncthreads();
        {
            const int hf = tid >> 8, col = tid & 255;
            float w[16];
#pragma unroll
            for (int r = 0; r < 16; ++r) w[r] = F.in[I_GWA2][((size_t)d * 16 + r) * 1024 + h * 256 + col];
            const float bias = F.in[I_GBA][d * 1024 + h * 256 + col];
            float g[32]; float tot = 0.f;
#pragma unroll
            for (int ii = 0; ii < 32; ++ii) { const int i = hf * 32 + ii; float z = bias;
#pragma unroll
                for (int q4 = 0; q4 < 4; ++q4) { const f32x4 uv = *(const LAS f32x4*)(L + OUB + (i * 16 + q4 * 4) * 4); z += uv[0] * w[4 * q4] + uv[1] * w[4 * q4 + 1] + uv[2] * w[4 * q4 + 2] + uv[3] * w[4 * q4 + 3]; }
                const float ls = fminf(z, 0.f) - __logf(1.f + __expf(-fabsf(z)));
                g[ii] = ls * 0.0625f; tot += g[ii]; }
            ((LAS float*)(L + OHT))[hf * 256 + col] = tot;
            __syncthreads();
            const float other = ((const LAS float*)(L + OHT))[(1 - hf) * 256 + col];
            const float T = tot + other;
            float run = (d == 0) ? (hf == 1 ? other : 0.f) : (hf == 0 ? other : 0.f);
            if (hf == 0) DEC[col] = __expf(T);
#pragma unroll
            for (int s = 0; s < 32; ++s) {
                const int ii = (d == 0) ? s : 31 - s;
                run += (d == 0) ? g[s] : g[31 - s];
                const int i = hf * 32 + ii;
                LAS bf16* qp = (LAS bf16*)(L + OQ + i * PQ) + col; LAS bf16* kp = (LAS bf16*)(L + OK_ + i * PQ) + col; LAS bf16* ktp = (LAS bf16*)(L + OKT + i * PQ) + col;
                const float qv = bf2f(*qp), kv = bf2f(*kp);
                *qp = (bf16)f2bf(qv * __expf(run)); *ktp = (bf16)f2bf(kv * __expf(-run)); *kp = (bf16)f2bf(kv * __expf(T - run));
            }
        }
        __syncthreads();
        {
            const int gq = lane >> 4, cl = lane & 15;
#pragma unroll
            for (int s2 = 0; s2 < 2; ++s2) {
                const int T16 = 2 * wave + s2, ti = T16 >> 2, tj = T16 & 3;
                f32x4 acc = {0.f, 0.f, 0.f, 0.f};
#pragma unroll
                for (int ks = 0; ks < 8; ++ks) {
                    const bf16x8 a = *(const LAS bf16x8*)(L + OQ + (16 * ti + cl) * PQ + (32 * ks + 8 * gq) * 2);
                    const bf16x8 b = *(const LAS bf16x8*)(L + OKT + (16 * tj + cl) * PQ + (32 * ks + 8 * gq) * 2);
                    acc = MFMA16(a, b, acc);
                }
                const int jcol = 16 * tj + cl;
#pragma unroll
                for (int r = 0; r < 4; ++r) { const int i = 16 * ti + 4 * gq + r; const bool keep = (d == 0) ? (jcol <= i) : (jcol >= i);
                    ((LAS bf16*)(L + OAT))[i * 64 + jcol] = (bf16)f2bf(keep ? acc[r] : 0.f); }
            }
        }
        __syncthreads();
#pragma unroll
        for (int i = 0; i < 4; ++i) { const int e = tid + 512 * i, row = e >> 5, cc = e & 31; const size_t go = (size_t)(row0 + row) * 1024 + h * 256 + cc * 8;
            *(v4u*)(QT + go) = *(const LAS v4u*)(L + OQ + row * PQ + cc * 16); *(v4u*)(KD + go) = *(const LAS v4u*)(L + OK_ + row * PQ + cc * 16); }
        *(v4u*)(AM + tid * 8) = *(const LAS v4u*)(L + OAT + tid * 16);
        __syncthreads();
    }
}

__device__ __forceinline__ void gla_scan_item(Frame& F, int seq, int h, int d, int sl) {
    constexpr int PQ = 528, PK = 544, PA = 136, PV = 288;
    constexpr int OQ = 0, OK_ = 64 * PQ, OA = OK_ + 64 * PK, OV = OA + 64 * PA, ODEC = OV + 64 * PV;
    LAS char* L = (LAS char*)F.lds; const int tid = F.tid, lane = F.lane, wave = F.wave, gq = lane >> 4, cl = lane & 15;
    const bool sample = seq >= 32; const int base = sample ? MP + (seq - 32) * 4096 : seq * 256, nch = sample ? 64 : 4;
    const bf16* QT = WSP(bf16, WS_GQT) + (size_t)d * MTOK * 1024; const bf16* KD = WSP(bf16, WS_GKD) + (size_t)d * MTOK * 1024;
    const bf16* AM = WSP(bf16, WS_GAM) + (size_t)d * 1024 * 4096; const float* DEC = WSP(float, WS_GDEC) + (size_t)d * 1024 * 256;
    const bf16* GV = WSP(bf16, WS_GV); float* OD = WSP(float, d == 0 ? WS_GOF : WS_GOB);
    const int dvc = h * 512 + sl * 128;
    f32x4 S[16];
    if (sample) { const float* s0 = F.in[d == 0 ? I_SGF : I_SGB] + ((size_t)((seq - 32) * 4 + h) * 256) * 512 + sl * 128 + 16 * wave + cl;
#pragma unroll
        for (int t = 0; t < 16; ++t)
#pragma unroll
            for (int r = 0; r < 4; ++r) S[t][r] = s0[(size_t)(16 * t + 4 * gq + r) * 512];
    } else {
#pragma unroll
        for (int t = 0; t < 16; ++t) S[t] = (f32x4){0.f, 0.f, 0.f, 0.f};
    }
    v4u rq[4], rk[4], rv[2], ra; float rdec = 0.f;
#define GLOAD(ci) do { const int r0_ = base + 64 * (ci); const int chx_ = (r0_ >> 6) * 4 + h; \
    _Pragma("unroll") for (int i = 0; i < 4; ++i) { const int e = tid + 512 * i, row = e >> 5, cc = e & 31; const size_t go = (size_t)(r0_ + row) * 1024 + h * 256 + cc * 8; rq[i] = *(const v4u*)(QT + go); rk[i] = *(const v4u*)(KD + go); } \
    _Pragma("unroll") for (int i = 0; i < 2; ++i) { const int e = tid + 512 * i, row = e >> 4, cc = e & 15; rv[i] = *(const v4u*)(GV + (size_t)(r0_ + row) * 2048 + dvc + cc * 8); } \
    ra = *(const v4u*)(AM + (size_t)chx_ * 4096 + tid * 8); if (tid < 256) rdec = DEC[(size_t)chx_ * 256 + tid]; } while (0)
#define LWRITE() do { \
    _Pragma("unroll") for (int i = 0; i < 4; ++i) { const int e = tid + 512 * i, row = e >> 5, cc = e & 31; *(LAS v4u*)(L + OQ + row * PQ + cc * 16) = rq[i]; *(LAS v4u*)(L + OK_ + row * PK + cc * 16) = rk[i]; } \
    _Pragma("unroll") for (int i = 0; i < 2; ++i) { const int e = tid + 512 * i, row = e >> 4, cc = e & 15; *(LAS v4u*)(L + OV + row * PV + cc * 16) = rv[i]; } \
    { const int row = tid >> 3, cc = tid & 7; *(LAS v2u*)(L + OA + row * PA + cc * 16) = (v2u){ra.x, ra.y}; *(LAS v2u*)(L + OA + row * PA + cc * 16 + 8) = (v2u){ra.z, ra.w}; } \
    if (tid < 256) ((LAS float*)(L + ODEC))[tid] = rdec; } while (0)
    GLOAD(d == 0 ? 0 : nch - 1);
    LWRITE();
    __syncthreads();
    for (int s = 0; s < nch; ++s) {
        const int ci = d == 0 ? s : nch - 1 - s, row0 = base + 64 * ci;
        if (s + 1 < nch) GLOAD(d == 0 ? s + 1 : nch - 2 - s);
        f32x4 o[4];
#pragma unroll
        for (int ti = 0; ti < 4; ++ti) o[ti] = (f32x4){0.f, 0.f, 0.f, 0.f};
#pragma unroll
        for (int ks = 0; ks < 8; ++ks) {
            v4u bw; bw.x = cvtpk(S[2 * ks][0], S[2 * ks][1]); bw.y = cvtpk(S[2 * ks][2], S[2 * ks][3]); bw.z = cvtpk(S[2 * ks + 1][0], S[2 * ks + 1][1]); bw.w = cvtpk(S[2 * ks + 1][2], S[2 * ks + 1][3]);
            const bf16x8 bfr = __builtin_bit_cast(bf16x8, bw);
#pragma unroll
            for (int ti = 0; ti < 4; ++ti) {
                const LAS char* ap = L + OQ + (16 * ti + cl) * PQ + (32 * ks + 4 * gq) * 2;
                const s16x4 lo = *(const LAS s16x4*)ap, hi = *(const LAS s16x4*)(ap + 32);
                o[ti] = MFMA16(CAT8(lo, hi), bfr, o[ti]);
            }
        }
        bf16x8 vb[2];
#pragma unroll
        for (int ks = 0; ks < 2; ++ks) { const LAS char* vp = L + OV + (32 * ks + 4 * gq + (cl >> 2)) * PV + 32 * wave + 8 * (cl & 3);
            const s16x4 lo = vtr(vp), hi = vtr(vp + 16 * PV); vb[ks] = CAT8(lo, hi); }
#pragma unroll
        for (int ks = 0; ks < 2; ++ks)
#pragma unroll
            for (int ti = 0; ti < 4; ++ti) {
                const LAS char* ap = L + OA + (16 * ti + cl) * PA + (32 * ks + 4 * gq) * 2;
                const s16x4 lo = *(const LAS s16x4*)ap, hi = *(const LAS s16x4*)(ap + 32);
                o[ti] = MFMA16(CAT8(lo, hi), vb[ks], o[ti]);
            }
#pragma unroll
        for (int ti = 0; ti < 4; ++ti)
#pragma unroll
            for (int r = 0; r < 4; ++r) OD[(size_t)(row0 + 16 * ti + 4 * gq + r) * 2048 + dvc + 16 * wave + cl] = o[ti][r];
#pragma unroll
        for (int t = 0; t < 16; ++t) {
            const f32x4 dc = *(const LAS f32x4*)(L + ODEC + (16 * t + 4 * gq) * 4);
            S[t] = S[t] * dc;
#pragma unroll
            for (int ks = 0; ks < 2; ++ks) { const LAS char* kp = L + OK_ + (32 * ks + 4 * gq + (cl >> 2)) * PK + 32 * t + 8 * (cl & 3);
                const s16x4 lo = vtr(kp), hi = vtr(kp + 16 * PK); S[t] = MFMA16(CAT8(lo, hi), vb[ks], S[t]); }
        }
        __syncthreads();
        if (s + 1 < nch) { LWRITE(); }
        __syncthreads();
    }
    if (!sample) { float* so = F.out + (d == 0 ? O_GF : O_GB) + ((size_t)(seq * 4 + h) * 256) * 512 + sl * 128 + 16 * wave + cl;
#pragma unroll
        for (int t = 0; t < 16; ++t)
#pragma unroll
            for (int r = 0; r < 4; ++r) so[(size_t)(16 * t + 4 * gq + r) * 512] = S[t][r];
    }
#undef GLOAD
#undef LWRITE
}
__device__ __forceinline__ void gla_scan_phase(Frame& F) {
    const int NS = 64;
    if (F.G > 2 * NS) {
        if (F.bx < NS) { const int c = F.bx; gla_scan_item(F, 32 + (c >> 5), (c >> 3) & 3, (c >> 2) & 1, c & 3); }
        else for (int it = F.bx - NS; it < 1024; it += F.G - NS) gla_scan_item(F, it >> 5, (it >> 3) & 3, (it >> 2) & 1, it & 3);
    } else {
        for (int it = F.bx; it < 1024 + NS; it += F.G) { if (it < NS) gla_scan_item(F, 32 + (it >> 5), (it >> 3) & 3, (it >> 2) & 1, it & 3); else { const int i2 = it - NS; gla_scan_item(F, i2 >> 5, (i2 >> 3) & 3, (i2 >> 2) & 1, i2 & 3); } }
    }
}
__device__ __forceinline__ void gla_post_phase(Frame& F) {
    const int gw = F.bx * NWAVES + F.wave, NGW = F.G * NWAVES, lane = F.lane;
    const float* OFp = WSP(float, WS_GOF); const float* OBp = WSP(float, WS_GOB); const bf16* GR = WSP(bf16, WS_GR); bf16* AO = WSP(bf16, WS_AO); const float* gn = F.in[I_GNORM];
    for (int row = gw; row < MTOK; row += NGW) {
#pragma unroll
        for (int hh = 0; hh < 4; ++hh) {
            const size_t o0 = (size_t)row * 2048 + hh * 512 + 4 * lane;
            const f32x4 v0 = *(const f32x4*)(OFp + o0) + *(const f32x4*)(OBp + o0), v1 = *(const f32x4*)(OFp + o0 + 256) + *(const f32x4*)(OBp + o0 + 256);
            float ss = (v0[0] * v0[0] + v0[1] * v0[1]) + (v0[2] * v0[2] + v0[3] * v0[3]) + (v1[0] * v1[0] + v1[1] * v1[1]) + (v1[2] * v1[2] + v1[3] * v1[3]);
            const float rstd = rsqrtf(wave_sum(ss) * (1.f / 512.f) + EPS);
            const v2u r0 = *(const v2u*)(GR + o0), r1 = *(const v2u*)(GR + o0 + 256);
            f32x4 ra = {bf2f((unsigned short)(r0.x & 0xffff)), bf2f((unsigned short)(r0.x >> 16)), bf2f((unsigned short)(r0.y & 0xffff)), bf2f((unsigned short)(r0.y >> 16))};
            f32x4 rb = {bf2f((unsigned short)(r1.x & 0xffff)), bf2f((unsigned short)(r1.x >> 16)), bf2f((unsigned short)(r1.y & 0xffff)), bf2f((unsigned short)(r1.y >> 16))};
#pragma unroll
            for (int i = 0; i < 4; ++i) { ra[i] = ra[i] / (1.f + __expf(-ra[i])); rb[i] = rb[i] / (1.f + __expf(-rb[i])); }
            const f32x4 y0 = v0 * rstd * *(const f32x4*)(gn + 4 * lane) * ra, y1 = v1 * rstd * *(const f32x4*)(gn + 256 + 4 * lane) * rb;
            v2u w; w.x = cvtpk(y0[0], y0[1]); w.y = cvtpk(y0[2], y0[3]); *(v2u*)(AO + o0) = w;
            w.x = cvtpk(y1[0], y1[1]); w.y = cvtpk(y1[2], y1[3]); *(v2u*)(AO + o0 + 256) = w;
        }
    }
}

#ifndef MK_N_LAUNCHES
#define MK_N_LAUNCHES 1
#ifndef PG8_ALIGN
#define PG8_ALIGN true
#endif
#ifndef PG8_SP2
#define PG8_SP2 true
#endif
#endif
constexpr int N_PHASES = 28;
__global__ void __launch_bounds__(NWAVES * 64, 2) mk_fwd(Args args) {
    extern __shared__ __attribute__((aligned(16))) unsigned char lds[];
    Frame F;
    F.lds = (LAS unsigned char*)lds; F.ldsg = lds;
    F.tid = threadIdx.x; F.lane = F.tid & 63; F.wave = __builtin_amdgcn_readfirstlane(F.tid >> 6);
    F.G = gridDim.x; F.bx = blockIdx.x;
    F.in = args.in; F.out = args.out; F.ws = args.ws;
    volatile LAS unsigned* MISC = (volatile LAS unsigned*)(F.lds + MISC_OFF);
    if (F.tid < 32) MISC[F.tid] = 0u;
    __syncthreads();
    const int lo = args.ph_lo, hi = args.ph_hi;
    const bool use_bar = (hi - lo) > 1;
    XcdBarrier bar; bar.bar = (unsigned*)(F.ws + WS_CTL) + CW_BAR + args.li * XCD_BAR_WORDS; bar.x = 0; bar.st = nullptr;
    if (use_bar) bar = xcd_barrier_post((unsigned*)(F.ws + WS_CTL) + CW_BAR + args.li * XCD_BAR_WORDS, MISC + 8);
#ifdef PH_ONLY
#define IN(k) ((k) == PH_ONLY && lo <= (k) && (k) < hi)
#else
#define IN(k) (lo <= (k) && (k) < hi)
#endif
#define SEAM(k) do { if (IN(k) && IN((k) + 1)) xcd_barrier(bar); } while (0)
    LAS unsigned char* ring = F.lds;

#ifndef PROBE_MASK
#define PROBE_MASK 0ull
#endif
    constexpr unsigned long long REP_MASK = PROBE_MASK;
#define PHASE(k, ...) if (IN(k)) { if (((REP_MASK >> (k)) & 1ull) != 0ull) { const bool dry_ = true; (void)dry_; __VA_ARGS__ xcd_barrier(bar); } { const bool dry_ = false; (void)dry_; __VA_ARGS__ } } SEAM(k);
#define GATE(L, q) (dry_ ? (const float*)(F.ws + WS_CTL + 524288) : WSP(float, WS_MOD) + (size_t)((L) * 3) * 12288 + (q) * 2048)
#define NORMIN(site) NormIn{WSP(float, WS_PART) + (size_t)(site) * MTOK * 32, WSP(float, WS_SW) + (size_t)(site) * 3 * 8192, (const LAS float*)(F.lds + LDS_RSTD_OFF), pm0_}
    PHASE(0, p0_prologue(F);)
    PHASE(1, p1_phase(F);)

#define GEMM_PHASE(EpiT, epi, Aptr, Bptr, M_, N_, K_) do { int kk_ = (K_); asm volatile("" : "+s"(kk_)); pg8::Gemm g{(const pg8::bf16_t*)(Aptr), (const pg8::bf16_t*)(Bptr), (M_), (N_), kk_}; pg8::StaticOrder S; S.init((M_), (N_), F.G, F.bx); \
        pg8::gemm_phase<EpiT, pg8::StaticOrder, PG8_ALIGN, PG8_SP2>(ring, g, S, epi); } while (0)

#define GEMM_PHASE_N(site, EpiT, EPI_INIT, Aptr, Bptr, M_, N_, K_) do { int kk_ = (K_); asm volatile("" : "+s"(kk_)); pg8::Gemm g{(const pg8::bf16_t*)(Aptr), (const pg8::bf16_t*)(Bptr), (M_), (N_), kk_}; pg8::StaticOrder S; S.init((M_), (N_), F.G, F.bx); \
        const int pm0_ = prep_rstd(F, S, (site)); EpiT E EPI_INIT; pg8::gemm_phase<EpiT, pg8::StaticOrder, PG8_ALIGN, PG8_SP2>(ring, g, S, E); } while (0)
#define ARGS(...) {__VA_ARGS__}
#define LAYER_TAIL(P, L, WOT) \
    PHASE((P), EpiResid E{F.in[I_XP], F.in[I_XS], WSP(float, WS_X), GATE((L), 2), (L) == 0 ? 1 : 0, dry_ ? (bf16*)nullptr : WSP(bf16, WS_H), F.in[I_NORMG] + (size_t)((L) * 2 + 1) * 2048, \
            WSP(float, WS_MOD) + (size_t)((L) * 3) * 12288 + 4 * 2048, WSP(float, WS_PART) + (size_t)(2 * (L) + 1) * MTOK * 32}; GEMM_PHASE(EpiResid, E, WSP(bf16, WS_AO), (WOT), MTOK, DM, DM);) \
    PHASE((P) + 1, GEMM_PHASE_N(2 * (L) + 1, EpiRelu2, ARGS(WSP(bf16, WS_HID), FFH, NORMIN(2 * (L) + 1)), WSP(bf16, WS_H), WSP(bf16, WS_W1T) + (size_t)(L) * FFH * DM, MTOK, FFH, DM);) \
    PHASE((P) + 2, EpiResid E{F.in[I_XP], F.in[I_XS], WSP(float, WS_X), GATE((L), 5), 0, (dry_ || (L) == 3) ? (bf16*)nullptr : WSP(bf16, WS_H), F.in[I_NORMG] + (size_t)(((L) + 1) * 2) * 2048, \
            WSP(float, WS_MOD) + (size_t)(((L) + 1) * 3) * 12288 + 1 * 2048, WSP(float, WS_PART) + (size_t)(2 * ((L) + 1)) * MTOK * 32}; GEMM_PHASE(EpiResid, E, WSP(bf16, WS_HID), WSP(bf16, WS_W2T) + (size_t)(L) * DM * FFH, MTOK, DM, FFH);)

#define WIN_LAYER(P, L, J) \
    PHASE((P), GEMM_PHASE_N(2 * (L), EpiQkvWin, ARGS(WSP(bf16, WS_WQ), WSP(bf16, WS_WK), WSP(bf16, WS_WV), F.out + O_WK, F.out + O_WV, (J), WSP(f32x2, WS_TABW), NORMIN(2 * (L))), \
        WSP(bf16, WS_H), WSP(bf16, WS_WQKVT) + (size_t)(J) * 3072 * DM, MTOK, 3072, DM);) \
    PHASE((P) + 1, attn_win_phase(F, (J));) \
    LAYER_TAIL((P) + 2, (L), WSP(bf16, WS_WWOT) + (size_t)(J) * DM * DM)

    WIN_LAYER(2, 0, 0)
    PHASE(7, GEMM_PHASE_N(2, EpiF32, ARGS(WSP(float, WS_MD), 1024, NORMIN(2)), WSP(bf16, WS_H), WSP(bf16, WS_MWDT), MTOK, 1024, DM);)
    PHASE(8, mla_norm_phase(F);)
    PHASE(9, EpiMlaQ E{WSP(bf16, WS_MQ), WSP(f32x2, WS_TABM)}; GEMM_PHASE(EpiMlaQ, E, WSP(bf16, WS_MCQ), WSP(bf16, WS_MWUQT), MTOK, 3072, 512);)
    PHASE(10, EpiMlaKV E{WSP(bf16, WS_MKN), WSP(bf16, WS_MV)}; GEMM_PHASE(EpiMlaKV, E, WSP(bf16, WS_MCKV), WSP(bf16, WS_MWUKVT), MTOK + 1024, 4096, 256);)
    PHASE(11, attn_mla_phase(F);)
    LAYER_TAIL(12, 1, WSP(bf16, WS_MWOT))
    PHASE(15, GEMM_PHASE_N(4, EpiGlaIn, ARGS(WSP(bf16, WS_GQ), WSP(bf16, WS_GK), WSP(bf16, WS_GV), WSP(bf16, WS_GR), WSP(float, WS_GU), NORMIN(4)), WSP(bf16, WS_H), WSP(bf16, WS_GWINT), MTOK, 6400, DM);)
    PHASE(16, gla_prep_phase(F);)
    PHASE(17, gla_scan_phase(F);)
    PHASE(18, gla_post_phase(F);)
    LAYER_TAIL(19, 2, WSP(bf16, WS_GWOT))
    WIN_LAYER(22, 3, 1)
    PHASE(27, final_phase(F);)
#undef IN
#undef SEAM
}

extern "C" void kernel_launch(void* const* d_in, const int* in_sizes, int n_in, void* d_out, int out_size, void* d_ws, size_t ws_size, hipStream_t stream) {
    static int grid = 0;
    if (grid == 0) {
        if (n_in != 31 || (size_t)out_size != O_END || ws_size < WS_END) { fprintf(stderr, "kernel_launch: shape mismatch n_in %d out %d ws %zu (need %zu)\n", n_in, out_size, ws_size, (size_t)WS_END); grid = -1; return; }
        int dev = 0, cus = 0, per_cu = 0;
        if (hipGetDevice(&dev) != hipSuccess || hipDeviceGetAttribute(&cus, hipDeviceAttributeMultiprocessorCount, dev) != hipSuccess) { grid = -1; return; }
        if (hipFuncSetAttribute((const void*)mk_fwd, hipFuncAttributeMaxDynamicSharedMemorySize, LDS_BYTES) != hipSuccess) { fprintf(stderr, "kernel_launch: hipFuncSetAttribute failed\n"); grid = -1; return; }
        if (hipOccupancyMaxActiveBlocksPerMultiprocessor(&per_cu, (const void*)mk_fwd, NWAVES * 64, LDS_BYTES) != hipSuccess || per_cu < 1) fprintf(stderr, "kernel_launch: occupancy query says %d\n", per_cu);
        (void)hipGetLastError();
        grid = cus;
    }
    if (grid < 0) return;
    if (hipMemsetAsync((char*)d_ws + WS_CTL, 0, CTL_ZERO_BYTES, stream) != hipSuccess) return;
    Args a{};
    for (int i = 0; i < 31; ++i) a.in[i] = (const float*)d_in[i];
    a.in[31] = nullptr;
    a.out = (float*)d_out; a.ws = (unsigned char*)d_ws; a.pad = 0; a.rep_mask = 0ull; a.rep_n = 1; a.pad2 = 0;
#if MK_N_LAUNCHES == 1
    a.ph_lo = 0; a.ph_hi = N_PHASES; a.li = 0;
    hipLaunchKernelGGL(mk_fwd, dim3(grid), dim3(NWAVES * 64), LDS_BYTES, stream, a);
#else
    for (int p = 0; p < N_PHASES; ++p) { a.ph_lo = p; a.ph_hi = p + 1; a.li = 0; hipLaunchKernelGGL(mk_fwd, dim3(grid), dim3(NWAVES * 64), LDS_BYTES, stream, a); }
#endif
}
```

```cpp
#include <hip/hip_runtime.h>
#include <cstdio>
#include <cstdint>
namespace pg8 {
#define PG8_LAS __attribute__((address_space(3)))
typedef unsigned short bf16_t;
typedef short bf16x8 __attribute__((ext_vector_type(8)));
typedef float f32x4 __attribute__((ext_vector_type(4)));
typedef unsigned u32x4 __attribute__((ext_vector_type(4)));
constexpr int BM = 256, BK = 64, HALF = 128, HTB = HALF * BK * 2  , STAGE_BYTES = 8 * HTB, NXCD = 8, WGM = 8;

__host__ __device__ __forceinline__ int lds_byte(int r, int c) { const int st = (r >> 4) * 2 + (c >> 5), rr = r & 15, cc = c & 31, ob = rr * 64 + cc * 2; return st * 1024 + (ob ^ (((ob >> 9) & 1) << 5)); }
__host__ __device__ __forceinline__ void stage_rc(int b, int& R, int& C) { const int st = b / 1024, sb = b % 1024, swz = sb ^ (((sb >> 9) & 1) << 5); R = (st >> 1) * 16 + swz / 64; C = (st & 1) * 32 + (swz % 64) / 2; }
__host__ __device__ __forceinline__ int perm32(int rho) { const int n = rho >> 4, i = rho & 15; return 8 * (i >> 2) + 4 * n + (i & 3); }

struct Unit { int pm, pn; };
struct Gemm { const bf16_t* A; const bf16_t* Bt; int M, N, K; };

struct StaticOrder {
    int nM, nN, nwg, G, c;
    __host__ __device__ void init(int M, int N, int G_, int c_) { nM = M / BM; nN = N / BM; nwg = nM * nN; G = G_; c = c_; }
    __host__ __device__ bool next(int i, Unit& u) const {
        const long L = (long)i * G + c; if (L >= nwg) return false;
        int wgid = (int)L; { const int q = nwg / NXCD, r = nwg % NXCD, xcd = wgid % NXCD, off = wgid / NXCD; wgid = (xcd < r ? xcd * (q + 1) : r * (q + 1) + (xcd - r) * q) + off; }
        const int nig = WGM * nN, gid = wgid / nig, fm = gid * WGM, gsz = (nM - fm) < WGM ? (nM - fm) : WGM;
        u.pm = fm + ((wgid % nig) % gsz); u.pn = (wgid % nig) / gsz; return true;
    }
    __device__ __forceinline__ void a_ready(const Unit&) const {}
    __device__ __forceinline__ void done(const Unit&) const {}
};
__device__ __forceinline__ unsigned cvt_pk_bf16(float lo, float hi) { unsigned r; asm volatile("v_cvt_pk_bf16_f32 %0, %1, %2" : "=v"(r) : "v"(lo), "v"(hi)); return r; }
typedef float f32x2 __attribute__((ext_vector_type(2)));
typedef int i32x4 __attribute__((ext_vector_type(4)));
template <bool I8> __device__ __forceinline__ f32x4 mma16(bf16x8 b, bf16x8 a, f32x4 c) {
    if constexpr (I8) return __builtin_bit_cast(f32x4, __builtin_amdgcn_mfma_i32_16x16x64_i8(__builtin_bit_cast(i32x4, b), __builtin_bit_cast(i32x4, a), __builtin_bit_cast(i32x4, c), 0, 0, 0));
    else return __builtin_amdgcn_mfma_f32_16x16x32_bf16(b, a, c, 0, 0, 0);
}
template <class Epi, class Sched, bool ALIGN_EPI = false, bool SP2 = false, bool I8 = false>
__device__ __forceinline__ void gemm_phase(PG8_LAS unsigned char* lds, const Gemm g, const Sched& S, const Epi& E) {
    const int tid = threadIdx.x, wid = __builtin_amdgcn_readfirstlane(tid >> 6), lane = tid & 63, wr = wid >> 2, wc = wid & 3, fr = lane & 15, fq = lane >> 4;
    const int K = g.K, nt = K / BK;
    unsigned voffA[2], voffB[2];
#pragma unroll
    for (int i = 0; i < 2; ++i) { int R, C; stage_rc(tid * 16 + i * 8192, R, C); const int Rb = Epi::PERM ? ((R & ~31) + perm32(R & 31)) : R;
        voffA[i] = (unsigned)(R * K + C) * 2u; voffB[i] = (unsigned)(Rb * K + C) * 2u; }
    const size_t kstep = (size_t)(BK * 2);
    const size_t hstep = (size_t)HALF * K * 2;
    const size_t tstep = 2 * hstep;
    const unsigned ldsw = (unsigned)wid * 1024u;
    const int aoff = lds_byte(wr * 64 + fr, fq * 8), boff = lds_byte(wc * 32 + fr, fq * 8);
#define PG8_SA(b, h) (((b) * 2 + (h)) * HTB)
#define PG8_SB(b, h) ((4 + (b) * 2 + (h)) * HTB)
#define PG8_STAGE(bufoff, gbase, voff) do { _Pragma("unroll") for (int _i = 0; _i < 2; ++_i) \
        __builtin_amdgcn_global_load_lds((const unsigned*)((const char*)(gbase) + (voff)[_i]), (PG8_LAS unsigned*)(lds + (bufoff) + ldsw + _i * 8192), 16, 0, 0); } while (0)
#define PG8_LDA(dst, b, h) do { _Pragma("unroll") for (int m = 0; m < 4; ++m) _Pragma("unroll") for (int k = 0; k < 2; ++k) dst[m][k] = *(const PG8_LAS bf16x8*)(lds + PG8_SA(b, h) + aoff + m * 2048 + k * 1024); } while (0)
#define PG8_LDB(dst, b, h) do { _Pragma("unroll") for (int n = 0; n < 2; ++n) _Pragma("unroll") for (int k = 0; k < 2; ++k) dst[n][k] = *(const PG8_LAS bf16x8*)(lds + PG8_SB(b, h) + boff + n * 2048 + k * 1024); } while (0)
#define PG8_MMA(ai, bj, At, Bt) do { __builtin_amdgcn_s_setprio(1); _Pragma("unroll") for (int m = 0; m < 4; ++m) _Pragma("unroll") for (int n = 0; n < 2; ++n) _Pragma("unroll") for (int k = 0; k < 2; ++k) \
        acc[ai][bj][m][n] = mma16<I8>(Bt[n][k], At[m][k], acc[ai][bj][m][n]); __builtin_amdgcn_s_setprio(0); } while (0)
#define PG8_WAIT_V(n) asm volatile("s_waitcnt vmcnt(" #n ")" ::: "memory")
#define PG8_WAIT_L(n) asm volatile("s_waitcnt lgkmcnt(" #n ")" ::: "memory")
#define PG8_BAR __builtin_amdgcn_s_barrier()
#define PG8_SCHED __builtin_amdgcn_sched_barrier(0)
    Unit cur, nxt; int ui = 0;
    if (!S.next(0, cur)) return;
    f32x4 acc[2][2][4][2];
#pragma unroll
    for (int a = 0; a < 2; ++a)
#pragma unroll
        for (int b = 0; b < 2; ++b)
#pragma unroll
            for (int m = 0; m < 4; ++m)
#pragma unroll
                for (int n = 0; n < 2; ++n) acc[a][b][m][n] = (f32x4){0.f, 0.f, 0.f, 0.f};
    bf16x8 At[4][2], B0[2][2], B1[2][2];
    const char* cA = (const char*)g.A + (size_t)cur.pm * tstep; const char* cB = (const char*)g.Bt + (size_t)cur.pn * tstep;
    S.a_ready(cur);
    if constexpr (SP2) {
        PG8_STAGE(PG8_SB(0, 0), cB, voffB); PG8_STAGE(PG8_SB(0, 1), cB + hstep, voffB); PG8_STAGE(PG8_SA(0, 0), cA, voffA); PG8_STAGE(PG8_SA(0, 1), cA + hstep, voffA);
        if (wr == 1) PG8_BAR;
        PG8_WAIT_V(2); PG8_BAR;
        PG8_STAGE(PG8_SB(1, 0), cB + kstep, voffB); PG8_STAGE(PG8_SA(1, 0), cA + kstep, voffA); PG8_STAGE(PG8_SB(1, 1), cB + hstep + kstep, voffB);
        PG8_WAIT_V(6); PG8_BAR;
    } else {
        PG8_STAGE(PG8_SB(0, 0), cB, voffB); PG8_STAGE(PG8_SA(0, 0), cA, voffA); PG8_STAGE(PG8_SB(0, 1), cB + hstep, voffB); PG8_STAGE(PG8_SA(0, 1), cA + hstep, voffA);
        if (wr == 1) PG8_BAR;
        PG8_WAIT_V(4); PG8_BAR;
        PG8_STAGE(PG8_SB(1, 0), cB + kstep, voffB); PG8_STAGE(PG8_SA(1, 0), cA + kstep, voffA); PG8_STAGE(PG8_SB(1, 1), cB + hstep + kstep, voffB);
        PG8_WAIT_V(6); PG8_BAR;
    }
    for (;;) {
        const bool has_next = S.next(ui + 1, nxt);
        const char* nA = has_next ? (const char*)g.A + (size_t)nxt.pm * tstep : cA; const char* nB = has_next ? (const char*)g.Bt + (size_t)nxt.pn * tstep : cB;
        asm volatile(".p2align 8");
        for (int t = 0; t < nt; t += 2) {
            const bool last = (t == nt - 2);
            const char* a1 = cA + (size_t)(t + 1) * kstep;
            const char* a2 = last ? nA : cA + (size_t)(t + 2) * kstep; const char* b2 = last ? nB : cB + (size_t)(t + 2) * kstep;
            const char* a3 = a2 + kstep; const char* b3 = b2 + kstep;
            if (last && has_next) S.a_ready(nxt);
            if constexpr (SP2) {
            PG8_LDB(B0, 0, 0); PG8_LDB(B1, 0, 1); PG8_SCHED; PG8_LDA(At, 0, 0); PG8_STAGE(PG8_SA(1, 1), a1 + hstep, voffA);
            PG8_WAIT_V(8); PG8_WAIT_L(0); PG8_BAR; PG8_MMA(0, 0, At, B0); PG8_MMA(0, 1, At, B1); PG8_BAR; PG8_SCHED;
            PG8_LDA(At, 0, 1); PG8_STAGE(PG8_SB(0, 0), b2, voffB); PG8_STAGE(PG8_SB(0, 1), b2 + hstep, voffB); PG8_STAGE(PG8_SA(0, 0), a2, voffA);
            PG8_WAIT_V(8); PG8_WAIT_L(0); PG8_BAR; PG8_MMA(1, 0, At, B0); PG8_MMA(1, 1, At, B1); PG8_BAR; PG8_SCHED;
            PG8_LDB(B0, 1, 0); PG8_LDB(B1, 1, 1); PG8_SCHED; PG8_LDA(At, 1, 0); PG8_STAGE(PG8_SA(0, 1), a2 + hstep, voffA);
            PG8_WAIT_V(8); PG8_WAIT_L(0); PG8_BAR; PG8_MMA(0, 0, At, B0); PG8_MMA(0, 1, At, B1); PG8_BAR; PG8_SCHED;
            PG8_LDA(At, 1, 1); PG8_STAGE(PG8_SB(1, 0), b3, voffB); PG8_STAGE(PG8_SB(1, 1), b3 + hstep, voffB); PG8_STAGE(PG8_SA(1, 0), a3, voffA);
            PG8_WAIT_V(8); PG8_WAIT_L(0); PG8_BAR; PG8_MMA(1, 0, At, B0); PG8_MMA(1, 1, At, B1); PG8_BAR; PG8_SCHED;
            } else {
            PG8_LDB(B0, 0, 0); PG8_SCHED; PG8_LDA(At, 0, 0); PG8_STAGE(PG8_SA(1, 1), a1 + hstep, voffA);
            PG8_WAIT_L(8); PG8_BAR; PG8_WAIT_L(0); PG8_MMA(0, 0, At, B0); PG8_BAR; PG8_SCHED;
            PG8_LDB(B1, 0, 1); PG8_STAGE(PG8_SB(0, 0), b2, voffB);
            PG8_BAR; PG8_WAIT_L(0); PG8_MMA(0, 1, At, B1); PG8_BAR;
            PG8_LDA(At, 0, 1); PG8_STAGE(PG8_SA(0, 0), a2, voffA);
            PG8_BAR; PG8_WAIT_L(0); PG8_MMA(1, 0, At, B0); PG8_BAR; PG8_SCHED;
            PG8_STAGE(PG8_SB(0, 1), b2 + hstep, voffB);
            PG8_WAIT_V(6); PG8_BAR; PG8_MMA(1, 1, At, B1); PG8_BAR;
            PG8_LDB(B0, 1, 0); PG8_SCHED; PG8_LDA(At, 1, 0); PG8_STAGE(PG8_SA(0, 1), a2 + hstep, voffA);
            PG8_WAIT_L(8); PG8_BAR; PG8_WAIT_L(0); PG8_MMA(0, 0, At, B0); PG8_BAR; PG8_SCHED;
            PG8_LDB(B1, 1, 1); PG8_STAGE(PG8_SB(1, 0), b3, voffB);
            PG8_BAR; PG8_WAIT_L(0); PG8_MMA(0, 1, At, B1); PG8_BAR;
            PG8_LDA(At, 1, 1); PG8_STAGE(PG8_SA(1, 0), a3, voffA);
            PG8_BAR; PG8_WAIT_L(0); PG8_MMA(1, 0, At, B0); PG8_BAR; PG8_SCHED;
            PG8_STAGE(PG8_SB(1, 1), b3 + hstep, voffB);
            PG8_WAIT_V(6); PG8_BAR; PG8_MMA(1, 1, At, B1); PG8_BAR;
            }
        }
        if constexpr (ALIGN_EPI) { if (wr == 0) PG8_BAR; }
        if constexpr (!Epi::AFTER_DRAIN) { E(acc, cur, wr, wc, fr, fq); S.done(cur); }
        if (!has_next) break;
#pragma unroll
        for (int a = 0; a < 2; ++a)
#pragma unroll
            for (int b = 0; b < 2; ++b)
#pragma unroll
                for (int m = 0; m < 4; ++m)
#pragma unroll
                    for (int n = 0; n < 2; ++n) acc[a][b][m][n] = (f32x4){0.f, 0.f, 0.f, 0.f};
        cur = nxt; cA = nA; cB = nB; ++ui;
        if constexpr (ALIGN_EPI) { if (wr == 1) PG8_BAR; }
    }
    PG8_WAIT_V(0);
    if constexpr (!ALIGN_EPI) { if (wr == 0) PG8_BAR; }
    PG8_BAR;
    if constexpr (Epi::AFTER_DRAIN) { E.fused(acc, cur, wr, wc, fr, fq, lds, wid, lane); S.done(cur); }
#undef PG8_SA
#undef PG8_SB
#undef PG8_STAGE
#undef PG8_LDA
#undef PG8_LDB
#undef PG8_MMA
#undef PG8_WAIT_V
#undef PG8_WAIT_L
#undef PG8_BAR
#undef PG8_SCHED
}
}

#define GAS __attribute__((address_space(1)))
#define LAS __attribute__((address_space(3)))
typedef unsigned short bf16;
typedef unsigned v4u __attribute__((ext_vector_type(4)));
typedef unsigned v2u __attribute__((ext_vector_type(2)));
typedef float f32x4 __attribute__((ext_vector_type(4)));
typedef float f32x2 __attribute__((ext_vector_type(2)));
typedef float f32x16 __attribute__((ext_vector_type(16)));
typedef short bf16x8 __attribute__((ext_vector_type(8)));
typedef short s16x4 __attribute__((ext_vector_type(4)));
typedef GAS unsigned gu32;
#define RLX_AGENT __ATOMIC_RELAXED, __HIP_MEMORY_SCOPE_AGENT
#define LDS_WAIT() asm volatile("s_waitcnt lgkmcnt(0)" ::: "memory")
#define VM_WAIT() asm volatile("s_waitcnt vmcnt(0)" ::: "memory")
#define SBAR() __builtin_amdgcn_sched_barrier(0)
__device__ __forceinline__ unsigned f2bf(float f) { unsigned u = __builtin_bit_cast(unsigned, f); return (u + 0x7fffu + ((u >> 16) & 1u)) >> 16; }
__device__ __forceinline__ unsigned pk2(float lo, float hi) { return f2bf(lo) | (f2bf(hi) << 16); }
__device__ __forceinline__ float bf2f(unsigned short b) { return __builtin_bit_cast(float, (unsigned)b << 16); }
__device__ __forceinline__ unsigned cvtpk(float lo, float hi) { unsigned r; asm volatile("v_cvt_pk_bf16_f32 %0, %1, %2" : "=v"(r) : "v"(lo), "v"(hi)); return r; }
__device__ __forceinline__ float wave_sum(float v) {
#pragma unroll
    for (int o = 1; o < 64; o <<= 1) v += __shfl_xor(v, o);
    return v;
}
#define XB_TMO      128
#define XB_XCNT(j)  (256  + 64 * (j))
#define XB_XSUB(j)  (1280 + 64 * (j))
#define XB_XGEN(j)  (2304 + 64 * (j))
#define XB_TOP      3328
#define XB_TOPGEN   3392
#define XCD_BAR_WORDS 3456
#define XB_SPIN_CAP (1u << 18)

__device__ __forceinline__ unsigned xb_ld(unsigned* p)              { return __hip_atomic_load(p, __ATOMIC_RELAXED, __HIP_MEMORY_SCOPE_AGENT); }
__device__ __forceinline__ unsigned xb_add(unsigned* p, unsigned v) { return __hip_atomic_fetch_add(p, v, __ATOMIC_RELAXED, __HIP_MEMORY_SCOPE_AGENT); }
__device__ __forceinline__ unsigned xb_xcc_id() { return (unsigned)__builtin_amdgcn_s_getreg((3 << 11) | 20) & 0xFu; }
#define XB_SPIN(cond, bar) do { unsigned _sp = 0; while (cond) { __builtin_amdgcn_s_sleep(1); \
    if ((++_sp & 255u) == 0u) { if (xb_ld(&(bar)[XB_TMO])) break; if (_sp > XB_SPIN_CAP) { atomicAdd(&(bar)[XB_TMO], 1u); break; } } } } while (0)

struct XcdBarrier {
    unsigned* bar; unsigned x;
    volatile LAS unsigned* st;
};

__device__ __forceinline__ XcdBarrier xcd_barrier_post(unsigned* bar, volatile LAS unsigned* st) {
    XcdBarrier b; b.bar = bar; b.x = xb_xcc_id(); b.st = st;
    if (threadIdx.x == 0) (void)xb_add(&bar[XB_XCNT(b.x)], 1u);
    return b;
}
__device__ __forceinline__ void xcd_barrier_complete(unsigned* bar, unsigned x, unsigned& nloc, unsigned& nx) {
    const unsigned G = gridDim.x * gridDim.y * gridDim.z;
    unsigned sum, cnt, mine, sp = 0u;
    for (;;) {
        sum = 0u; cnt = 0u; mine = 0u;
#pragma unroll
        for (unsigned j = 0; j < 16; ++j) { const unsigned c = xb_ld(&bar[XB_XCNT(j)]); sum += c; cnt += (c > 0u) ? 1u : 0u; mine = (j == x) ? c : mine; }
        if (sum == G) break;
        __builtin_amdgcn_s_sleep(1);
        if ((++sp & 255u) == 0u) { if (xb_ld(&bar[XB_TMO])) break; if (sp > XB_SPIN_CAP) { atomicAdd(&bar[XB_TMO], 1u); break; } }
    }
    nloc = mine > 0u ? mine : 1u; nx = cnt > 0u ? cnt : 1u;
}

__device__ __forceinline__ void xcd_barrier(const XcdBarrier& b) {
    asm volatile("s_waitcnt vmcnt(0)" ::: "memory");
    __syncthreads();
    if (threadIdx.x == 0) {
        unsigned* bar = b.bar;
        __builtin_amdgcn_s_waitcnt(0);
        unsigned nloc = b.st[0], nx = b.st[1];
        if (nloc == 0u) { xcd_barrier_complete(bar, b.x, nloc, nx); b.st[0] = nloc; b.st[1] = nx; }
        const unsigned old = xb_add(&bar[XB_XSUB(b.x)], 1u);
        const unsigned gen = old / nloc;
        if (old + 1u == (gen + 1u) * nloc) {
            __builtin_amdgcn_fence(__ATOMIC_RELEASE, "agent");
            asm volatile("s_waitcnt vmcnt(0)" ::: "memory");
            const unsigned og = xb_add(&bar[XB_TOP], 1u);
            const unsigned tg = og / nx;
            if (og + 1u == (tg + 1u) * nx) xb_add(&bar[XB_TOPGEN], 1u);
            else XB_SPIN(xb_ld(&bar[XB_TOPGEN]) == tg, bar);
            __builtin_amdgcn_fence(__ATOMIC_ACQUIRE, "agent");
            xb_add(&bar[XB_XGEN(b.x)], 1u);
            asm volatile("s_waitcnt vmcnt(0)" ::: "memory");
        } else {
            XB_SPIN(xb_ld(&bar[XB_XGEN(b.x)]) == gen, bar);
            __builtin_amdgcn_fence(__ATOMIC_ACQUIRE, "agent");
            asm volatile("s_waitcnt vmcnt(0)" ::: "memory");
        }
    }
    __syncthreads();
}

constexpr int NWAVES = 8;
constexpr int DM = 2048, MTOK = 16384, MP = 8192, FFH = 8192;
constexpr float EPS = 1e-6f;
constexpr size_t MiB = 1u << 20;
constexpr size_t WS_CTL = 0, CTL_ZERO_BYTES = 1 * MiB;
constexpr size_t WS_MOD = 2 * MiB;
constexpr size_t WS_TABW = 2 * MiB + 655360;
constexpr size_t WS_TABM = 2 * MiB + 720896;
constexpr size_t WS_SW = 3 * MiB;
constexpr size_t WS_W1T = 4 * MiB;
constexpr size_t WS_SCOL = 3 * MiB + 786432;
constexpr size_t WS_W2T = 132 * MiB;
constexpr size_t WS_WQKVT = 260 * MiB;
constexpr size_t WS_WWOT = 284 * MiB;
constexpr size_t WS_SCOLO = 3 * MiB + 786432 + 131072;
constexpr size_t WS_MWDT = 300 * MiB;
constexpr size_t WS_MWUQT = 304 * MiB;
constexpr size_t WS_MWUKVT = 307 * MiB;
constexpr size_t WS_MWOT = 309 * MiB;
constexpr size_t WS_GWINT = 317 * MiB;
constexpr size_t WS_GWOT = 342 * MiB;
constexpr size_t WS_CTXK = 350 * MiB;
constexpr size_t WS_CTXV = 352 * MiB;
constexpr size_t WS_X = 354 * MiB;
constexpr size_t WS_H = 482 * MiB;
constexpr size_t WS_AO = 546 * MiB;
constexpr size_t WS_SCR = 610 * MiB;
constexpr size_t WS_HID = WS_SCR;
constexpr size_t WS_WQ = WS_SCR, WS_WK = WS_SCR + 64 * MiB, WS_WV = WS_SCR + 80 * MiB;
constexpr size_t WS_MD = WS_SCR, WS_MCQ = WS_SCR + 64 * MiB, WS_MCKV = WS_SCR + 80 * MiB, WS_MKR = WS_SCR + 89 * MiB, WS_MQ = WS_SCR + 92 * MiB, WS_MKN = WS_SCR + 188 * MiB, WS_MV = WS_SCR + 256 * MiB;
constexpr size_t WS_GQ = WS_SCR, WS_GK = WS_SCR + 32 * MiB, WS_GV = WS_SCR + 64 * MiB, WS_GR = WS_SCR + 128 * MiB, WS_GU = WS_SCR + 192 * MiB,
                 WS_GQT = WS_SCR + 194 * MiB, WS_GKD = WS_SCR + 258 * MiB, WS_GAM = WS_SCR + 322 * MiB, WS_GDEC = WS_SCR + 338 * MiB, WS_GOF = WS_SCR + 340 * MiB, WS_GOB = WS_SCR + 468 * MiB;
constexpr size_t WS_PART = WS_SCR + 596 * MiB;
constexpr size_t WS_PMAX = WS_PART + 16 * MiB;
constexpr size_t WS_FROW = WS_PMAX + 16 * MiB;
constexpr size_t WS_H8 = WS_FROW + 1 * MiB;
constexpr size_t WS_GLS = WS_H8 + 32 * MiB;
constexpr size_t WS_GDS = WS_GLS + 24 * MiB;
constexpr size_t WS_AO8 = WS_GDS + 1 * MiB;
constexpr size_t WS_AROW = WS_AO8 + 32 * MiB;
constexpr size_t WS_END = WS_AROW + 1 * MiB;
constexpr size_t O_YP = 0, O_YS = 16777216, O_WK = 33554432, O_WV = 41943040, O_CKV = 50331648, O_KR = 52428800, O_GF = 52953088, O_GB = 69730304, O_END = 86507520;
constexpr int CW_BAR = 4096;
constexpr int RING_BYTES = 131072, MISC_OFF = 159744 + 320, LDS_BYTES = 163840;

struct Args {
    const float* in[32]; float* out; unsigned char* ws; int ph_lo, ph_hi, li, pad; unsigned long long rep_mask; int rep_n, pad2;
};
enum { I_XP = 0, I_XS, I_C, I_CWK, I_CWV, I_CCKV, I_CKR, I_SGF, I_SGB, I_CCTX, I_ADAW, I_ADAB, I_NORMG, I_WQKV, I_SINK, I_WWO, I_MWD, I_MQN, I_MWUQ, I_MKVN, I_MWUKV, I_MWO,
       I_GWIN, I_GWA1, I_GWA2, I_GBA, I_GNORM, I_GWO, I_W1, I_W2, I_FNORM };

__device__ __forceinline__ int cond_of_pm(int pm) { return pm < 32 ? 0 : (pm >> 4) - 1; }

__device__ __forceinline__ v4u pack8(const f32x4& a, const f32x4& b) { v4u w; w.x = cvtpk(a[0], a[1]); w.y = cvtpk(a[2], a[3]); w.z = cvtpk(b[0], b[1]); w.w = cvtpk(b[2], b[3]); return w; }

struct NormIn {
    const float* part; const float* sW; const LAS float* lrs; int pm0;
    __device__ __forceinline__ float rstd(int row, int pm) const {
        if (pm == pm0) return lrs[row & 255];
        const f32x4* pp = (const f32x4*)(part + (size_t)row * 32); f32x4 t = pp[0];
#pragma unroll
        for (int i = 1; i < 8; ++i) t += pp[i];
        return rsqrtf(((t[0] + t[1]) + (t[2] + t[3])) * (1.f / 2048.f) + EPS);
    }
    __device__ __forceinline__ const float* swp(int pm) const { return sW + (size_t)cond_of_pm(pm) * 8192; }
};

template <bool I8> struct EpiResidT {
    static constexpr bool PERM = true, AFTER_DRAIN = false;
    const float* xp; const float* xs; float* X; const float* gate; int first;
    const float* arow; const float* scol;
    bf16* H; const float* ng; const float* nsc; float* rss; float* rmx;
    __device__ __forceinline__ void operator()(const pg8::f32x4 (&acc)[2][2][4][2], const pg8::Unit& u, int wr, int wc, int fr, int fq) const {
        const int row0 = u.pm * 256 + wr * 64 + fr, col0 = u.pn * 256 + wc * 32 + 8 * fq, cond = cond_of_pm(u.pm);
        const float* gp = gate + (size_t)cond * 12288 + col0;
        f32x4 gv[2][2], av[2][2];
#pragma unroll
        for (int bj = 0; bj < 2; ++bj)
#pragma unroll
            for (int n = 0; n < 2; ++n) { gv[bj][n] = *(const f32x4*)(gp + bj * 128 + 4 * n); if constexpr (I8) gv[bj][n] = gv[bj][n] * *(const f32x4*)(scol + col0 + bj * 128 + 4 * n);
                av[bj][n] = H ? *(const f32x4*)(ng + col0 + bj * 128 + 4 * n) * (*(const f32x4*)(nsc + (size_t)cond * 12288 + col0 + bj * 128 + 4 * n) + 1.f) : (f32x4){0.f, 0.f, 0.f, 0.f}; }
        f32x4 xv[2][2][2];
#define ER_LOAD(r, buf) do { const int row_ = row0 + ((r) >> 2) * 128 + ((r) & 3) * 16; const float* sp_ = first ? (row_ < MP ? xp + (size_t)row_ * DM : xs + (size_t)(row_ - MP) * DM) : X + (size_t)row_ * DM; \
        _Pragma("unroll") for (int bj = 0; bj < 2; ++bj) { xv[buf][bj][0] = *(const f32x4*)(sp_ + col0 + bj * 128); xv[buf][bj][1] = *(const f32x4*)(sp_ + col0 + bj * 128 + 4); } } while (0)
        ER_LOAD(0, 0);
#pragma unroll
        for (int r = 0; r < 8; ++r) {
            if (r + 1 < 8) ER_LOAD(r + 1, (r + 1) & 1);
            SBAR();
            const int ai = r >> 2, m = r & 3, row = row0 + ai * 128 + m * 16;
            float* dp = X + (size_t)row * DM;
            float ar_ = 1.f; if constexpr (I8) ar_ = arow[row];
            float ss = 0.f, mx = 0.f;
#pragma unroll
            for (int bj = 0; bj < 2; ++bj) {
                const int c = col0 + bj * 128;
                f32x4 a0 = acc[ai][bj][m][0], a1 = acc[ai][bj][m][1];
                if constexpr (I8) { const pg8::i32x4 i0 = __builtin_bit_cast(pg8::i32x4, a0), i1 = __builtin_bit_cast(pg8::i32x4, a1);
                    a0 = (f32x4){(float)i0[0], (float)i0[1], (float)i0[2], (float)i0[3]} * ar_; a1 = (f32x4){(float)i1[0], (float)i1[1], (float)i1[2], (float)i1[3]} * ar_; }
                const f32x4 x0 = xv[r & 1][bj][0] + gv[bj][0] * a0, x1 = xv[r & 1][bj][1] + gv[bj][1] * a1;
                *(f32x4*)(dp + c) = x0; *(f32x4*)(dp + c + 4) = x1;
                if (H) { ss += (x0[0] * x0[0] + x0[1] * x0[1]) + (x0[2] * x0[2] + x0[3] * x0[3]) + (x1[0] * x1[0] + x1[1] * x1[1]) + (x1[2] * x1[2] + x1[3] * x1[3]);
                    const v4u hw = pack8(x0 * av[bj][0], x1 * av[bj][1]);
                    *(v4u*)(H + (size_t)row * DM + c) = hw;
                    if (rmx) {
#pragma unroll
                        for (int e = 0; e < 4; ++e) { mx = fmaxf(mx, fabsf(__builtin_bit_cast(float, hw[e] << 16))); mx = fmaxf(mx, fabsf(__builtin_bit_cast(float, hw[e] & 0xffff0000u))); } } }
            }
            if (H) { ss += __shfl_xor(ss, 16); ss += __shfl_xor(ss, 32);
                if (rmx) { mx = fmaxf(mx, __shfl_xor(mx, 16)); mx = fmaxf(mx, __shfl_xor(mx, 32)); }
                if (fq == 0) { rss[(size_t)row * 32 + u.pn * 4 + wc] = ss; if (rmx) rmx[(size_t)row * 32 + u.pn * 4 + wc] = mx; } }
            SBAR();
        }
#undef ER_LOAD
    }
};

struct EpiRelu2 {
    static constexpr bool PERM = true, AFTER_DRAIN = false;
    bf16* O; int ldc; NormIn ni;
    __device__ __forceinline__ void operator()(const pg8::f32x4 (&acc)[2][2][4][2], const pg8::Unit& u, int wr, int wc, int fr, int fq) const {
        const int row0 = u.pm * 256 + wr * 64 + fr, col0 = u.pn * 256 + wc * 32 + 8 * fq;
        const float* swp = ni.swp(u.pm) + col0; f32x4 sw[2][2];
#pragma unroll
        for (int bj = 0; bj < 2; ++bj)
#pragma unroll
            for (int n = 0; n < 2; ++n) sw[bj][n] = *(const f32x4*)(swp + bj * 128 + 4 * n);
#pragma unroll
        for (int ai = 0; ai < 2; ++ai)
#pragma unroll
            for (int m = 0; m < 4; ++m) {
                const int row = row0 + ai * 128 + m * 16; const float rs = ni.rstd(row, u.pm);
                bf16* rp = O + (size_t)row * ldc + col0;
#pragma unroll
                for (int bj = 0; bj < 2; ++bj) {
                    f32x4 a = acc[ai][bj][m][0] * rs + sw[bj][0], b = acc[ai][bj][m][1] * rs + sw[bj][1];
                    a = __builtin_elementwise_max(a, (f32x4){0.f, 0.f, 0.f, 0.f}); b = __builtin_elementwise_max(b, (f32x4){0.f, 0.f, 0.f, 0.f});
                    a = a * a; b = b * b;
                    *(v4u*)(rp + bj * 128) = pack8(a, b);
                }
            }
    }
};

typedef EpiResidT<false> EpiResid;

struct EpiRelu2I8 {
    static constexpr bool PERM = true, AFTER_DRAIN = false;
    bf16* O; int ldc; const float* frow; const float* scol; const float* sW;
    __device__ __forceinline__ void operator()(const pg8::f32x4 (&acc)[2][2][4][2], const pg8::Unit& u, int wr, int wc, int fr, int fq) const {
        const int row0 = u.pm * 256 + wr * 64 + fr, col0 = u.pn * 256 + wc * 32 + 8 * fq;
        const float* swp = sW + (size_t)cond_of_pm(u.pm) * 8192 + col0; f32x4 sw[2][2], sc[2][2];
#pragma unroll
        for (int bj = 0; bj < 2; ++bj)
#pragma unroll
            for (int n = 0; n < 2; ++n) { sw[bj][n] = *(const f32x4*)(swp + bj * 128 + 4 * n); sc[bj][n] = *(const f32x4*)(scol + col0 + bj * 128 + 4 * n); }
#pragma unroll
        for (int ai = 0; ai < 2; ++ai)
#pragma unroll
            for (int m = 0; m < 4; ++m) {
                const int row = row0 + ai * 128 + m * 16; const float fr_ = frow[row];
                bf16* rp = O + (size_t)row * ldc + col0;
#pragma unroll
                for (int bj = 0; bj < 2; ++bj) {
                    const pg8::i32x4 i0 = __builtin_bit_cast(pg8::i32x4, acc[ai][bj][m][0]), i1 = __builtin_bit_cast(pg8::i32x4, acc[ai][bj][m][1]);
                    f32x4 a = {(float)i0[0], (float)i0[1], (float)i0[2], (float)i0[3]}, b = {(float)i1[0], (float)i1[1], (float)i1[2], (float)i1[3]};
                    a = a * (sc[bj][0] * fr_) + sw[bj][0]; b = b * (sc[bj][1] * fr_) + sw[bj][1];
                    a = __builtin_elementwise_max(a, (f32x4){0.f, 0.f, 0.f, 0.f}); b = __builtin_elementwise_max(b, (f32x4){0.f, 0.f, 0.f, 0.f});
                    a = a * a; b = b * b;
                    *(v4u*)(rp + bj * 128) = pack8(a, b);
                }
            }
    }
};

struct EpiF32 {
    static constexpr bool PERM = true, AFTER_DRAIN = false;
    float* O; int ldc; NormIn ni;
    __device__ __forceinline__ void operator()(const pg8::f32x4 (&acc)[2][2][4][2], const pg8::Unit& u, int wr, int wc, int fr, int fq) const {
        const int row0 = u.pm * 256 + wr * 64 + fr, col0 = u.pn * 256 + wc * 32 + 8 * fq;
        const float* swp = ni.swp(u.pm) + col0; f32x4 sw[2][2];
#pragma unroll
        for (int bj = 0; bj < 2; ++bj)
#pragma unroll
            for (int n = 0; n < 2; ++n) sw[bj][n] = *(const f32x4*)(swp + bj * 128 + 4 * n);
#pragma unroll
        for (int ai = 0; ai < 2; ++ai)
#pragma unroll
            for (int m = 0; m < 4; ++m) {
                const int row = row0 + ai * 128 + m * 16; const float rs = ni.rstd(row, u.pm);
                float* rp = O + (size_t)row * ldc + col0;
#pragma unroll
                for (int bj = 0; bj < 2; ++bj) { *(f32x4*)(rp + bj * 128) = acc[ai][bj][m][0] * rs + sw[bj][0]; *(f32x4*)(rp + bj * 128 + 4) = acc[ai][bj][m][1] * rs + sw[bj][1]; }
            }
    }
};

struct EpiQkvWin {
    static constexpr bool PERM = true, AFTER_DRAIN = false;
    bf16 *Q, *K, *V; float* outk; float* outv; int j; const f32x2* tab; NormIn ni;
    __device__ __forceinline__ void operator()(const pg8::f32x4 (&acc)[2][2][4][2], const pg8::Unit& u, int wr, int wc, int fr, int fq) const {
        const int row0 = u.pm * 256 + wr * 64 + fr, cl = wc * 32 + 8 * fq;
        const int pn = u.pn; const bool sample = u.pm >= 32;
        const int ug = 4 * wc + fq, idx0 = (ug & 7) * 4, d1 = (ug < 8 ? 0 : 64) + idx0;
        const float* swp = ni.swp(u.pm) + u.pn * 256 + cl; f32x4 sw[2][2];
#pragma unroll
        for (int bj = 0; bj < 2; ++bj)
#pragma unroll
            for (int n = 0; n < 2; ++n) sw[bj][n] = *(const f32x4*)(swp + bj * 128 + 4 * n);
#pragma unroll
        for (int ai = 0; ai < 2; ++ai)
#pragma unroll
            for (int m = 0; m < 4; ++m) {
                const int row = row0 + ai * 128 + m * 16; const float rs = ni.rstd(row, u.pm);
                f32x4 cs0 = {1.f, 0.f, 1.f, 0.f}, cs1 = {1.f, 0.f, 1.f, 0.f};
                if (sample && pn < 10) { const int t = row & 4095, pos = (ug < 8) ? (t >> 6) : (t & 63); const f32x4* tp = (const f32x4*)(tab + pos * 32 + idx0); cs0 = tp[0]; cs1 = tp[1]; }
#pragma unroll
                for (int bj = 0; bj < 2; ++bj) {
                    f32x4 a = acc[ai][bj][m][0] * rs + sw[bj][0], b = acc[ai][bj][m][1] * rs + sw[bj][1];
                    if (pn < 10) {
                        if (sample) {
                            const f32x4 co = {cs0[0], cs0[2], cs1[0], cs1[2]}, si = {cs0[1], cs0[3], cs1[1], cs1[3]};
                            const f32x4 na = a * co - b * si, nb = b * co + a * si; a = na; b = nb;
                        }
                        if (pn < 8) { *(v4u*)(Q + (size_t)row * 2048 + pn * 256 + bj * 128 + cl) = pack8(a, b); }
                        else {
                            const int kvh = (pn - 8) * 2 + bj;
                            *(v4u*)(K + (size_t)row * 512 + kvh * 128 + cl) = pack8(a, b);
                            if (!sample) { float* op = outk + ((size_t)(u.pm * 2 + j) * 256 + (row & 255)) * 512 + kvh * 128 + d1; *(f32x4*)op = a; *(f32x4*)(op + 32) = b; }
                        }
                    } else {
                        const int kvh = (pn - 10) * 2 + bj;
                        *(v4u*)(V + (size_t)row * 512 + kvh * 128 + cl) = pack8(a, b);
                        if (!sample) { float* op = outv + ((size_t)(u.pm * 2 + j) * 256 + (row & 255)) * 512 + kvh * 128 + cl; *(f32x4*)op = a; *(f32x4*)(op + 4) = b; }
                    }
                }
            }
    }
};

struct EpiMlaQ {
    static constexpr bool PERM = true, AFTER_DRAIN = false;
    bf16* Q; const f32x2* tab;
    __device__ __forceinline__ void operator()(const pg8::f32x4 (&acc)[2][2][4][2], const pg8::Unit& u, int wr, int wc, int fr, int fq) const {
        const int row0 = u.pm * 256 + wr * 64 + fr, col0 = u.pn * 256 + wc * 32 + 8 * fq;
        const bool sample = u.pm >= 32;
#pragma unroll
        for (int bj = 0; bj < 2; ++bj) {
            const int c0 = col0 + bj * 128, p0 = c0 % 192; const bool isr = p0 >= 128; const int ug = isr ? ((p0 - 128) >> 3) : 0, idx0 = (ug & 3) * 4;
#pragma unroll
            for (int ai = 0; ai < 2; ++ai)
#pragma unroll
                for (int m = 0; m < 4; ++m) {
                    const int row = row0 + ai * 128 + m * 16;
                    f32x4 a = acc[ai][bj][m][0], b = acc[ai][bj][m][1];
                    if (sample) {
                        const int t = row & 4095, pos = (ug < 4) ? (t >> 6) : (t & 63); const f32x4* tp = (const f32x4*)(tab + pos * 16 + idx0); const f32x4 cs0 = tp[0], cs1 = tp[1];
                        const f32x4 co = {cs0[0], cs0[2], cs1[0], cs1[2]}, si = {cs0[1], cs0[3], cs1[1], cs1[3]};
                        const f32x4 na = a * co - b * si, nb = b * co + a * si;
                        if (isr) { a = na; b = nb; }
                    }
                    *(v4u*)(Q + (size_t)row * 3072 + c0) = pack8(a, b);
                }
        }
    }
};

struct EpiMlaKV {
    static constexpr bool PERM = true, AFTER_DRAIN = false;
    bf16 *KN, *V;
    __device__ __forceinline__ void operator()(const pg8::f32x4 (&acc)[2][2][4][2], const pg8::Unit& u, int wr, int wc, int fr, int fq) const {
        const int row0 = u.pm * 256 + wr * 64 + fr, cl = u.pn * 128 + wc * 32 + 8 * fq;
#pragma unroll
        for (int ai = 0; ai < 2; ++ai)
#pragma unroll
            for (int m = 0; m < 4; ++m) {
                const size_t ro = (size_t)(row0 + ai * 128 + m * 16) * 2048 + cl;
                *(v4u*)(KN + ro) = pack8(acc[ai][0][m][0], acc[ai][0][m][1]);
                *(v4u*)(V + ro) = pack8(acc[ai][1][m][0], acc[ai][1][m][1]);
            }
    }
};

struct EpiGlaIn {
    static constexpr bool PERM = true, AFTER_DRAIN = false;
    bf16 *q, *k, *v, *r; float* uo; NormIn ni;
    __device__ __forceinline__ void operator()(const pg8::f32x4 (&acc)[2][2][4][2], const pg8::Unit& u, int wr, int wc, int fr, int fq) const {
        const int row0 = u.pm * 256 + wr * 64 + fr, cl = wc * 32 + 8 * fq; const int pn = u.pn;
        const float* swp = ni.swp(u.pm) + pn * 256 + cl; f32x4 sw[2][2];
#pragma unroll
        for (int bj = 0; bj < 2; ++bj)
#pragma unroll
            for (int n = 0; n < 2; ++n) sw[bj][n] = *(const f32x4*)(swp + bj * 128 + 4 * n);
#pragma unroll
        for (int ai = 0; ai < 2; ++ai)
#pragma unroll
            for (int m = 0; m < 4; ++m) {
                const int row = row0 + ai * 128 + m * 16; const float rs = ni.rstd(row, u.pm);
#pragma unroll
                for (int bj = 0; bj < 2; ++bj) {
                    f32x4 a = acc[ai][bj][m][0] * rs + sw[bj][0], b = acc[ai][bj][m][1] * rs + sw[bj][1];
                    const int c = pn * 256 + bj * 128 + cl;
                    if (pn < 4) { a = a * 0.0625f; b = b * 0.0625f; *(v4u*)(q + (size_t)row * 1024 + c) = pack8(a, b); }
                    else if (pn < 8) { *(v4u*)(k + (size_t)row * 1024 + (c - 1024)) = pack8(a, b); }
                    else if (pn < 16) { *(v4u*)(v + (size_t)row * 2048 + (c - 2048)) = pack8(a, b); }
                    else if (pn < 24) { *(v4u*)(r + (size_t)row * 2048 + (c - 4096)) = pack8(a, b); }
                    else if (bj == 0 && wc == 0) { float* op = uo + (size_t)row * 32 + 8 * fq; *(f32x4*)op = a; *(f32x4*)(op + 4) = b; }
                }
            }
    }
};

struct Frame {
    LAS unsigned char* lds; unsigned char* ldsg;
    int tid, lane, wave, G, bx;
    const float* const* in; float* out; unsigned char* ws;
};
#define WSP(T, off) ((T*)(F.ws + (off)))
constexpr int LDS_RSTD_OFF = 131072;
__device__ __forceinline__ int prep_rstd(Frame& F, const pg8::StaticOrder& S, int site) {
    pg8::Unit u0; int pm0 = -1; if (S.next(0, u0)) pm0 = u0.pm;
    LAS float* lrs = (LAS float*)(F.lds + LDS_RSTD_OFF);
    if (pm0 >= 0 && F.tid < 256) { const int row = pm0 * 256 + F.tid; const f32x4* pp = (const f32x4*)(WSP(float, WS_PART) + ((size_t)site * MTOK + row) * 32); f32x4 t = pp[0];
#pragma unroll
        for (int i = 1; i < 8; ++i) t += pp[i];
        lrs[F.tid] = rsqrtf(((t[0] + t[1]) + (t[2] + t[3])) * (1.f / 2048.f) + EPS); }
    __syncthreads();
    return pm0;
}

__device__ __forceinline__ int perm_win(int p) { const int u = p >> 3, v = p & 7; return (u < 8 ? 0 : 64) + (u & 7) * 4 + (v & 3) + ((v & 4) ? 32 : 0); }
__device__ __forceinline__ int perm_mla(int p) { const int u = p >> 3, v = p & 7; return (u < 4 ? 0 : 32) + (u & 3) * 4 + (v & 3) + ((v & 4) ? 16 : 0); }
__device__ __forceinline__ int srcmap(int mode, int n) {
    if (mode == 1) { if (n >= 2560) return n; return (n & ~127) + perm_win(n & 127); }
    if (mode == 2) { if (n < 768) return n; if (n >= 832) return -1; return 768 + perm_mla(n - 768); }
    if (mode == 3) { const int hh = n / 192, p = n - hh * 192; if (p < 128) return n; return hh * 192 + 128 + perm_mla(p - 128); }
    return n;
}
#ifndef WMANT
#define WMANT 7
#endif
__device__ __forceinline__ unsigned f2bfw(float f) { constexpr int sh = 23 - WMANT; unsigned u = __builtin_bit_cast(unsigned, f); u += ((1u << sh) >> 1) - 1u + ((u >> sh) & 1u); u &= ~((1u << sh) - 1u); return u >> 16; }
__device__ __forceinline__ unsigned pk2w(float lo, float hi) { return f2bfw(lo) | (f2bfw(hi) << 16); }
__device__ __forceinline__ void tr_item(const float* W, int K, int Nsrc, int nblk, bf16* WT, int mode, LAS float* scr, int item, int lane) {
    const int kb = item / nblk, nb = item - kb * nblk, k0 = 64 * kb, n0 = 64 * nb;
    const int ln = (lane & 15) * 4, lk = lane >> 4;
    const int sc = srcmap(mode, n0 + ln);
    f32x4 v[16];
    const float* Wp = W + (size_t)(k0 + lk) * Nsrc + (sc >= 0 ? sc : 0);
#pragma unroll
    for (int i = 0; i < 16; ++i) v[i] = sc >= 0 ? __builtin_nontemporal_load((const f32x4*)(Wp + (size_t)(4 * i) * Nsrc)) : (f32x4){0.f, 0.f, 0.f, 0.f};
#pragma unroll
    for (int i = 0; i < 16; ++i) { LAS float* d = scr + (4 * i + lk) * 65 + ln; d[0] = v[i][0]; d[1] = v[i][1]; d[2] = v[i][2]; d[3] = v[i][3]; }
    LDS_WAIT(); asm volatile("" ::: "memory");
    const int c = lane & 7;
#pragma unroll
    for (int jj = 0; jj < 8; ++jj) { const int n = (lane >> 3) + 8 * jj; const LAS float* s = scr + (8 * c) * 65 + n;
        v4u o; o.x = pk2w(s[0 * 65], s[1 * 65]); o.y = pk2w(s[2 * 65], s[3 * 65]); o.z = pk2w(s[4 * 65], s[5 * 65]); o.w = pk2w(s[6 * 65], s[7 * 65]);
        *(GAS v4u*)(WT + (size_t)(n0 + n) * K + k0 + 8 * c) = o; }
    LDS_WAIT(); asm volatile("" ::: "memory");
}

__device__ __forceinline__ const float* wo_src(Frame& F, int lw) { return lw == 0 ? F.in[I_WWO] : (lw == 1 ? F.in[I_MWO] : (lw == 2 ? F.in[I_GWO] : F.in[I_WWO] + (size_t)2048 * 2048)); }
__device__ __forceinline__ void tr_item_q8(const float* W, int N, int nblk, signed char* Wq, const float* scol, LAS float* scr, int item, int lane) {
    constexpr int K = 2048;
    const int kb = item / nblk, nb = item - kb * nblk, k0 = 64 * kb, n0 = 64 * nb;
    const int ln = (lane & 15) * 4, lk = lane >> 4;
    f32x4 v[16];
    const float* Wp = W + (size_t)(k0 + lk) * N + n0 + ln;
#pragma unroll
    for (int i = 0; i < 16; ++i) v[i] = __builtin_nontemporal_load((const f32x4*)(Wp + (size_t)(4 * i) * N));
#pragma unroll
    for (int i = 0; i < 16; ++i) { LAS float* d = scr + (4 * i + lk) * 65 + ln; d[0] = v[i][0]; d[1] = v[i][1]; d[2] = v[i][2]; d[3] = v[i][3]; }
    LDS_WAIT(); asm volatile("" ::: "memory");
    const int c = lane & 7;
#pragma unroll
    for (int jj = 0; jj < 8; ++jj) { const int n = (lane >> 3) + 8 * jj; const LAS float* s = scr + (8 * c) * 65 + n; const float inv = 1.f / scol[n0 + n];
        unsigned b[8];
#pragma unroll
        for (int e = 0; e < 8; ++e) { int q = (int)rintf(s[e * 65] * inv); q = q > 127 ? 127 : (q < -127 ? -127 : q); b[e] = (unsigned)q & 0xffu; }
        v2u o; o.x = b[0] | (b[1] << 8) | (b[2] << 16) | (b[3] << 24); o.y = b[4] | (b[5] << 8) | (b[6] << 16) | (b[7] << 24);
        *(GAS v2u*)(Wq + (size_t)(n0 + n) * K + k0 + 8 * c) = o; }
    LDS_WAIT(); asm volatile("" ::: "memory");
}

__device__ __forceinline__ void q8w_item(Frame& F, const float* W, int N, int n0, signed char* Wq, float* scol) {
    const int tid = F.tid, lane = F.lane, wave = F.wave, cg = tid & 7, rq = tid >> 3;
    LAS unsigned char* T = F.lds; LAS float* red = (LAS float*)(F.lds + 32 * 2064);
    f32x4 v[8][4];
    const float* wp = W + (size_t)(4 * rq) * N + n0 + 4 * cg;
#pragma unroll
    for (int i = 0; i < 8; ++i)
#pragma unroll
        for (int j = 0; j < 4; ++j) v[i][j] = __builtin_nontemporal_load((const f32x4*)(wp + (size_t)(256 * i + j) * N));
    f32x4 m = {0.f, 0.f, 0.f, 0.f};
#pragma unroll
    for (int i = 0; i < 8; ++i)
#pragma unroll
        for (int j = 0; j < 4; ++j) m = __builtin_elementwise_max(m, __builtin_elementwise_abs(v[i][j]));
#pragma unroll
    for (int o = 8; o < 64; o <<= 1) { m[0] = fmaxf(m[0], __shfl_xor(m[0], o)); m[1] = fmaxf(m[1], __shfl_xor(m[1], o)); m[2] = fmaxf(m[2], __shfl_xor(m[2], o)); m[3] = fmaxf(m[3], __shfl_xor(m[3], o)); }
    if (lane < 8) *(LAS f32x4*)(red + wave * 32 + 4 * lane) = m;
    __syncthreads();
    f32x4 mm = *(const LAS f32x4*)(red + 4 * cg);
#pragma unroll
    for (int w8 = 1; w8 < 8; ++w8) mm = __builtin_elementwise_max(mm, *(const LAS f32x4*)(red + w8 * 32 + 4 * cg));
    f32x4 sc, inv;
#pragma unroll
    for (int c = 0; c < 4; ++c) { sc[c] = fmaxf(mm[c], 1e-30f) * (1.f / 127.f); inv[c] = 1.f / sc[c]; }
    if (tid < 8) *(f32x4*)(scol + n0 + 4 * cg) = sc;
#pragma unroll
    for (int i = 0; i < 8; ++i)
#pragma unroll
        for (int c = 0; c < 4; ++c) { unsigned b[4];
#pragma unroll
            for (int j = 0; j < 4; ++j) { int q = (int)rintf(v[i][j][c] * inv[c]); q = q > 127 ? 127 : (q < -127 ? -127 : q); b[j] = (unsigned)q & 0xffu; }
            *(LAS unsigned*)(T + (4 * cg + c) * 2064 + 256 * i + 4 * rq) = b[0] | (b[1] << 8) | (b[2] << 16) | (b[3] << 24); }
    __syncthreads();
    { const int row = tid >> 4, c16 = tid & 15; signed char* dp = Wq + (size_t)(n0 + row) * 2048;
#pragma unroll
      for (int j = 0; j < 8; ++j) { const int ch = c16 + 16 * j; *(v4u*)(dp + 16 * ch) = *(const LAS v4u*)(T + row * 2064 + 16 * ch); } }
    __syncthreads();
}

__device__ __forceinline__ void p0_prologue(Frame& F) {
    const int tid = F.tid, lane = F.lane, wave = F.wave;
    for (int it = F.bx; it < 192; it += F.G) {
        const int l = it / 48, nb = it - l * 48;
        LAS float* sl = (LAS float*)F.lds; LAS float* red = sl + 3 * 2048;
        for (int e = tid; e < 3 * 2048; e += 512) { const int c = e >> 11, k = e & 2047; const float v = (c == 0) ? F.in[I_CCTX][k] : F.in[I_C][(c - 1) * 2048 + k]; sl[e] = v / (1.f + __expf(-v)); }
        __syncthreads();
        const float* Wp = F.in[I_ADAW] + ((size_t)l * 2048 + wave * 256) * 12288 + nb * 256 + lane * 4;
        f32x4 a0 = {0.f, 0.f, 0.f, 0.f}, a1 = a0, a2 = a0;
        for (int k = 0; k < 256; k += 8) {
            f32x4 w[8];
#pragma unroll
            for (int jj = 0; jj < 8; ++jj) w[jj] = __builtin_nontemporal_load((const f32x4*)(Wp + (size_t)(k + jj) * 12288));
#pragma unroll
            for (int jj = 0; jj < 8; ++jj) { const int kk = wave * 256 + k + jj; a0 += w[jj] * sl[kk]; a1 += w[jj] * sl[2048 + kk]; a2 += w[jj] * sl[4096 + kk]; }
        }
        *(LAS f32x4*)(red + (wave * 3 + 0) * 256 + lane * 4) = a0; *(LAS f32x4*)(red + (wave * 3 + 1) * 256 + lane * 4) = a1; *(LAS f32x4*)(red + (wave * 3 + 2) * 256 + lane * 4) = a2;
        __syncthreads();
        for (int e = tid; e < 768; e += 512) { const int c = e >> 8, n = e & 255; float s = F.in[I_ADAB][l * 12288 + nb * 256 + n];
#pragma unroll
            for (int w8 = 0; w8 < 8; ++w8) s += red[(w8 * 3 + c) * 256 + n];
            WSP(float, WS_MOD)[(size_t)(l * 3 + c) * 12288 + nb * 256 + n] = s; }
        __syncthreads();
    }
    if (F.bx == F.G - 1) {
        for (int e = tid; e < 64 * 32; e += 512) { const int pos = e >> 5, i = e & 31; const float inv = exp2f(-(float)i * (13.287712379549449f / 32.f)); const float ang = (float)pos * inv;
            WSP(f32x2, WS_TABW)[e] = (f32x2){cosf(ang), sinf(ang)}; }
        for (int e = tid; e < 64 * 16; e += 512) { const int pos = e >> 4, i = e & 15; const float inv = exp2f(-(float)i * (13.287712379549449f / 16.f)); const float ang = (float)pos * inv;
            WSP(f32x2, WS_TABM)[e] = (f32x2){cosf(ang), sinf(ang)}; }
    }
    const int gt = F.bx * 512 + tid, NGT = F.G * 512;
    for (int e = gt; e < 2 * 2 * 512 * 512; e += NGT) {
        const int c = e & 511, pos = (e >> 9) & 511, b = (e >> 18) & 1, jj = e >> 19;
        const size_t sbase = (((size_t)b * 2 + jj) * 512 + pos) * 512;
        WSP(bf16, WS_CTXK)[e] = (bf16)f2bf(F.in[I_CWK][sbase + (c & ~127) + perm_win(c & 127)]);
        WSP(bf16, WS_CTXV)[e] = (bf16)f2bf(F.in[I_CWV][sbase + c]);
    }
    for (int e = gt; e < 256 * 2048; e += NGT) { const int n = e >> 11, k = e & 2047; float v = 0.f; if (n < 32) v = F.in[I_GWA1][((size_t)(n >> 4) * 2048 + k) * 16 + (n & 15)];
        WSP(bf16, WS_GWINT)[(size_t)(6144 + n) * 2048 + k] = (bf16)f2bf(v); }
    LAS float* scr = (LAS float*)(F.lds + wave * 16640);
    constexpr int C_W2 = 128 * 32, C_QKV = 32 * 48, C_MWD = 32 * 16, C_MUQ = 8 * 48, C_MUKV = 4 * 64, C_GWIN = 32 * 96;
    constexpr int NITEMS = 4 * C_W2 + 2 * C_QKV + C_MWD + C_MUQ + C_MUKV + C_GWIN;
    const bool bal = (F.G == 256);
    const int nslot = bal ? (F.bx < 192 ? 1 : 2) : 1;
    const int slot0 = bal ? (F.bx < 192 ? F.bx : 192 + (F.bx - 192) * 2) : F.bx;
    const int NVW = (bal ? 320 : F.G) * NWAVES;
    for (int sl = 0; sl < nslot; ++sl)
    for (int it = (slot0 + sl) * NWAVES + wave; it < NITEMS; it += NVW) {
        int r = it;
        if (r < 4 * C_W2) { const int l = r / C_W2; r -= l * C_W2; tr_item(F.in[I_W2] + (size_t)l * 8192 * 2048, 8192, 2048, 32, WSP(bf16, WS_W2T) + (size_t)l * 2048 * 8192, 0, scr, r, lane); continue; } r -= 4 * C_W2;
        if (r < 2 * C_QKV) { const int l = r / C_QKV; r -= l * C_QKV; tr_item(F.in[I_WQKV] + (size_t)l * 2048 * 3072, 2048, 3072, 48, WSP(bf16, WS_WQKVT) + (size_t)l * 3072 * 2048, 1, scr, r, lane); continue; } r -= 2 * C_QKV;
        if (r < C_MWD) { tr_item(F.in[I_MWD], 2048, 832, 16, WSP(bf16, WS_MWDT), 2, scr, r, lane); continue; } r -= C_MWD;
        if (r < C_MUQ) { tr_item(F.in[I_MWUQ], 512, 3072, 48, WSP(bf16, WS_MWUQT), 3, scr, r, lane); continue; } r -= C_MUQ;
        if (r < C_MUKV) { tr_item(F.in[I_MWUKV], 256, 4096, 64, WSP(bf16, WS_MWUKVT), 0, scr, r, lane); continue; } r -= C_MUKV;
        tr_item(F.in[I_GWIN], 2048, 6144, 96, WSP(bf16, WS_GWINT), 0, scr, r, lane);
    }
}

__device__ __forceinline__ const float* x_row(Frame& F, int L, int row) {
    return L == 0 ? (row < MP ? F.in[I_XP] + (size_t)row * DM : F.in[I_XS] + (size_t)(row - MP) * DM) : WSP(float, WS_X) + (size_t)row * DM;
}
__device__ __forceinline__ void p1_phase(Frame& F) {
    const int gw = F.bx * NWAVES + F.wave, NGW = F.G * NWAVES, lane = F.lane;
    for (int rb = gw; rb < MTOK / 8; rb += NGW) {
        const int row0 = rb * 8, cond = row0 < MP ? 0 : (row0 >> 12) - 1;
        const float* mv = WSP(float, WS_MOD) + (size_t)cond * 12288;
        const float* g = F.in[I_NORMG];
        f32x4 a[8];
#pragma unroll
        for (int jj = 0; jj < 8; ++jj) { const int col = 4 * lane + 256 * jj; a[jj] = *(const f32x4*)(g + col) * (*(const f32x4*)(mv + 2048 + col) + 1.f); }
#pragma unroll 1
        for (int r = 0; r < 8; r += 2) {
            f32x4 v[2][8];
#pragma unroll
            for (int q = 0; q < 2; ++q) { const float* xr = x_row(F, 0, row0 + r + q);
#pragma unroll
                for (int jj = 0; jj < 8; ++jj) v[q][jj] = *(const f32x4*)(xr + 4 * lane + 256 * jj); }
#pragma unroll
            for (int q = 0; q < 2; ++q) { const int row = row0 + r + q; float ss = 0.f;
#pragma unroll
                for (int jj = 0; jj < 8; ++jj) ss += (v[q][jj][0] * v[q][jj][0] + v[q][jj][1] * v[q][jj][1]) + (v[q][jj][2] * v[q][jj][2] + v[q][jj][3] * v[q][jj][3]);
                ss = wave_sum(ss);
                if (lane < 32) WSP(float, WS_PART)[(size_t)row * 32 + lane] = lane == 0 ? ss : 0.f;
                bf16* hr = WSP(bf16, WS_H) + (size_t)row * DM;
#pragma unroll
                for (int jj = 0; jj < 8; ++jj) { const f32x4 y = v[q][jj] * a[jj]; v2u w; w.x = cvtpk(y[0], y[1]); w.y = cvtpk(y[2], y[3]); *(v2u*)(hr + 4 * lane + 256 * jj) = w; } }
        }
    }
    __syncthreads();
    for (int it = F.bx; it < 1280; it += F.G) {
        if (it < 1024) { const int l = it >> 8, nb = it & 255; q8w_item(F, F.in[I_W1] + (size_t)l * 2048 * 8192, 8192, nb * 32, (signed char*)(F.ws + WS_W1T) + (size_t)l * 8192 * 2048, WSP(float, WS_SCOL) + l * 8192); }
        else { const int lw = (it - 1024) >> 6, nb = (it - 1024) & 63; q8w_item(F, wo_src(F, lw), 2048, nb * 32, (signed char*)(F.ws + WS_WWOT) + (size_t)lw * 2048 * 2048, WSP(float, WS_SCOLO) + lw * 2048); }
    }
    constexpr int NCH = 96 + 32 + 200 + 96;
    for (int ch = gw; ch < NCH; ch += NGW) {
        int c = ch, site = 0; const bf16* Wt = WSP(bf16, WS_WQKVT);
        if (c >= 96) { c -= 96; site = 2; Wt = WSP(bf16, WS_MWDT);
          if (c >= 32) { c -= 32; site = 4; Wt = WSP(bf16, WS_GWINT);
            if (c >= 200) { c -= 200; site = 6; Wt = WSP(bf16, WS_WQKVT) + (size_t)3072 * DM; } } }
        const int L = site >> 1, which = site & 1;
        const float* sv = WSP(float, WS_MOD) + (size_t)(L * 3) * 12288 + (which ? 3 * 2048 : 0);
        f32x4 s0[3][4], s1[3][4];
#pragma unroll
        for (int cc = 0; cc < 3; ++cc)
#pragma unroll
            for (int jj = 0; jj < 4; ++jj) { const float* sp = sv + (size_t)cc * 12288 + 8 * lane + 512 * jj; s0[cc][jj] = *(const f32x4*)sp; s1[cc][jj] = *(const f32x4*)(sp + 4); }
        float* so = WSP(float, WS_SW) + (size_t)site * 3 * 8192;
#pragma unroll 1
        for (int r2 = 0; r2 < 32; r2 += 2) {
            const bf16* wr0 = Wt + (size_t)(c * 32 + r2) * DM + 8 * lane; const bf16* wr1 = wr0 + DM;
            const v4u w00 = *(const v4u*)(wr0), w01 = *(const v4u*)(wr0 + 512), w02 = *(const v4u*)(wr0 + 1024), w03 = *(const v4u*)(wr0 + 1536);
            const v4u w10 = *(const v4u*)(wr1), w11 = *(const v4u*)(wr1 + 512), w12 = *(const v4u*)(wr1 + 1024), w13 = *(const v4u*)(wr1 + 1536);
            float a0 = 0.f, a1 = 0.f, a2 = 0.f, b0 = 0.f, b1 = 0.f, b2 = 0.f;
#define SW_ACC(W_, jj, d0_, d1_, d2_) do { const v4u q_ = (W_); \
                const f32x4 wa = {__builtin_bit_cast(float, q_[0] << 16), __builtin_bit_cast(float, q_[0] & 0xffff0000u), __builtin_bit_cast(float, q_[1] << 16), __builtin_bit_cast(float, q_[1] & 0xffff0000u)}; \
                const f32x4 wb = {__builtin_bit_cast(float, q_[2] << 16), __builtin_bit_cast(float, q_[2] & 0xffff0000u), __builtin_bit_cast(float, q_[3] << 16), __builtin_bit_cast(float, q_[3] & 0xffff0000u)}; \
                f32x4 t = wa * s0[0][jj] + wb * s1[0][jj]; d0_ += (t[0] + t[1]) + (t[2] + t[3]); \
                t = wa * s0[1][jj] + wb * s1[1][jj]; d1_ += (t[0] + t[1]) + (t[2] + t[3]); \
                t = wa * s0[2][jj] + wb * s1[2][jj]; d2_ += (t[0] + t[1]) + (t[2] + t[3]); } while (0)
            SW_ACC(w00, 0, a0, a1, a2); SW_ACC(w01, 1, a0, a1, a2); SW_ACC(w02, 2, a0, a1, a2); SW_ACC(w03, 3, a0, a1, a2);
            SW_ACC(w10, 0, b0, b1, b2); SW_ACC(w11, 1, b0, b1, b2); SW_ACC(w12, 2, b0, b1, b2); SW_ACC(w13, 3, b0, b1, b2);
#undef SW_ACC
#pragma unroll
            for (int o = 1; o < 64; o <<= 1) { a0 += __shfl_xor(a0, o); a1 += __shfl_xor(a1, o); a2 += __shfl_xor(a2, o); b0 += __shfl_xor(b0, o); b1 += __shfl_xor(b1, o); b2 += __shfl_xor(b2, o); }
            if (lane == 0) { const int n = c * 32 + r2; so[n] = a0; so[8192 + n] = a1; so[2 * 8192 + n] = a2; so[n + 1] = b0; so[8192 + n + 1] = b1; so[2 * 8192 + n + 1] = b2; }
        }
    }
}
__device__ __forceinline__ void q8_phase(Frame& F, int L, bool with_sw) {
    const int gw = F.bx * NWAVES + F.wave, NGW = F.G * NWAVES, lane = F.lane;
    const float* part = WSP(float, WS_PART) + (size_t)(2 * L + 1) * MTOK * 32; const float* pmax = WSP(float, WS_PMAX) + (size_t)(2 * L + 1) * MTOK * 32;
    const bf16* H = WSP(bf16, WS_H); signed char* H8 = (signed char*)(F.ws + WS_H8); float* frow = WSP(float, WS_FROW) + (size_t)L * MTOK;
    for (int row0 = gw; row0 < MTOK; row0 += 4 * NGW) {
        float ss[4], mx[4]; v4u w[4][4];
#pragma unroll
        for (int r = 0; r < 4; ++r) { const int row = row0 + r * NGW; const bool ok = row < MTOK && lane < 32;
            ss[r] = ok ? part[(size_t)row * 32 + lane] : 0.f; mx[r] = ok ? pmax[(size_t)row * 32 + lane] : 0.f; }
#pragma unroll
        for (int r = 0; r < 4; ++r) { const int row = row0 + r * NGW;
            if (row < MTOK) { const bf16* hr = H + (size_t)row * DM + 8 * lane;
#pragma unroll
                for (int jj = 0; jj < 4; ++jj) w[r][jj] = *(const v4u*)(hr + 512 * jj); } }
#pragma unroll
        for (int r = 0; r < 4; ++r) { const int row = row0 + r * NGW;
            if (row < MTOK) {
                float s1 = ss[r], m1 = mx[r];
#pragma unroll
                for (int o = 1; o < 64; o <<= 1) { s1 += __shfl_xor(s1, o); m1 = fmaxf(m1, __shfl_xor(m1, o)); }
                m1 = fmaxf(m1, 1e-30f);
                const float rstd = rsqrtf(s1 * (1.f / 2048.f) + EPS), scale = m1 * (1.f / 127.f), inv = 127.f / m1;
                if (lane == 0) frow[row] = rstd * scale;
                signed char* qr = H8 + (size_t)row * DM + 8 * lane;
#pragma unroll
                for (int jj = 0; jj < 4; ++jj) { unsigned b[8];
#pragma unroll
                    for (int e = 0; e < 4; ++e) { int q0 = (int)rintf(__builtin_bit_cast(float, w[r][jj][e] << 16) * inv), q1 = (int)rintf(__builtin_bit_cast(float, w[r][jj][e] & 0xffff0000u) * inv);
                        q0 = q0 > 127 ? 127 : (q0 < -127 ? -127 : q0); q1 = q1 > 127 ? 127 : (q1 < -127 ? -127 : q1); b[2 * e] = (unsigned)q0 & 0xffu; b[2 * e + 1] = (unsigned)q1 & 0xffu; }
                    v2u o; o.x = b[0] | (b[1] << 8) | (b[2] << 16) | (b[3] << 24); o.y = b[4] | (b[5] << 8) | (b[6] << 16) | (b[7] << 24);
                    *(v2u*)(qr + 512 * jj) = o; } } }
    }
    if (with_sw) {
        for (int ch = gw; ch < 4 * 512; ch += NGW) {
            const int l = ch >> 9, c = ch & 511;
            const signed char* Wq = (const signed char*)(F.ws + WS_W1T) + (size_t)l * 8192 * 2048;
            const float* sv = WSP(float, WS_MOD) + (size_t)(l * 3) * 12288 + 3 * 2048;
            f32x4 s0[3][4], s1[3][4];
#pragma unroll
            for (int cc = 0; cc < 3; ++cc)
#pragma unroll
                for (int jj = 0; jj < 4; ++jj) { const float* sp = sv + (size_t)cc * 12288 + 8 * lane + 512 * jj; s0[cc][jj] = *(const f32x4*)sp; s1[cc][jj] = *(const f32x4*)(sp + 4); }
            float* so = WSP(float, WS_SW) + (size_t)(2 * l + 1) * 3 * 8192; const float* scol = WSP(float, WS_SCOL) + l * 8192;
#pragma unroll 1
            for (int r = 0; r < 16; ++r) {
                const int n = c * 16 + r; const signed char* wr_ = Wq + (size_t)n * 2048 + 8 * lane;
                float d0 = 0.f, d1 = 0.f, d2 = 0.f;
#pragma unroll
                for (int jj = 0; jj < 4; ++jj) { const v2u w = *(const v2u*)(wr_ + 512 * jj);
                    const f32x4 wa = {(float)(int)(signed char)(w.x & 0xff), (float)(int)(signed char)((w.x >> 8) & 0xff), (float)(int)(signed char)((w.x >> 16) & 0xff), (float)(int)(signed char)(w.x >> 24)};
                    const f32x4 wb = {(float)(int)(signed char)(w.y & 0xff), (float)(int)(signed char)((w.y >> 8) & 0xff), (float)(int)(signed char)((w.y >> 16) & 0xff), (float)(int)(signed char)(w.y >> 24)};
                    f32x4 t = wa * s0[0][jj] + wb * s1[0][jj]; d0 += (t[0] + t[1]) + (t[2] + t[3]);
                    t = wa * s0[1][jj] + wb * s1[1][jj]; d1 += (t[0] + t[1]) + (t[2] + t[3]);
                    t = wa * s0[2][jj] + wb * s1[2][jj]; d2 += (t[0] + t[1]) + (t[2] + t[3]); }
#pragma unroll
                for (int o = 1; o < 64; o <<= 1) { d0 += __shfl_xor(d0, o); d1 += __shfl_xor(d1, o); d2 += __shfl_xor(d2, o); }
                if (lane == 0) { const float sc = scol[n]; so[n] = d0 * sc; so[8192 + n] = d1 * sc; so[2 * 8192 + n] = d2 * sc; }
            }
        }
    }
}
__device__ __forceinline__ void aoq_phase(Frame& F) {
    const int gw = F.bx * NWAVES + F.wave, NGW = F.G * NWAVES, lane = F.lane;
    const bf16* AO = WSP(bf16, WS_AO); signed char* A8 = (signed char*)(F.ws + WS_AO8); float* arow = WSP(float, WS_AROW);
    for (int row0 = gw; row0 < MTOK; row0 += 4 * NGW) {
        v4u w[4][4];
#pragma unroll
        for (int r = 0; r < 4; ++r) { const int row = row0 + r * NGW;
            if (row < MTOK) { const bf16* hr = AO + (size_t)row * DM + 8 * lane;
#pragma unroll
                for (int jj = 0; jj < 4; ++jj) w[r][jj] = *(const v4u*)(hr + 512 * jj); } }
#pragma unroll
        for (int r = 0; r < 4; ++r) { const int row = row0 + r * NGW;
            if (row < MTOK) { float mx = 0.f;
#pragma unroll
                for (int jj = 0; jj < 4; ++jj) {
#pragma unroll
                    for (int e = 0; e < 4; ++e) { mx = fmaxf(mx, fabsf(__builtin_bit_cast(float, w[r][jj][e] << 16))); mx = fmaxf(mx, fabsf(__builtin_bit_cast(float, w[r][jj][e] & 0xffff0000u))); } }
#pragma unroll
                for (int o = 1; o < 64; o <<= 1) mx = fmaxf(mx, __shfl_xor(mx, o));
                mx = fmaxf(mx, 1e-30f); const float inv = 127.f / mx;
                if (lane == 0) arow[row] = mx * (1.f / 127.f);
                signed char* qr = A8 + (size_t)row * DM + 8 * lane;
#pragma unroll
                for (int jj = 0; jj < 4; ++jj) { unsigned b[8];
#pragma unroll
                    for (int e = 0; e < 4; ++e) { int q0 = (int)rintf(__builtin_bit_cast(float, w[r][jj][e] << 16) * inv), q1 = (int)rintf(__builtin_bit_cast(float, w[r][jj][e] & 0xffff0000u) * inv);
                        b[2 * e] = (unsigned)q0 & 0xffu; b[2 * e + 1] = (unsigned)q1 & 0xffu; }
                    v2u o; o.x = b[0] | (b[1] << 8) | (b[2] << 16) | (b[3] << 24); o.y = b[4] | (b[5] << 8) | (b[6] << 16) | (b[7] << 24);
                    *(v2u*)(qr + 512 * jj) = o; } } }
    }
}
__device__ __forceinline__ void final_phase(Frame& F) {
    const int gw = F.bx * NWAVES + F.wave, NGW = F.G * NWAVES, lane = F.lane;
    const float* g = F.in[I_FNORM];
    for (int row0 = gw; row0 < MTOK; row0 += 2 * NGW) {
        f32x4 v[2][8];
#pragma unroll
        for (int r = 0; r < 2; ++r) { const int row = row0 + r * NGW;
            if (row < MTOK) { const float* xr = WSP(float, WS_X) + (size_t)row * DM;
#pragma unroll
                for (int jj = 0; jj < 8; ++jj) v[r][jj] = __builtin_nontemporal_load((const f32x4*)(xr + 4 * lane + 256 * jj)); } }
#pragma unroll
        for (int r = 0; r < 2; ++r) { const int row = row0 + r * NGW;
            if (row < MTOK) { float ss = 0.f;
#pragma unroll
                for (int jj = 0; jj < 8; ++jj) ss += (v[r][jj][0] * v[r][jj][0] + v[r][jj][1] * v[r][jj][1]) + (v[r][jj][2] * v[r][jj][2] + v[r][jj][3] * v[r][jj][3]);
                const float rstd = rsqrtf(wave_sum(ss) * (1.f / 2048.f) + EPS);
                float* orow = F.out + (size_t)row * DM;
#pragma unroll
                for (int jj = 0; jj < 8; ++jj) { const int col = 4 * lane + 256 * jj; *(f32x4*)(orow + col) = v[r][jj] * rstd * *(const f32x4*)(g + col); } } }
    }
}

namespace att {
constexpr int QBLK = 32, KVBLK = 64;
constexpr int SHM_V = 16384, SHM_K = 16384, SHM_KR = 8192;
constexpr int OFF_V = 0, OFF_K = 3 * SHM_V, OFF_KR = 3 * SHM_V + 3 * SHM_K, OFF_WS = OFF_KR + 3 * SHM_KR, OFF_QR = OFF_WS + NWAVES * 64 * 4, LDS_ATT = OFF_QR + NWAVES * 4096;
#define KSWZ(row, colB) ((row) * 256 + ((colB) ^ (((row) & 7) << 4)))
#define KRSWZ(row, chunk) ((row) * 128 + ((((chunk) ^ ((row) >> 1)) & 7) << 4))
__device__ __forceinline__ int crow(int r, int hi) { return (r & 3) + 8 * (r >> 2) + 4 * hi; }
template <int DQK> struct Cst { static constexpr float SCALE = DQK == 128 ? 0.088388347648318440f : 0.072168783648703220f; static constexpr float C = SCALE * 1.4426950408889634f; };
constexpr float THR = 8.f;

template <int DQK>
__device__ __forceinline__ void partialSM(f32x16& p0, f32x16& p1, float& m_reg, float& mn, float& alpha) {
    constexpr float C = Cst<DQK>::C, SCALE = Cst<DQK>::SCALE;
    float pmax = p0[0];
#pragma unroll
    for (int r = 1; r < 16; ++r) pmax = fmaxf(pmax, p0[r]);
#pragma unroll
    for (int r = 0; r < 16; ++r) pmax = fmaxf(pmax, p1[r]);
    { auto rr = __builtin_amdgcn_permlane32_swap(__float_as_uint(pmax), __float_as_uint(pmax), false, false);
      pmax = fmaxf(__uint_as_float(rr[0]), __uint_as_float(rr[1])); }
    if (__builtin_expect(__all(pmax - m_reg <= THR / SCALE), 1)) { mn = m_reg; alpha = 1.f; }
    else { mn = fmaxf(m_reg, pmax); alpha = __builtin_amdgcn_exp2f((m_reg - mn) * C); m_reg = mn; }
    const float mnC = -mn * C;
#pragma unroll
    for (int r = 0; r < 16; ++r) p0[r] = __builtin_amdgcn_exp2f(fmaf(p0[r], C, mnC));
#pragma unroll
    for (int r = 0; r < 16; ++r) p1[r] = __builtin_amdgcn_exp2f(fmaf(p1[r], C, mnC));
}
__device__ __forceinline__ void finishSM(f32x16& p0, f32x16& p1, float alpha, float& l_reg, bf16x8& pa0, bf16x8& pa1, bf16x8& pa2, bf16x8& pa3) {
    float ps = 0;
#pragma unroll
    for (int r = 0; r < 16; ++r) ps += p0[r];
#pragma unroll
    for (int r = 0; r < 16; ++r) ps += p1[r];
    { auto rr = __builtin_amdgcn_permlane32_swap(__float_as_uint(ps), __float_as_uint(ps), false, false);
      ps = __uint_as_float(rr[0]) + __uint_as_float(rr[1]); }
    l_reg = l_reg * alpha + ps;
#define PK4(P, BASE, OUT) do { unsigned a0 = cvtpk(P[BASE + 0], P[BASE + 1]), a1 = cvtpk(P[BASE + 2], P[BASE + 3]);   \
    unsigned b0 = cvtpk(P[BASE + 4], P[BASE + 5]), b1 = cvtpk(P[BASE + 6], P[BASE + 7]);                              \
    auto r0 = __builtin_amdgcn_permlane32_swap(a0, b0, false, false); auto r1 = __builtin_amdgcn_permlane32_swap(a1, b1, false, false); \
    v4u w = {r0[0], r1[0], r0[1], r1[1]}; OUT = *reinterpret_cast<bf16x8*>(&w); } while (0)
    PK4(p0, 0, pa0); PK4(p0, 8, pa1); PK4(p1, 0, pa2); PK4(p1, 8, pa3);
#undef PK4
}
__device__ __forceinline__ int v_st(int k, int c) { const int kk = (k & ~0xC) | ((k & 4) << 1) | ((k & 8) >> 1); return ((kk >> 3) * 4 + (c >> 5)) * 512 + ((kk & 7) * 32 + (c & 31)) * 2; }
__device__ __forceinline__ int v_rd_base(int lane) { return ((lane & 3) << 3) | (((lane >> 2) & 3) << 6) | (((lane >> 4) & 1) << 5) | (((lane >> 5) & 1) << 8); }
constexpr int v_rd_off(int d0, int ks, int half) { return d0 * 512 + ks * 4096 + half * 2048; }
template <int OFF> __device__ __forceinline__ s16x4 tr_read(int vb) {
    s16x4 r; asm volatile("ds_read_b64_tr_b16 %0, %1 offset:%2" : "=&v"(r) : "v"(vb), "i"(OFF) : "memory"); return r;
}
template <int D0> __device__ __forceinline__ void pv_one(f32x16& od, int vb, bf16x8 pa0, bf16x8 pa1, bf16x8 pa2, bf16x8 pa3) {
#define PKV(L, H) (bf16x8){L[0], L[1], L[2], L[3], H[0], H[1], H[2], H[3]}
    const s16x4 l0 = tr_read<v_rd_off(D0, 0, 0)>(vb), h0 = tr_read<v_rd_off(D0, 0, 1)>(vb), l1 = tr_read<v_rd_off(D0, 1, 0)>(vb), h1 = tr_read<v_rd_off(D0, 1, 1)>(vb);
    asm volatile("s_waitcnt lgkmcnt(0)" ::: "memory"); SBAR();
    od = __builtin_amdgcn_mfma_f32_32x32x16_bf16(pa0, PKV(l0, h0), od, 0, 0, 0);
    const s16x4 l2 = tr_read<v_rd_off(D0, 2, 0)>(vb), h2 = tr_read<v_rd_off(D0, 2, 1)>(vb);
    od = __builtin_amdgcn_mfma_f32_32x32x16_bf16(pa1, PKV(l1, h1), od, 0, 0, 0);
    const s16x4 l3 = tr_read<v_rd_off(D0, 3, 0)>(vb), h3 = tr_read<v_rd_off(D0, 3, 1)>(vb);
    asm volatile("s_waitcnt lgkmcnt(0)" ::: "memory"); SBAR();
    od = __builtin_amdgcn_mfma_f32_32x32x16_bf16(pa2, PKV(l2, h2), od, 0, 0, 0);
    od = __builtin_amdgcn_mfma_f32_32x32x16_bf16(pa3, PKV(l3, h3), od, 0, 0, 0);
#undef PKV
}

template <int D0> __device__ __forceinline__ void v_ld8(s16x4 (&f)[8], int vb) {
    f[0] = tr_read<v_rd_off(D0, 0, 0)>(vb); f[1] = tr_read<v_rd_off(D0, 0, 1)>(vb); f[2] = tr_read<v_rd_off(D0, 1, 0)>(vb); f[3] = tr_read<v_rd_off(D0, 1, 1)>(vb);
    f[4] = tr_read<v_rd_off(D0, 2, 0)>(vb); f[5] = tr_read<v_rd_off(D0, 2, 1)>(vb); f[6] = tr_read<v_rd_off(D0, 3, 0)>(vb); f[7] = tr_read<v_rd_off(D0, 3, 1)>(vb);
}
__device__ __forceinline__ void pv_mm(f32x16& od, const s16x4 (&f)[8], bf16x8 pa0, bf16x8 pa1, bf16x8 pa2, bf16x8 pa3) {
#define PKV(L, H) (bf16x8){L[0], L[1], L[2], L[3], H[0], H[1], H[2], H[3]}
    od = __builtin_amdgcn_mfma_f32_32x32x16_bf16(pa0, PKV(f[0], f[1]), od, 0, 0, 0);
    od = __builtin_amdgcn_mfma_f32_32x32x16_bf16(pa1, PKV(f[2], f[3]), od, 0, 0, 0);
    od = __builtin_amdgcn_mfma_f32_32x32x16_bf16(pa2, PKV(f[4], f[5]), od, 0, 0, 0);
    od = __builtin_amdgcn_mfma_f32_32x32x16_bf16(pa3, PKV(f[6], f[7]), od, 0, 0, 0);
#undef PKV
}
__device__ __forceinline__ void pv_all(f32x16 (&o)[4], int vb, bf16x8 pa0, bf16x8 pa1, bf16x8 pa2, bf16x8 pa3) {
    s16x4 A[8], B[8];
    v_ld8<0>(A, vb); v_ld8<1>(B, vb);
    asm volatile("s_waitcnt lgkmcnt(8)" ::: "memory"); SBAR(); pv_mm(o[0], A, pa0, pa1, pa2, pa3); SBAR();
    v_ld8<2>(A, vb);
    asm volatile("s_waitcnt lgkmcnt(8)" ::: "memory"); SBAR(); pv_mm(o[1], B, pa0, pa1, pa2, pa3); SBAR();
    v_ld8<3>(B, vb);
    asm volatile("s_waitcnt lgkmcnt(8)" ::: "memory"); SBAR(); pv_mm(o[2], A, pa0, pa1, pa2, pa3); SBAR();
    asm volatile("s_waitcnt lgkmcnt(0)" ::: "memory"); SBAR(); pv_mm(o[3], B, pa0, pa1, pa2, pa3); SBAR();
}

template <int DQK, bool MASKED>
__device__ __forceinline__ void attn_unit(const bf16* __restrict__ Qb, int ldq,
                                          const bf16* __restrict__ KA, const bf16* __restrict__ VA, const bf16* __restrict__ KRA, int nA,
                                          const bf16* __restrict__ KB, const bf16* __restrict__ VB, const bf16* __restrict__ KRB, int nB,
                                          int ldk, int qpos0, int kposB0, float sink_l2, bf16* __restrict__ Ob, char* lds) {
    constexpr int ND = 8;
    constexpr float C = Cst<DQK>::C;
    const int tid = threadIdx.x, wid = tid >> 6, lane = tid & 63, r32 = lane & 31, hi = lane >> 5;
    float* wsf = (float*)(lds + OFF_WS) + wid * 64; float* li_l = wsf; float* al_l = wsf + 32;
    float m_reg = -1e30f, l_reg = 0.f; f32x16 o[4] = {}; bf16x8 qr[ND];
    const bf16* Qw = Qb + (size_t)(wid * QBLK + r32) * ldq + hi * 8;
#pragma unroll
    for (int d0 = 0; d0 < ND; ++d0) qr[d0] = *reinterpret_cast<const bf16x8*>(Qw + d0 * 16);
    if constexpr (DQK == 192) {
#pragma unroll
        for (int dd = 0; dd < 4; ++dd) { const bf16x8 qv = *reinterpret_cast<const bf16x8*>(Qw + 128 + dd * 16); *(bf16x8*)(lds + OFF_QR + wid * 4096 + KRSWZ(r32, dd * 2 + hi)) = qv; }
    }
    const int vb0 = (int)(uintptr_t)(LAS char*)(lds + OFF_V) + v_rd_base(lane);
    const int NT = nA + nB;
    unsigned gok, gov, gor;
    { const int krow = 4 * wid + (lane >> 4); gok = (unsigned)(krow * ldk) * 2u + (unsigned)(((lane & 15) << 4) ^ ((krow & 7) << 4));
      const int kk = 8 * (wid >> 1) + ((lane & 31) >> 2), kv = (kk & ~0xC) | ((kk & 4) << 1) | ((kk & 8) >> 1), cv = 32 * (2 * (wid & 1) + (lane >> 5)) + ((lane & 3) << 3);
      gov = (unsigned)(kv * ldk + cv) * 2u;
      const int rrow = 8 * wid + (lane >> 3); gor = (unsigned)(rrow * 128 + ((((lane & 7) ^ (rrow >> 1)) & 7) << 4)); }
    const unsigned g32 = (unsigned)(32 * ldk) * 2u;
    LAS char* const L3 = (LAS char*)lds;
#define SLOAD(t, b) do { const bool inA_ = (t) < nA; const int tt_ = inA_ ? (t) : (t) - nA; const char* Kt_ = (const char*)((inA_ ? KA : KB) + (size_t)tt_ * 64 * ldk); const char* Vt_ = (const char*)((inA_ ? VA : VB) + (size_t)tt_ * 64 * ldk); \
    __builtin_amdgcn_global_load_lds((const unsigned*)(Kt_ + gok), (LAS unsigned*)(L3 + OFF_K + (b) * SHM_K + wid * 1024), 16, 0, 0); \
    __builtin_amdgcn_global_load_lds((const unsigned*)(Kt_ + gok + g32), (LAS unsigned*)(L3 + OFF_K + (b) * SHM_K + 8192 + wid * 1024), 16, 0, 0); \
    __builtin_amdgcn_global_load_lds((const unsigned*)(Vt_ + gov), (LAS unsigned*)(L3 + OFF_V + (b) * SHM_V + wid * 1024), 16, 0, 0); \
    __builtin_amdgcn_global_load_lds((const unsigned*)(Vt_ + gov + g32), (LAS unsigned*)(L3 + OFF_V + (b) * SHM_V + 8192 + wid * 1024), 16, 0, 0); \
    if constexpr (DQK == 192) { const char* Rt_ = (const char*)((inA_ ? KRA : KRB) + (size_t)tt_ * 64 * 64); \
        __builtin_amdgcn_global_load_lds((const unsigned*)(Rt_ + gor), (LAS unsigned*)(L3 + OFF_KR + (b) * SHM_KR + wid * 1024), 16, 0, 0); } } while (0)
#define KLD_(dg, A0, A1) _Pragma("unroll") for (int dd = 0; dd < 2; ++dd) { const int cb_ = (((dg) * 2 + dd) * 16 + hi * 8) * 2; const LAS char* ka_ = (const LAS char*)(uintptr_t)(unsigned)(kb0_ + (cb_ ^ sw_)); A0[dd] = *reinterpret_cast<const LAS bf16x8*>(ka_); A1[dd] = *reinterpret_cast<const LAS bf16x8*>(ka_ + 32 * 256); }
#define KMM_(dg, A0, A1, P0, P1) _Pragma("unroll") for (int dd = 0; dd < 2; ++dd) { P0 = __builtin_amdgcn_mfma_f32_32x32x16_bf16(A0[dd], qr[(dg) * 2 + dd], P0, 0, 0, 0); P1 = __builtin_amdgcn_mfma_f32_32x32x16_bf16(A1[dd], qr[(dg) * 2 + dd], P1, 0, 0, 0); }
#define RLD_(dg, A0, A1, QF) _Pragma("unroll") for (int dd = 0; dd < 2; ++dd) { const int ch_ = ((dg) * 2 + dd) * 2 + hi; const int so_ = ((ch_ ^ rs_) & 7) << 4; const LAS char* ra_ = (const LAS char*)(uintptr_t)(unsigned)(rb0_ + so_); \
        A0[dd] = *reinterpret_cast<const LAS bf16x8*>(ra_); A1[dd] = *reinterpret_cast<const LAS bf16x8*>(ra_ + 32 * 128); QF[dd] = *reinterpret_cast<const LAS bf16x8*>((const LAS char*)(uintptr_t)(unsigned)(qb0_ + so_)); }
#define RMM_(A0, A1, QF, P0, P1) _Pragma("unroll") for (int dd = 0; dd < 2; ++dd) { P0 = __builtin_amdgcn_mfma_f32_32x32x16_bf16(A0[dd], QF[dd], P0, 0, 0, 0); P1 = __builtin_amdgcn_mfma_f32_32x32x16_bf16(A1[dd], QF[dd], P1, 0, 0, 0); }
#define QKT(P0, P1, b) do { P0 = f32x16{}; P1 = f32x16{}; int kb0_ = (int)(uintptr_t)(LAS char*)(lds + OFF_K) + (b) * SHM_K + r32 * 256, sw_ = (r32 & 7) << 4; asm volatile("" : "+v"(kb0_), "+v"(sw_));   \
    bf16x8 xa0_[2], xa1_[2], xb0_[2], xb1_[2]; \
    KLD_(0, xa0_, xa1_); SBAR(); \
    KLD_(1, xb0_, xb1_); SBAR(); KMM_(0, xa0_, xa1_, P0, P1); SBAR(); \
    KLD_(2, xa0_, xa1_); SBAR(); KMM_(1, xb0_, xb1_, P0, P1); SBAR(); \
    KLD_(3, xb0_, xb1_); SBAR(); KMM_(2, xa0_, xa1_, P0, P1); SBAR(); \
    if constexpr (DQK == 192) { int rb0_ = (int)(uintptr_t)(LAS char*)(lds + OFF_KR) + (b) * SHM_KR + r32 * 128, rs_ = (r32 >> 1) & 7, qb0_ = (int)(uintptr_t)(LAS char*)(lds + OFF_QR) + wid * 4096 + r32 * 128; asm volatile("" : "+v"(rb0_), "+v"(rs_), "+v"(qb0_)); \
        bf16x8 qa_[2], qb_[2]; \
        RLD_(0, xa0_, xa1_, qa_); SBAR(); KMM_(3, xb0_, xb1_, P0, P1); SBAR(); \
        RLD_(1, xb0_, xb1_, qb_); SBAR(); RMM_(xa0_, xa1_, qa_, P0, P1); SBAR(); \
        RMM_(xb0_, xb1_, qb_, P0, P1); SBAR(); } \
    else { KMM_(3, xb0_, xb1_, P0, P1); SBAR(); } } while (0)
#define MASKT(P0, P1, t) do { if constexpr (MASKED) { if ((t) >= nA) { const int qp_ = qpos0 + wid * QBLK + r32, kb_ = kposB0 + ((t) - nA) * 64; \
    _Pragma("unroll") for (int r = 0; r < 16; ++r) { const int d_ = qp_ - (kb_ + crow(r, hi)); if (d_ > 128 || d_ < -128) P0[r] = -1e30f; const int d2_ = d_ - 32; if (d2_ > 128 || d2_ < -128) P1[r] = -1e30f; } } } } while (0)
#define RESC(a) do { if (__any((a) < 1.f)) { if (hi == 0) al_l[r32] = (a); LDS_WAIT(); \
    _Pragma("unroll") for (int r = 0; r < 16; ++r) { const float al_ = al_l[crow(r, hi)]; _Pragma("unroll") for (int d = 0; d < 4; ++d) o[d][r] *= al_; } } } while (0)
#define PV(b) do { pv_all(o, vb0 + (b) * SHM_V, pa0, pa1, pa2, pa3); } while (0)
    constexpr int NL = DQK == 192 ? 5 : 4;
    f32x16 p0, p1; float mn, al; bf16x8 pa0, pa1, pa2, pa3;
    SLOAD(0, 0); if (NT > 1) SLOAD(1, 1);
    int sc = 0;
    asm volatile(".p2align 8");
    for (int t = 0; t < NT; ++t) {
        if (t + 1 < NT) { if constexpr (NL == 5) asm volatile("s_waitcnt vmcnt(5)" ::: "memory"); else asm volatile("s_waitcnt vmcnt(4)" ::: "memory"); } else { VM_WAIT(); }
        __syncthreads();
        const int sn = sc == 0 ? 2 : sc - 1;
        if (t + 2 < NT) SLOAD(t + 2, sn);
        SBAR(); QKT(p0, p1, sc); MASKT(p0, p1, t);
        partialSM<DQK>(p0, p1, m_reg, mn, al);
        RESC(al);
        finishSM(p0, p1, al, l_reg, pa0, pa1, pa2, pa3); SBAR();
        PV(sc);
        sc = sc == 2 ? 0 : sc + 1;
    }
    l_reg += __builtin_amdgcn_exp2f(sink_l2 - m_reg * C);
    if (hi == 0) li_l[r32] = l_reg; LDS_WAIT();
    int obase = (wid * QBLK + 4 * hi) * 2048 + r32; asm volatile("" : "+v"(obase));
#pragma unroll
    for (int r = 0; r < 16; ++r) { const float rl = __builtin_amdgcn_rcpf(li_l[crow(r, hi)]); const int ro = ((r & 3) + 8 * (r >> 2)) * 2048;
#pragma unroll
        for (int d0 = 0; d0 < 4; ++d0) *(bf16*)((char*)Ob + (unsigned)(obase + ro + d0 * 32) * 2u) = (bf16)f2bf(o[d0][r] * rl); }
    LDS_WAIT();
    __syncthreads();
#undef SLOAD
#undef QKT
#undef KLD_
#undef KMM_
#undef RLD_
#undef RMM_
#undef MASKT
#undef RESC
#undef PV
}
}

__device__ __forceinline__ void attn_win_phase(Frame& F, int j) {
    const bf16* Q = WSP(bf16, WS_WQ); const bf16* K = WSP(bf16, WS_WK); const bf16* V = WSP(bf16, WS_WV); bf16* O = WSP(bf16, WS_AO);
    const bf16* CK = WSP(bf16, WS_CTXK) + (size_t)j * 2 * 512 * 512; const bf16* CV = WSP(bf16, WS_CTXV) + (size_t)j * 2 * 512 * 512;
    for (int un = F.bx; un < 512; un += F.G) {
        const int h = un & 15, kvh = h >> 2; const float sink = F.in[I_SINK][j * 16 + h] * 1.4426950408889634f;
        const int qb = un >> 4, bs = qb >> 4, t0 = (qb & 15) * 256, row0 = MP + qb * 256;
        int kt0 = (t0 >> 6) - 2, kt1 = (t0 >> 6) + 5; if (kt0 < 0) kt0 = 0; if (kt1 > 63) kt1 = 63;
        const size_t kb = (size_t)(MP + bs * 4096 + kt0 * 64) * 512 + kvh * 128;
        att::attn_unit<128, true>(Q + (size_t)row0 * 2048 + h * 128, 2048, CK + (size_t)bs * 512 * 512 + kvh * 128, CV + (size_t)bs * 512 * 512 + kvh * 128, nullptr, 8,
                                 K + kb, V + kb, nullptr, kt1 - kt0 + 1, 512, t0, kt0 * 64, sink, O + (size_t)row0 * 2048 + h * 128, (char*)F.ldsg);
    }
    for (int un = F.bx; un < 512; un += F.G) {
        const int h = un & 15, kvh = h >> 2; const float sink = F.in[I_SINK][j * 16 + h] * 1.4426950408889634f;
        const int b = un >> 4, row0 = b * 256; const size_t kb = (size_t)row0 * 512 + kvh * 128;
        att::attn_unit<128, false>(Q + (size_t)row0 * 2048 + h * 128, 2048, nullptr, nullptr, nullptr, 0,
                                  K + kb, V + kb, nullptr, 4, 512, 0, 0, sink, O + (size_t)row0 * 2048 + h * 128, (char*)F.ldsg);
    }
}
__device__ __forceinline__ void attn_mla_phase(Frame& F) {
    const bf16* Q = WSP(bf16, WS_MQ); const bf16* KN = WSP(bf16, WS_MKN); const bf16* V = WSP(bf16, WS_MV); const bf16* KR = WSP(bf16, WS_MKR); bf16* O = WSP(bf16, WS_AO);
    for (int un = F.bx; un < 512; un += F.G) {
        const int h = un & 15, qb = un >> 4, bs = qb >> 4, row0 = MP + qb * 256;
        const size_t ra = (size_t)bs * 512, rb = (size_t)1024 + MP + bs * 4096;
        att::attn_unit<192, false>(Q + (size_t)row0 * 3072 + h * 192, 3072, KN + ra * 2048 + h * 128, V + ra * 2048 + h * 128, KR + ra * 64, 8,
                                  KN + rb * 2048 + h * 128, V + rb * 2048 + h * 128, KR + rb * 64, 64, 2048, 0, 0, -1e30f, O + (size_t)row0 * 2048 + h * 128, (char*)F.ldsg);
    }
    for (int un = F.bx; un < 512; un += F.G) {
        const int h = un & 15, b = un >> 4, row0 = b * 256; const size_t rb = (size_t)1024 + row0;
        att::attn_unit<192, false>(Q + (size_t)row0 * 3072 + h * 192, 3072, nullptr, nullptr, nullptr, 0,
                                  KN + rb * 2048 + h * 128, V + rb * 2048 + h * 128, KR + rb * 64, 4, 2048, 0, 0, -1e30f, O + (size_t)row0 * 2048 + h * 128, (char*)F.ldsg);
    }
}

__device__ __forceinline__ void mla_norm_phase(Frame& F) {
    const int gw = F.bx * NWAVES + F.wave, NGW = F.G * NWAVES, lane = F.lane;
    const float* D = WSP(float, WS_MD); bf16* CQ = WSP(bf16, WS_MCQ); bf16* CKV = WSP(bf16, WS_MCKV); bf16* KR = WSP(bf16, WS_MKR);
    const f32x2* tab = WSP(f32x2, WS_TABM);
    const float* qn = F.in[I_MQN]; const float* kvn = F.in[I_MKVN];
    for (int row = gw; row < MTOK; row += NGW) {
        const float* d = D + (size_t)row * 1024;
        {
            const f32x4 v0 = *(const f32x4*)(d + 4 * lane), v1 = *(const f32x4*)(d + 256 + 4 * lane);
            float ss = (v0[0] * v0[0] + v0[1] * v0[1]) + (v0[2] * v0[2] + v0[3] * v0[3]) + (v1[0] * v1[0] + v1[1] * v1[1]) + (v1[2] * v1[2] + v1[3] * v1[3]);
            const float rstd = rsqrtf(wave_sum(ss) * (1.f / 512.f) + EPS);
            const f32x4 y0 = v0 * rstd * *(const f32x4*)(qn + 4 * lane), y1 = v1 * rstd * *(const f32x4*)(qn + 256 + 4 * lane);
            v2u w; w.x = cvtpk(y0[0], y0[1]); w.y = cvtpk(y0[2], y0[3]); *(v2u*)(CQ + (size_t)row * 512 + 4 * lane) = w;
            w.x = cvtpk(y1[0], y1[1]); w.y = cvtpk(y1[2], y1[3]); *(v2u*)(CQ + (size_t)row * 512 + 256 + 4 * lane) = w;
        }
        {
            const f32x4 v0 = *(const f32x4*)(d + 512 + 4 * lane);
            float ss = (v0[0] * v0[0] + v0[1] * v0[1]) + (v0[2] * v0[2] + v0[3] * v0[3]);
            const float rstd = rsqrtf(wave_sum(ss) * (1.f / 256.f) + EPS);
            const f32x4 y0 = v0 * rstd * *(const f32x4*)(kvn + 4 * lane);
            v2u w; w.x = cvtpk(y0[0], y0[1]); w.y = cvtpk(y0[2], y0[3]); *(v2u*)(CKV + (size_t)(1024 + row) * 256 + 4 * lane) = w;
            if (row < MP) *(f32x4*)(F.out + O_CKV + (size_t)row * 256 + 4 * lane) = y0;
        }
        if (lane < 8) {
            const int ug = lane, idx0 = (ug & 3) * 4, d1 = (ug < 4 ? 0 : 32) + idx0;
            f32x4 a = *(const f32x4*)(d + 768 + 8 * ug), b = *(const f32x4*)(d + 768 + 8 * ug + 4);
            if (row < MP) { float* op = F.out + O_KR + (size_t)row * 64 + d1; *(f32x4*)op = a; *(f32x4*)(op + 16) = b; }
            else { const int t = row & 4095, pos = (ug < 4) ? (t >> 6) : (t & 63); const f32x4* tp = (const f32x4*)(tab + pos * 16 + idx0); const f32x4 cs0 = tp[0], cs1 = tp[1];
                const f32x4 co = {cs0[0], cs0[2], cs1[0], cs1[2]}, si = {cs0[1], cs0[3], cs1[1], cs1[3]};
                const f32x4 na = a * co - b * si, nb = b * co + a * si; a = na; b = nb; }
            *(v4u*)(KR + (size_t)(1024 + row) * 64 + 8 * ug) = pack8(a, b);
        }
    }
    const int gt = F.bx * 512 + F.tid, NGT = F.G * 512;
    for (int e = gt; e < 1024 * 256; e += NGT) CKV[e] = (bf16)f2bf(F.in[I_CCKV][e]);
    for (int e = gt; e < 1024 * 64; e += NGT) KR[e] = (bf16)f2bf(F.in[I_CKR][(e & ~63) + perm_mla(e & 63)]);
}

typedef short v4i16_t __attribute__((ext_vector_type(4)));
__device__ __forceinline__ s16x4 vtr(const LAS char* p) { return __builtin_bit_cast(s16x4, __builtin_amdgcn_ds_read_tr16_b64_v4i16((LAS v4i16_t*)p)); }
#define MFMA16(a, b, c) __builtin_amdgcn_mfma_f32_16x16x32_bf16((a), (b), (c), 0, 0, 0)
#define CAT8(L, H) (bf16x8){L[0], L[1], L[2], L[3], H[0], H[1], H[2], H[3]}
typedef __bf16 bf16x2_t __attribute__((ext_vector_type(2)));
typedef float f32x2_t __attribute__((ext_vector_type(2)));
__device__ __forceinline__ unsigned cvtpk2(float lo, float hi) { f32x2_t v = {lo, hi}; bf16x2_t b = __builtin_convertvector(v, bf16x2_t); return __builtin_bit_cast(unsigned, b); }

__device__ __forceinline__ void gla_u_phase(Frame& F) {
    const int lane = F.lane, wave = F.wave, tid = F.tid, cl = lane & 15, gq = lane >> 4;
    const bf16* H = WSP(bf16, WS_H); const bf16* Wt = WSP(bf16, WS_GWINT) + (size_t)6144 * DM;
    const float* part = WSP(float, WS_PART) + (size_t)4 * MTOK * 32; const float* sW = WSP(float, WS_SW) + (size_t)4 * 3 * 8192 + 6144;
    float* GU = WSP(float, WS_GU);
    LAS float* red = (LAS float*)F.lds;
    __syncthreads();
    for (int rb = F.bx; rb < MTOK / 64; rb += F.G) {
        const int row0 = rb * 64;
        f32x4 acc[4][2];
#pragma unroll
        for (int mi = 0; mi < 4; ++mi) { acc[mi][0] = (f32x4){0.f, 0.f, 0.f, 0.f}; acc[mi][1] = (f32x4){0.f, 0.f, 0.f, 0.f}; }
        const bf16* ap = H + (size_t)(row0 + cl) * DM + wave * 256 + 16 * gq;
        const bf16* bp = Wt + (size_t)cl * DM + wave * 256 + 16 * gq;
#pragma unroll
        for (int ks = 0; ks < 4; ++ks) {
            bf16x8 a[4][2], b[2][2];
#pragma unroll
            for (int mi = 0; mi < 4; ++mi) { a[mi][0] = *(const bf16x8*)(ap + (size_t)mi * 16 * DM + 64 * ks); a[mi][1] = *(const bf16x8*)(ap + (size_t)mi * 16 * DM + 64 * ks + 8); }
#pragma unroll
            for (int nj = 0; nj < 2; ++nj) { b[nj][0] = *(const bf16x8*)(bp + (size_t)nj * 16 * DM + 64 * ks); b[nj][1] = *(const bf16x8*)(bp + (size_t)nj * 16 * DM + 64 * ks + 8); }
#pragma unroll
            for (int mi = 0; mi < 4; ++mi)
#pragma unroll
                for (int nj = 0; nj < 2; ++nj) { acc[mi][nj] = MFMA16(a[mi][0], b[nj][0], acc[mi][nj]); acc[mi][nj] = MFMA16(a[mi][1], b[nj][1], acc[mi][nj]); }
        }
#pragma unroll
        for (int mi = 0; mi < 4; ++mi)
#pragma unroll
            for (int nj = 0; nj < 2; ++nj)
#pragma unroll
                for (int r = 0; r < 4; ++r) red[(wave * 64 + 16 * mi + 4 * gq + r) * 32 + 16 * nj + cl] = acc[mi][nj][r];
        __syncthreads();
        {
            const int rr = tid >> 3, c4 = (tid & 7) * 4, row = row0 + rr;
            f32x4 t = *(const LAS f32x4*)(red + rr * 32 + c4);
#pragma unroll
            for (int w = 1; w < 8; ++w) t += *(const LAS f32x4*)(red + (w * 64 + rr) * 32 + c4);
            const f32x4* pp = (const f32x4*)(part + (size_t)row * 32); f32x4 ps = pp[0];
#pragma unroll
            for (int i = 1; i < 8; ++i) ps += pp[i];
            const float rstd = rsqrtf(((ps[0] + ps[1]) + (ps[2] + ps[3])) * (1.f / 2048.f) + EPS);
            *(f32x4*)(GU + (size_t)row * 32 + c4) = t * rstd + *(const f32x4*)(sW + (size_t)cond_of_pm(row >> 8) * 8192 + c4);
        }
        __syncthreads();
    }
}
__device__ __forceinline__ void gla_prep_phase(Frame& F) {
    constexpr int PQ = 528, OQ = 0, OK_ = 64 * PQ, OKT = 2 * 64 * PQ, OUB = 3 * 64 * PQ, OHT = OUB + 4096, OAT = OHT + 2048;
    LAS char* L = (LAS char*)F.lds; const int tid = F.tid, lane = F.lane, wave = F.wave;
    const bf16* GQ = WSP(bf16, WS_GQ); const bf16* GK = WSP(bf16, WS_GK); const float* GU = WSP(float, WS_GU);
    v4u pq[4], pk[4]; f32x4 pu = {0.f, 0.f, 0.f, 0.f};
#define GLA_PREP_LOAD(UN) do { const int d_ = (UN) & 1, ch_ = (UN) >> 1, r0_ = (ch_ >> 2) * 64, h_ = ch_ & 3; \
        _Pragma("unroll") for (int i = 0; i < 4; ++i) { const int e = tid + 512 * i, row = e >> 5, cc = e & 31; const size_t go = (size_t)(r0_ + row) * 1024 + h_ * 256 + cc * 8; pq[i] = *(const v4u*)(GQ + go); pk[i] = *(const v4u*)(GK + go); } \
        if (tid < 256) pu = *(const f32x4*)(GU + (size_t)(r0_ + (tid >> 2)) * 32 + d_ * 16 + (tid & 3) * 4); } while (0)
    if (F.bx < 2048) GLA_PREP_LOAD(F.bx);
    float w[16]; float bias = 0.f; int cur_dh = -1;
#pragma unroll
    for (int r = 0; r < 16; ++r) w[r] = 0.f;
    for (int un = F.bx; un < 2048; un += F.G) {
        const int d = un & 1, ch = un >> 1, c = ch >> 2, h = ch & 3, row0 = c * 64;
        bf16* QT = WSP(bf16, WS_GQT) + (size_t)d * MTOK * 1024; bf16* KD = WSP(bf16, WS_GKD) + (size_t)d * MTOK * 1024;
        bf16* AM = WSP(bf16, WS_GAM) + ((size_t)d * 1024 + ch) * 4096; float* DEC = WSP(float, WS_GDEC) + ((size_t)d * 1024 + ch) * 256;
        if ((un & 7) != cur_dh) { cur_dh = un & 7; const int col = tid & 255;
#pragma unroll
            for (int r = 0; r < 16; ++r) w[r] = F.in[I_GWA2][((size_t)d * 16 + r) * 1024 + h * 256 + col] * 1.44269504f;
            bias = F.in[I_GBA][d * 1024 + h * 256 + col] * 1.44269504f; }
#pragma unroll
        for (int i = 0; i < 4; ++i) { const int e = tid + 512 * i, row = e >> 5, cc = e & 31;
            *(LAS v4u*)(L + OQ + row * PQ + cc * 16) = pq[i]; *(LAS v4u*)(L + OK_ + row * PQ + cc * 16) = pk[i]; }
        if (tid < 256) { const int row = tid >> 2, q4 = tid & 3; *(LAS f32x4*)(L + OUB + (row * 16 + q4 * 4) * 4) = pu; }
        __syncthreads();
        if (un + F.G < 2048) GLA_PREP_LOAD(un + F.G);
        {
            const int hf = tid >> 8, col = tid & 255;
            float g[32]; float tot = 0.f;
#pragma unroll
            for (int ii = 0; ii < 32; ++ii) { const int i = hf * 32 + ii; float z = bias;
#pragma unroll
                for (int q4 = 0; q4 < 4; ++q4) { const f32x4 uv = *(const LAS f32x4*)(L + OUB + (i * 16 + q4 * 4) * 4); z += uv[0] * w[4 * q4] + uv[1] * w[4 * q4 + 1] + uv[2] * w[4 * q4 + 2] + uv[3] * w[4 * q4 + 3]; }
                const float ls = fminf(z, 0.f) - __builtin_amdgcn_logf(1.f + __builtin_amdgcn_exp2f(-fabsf(z)));
                g[ii] = ls * 0.0625f; tot += g[ii]; }
            ((LAS float*)(L + OHT))[hf * 256 + col] = tot;
            __syncthreads();
            const float other = ((const LAS float*)(L + OHT))[(1 - hf) * 256 + col];
            const float T = tot + other, eT = __builtin_amdgcn_exp2f(T);
            float run = (d == 0) ? (hf == 1 ? other : 0.f) : (hf == 0 ? other : 0.f);
            if (hf == 0) DEC[col] = eT;
#pragma unroll
            for (int s = 0; s < 32; ++s) {
                const int ii = (d == 0) ? s : 31 - s;
                run += (d == 0) ? g[s] : g[31 - s];
                const int i = hf * 32 + ii;
                LAS bf16* qp = (LAS bf16*)(L + OQ + i * PQ) + col; LAS bf16* kp = (LAS bf16*)(L + OK_ + i * PQ) + col; LAS bf16* ktp = (LAS bf16*)(L + OKT + i * PQ) + col;
                const float qv = bf2f(*qp), kv = bf2f(*kp);
                const float kt = kv * __builtin_amdgcn_exp2f(-run);
                const unsigned wq = cvtpk(qv * __builtin_amdgcn_exp2f(run), kt), wk = cvtpk(kt * eT, 0.f);
                *qp = (bf16)(wq & 0xffffu); *ktp = (bf16)(wq >> 16); *kp = (bf16)(wk & 0xffffu);
            }
        }
        __syncthreads();
        {
            const int gq = lane >> 4, cl = lane & 15;
#pragma unroll
            for (int s2 = 0; s2 < 2; ++s2) {
                const int T16 = 2 * wave + s2, ti = T16 >> 2, tj = T16 & 3;
                f32x4 acc = {0.f, 0.f, 0.f, 0.f};
#pragma unroll
                for (int ks = 0; ks < 8; ++ks) {
                    const bf16x8 a = *(const LAS bf16x8*)(L + OQ + (16 * ti + cl) * PQ + (32 * ks + 8 * gq) * 2);
                    const bf16x8 b = *(const LAS bf16x8*)(L + OKT + (16 * tj + cl) * PQ + (32 * ks + 8 * gq) * 2);
                    acc = MFMA16(a, b, acc);
                }
                const int jcol = 16 * tj + cl;
#pragma unroll
                for (int r = 0; r < 4; ++r) { const int i = 16 * ti + 4 * gq + r; const bool keep = (d == 0) ? (jcol <= i) : (jcol >= i);
                    ((LAS bf16*)(L + OAT))[i * 64 + jcol] = (bf16)f2bf(keep ? acc[r] : 0.f); }
            }
        }
        __syncthreads();
#pragma unroll
        for (int i = 0; i < 4; ++i) { const int e = tid + 512 * i, row = e >> 5, cc = e & 31; const size_t go = (size_t)(row0 + row) * 1024 + h * 256 + cc * 8;
            *(v4u*)(QT + go) = *(const LAS v4u*)(L + OQ + row * PQ + cc * 16); *(v4u*)(KD + go) = *(const LAS v4u*)(L + OK_ + row * PQ + cc * 16); }
        *(v4u*)(AM + tid * 8) = *(const LAS v4u*)(L + OAT + tid * 16);
        __syncthreads();
    }
#undef GLA_PREP_LOAD
}

constexpr int GLA_NSEG = 4, GLA_SEGCH = 16;
template <bool LIGHT>
__device__ __forceinline__ void gla_scan_item(Frame& F, int seq, int h, int d, int sl, int seg) {
    constexpr int PQ = 528, PK = 544, PA = 136, PV = 288;
    constexpr int OQ = 0, OK_ = 64 * PQ, OA = OK_ + 64 * PK, OV = OA + 64 * PA, ODEC = OV + 64 * PV;
    LAS char* L = (LAS char*)F.lds; const int tid = F.tid, lane = F.lane, wave = F.wave, gq = lane >> 4, cl = lane & 15;
    const bool sample = seq >= 32; const int base = sample ? MP + (seq - 32) * 4096 : seq * 256, ntot = sample ? 64 : 4;
    const int p0 = sample ? seg * GLA_SEGCH : 0, nch = sample ? GLA_SEGCH : 4;
    const bf16* QT = WSP(bf16, WS_GQT) + (size_t)d * MTOK * 1024; const bf16* KD = WSP(bf16, WS_GKD) + (size_t)d * MTOK * 1024;
    const bf16* AM = WSP(bf16, WS_GAM) + (size_t)d * 1024 * 4096; const float* DEC = WSP(float, WS_GDEC) + (size_t)d * 1024 * 256;
    const bf16* GV = WSP(bf16, WS_GV); bf16* OD = WSP(bf16, d == 0 ? WS_GOF : WS_GOB);
    const int dvc = h * 512 + sl * 128;
    const int sidx = sample ? (((seq - 32) * 4 + h) * 2 + d) : 0;
    float* GLs = WSP(float, WS_GLS); float* GDS = WSP(float, WS_GDS);
    f32x4 S[16];
#pragma unroll
    for (int t = 0; t < 16; ++t) S[t] = (f32x4){0.f, 0.f, 0.f, 0.f};
    if (sample && !LIGHT) {
        { const float* s0 = F.in[d == 0 ? I_SGF : I_SGB] + ((size_t)((seq - 32) * 4 + h) * 256) * 512 + sl * 128 + 16 * wave;
          int lb = (4 * gq) * 512 + cl; asm volatile("" : "+v"(lb));
#pragma unroll
          for (int t = 0; t < 16; ++t)
#pragma unroll
            for (int r = 0; r < 4; ++r) S[t][r] = s0[(unsigned)(lb + (16 * t + r) * 512)]; }
        for (int g = 0; g < seg; ++g) {
            const float* Lg = GLs + ((size_t)(sidx * 3 + g) * 256) * 512 + sl * 128 + 16 * wave; const float* Dg = GDS + (size_t)(sidx * 3 + g) * 256;
            int lb = (4 * gq) * 512 + cl, db = 4 * gq; asm volatile("" : "+v"(lb), "+v"(db));
#pragma unroll
            for (int t = 0; t < 16; ++t) { const f32x4 dg = *(const f32x4*)(Dg + (unsigned)(db + 16 * t));
#pragma unroll
                for (int r = 0; r < 4; ++r) S[t][r] = S[t][r] * dg[r] + Lg[(unsigned)(lb + (16 * t + r) * 512)]; }
        }
    }
    float dprod = 1.f;
    v4u rq[LIGHT ? 1 : 4], rk[4], rv[2], ra; float rdec = 0.f;
    const int tr = tid >> 5, tc = tid & 31, vr = tid >> 4, vc = tid & 15;
    const unsigned goq = (unsigned)(tr * 1024 + h * 256 + tc * 8) * 2u, gov = (unsigned)(vr * 2048 + dvc + vc * 8) * 2u;
    LAS char* const lq = L + OQ + tr * PQ + tc * 16; LAS char* const lk = L + OK_ + tr * PK + tc * 16; LAS char* const lv = L + OV + vr * PV + vc * 16;
#define GLOAD1(ps) do { const int ci_ = d == 0 ? (ps) : ntot - 1 - (ps); const size_t rb_ = (size_t)(base + 64 * ci_) * 2048;   \
    _Pragma("unroll") for (int i = 0; i < 4; ++i) { if constexpr (!LIGHT) rq[i] = *(const v4u*)((const char*)QT + rb_ + goq + i * 16 * 2048); rk[i] = *(const v4u*)((const char*)KD + rb_ + goq + i * 16 * 2048); } } while (0)
#define GLOAD2(ps) do { const int ci_ = d == 0 ? (ps) : ntot - 1 - (ps); const int r0_ = base + 64 * ci_; const int chx_ = (r0_ >> 6) * 4 + h; \
    _Pragma("unroll") for (int i = 0; i < 2; ++i) rv[i] = *(const v4u*)((const char*)GV + (size_t)r0_ * 4096 + gov + i * 32 * 4096); \
    if constexpr (!LIGHT) ra = *(const v4u*)(AM + (size_t)chx_ * 4096 + tid * 8); if (tid < 256) rdec = DEC[(size_t)chx_ * 256 + tid]; } while (0)
#define LWRITE() do { \
    _Pragma("unroll") for (int i = 0; i < 4; ++i) { if constexpr (!LIGHT) *(LAS v4u*)(lq + i * 16 * PQ) = rq[i]; *(LAS v4u*)(lk + i * 16 * PK) = rk[i]; } \
    _Pragma("unroll") for (int i = 0; i < 2; ++i) *(LAS v4u*)(lv + i * 32 * PV) = rv[i]; \
    if constexpr (!LIGHT) { const int row = tid >> 3, cc = tid & 7; *(LAS v2u*)(L + OA + row * PA + cc * 16) = (v2u){ra.x, ra.y}; *(LAS v2u*)(L + OA + row * PA + cc * 16 + 8) = (v2u){ra.z, ra.w}; } \
    if (tid < 256) ((LAS float*)(L + ODEC))[tid] = rdec; } while (0)
    GLOAD1(p0); GLOAD2(p0);
    LWRITE();
    __syncthreads();
    asm volatile(".p2align 8");
    for (int s = 0; s < nch; ++s) {
        const int ps = p0 + s, ci = d == 0 ? ps : ntot - 1 - ps, row0 = base + 64 * ci;
        if constexpr (LIGHT) dprod *= rdec;
        if (s + 1 < nch) { GLOAD1(ps + 1); GLOAD2(ps + 1); }
        bf16x8 vb[2];
#define LOADVB() do { _Pragma("unroll") for (int ks = 0; ks < 2; ++ks) { const LAS char* vp = L + OV + (32 * ks + 4 * gq + (cl >> 2)) * PV + 32 * wave + 8 * (cl & 3); \
            const s16x4 lo = vtr(vp), hi = vtr(vp + 16 * PV); vb[ks] = CAT8(lo, hi); } } while (0)
        SBAR(); LOADVB();
        if constexpr (!LIGHT) {
            f32x4 o[4];
#pragma unroll
            for (int ti = 0; ti < 4; ++ti) o[ti] = (f32x4){0.f, 0.f, 0.f, 0.f};
            const LAS char* qb_ = L + OQ + cl * PQ + 8 * gq; const LAS char* ab_ = L + OA + cl * PA + 8 * gq;
            int qh_ = (int)(uintptr_t)qb_ + 32, ah_ = (int)(uintptr_t)ab_ + 32; asm volatile("" : "+v"(qh_), "+v"(ah_));
#define OLD_(g, F) do { _Pragma("unroll") for (int ti = 0; ti < 4; ++ti) { const LAS char* ap = (g) < 8 ? qb_ + 16 * ti * PQ + 64 * (g) : ab_ + 16 * ti * PA + 64 * ((g) - 8); const LAS char* ah2 = (const LAS char*)(uintptr_t)(unsigned)((g) < 8 ? qh_ + 16 * ti * PQ + 64 * (g) : ah_ + 16 * ti * PA + 64 * ((g) - 8)); F[2 * ti] = *(const LAS s16x4*)ap; F[2 * ti + 1] = *(const LAS s16x4*)ah2; } } while (0)
#define OMM_(g, F) do { bf16x8 b_; if constexpr ((g) < 8) { constexpr int k2 = 2 * ((g) < 8 ? (g) : 0); v4u bw; bw.x = cvtpk2(S[k2][0], S[k2][1]); bw.y = cvtpk2(S[k2][2], S[k2][3]); bw.z = cvtpk2(S[k2 + 1][0], S[k2 + 1][1]); bw.w = cvtpk2(S[k2 + 1][2], S[k2 + 1][3]); b_ = __builtin_bit_cast(bf16x8, bw); } else b_ = vb[(g) < 8 ? 0 : (g) - 8]; \
                _Pragma("unroll") for (int ti = 0; ti < 4; ++ti) o[ti] = MFMA16(CAT8(F[2 * ti], F[2 * ti + 1]), b_, o[ti]); } while (0)
            s16x4 fa[8], fb[8], fc[8];
            OLD_(0, fa); OLD_(1, fb); SBAR();
            OLD_(2, fc); SBAR(); OMM_(0, fa); SBAR();
            OLD_(3, fa); SBAR(); OMM_(1, fb); SBAR();
            OLD_(4, fb); SBAR(); OMM_(2, fc); SBAR();
            OLD_(5, fc); SBAR(); OMM_(3, fa); SBAR();
            OLD_(6, fa); SBAR(); OMM_(4, fb); SBAR();
            OLD_(7, fb); SBAR(); OMM_(5, fc); SBAR();
            OLD_(8, fc); SBAR(); OMM_(6, fa); SBAR();
            OLD_(9, fa); SBAR(); OMM_(7, fb); SBAR();
            OMM_(8, fc); SBAR(); OMM_(9, fa); SBAR();
#undef OLD_
#undef OMM_
            { bf16* ODr = OD + (size_t)row0 * 2048 + dvc + 16 * wave; int ob = (4 * gq) * 2048 + cl; asm volatile("" : "+v"(ob));
#pragma unroll
              for (int ti = 0; ti < 4; ++ti)
#pragma unroll
                for (int r = 0; r < 4; r += 2) { const unsigned w2 = cvtpk2(o[ti][r], o[ti][r + 1]); ODr[(unsigned)(ob + (16 * ti + r) * 2048)] = (bf16)(w2 & 0xffffu); ODr[(unsigned)(ob + (16 * ti + r + 1) * 2048)] = (bf16)(w2 >> 16); } }
            SBAR();
        }
        {
            const LAS char* db_ = L + ODEC + 16 * gq; const LAS char* kb_ = L + OK_ + (4 * gq + (cl >> 2)) * PK + 8 * (cl & 3);
#define SLD_(t, DC, KF) do { DC = *(const LAS f32x4*)(db_ + 64 * (t)); KF[0] = vtr(kb_ + 32 * (t)); KF[1] = vtr(kb_ + 32 * (t) + 16 * PK); KF[2] = vtr(kb_ + 32 * (t) + 32 * PK); KF[3] = vtr(kb_ + 32 * (t) + 48 * PK); } while (0)
#define SMM_(t, DC, KF) do { S[t] = S[t] * DC; S[t] = MFMA16(CAT8(KF[0], KF[1]), vb[0], S[t]); S[t] = MFMA16(CAT8(KF[2], KF[3]), vb[1], S[t]); } while (0)
            f32x4 da, dbv, dcv; s16x4 ka[4], kbv[4], kc[4];
            SBAR(); SLD_(0, da, ka); SLD_(1, dbv, kbv); SBAR();
            SLD_(2, dcv, kc); SBAR(); SMM_(0, da, ka); SBAR();
            SLD_(3, da, ka); SBAR(); SMM_(1, dbv, kbv); SBAR();
            SLD_(4, dbv, kbv); SBAR(); SMM_(2, dcv, kc); SBAR();
            SLD_(5, dcv, kc); SBAR(); SMM_(3, da, ka); SBAR();
            SLD_(6, da, ka); SBAR(); SMM_(4, dbv, kbv); SBAR();
            SLD_(7, dbv, kbv); SBAR(); SMM_(5, dcv, kc); SBAR();
            SLD_(8, dcv, kc); SBAR(); SMM_(6, da, ka); SBAR();
            SLD_(9, da, ka); SBAR(); SMM_(7, dbv, kbv); SBAR();
            SLD_(10, dbv, kbv); SBAR(); SMM_(8, dcv, kc); SBAR();
            SLD_(11, dcv, kc); SBAR(); SMM_(9, da, ka); SBAR();
            SLD_(12, da, ka); SBAR(); SMM_(10, dbv, kbv); SBAR();
            SLD_(13, dbv, kbv); SBAR(); SMM_(11, dcv, kc); SBAR();
            SLD_(14, dcv, kc); SBAR(); SMM_(12, da, ka); SBAR();
            SLD_(15, da, ka); SBAR(); SMM_(13, dbv, kbv); SBAR();
            SMM_(14, dcv, kc); SBAR(); SMM_(15, da, ka); SBAR();
#undef SLD_
#undef SMM_
        }
        __syncthreads();
        if (s + 1 < nch) { LWRITE(); }
        __syncthreads();
    }
    if constexpr (LIGHT) {
        float* Lg = GLs + ((size_t)(sidx * 3 + seg) * 256) * 512 + sl * 128 + 16 * wave; int lb = (4 * gq) * 512 + cl; asm volatile("" : "+v"(lb));
#pragma unroll
        for (int t = 0; t < 16; ++t)
#pragma unroll
            for (int r = 0; r < 4; ++r) Lg[(unsigned)(lb + (16 * t + r) * 512)] = S[t][r];
        if (sl == 0 && tid < 256) { float* Dg = GDS + (size_t)(sidx * 3 + seg) * 256; Dg[tid] = dprod; }
    } else if (!sample) { float* so = F.out + (d == 0 ? O_GF : O_GB) + ((size_t)(seq * 4 + h) * 256) * 512 + sl * 128 + 16 * wave; int lb = (4 * gq) * 512 + cl; asm volatile("" : "+v"(lb));
#pragma unroll
        for (int t = 0; t < 16; ++t)
#pragma unroll
            for (int r = 0; r < 4; ++r) so[(unsigned)(lb + (16 * t + r) * 512)] = S[t][r];
    }
#undef GLOAD1
#undef GLOAD2
#undef LWRITE
#undef LOADVB
}
__device__ __forceinline__ int gla_item_of(int bx, int G) { return G == 256 ? (((bx & 7) + 8 * (bx >> 5)) << 2) + ((bx >> 3) & 3) : bx; }
__device__ __forceinline__ void gla_scanA_phase(Frame& F) {
    for (int it = gla_item_of(F.bx, F.G); it < 192; it += F.G) { const int sl = it & 3, g = (it >> 2) % 3, r = (it >> 2) / 3;
        gla_scan_item<true>(F, 32 + (r >> 3), (r >> 1) & 3, r & 1, sl, g); }
}
__device__ __forceinline__ void gla_scan_phase(Frame& F) {
    for (int it = gla_item_of(F.bx, F.G); it < 1280; it += F.G) {
        int seq, h, d, sl, g;
        if (it < 256) { const int r = it >> 4; sl = it & 3; g = (it >> 2) & 3; seq = 32 + (r >> 3); h = (r >> 1) & 3; d = r & 1; }
        else { const int i2 = it - 256; seq = i2 >> 5; h = (i2 >> 3) & 3; d = (i2 >> 2) & 1; sl = i2 & 3; g = 0; }
        gla_scan_item<false>(F, seq, h, d, sl, g);
    }
}
__device__ __forceinline__ void gla_post_phase(Frame& F) {
    const int gw = F.bx * NWAVES + F.wave, NGW = F.G * NWAVES, lane = F.lane;
    const bf16* OFp = WSP(bf16, WS_GOF); const bf16* OBp = WSP(bf16, WS_GOB); const bf16* GR = WSP(bf16, WS_GR); const float* gn = F.in[I_GNORM];
    signed char* A8 = (signed char*)(F.ws + WS_AO8); float* arow = WSP(float, WS_AROW);
#define UNPK4(w) (f32x4){__builtin_bit_cast(float, (w).x << 16), __builtin_bit_cast(float, (w).x & 0xffff0000u), __builtin_bit_cast(float, (w).y << 16), __builtin_bit_cast(float, (w).y & 0xffff0000u)}
    for (int row = gw; row < MTOK; row += NGW) {
        f32x4 ya[4], yb[4]; float mx = 0.f;
#pragma unroll
        for (int hh = 0; hh < 4; ++hh) {
            const size_t o0 = (size_t)row * 2048 + hh * 512 + 4 * lane;
            const v2u f0 = *(const v2u*)(OFp + o0), f1 = *(const v2u*)(OFp + o0 + 256), b0 = *(const v2u*)(OBp + o0), b1 = *(const v2u*)(OBp + o0 + 256);
            const f32x4 v0 = UNPK4(f0) + UNPK4(b0), v1 = UNPK4(f1) + UNPK4(b1);
            float ss = (v0[0] * v0[0] + v0[1] * v0[1]) + (v0[2] * v0[2] + v0[3] * v0[3]) + (v1[0] * v1[0] + v1[1] * v1[1]) + (v1[2] * v1[2] + v1[3] * v1[3]);
            const float rstd = rsqrtf(wave_sum(ss) * (1.f / 512.f) + EPS);
            const v2u r0 = *(const v2u*)(GR + o0), r1 = *(const v2u*)(GR + o0 + 256);
            f32x4 ra = UNPK4(r0), rb = UNPK4(r1);
#pragma unroll
            for (int i = 0; i < 4; ++i) { ra[i] = ra[i] / (1.f + __expf(-ra[i])); rb[i] = rb[i] / (1.f + __expf(-rb[i])); }
            ya[hh] = v0 * rstd * *(const f32x4*)(gn + 4 * lane) * ra; yb[hh] = v1 * rstd * *(const f32x4*)(gn + 256 + 4 * lane) * rb;
#pragma unroll
            for (int i = 0; i < 4; ++i) mx = fmaxf(mx, fmaxf(fabsf(ya[hh][i]), fabsf(yb[hh][i])));
        }
#pragma unroll
        for (int o = 1; o < 64; o <<= 1) mx = fmaxf(mx, __shfl_xor(mx, o));
        mx = fmaxf(mx, 1e-30f); const float inv = 127.f / mx;
        if (lane == 0) arow[row] = mx * (1.f / 127.f);
#pragma unroll
        for (int hh = 0; hh < 4; ++hh) {
            const size_t o0 = (size_t)row * 2048 + hh * 512 + 4 * lane;
            const f32x4 qa = ya[hh] * inv, qb = yb[hh] * inv;
            const unsigned wa = ((unsigned)(int)rintf(qa[0]) & 0xffu) | (((unsigned)(int)rintf(qa[1]) & 0xffu) << 8) | (((unsigned)(int)rintf(qa[2]) & 0xffu) << 16) | (((unsigned)(int)rintf(qa[3]) & 0xffu) << 24);
            const unsigned wb = ((unsigned)(int)rintf(qb[0]) & 0xffu) | (((unsigned)(int)rintf(qb[1]) & 0xffu) << 8) | (((unsigned)(int)rintf(qb[2]) & 0xffu) << 16) | (((unsigned)(int)rintf(qb[3]) & 0xffu) << 24);
            *(unsigned*)(A8 + o0) = wa; *(unsigned*)(A8 + o0 + 256) = wb;
        }
    }
#undef UNPK4
}

#ifndef MK_N_LAUNCHES
#define MK_N_LAUNCHES 1
#ifndef I8_SP2
#define I8_SP2 true
#endif
#ifndef I8_ALIGN
#define I8_ALIGN true
#endif
#ifndef PG8_ALIGN
#define PG8_ALIGN true
#endif
#ifndef PG8_SP2
#define PG8_SP2 true
#endif
#endif
constexpr int N_PHASES = 35;
__global__ void __launch_bounds__(NWAVES * 64, 2) mk_fwd(Args args) {
    extern __shared__ __attribute__((aligned(16))) unsigned char lds[];
    Frame F;
    F.lds = (LAS unsigned char*)lds; F.ldsg = lds;
    F.tid = threadIdx.x; F.lane = F.tid & 63; F.wave = __builtin_amdgcn_readfirstlane(F.tid >> 6);
    F.G = gridDim.x; F.bx = blockIdx.x;
    F.in = args.in; F.out = args.out; F.ws = args.ws;
    volatile LAS unsigned* MISC = (volatile LAS unsigned*)(F.lds + MISC_OFF);
    if (F.tid < 32) MISC[F.tid] = 0u;
    __syncthreads();
    const int lo = args.ph_lo, hi = args.ph_hi;
    const bool use_bar = (hi - lo) > 1;
    XcdBarrier bar; bar.bar = (unsigned*)(F.ws + WS_CTL) + CW_BAR + args.li * XCD_BAR_WORDS; bar.x = 0; bar.st = nullptr;
    if (use_bar) bar = xcd_barrier_post((unsigned*)(F.ws + WS_CTL) + CW_BAR + args.li * XCD_BAR_WORDS, MISC + 8);
#ifdef PH_ONLY
#define IN(k) ((k) == PH_ONLY && lo <= (k) && (k) < hi)
#else
#define IN(k) (lo <= (k) && (k) < hi)
#endif
#define SEAM(k) do { if (IN(k) && IN((k) + 1)) xcd_barrier(bar); } while (0)
    LAS unsigned char* ring = F.lds;

#ifndef PROBE_MASK
#define PROBE_MASK 0ull
#endif
    constexpr unsigned long long REP_MASK = PROBE_MASK;
#define PHASE(k, ...) if (IN(k)) { if (((REP_MASK >> (k)) & 1ull) != 0ull) { const bool dry_ = true; (void)dry_; __VA_ARGS__ xcd_barrier(bar); } { const bool dry_ = false; (void)dry_; __VA_ARGS__ } } SEAM(k);
#define GATE(L, q) (dry_ ? (const float*)(F.ws + WS_CTL + 524288) : WSP(float, WS_MOD) + (size_t)((L) * 3) * 12288 + (q) * 2048)
#define NORMIN(site) NormIn{WSP(float, WS_PART) + (size_t)(site) * MTOK * 32, WSP(float, WS_SW) + (size_t)(site) * 3 * 8192, (const LAS float*)(F.lds + LDS_RSTD_OFF), pm0_}
    PHASE(0, p0_prologue(F);)
    PHASE(1, p1_phase(F);)

#define GEMM_PHASE(EpiT, epi, Aptr, Bptr, M_, N_, K_) do { int kk_ = (K_); asm volatile("" : "+s"(kk_)); pg8::Gemm g{(const pg8::bf16_t*)(Aptr), (const pg8::bf16_t*)(Bptr), (M_), (N_), kk_}; pg8::StaticOrder S; S.init((M_), (N_), F.G, F.bx); \
        pg8::gemm_phase<EpiT, pg8::StaticOrder, PG8_ALIGN, PG8_SP2>(ring, g, S, epi); } while (0)

#define GEMM_PHASE_N(site, EpiT, EPI_INIT, Aptr, Bptr, M_, N_, K_) do { int kk_ = (K_); asm volatile("" : "+s"(kk_)); pg8::Gemm g{(const pg8::bf16_t*)(Aptr), (const pg8::bf16_t*)(Bptr), (M_), (N_), kk_}; pg8::StaticOrder S; S.init((M_), (N_), F.G, F.bx); \
        const int pm0_ = prep_rstd(F, S, (site)); EpiT E EPI_INIT; pg8::gemm_phase<EpiT, pg8::StaticOrder, PG8_ALIGN, PG8_SP2>(ring, g, S, E); } while (0)
#define ARGS(...) {__VA_ARGS__}
#ifndef RES_ALIGN
#define RES_ALIGN true
#endif
#define GEMM_PHASE_R(EpiT, epi, Aptr, Bptr, M_, N_, K_) do { int kk_ = (K_); asm volatile("" : "+s"(kk_)); pg8::Gemm g{(const pg8::bf16_t*)(Aptr), (const pg8::bf16_t*)(Bptr), (M_), (N_), kk_}; pg8::StaticOrder S; S.init((M_), (N_), F.G, F.bx); \
        pg8::gemm_phase<EpiT, pg8::StaticOrder, RES_ALIGN, PG8_SP2>(ring, g, S, epi); } while (0)
#define LAYER_TAIL(P, L) \
    PHASE((P), { EpiResidT<true> E{F.in[I_XP], F.in[I_XS], WSP(float, WS_X), GATE((L), 2), (L) == 0 ? 1 : 0, WSP(float, WS_AROW), WSP(float, WS_SCOLO) + (L) * 2048, dry_ ? (bf16*)nullptr : WSP(bf16, WS_H), F.in[I_NORMG] + (size_t)((L) * 2 + 1) * 2048, \
            WSP(float, WS_MOD) + (size_t)((L) * 3) * 12288 + 4 * 2048, WSP(float, WS_PART) + (size_t)(2 * (L) + 1) * MTOK * 32, WSP(float, WS_PMAX) + (size_t)(2 * (L) + 1) * MTOK * 32}; \
            int kk_ = 1024; asm volatile("" : "+s"(kk_)); pg8::Gemm g{(const pg8::bf16_t*)(F.ws + WS_AO8), (const pg8::bf16_t*)(F.ws + WS_WWOT + (size_t)(L) * 2048 * 2048), MTOK, DM, kk_}; pg8::StaticOrder S; S.init(MTOK, DM, F.G, F.bx); \
            pg8::gemm_phase<EpiResidT<true>, pg8::StaticOrder, PG8_ALIGN, PG8_SP2, true>(ring, g, S, E); }) \
    PHASE((P) + 1, q8_phase(F, (L), (L) == 0);) \
    PHASE((P) + 2, { EpiRelu2I8 E{WSP(bf16, WS_HID), FFH, WSP(float, WS_FROW) + (size_t)(L) * MTOK, WSP(float, WS_SCOL) + (L) * 8192, WSP(float, WS_SW) + (size_t)(2 * (L) + 1) * 3 * 8192}; \
            int kk_ = 1024; asm volatile("" : "+s"(kk_)); pg8::Gemm g{(const pg8::bf16_t*)(F.ws + WS_H8), (const pg8::bf16_t*)(F.ws + WS_W1T + (size_t)(L) * 8192 * 2048), MTOK, FFH, kk_}; pg8::StaticOrder S; S.init(MTOK, FFH, F.G, F.bx); \
            pg8::gemm_phase<EpiRelu2I8, pg8::StaticOrder, I8_ALIGN, I8_SP2, true>(ring, g, S, E); }) \
    PHASE((P) + 3, EpiResid E{F.in[I_XP], F.in[I_XS], WSP(float, WS_X), GATE((L), 5), 0, (const float*)nullptr, (const float*)nullptr, (dry_ || (L) == 3) ? (bf16*)nullptr : WSP(bf16, WS_H), F.in[I_NORMG] + (size_t)(((L) + 1) * 2) * 2048, \
            WSP(float, WS_MOD) + (size_t)(((L) + 1) * 3) * 12288 + 1 * 2048, WSP(float, WS_PART) + (size_t)(2 * ((L) + 1)) * MTOK * 32, (float*)nullptr}; GEMM_PHASE(EpiResid, E, WSP(bf16, WS_HID), WSP(bf16, WS_W2T) + (size_t)(L) * DM * FFH, MTOK, DM, FFH);)

#define WIN_LAYER(P, L, J) \
    PHASE((P), GEMM_PHASE_N(2 * (L), EpiQkvWin, ARGS(WSP(bf16, WS_WQ), WSP(bf16, WS_WK), WSP(bf16, WS_WV), F.out + O_WK, F.out + O_WV, (J), WSP(f32x2, WS_TABW), NORMIN(2 * (L))), \
        WSP(bf16, WS_H), WSP(bf16, WS_WQKVT) + (size_t)(J) * 3072 * DM, MTOK, 3072, DM);) \
    PHASE((P) + 1, attn_win_phase(F, (J));) \
    PHASE((P) + 2, aoq_phase(F);) \
    LAYER_TAIL((P) + 3, (L))

    WIN_LAYER(2, 0, 0)
    PHASE(9, GEMM_PHASE_N(2, EpiF32, ARGS(WSP(float, WS_MD), 1024, NORMIN(2)), WSP(bf16, WS_H), WSP(bf16, WS_MWDT), MTOK, 1024, DM);)
    PHASE(10, mla_norm_phase(F);)
    PHASE(11, { EpiMlaQ E{WSP(bf16, WS_MQ), WSP(f32x2, WS_TABM)}; GEMM_PHASE(EpiMlaQ, E, WSP(bf16, WS_MCQ), WSP(bf16, WS_MWUQT), MTOK, 3072, 512); }
             { EpiMlaKV E{WSP(bf16, WS_MKN), WSP(bf16, WS_MV)}; GEMM_PHASE(EpiMlaKV, E, WSP(bf16, WS_MCKV), WSP(bf16, WS_MWUKVT), MTOK + 1024, 4096, 256); })
#ifdef PROBE_SLEEP
    if (IN(11)) { const unsigned long long t0_ = __builtin_amdgcn_s_memrealtime(); while (__builtin_amdgcn_s_memrealtime() - t0_ < (unsigned long long)PROBE_SLEEP * 100ull) __builtin_amdgcn_s_sleep(8); }
#endif
    PHASE(12, attn_mla_phase(F);)
    PHASE(13, aoq_phase(F);)
    LAYER_TAIL(14, 1)
    PHASE(18, GEMM_PHASE_N(4, EpiGlaIn, ARGS(WSP(bf16, WS_GQ), WSP(bf16, WS_GK), WSP(bf16, WS_GV), WSP(bf16, WS_GR), WSP(float, WS_GU), NORMIN(4)), WSP(bf16, WS_H), WSP(bf16, WS_GWINT), MTOK, 6144, DM); gla_u_phase(F);)
    PHASE(19, gla_prep_phase(F);)
    PHASE(20, gla_scanA_phase(F);)
    PHASE(21, gla_scan_phase(F);)
    PHASE(22, gla_post_phase(F);)
    LAYER_TAIL(23, 2)
    WIN_LAYER(27, 3, 1)
    PHASE(34, final_phase(F);)
#undef IN
#undef SEAM
}

extern "C" void kernel_launch(void* const* d_in, const int* in_sizes, int n_in, void* d_out, int out_size, void* d_ws, size_t ws_size, hipStream_t stream) {
    static int grid = 0;
    if (grid == 0) {
        if (n_in != 31 || (size_t)out_size != O_END || ws_size < WS_END) { fprintf(stderr, "kernel_launch: shape mismatch n_in %d out %d ws %zu (need %zu)\n", n_in, out_size, ws_size, (size_t)WS_END); grid = -1; return; }
        int dev = 0, cus = 0, per_cu = 0;
        if (hipGetDevice(&dev) != hipSuccess || hipDeviceGetAttribute(&cus, hipDeviceAttributeMultiprocessorCount, dev) != hipSuccess) { grid = -1; return; }
        if (hipFuncSetAttribute((const void*)mk_fwd, hipFuncAttributeMaxDynamicSharedMemorySize, LDS_BYTES) != hipSuccess) { fprintf(stderr, "kernel_launch: hipFuncSetAttribute failed\n"); grid = -1; return; }
        if (hipOccupancyMaxActiveBlocksPerMultiprocessor(&per_cu, (const void*)mk_fwd, NWAVES * 64, LDS_BYTES) != hipSuccess || per_cu < 1) fprintf(stderr, "kernel_launch: occupancy query says %d\n", per_cu);
        (void)hipGetLastError();
        grid = cus;
    }
    if (grid < 0) return;
    if (hipMemsetAsync((char*)d_ws + WS_CTL, 0, CTL_ZERO_BYTES, stream) != hipSuccess) return;
    Args a{};
    for (int i = 0; i < 31; ++i) a.in[i] = (const float*)d_in[i];
    a.in[31] = nullptr;
    a.out = (float*)d_out; a.ws = (unsigned char*)d_ws; a.pad = 0; a.rep_mask = 0ull; a.rep_n = 1; a.pad2 = 0;
#if MK_N_LAUNCHES == 1
    a.ph_lo = 0; a.ph_hi = N_PHASES; a.li = 0;
    hipLaunchKernelGGL(mk_fwd, dim3(grid), dim3(NWAVES * 64), LDS_BYTES, stream, a);
#else
    for (int p = 0; p < N_PHASES; ++p) { a.ph_lo = p; a.ph_hi = p + 1; a.li = 0; hipLaunchKernelGGL(mk_fwd, dim3(grid), dim3(NWAVES * 64), LDS_BYTES, stream, a); }
#endif
}
```

```cpp
#include <hip/hip_runtime.h>
#include <cstdio>
#include <cstdint>
namespace pg8 {
#define PG8_LAS __attribute__((address_space(3)))
typedef unsigned short bf16_t;
typedef short bf16x8 __attribute__((ext_vector_type(8)));
typedef float f32x4 __attribute__((ext_vector_type(4)));
typedef unsigned u32x4 __attribute__((ext_vector_type(4)));
constexpr int BM = 256, BK = 64, HALF = 128, HTB = HALF * BK * 2  , STAGE_BYTES = 8 * HTB, NXCD = 8, WGM = 8;

__host__ __device__ __forceinline__ int lds_byte(int r, int c) { const int st = (r >> 4) * 2 + (c >> 5), rr = r & 15, cc = c & 31, ob = rr * 64 + cc * 2; return st * 1024 + (ob ^ (((ob >> 9) & 1) << 5)); }
__host__ __device__ __forceinline__ void stage_rc(int b, int& R, int& C) { const int st = b / 1024, sb = b % 1024, swz = sb ^ (((sb >> 9) & 1) << 5); R = (st >> 1) * 16 + swz / 64; C = (st & 1) * 32 + (swz % 64) / 2; }
__host__ __device__ __forceinline__ int perm32(int rho) { const int n = rho >> 4, i = rho & 15; return 8 * (i >> 2) + 4 * n + (i & 3); }

struct Unit { int pm, pn; };
struct Gemm { const bf16_t* A; const bf16_t* Bt; int M, N, K; };

struct StaticOrder {
    int nM, nN, nwg, G, c, wgm;
    __host__ __device__ void init(int M, int N, int G_, int c_, int wgm_ = WGM) { nM = M / BM; nN = N / BM; nwg = nM * nN; G = G_; c = c_; wgm = wgm_; }
    __host__ __device__ bool next(int i, Unit& u) const {
        const long L = (long)i * G + c; if (L >= nwg) return false;
        int wgid = (int)L; { const int q = nwg / NXCD, r = nwg % NXCD, xcd = wgid % NXCD, off = wgid / NXCD; wgid = (xcd < r ? xcd * (q + 1) : r * (q + 1) + (xcd - r) * q) + off; }
        const int nig = wgm * nN, gid = wgid / nig, fm = gid * wgm, gsz = (nM - fm) < wgm ? (nM - fm) : wgm;
        u.pm = fm + ((wgid % nig) % gsz); u.pn = (wgid % nig) / gsz; return true;
    }
    __device__ __forceinline__ void a_ready(const Unit&) const {}
    __device__ __forceinline__ void done(const Unit&) const {}
};
__device__ __forceinline__ unsigned cvt_pk_bf16(float lo, float hi) { unsigned r; asm volatile("v_cvt_pk_bf16_f32 %0, %1, %2" : "=v"(r) : "v"(lo), "v"(hi)); return r; }
typedef float f32x2 __attribute__((ext_vector_type(2)));
typedef int i32x4 __attribute__((ext_vector_type(4)));
template <bool I8> __device__ __forceinline__ f32x4 mma16(bf16x8 b, bf16x8 a, f32x4 c) {
    if constexpr (I8) return __builtin_bit_cast(f32x4, __builtin_amdgcn_mfma_i32_16x16x64_i8(__builtin_bit_cast(i32x4, b), __builtin_bit_cast(i32x4, a), __builtin_bit_cast(i32x4, c), 0, 0, 0));
    else return __builtin_amdgcn_mfma_f32_16x16x32_bf16(b, a, c, 0, 0, 0);
}
template <class Epi, class Sched, bool ALIGN_EPI = false, bool SP2 = false, bool I8 = false>
__device__ __forceinline__ void gemm_phase(PG8_LAS unsigned char* lds, const Gemm g, const Sched& S, const Epi& E) {
    const int tid = threadIdx.x, wid = __builtin_amdgcn_readfirstlane(tid >> 6), lane = tid & 63, wr = wid >> 2, wc = wid & 3, fr = lane & 15, fq = lane >> 4;
    const int K = g.K, nt = K / BK;
    unsigned voffA[2], voffB[2];
#pragma unroll
    for (int i = 0; i < 2; ++i) { int R, C; stage_rc(tid * 16 + i * 8192, R, C); const int Rb = Epi::PERM ? ((R & ~31) + perm32(R & 31)) : R;
        voffA[i] = (unsigned)(R * K + C) * 2u; voffB[i] = (unsigned)(Rb * K + C) * 2u; }
    const size_t kstep = (size_t)(BK * 2);
    const size_t hstep = (size_t)HALF * K * 2;
    const size_t tstep = 2 * hstep;
    const unsigned ldsw = (unsigned)wid * 1024u;
    const int aoff = lds_byte(wr * 64 + fr, fq * 8), boff = lds_byte(wc * 32 + fr, fq * 8);
#define PG8_SA(b, h) (((b) * 2 + (h)) * HTB)
#define PG8_SB(b, h) ((4 + (b) * 2 + (h)) * HTB)
#define PG8_STAGE(bufoff, gbase, voff) do { _Pragma("unroll") for (int _i = 0; _i < 2; ++_i) \
        __builtin_amdgcn_global_load_lds((const unsigned*)((const char*)(gbase) + (voff)[_i]), (PG8_LAS unsigned*)(lds + (bufoff) + ldsw + _i * 8192), 16, 0, 0); } while (0)
#define PG8_LDA(dst, b, h) do { _Pragma("unroll") for (int m = 0; m < 4; ++m) _Pragma("unroll") for (int k = 0; k < 2; ++k) dst[m][k] = *(const PG8_LAS bf16x8*)(lds + PG8_SA(b, h) + aoff + m * 2048 + k * 1024); } while (0)
#define PG8_LDB(dst, b, h) do { _Pragma("unroll") for (int n = 0; n < 2; ++n) _Pragma("unroll") for (int k = 0; k < 2; ++k) dst[n][k] = *(const PG8_LAS bf16x8*)(lds + PG8_SB(b, h) + boff + n * 2048 + k * 1024); } while (0)
#define PG8_MMA(ai, bj, At, Bt) do { __builtin_amdgcn_s_setprio(1); _Pragma("unroll") for (int m = 0; m < 4; ++m) _Pragma("unroll") for (int n = 0; n < 2; ++n) _Pragma("unroll") for (int k = 0; k < 2; ++k) \
        acc[ai][bj][m][n] = mma16<I8>(Bt[n][k], At[m][k], acc[ai][bj][m][n]); __builtin_amdgcn_s_setprio(0); } while (0)
#define PG8_WAIT_V(n) asm volatile("s_waitcnt vmcnt(" #n ")" ::: "memory")
#define PG8_WAIT_L(n) asm volatile("s_waitcnt lgkmcnt(" #n ")" ::: "memory")
#define PG8_BAR __builtin_amdgcn_s_barrier()
#define PG8_SCHED __builtin_amdgcn_sched_barrier(0)
    Unit cur, nxt; int ui = 0;
    if (!S.next(0, cur)) return;
    f32x4 acc[2][2][4][2];
#pragma unroll
    for (int a = 0; a < 2; ++a)
#pragma unroll
        for (int b = 0; b < 2; ++b)
#pragma unroll
            for (int m = 0; m < 4; ++m)
#pragma unroll
                for (int n = 0; n < 2; ++n) acc[a][b][m][n] = (f32x4){0.f, 0.f, 0.f, 0.f};
    bf16x8 At[4][2], B0[2][2], B1[2][2];
    const char* cA = (const char*)g.A + (size_t)cur.pm * tstep; const char* cB = (const char*)g.Bt + (size_t)cur.pn * tstep;
    S.a_ready(cur);
    if constexpr (SP2) {
        PG8_STAGE(PG8_SB(0, 0), cB, voffB); PG8_STAGE(PG8_SB(0, 1), cB + hstep, voffB); PG8_STAGE(PG8_SA(0, 0), cA, voffA); PG8_STAGE(PG8_SA(0, 1), cA + hstep, voffA);
        if (wr == 1) PG8_BAR;
        PG8_WAIT_V(2); PG8_BAR;
        PG8_STAGE(PG8_SB(1, 0), cB + kstep, voffB); PG8_STAGE(PG8_SA(1, 0), cA + kstep, voffA); PG8_STAGE(PG8_SB(1, 1), cB + hstep + kstep, voffB);
        PG8_WAIT_V(6); PG8_BAR;
    } else {
        PG8_STAGE(PG8_SB(0, 0), cB, voffB); PG8_STAGE(PG8_SA(0, 0), cA, voffA); PG8_STAGE(PG8_SB(0, 1), cB + hstep, voffB); PG8_STAGE(PG8_SA(0, 1), cA + hstep, voffA);
        if (wr == 1) PG8_BAR;
        PG8_WAIT_V(4); PG8_BAR;
        PG8_STAGE(PG8_SB(1, 0), cB + kstep, voffB); PG8_STAGE(PG8_SA(1, 0), cA + kstep, voffA); PG8_STAGE(PG8_SB(1, 1), cB + hstep + kstep, voffB);
        PG8_WAIT_V(6); PG8_BAR;
    }
    for (;;) {
        const bool has_next = S.next(ui + 1, nxt);
        const char* nA = has_next ? (const char*)g.A + (size_t)nxt.pm * tstep : cA; const char* nB = has_next ? (const char*)g.Bt + (size_t)nxt.pn * tstep : cB;
        asm volatile(".p2align 8");
        for (int t = 0; t < nt; t += 2) {
            const bool last = (t == nt - 2);
            const char* a1 = cA + (size_t)(t + 1) * kstep;
            const char* a2 = last ? nA : cA + (size_t)(t + 2) * kstep; const char* b2 = last ? nB : cB + (size_t)(t + 2) * kstep;
            const char* a3 = a2 + kstep; const char* b3 = b2 + kstep;
            if (last && has_next) S.a_ready(nxt);
            if constexpr (SP2) {
            PG8_LDB(B0, 0, 0); PG8_LDB(B1, 0, 1); PG8_SCHED; PG8_LDA(At, 0, 0); PG8_STAGE(PG8_SA(1, 1), a1 + hstep, voffA);
            PG8_WAIT_V(8); PG8_WAIT_L(0); PG8_BAR; PG8_MMA(0, 0, At, B0); PG8_MMA(0, 1, At, B1); PG8_BAR; PG8_SCHED;
            PG8_LDA(At, 0, 1); PG8_STAGE(PG8_SB(0, 0), b2, voffB); PG8_STAGE(PG8_SB(0, 1), b2 + hstep, voffB); PG8_STAGE(PG8_SA(0, 0), a2, voffA);
            PG8_WAIT_V(8); PG8_WAIT_L(0); PG8_BAR; PG8_MMA(1, 0, At, B0); PG8_MMA(1, 1, At, B1); PG8_BAR; PG8_SCHED;
            PG8_LDB(B0, 1, 0); PG8_LDB(B1, 1, 1); PG8_SCHED; PG8_LDA(At, 1, 0); PG8_STAGE(PG8_SA(0, 1), a2 + hstep, voffA);
            PG8_WAIT_V(8); PG8_WAIT_L(0); PG8_BAR; PG8_MMA(0, 0, At, B0); PG8_MMA(0, 1, At, B1); PG8_BAR; PG8_SCHED;
            PG8_LDA(At, 1, 1); PG8_STAGE(PG8_SB(1, 0), b3, voffB); PG8_STAGE(PG8_SB(1, 1), b3 + hstep, voffB); PG8_STAGE(PG8_SA(1, 0), a3, voffA);
            PG8_WAIT_V(8); PG8_WAIT_L(0); PG8_BAR; PG8_MMA(1, 0, At, B0); PG8_MMA(1, 1, At, B1); PG8_BAR; PG8_SCHED;
            } else {
            PG8_LDB(B0, 0, 0); PG8_SCHED; PG8_LDA(At, 0, 0); PG8_STAGE(PG8_SA(1, 1), a1 + hstep, voffA);
            PG8_WAIT_L(8); PG8_BAR; PG8_WAIT_L(0); PG8_MMA(0, 0, At, B0); PG8_BAR; PG8_SCHED;
            PG8_LDB(B1, 0, 1); PG8_STAGE(PG8_SB(0, 0), b2, voffB);
            PG8_BAR; PG8_WAIT_L(0); PG8_MMA(0, 1, At, B1); PG8_BAR;
            PG8_LDA(At, 0, 1); PG8_STAGE(PG8_SA(0, 0), a2, voffA);
            PG8_BAR; PG8_WAIT_L(0); PG8_MMA(1, 0, At, B0); PG8_BAR; PG8_SCHED;
            PG8_STAGE(PG8_SB(0, 1), b2 + hstep, voffB);
            PG8_WAIT_V(6); PG8_BAR; PG8_MMA(1, 1, At, B1); PG8_BAR;
            PG8_LDB(B0, 1, 0); PG8_SCHED; PG8_LDA(At, 1, 0); PG8_STAGE(PG8_SA(0, 1), a2 + hstep, voffA);
            PG8_WAIT_L(8); PG8_BAR; PG8_WAIT_L(0); PG8_MMA(0, 0, At, B0); PG8_BAR; PG8_SCHED;
            PG8_LDB(B1, 1, 1); PG8_STAGE(PG8_SB(1, 0), b3, voffB);
            PG8_BAR; PG8_WAIT_L(0); PG8_MMA(0, 1, At, B1); PG8_BAR;
            PG8_LDA(At, 1, 1); PG8_STAGE(PG8_SA(1, 0), a3, voffA);
            PG8_BAR; PG8_WAIT_L(0); PG8_MMA(1, 0, At, B0); PG8_BAR; PG8_SCHED;
            PG8_STAGE(PG8_SB(1, 1), b3 + hstep, voffB);
            PG8_WAIT_V(6); PG8_BAR; PG8_MMA(1, 1, At, B1); PG8_BAR;
            }
        }
        if constexpr (ALIGN_EPI) { if (wr == 0) PG8_BAR; }
        if constexpr (!Epi::AFTER_DRAIN) { E(acc, cur, wr, wc, fr, fq); S.done(cur); }
        if (!has_next) break;
#pragma unroll
        for (int a = 0; a < 2; ++a)
#pragma unroll
            for (int b = 0; b < 2; ++b)
#pragma unroll
                for (int m = 0; m < 4; ++m)
#pragma unroll
                    for (int n = 0; n < 2; ++n) acc[a][b][m][n] = (f32x4){0.f, 0.f, 0.f, 0.f};
        cur = nxt; cA = nA; cB = nB; ++ui;
        if constexpr (ALIGN_EPI) { if (wr == 1) PG8_BAR; }
    }
    PG8_WAIT_V(0);
    if constexpr (!ALIGN_EPI) { if (wr == 0) PG8_BAR; }
    PG8_BAR;
    if constexpr (Epi::AFTER_DRAIN) { E.fused(acc, cur, wr, wc, fr, fq, lds, wid, lane); S.done(cur); }
#undef PG8_SA
#undef PG8_SB
#undef PG8_STAGE
#undef PG8_LDA
#undef PG8_LDB
#undef PG8_MMA
#undef PG8_WAIT_V
#undef PG8_WAIT_L
#undef PG8_BAR
#undef PG8_SCHED
}
}

#define GAS __attribute__((address_space(1)))
#define LAS __attribute__((address_space(3)))
typedef unsigned short bf16;
typedef unsigned v4u __attribute__((ext_vector_type(4)));
typedef unsigned v2u __attribute__((ext_vector_type(2)));
typedef float f32x4 __attribute__((ext_vector_type(4)));
typedef float f32x2 __attribute__((ext_vector_type(2)));
typedef float f32x16 __attribute__((ext_vector_type(16)));
typedef short bf16x8 __attribute__((ext_vector_type(8)));
typedef short s16x4 __attribute__((ext_vector_type(4)));
typedef GAS unsigned gu32;
#define RLX_AGENT __ATOMIC_RELAXED, __HIP_MEMORY_SCOPE_AGENT
#define LDS_WAIT() asm volatile("s_waitcnt lgkmcnt(0)" ::: "memory")
#define VM_WAIT() asm volatile("s_waitcnt vmcnt(0)" ::: "memory")
#define SBAR() __builtin_amdgcn_sched_barrier(0)
__device__ __forceinline__ unsigned f2bf(float f) { unsigned u = __builtin_bit_cast(unsigned, f); return (u + 0x7fffu + ((u >> 16) & 1u)) >> 16; }
__device__ __forceinline__ unsigned pk2(float lo, float hi) { return f2bf(lo) | (f2bf(hi) << 16); }
__device__ __forceinline__ float bf2f(unsigned short b) { return __builtin_bit_cast(float, (unsigned)b << 16); }
__device__ __forceinline__ unsigned cvtpk(float lo, float hi) { unsigned r; asm volatile("v_cvt_pk_bf16_f32 %0, %1, %2" : "=v"(r) : "v"(lo), "v"(hi)); return r; }
__device__ __forceinline__ float wave_sum(float v) {
#pragma unroll
    for (int o = 1; o < 64; o <<= 1) v += __shfl_xor(v, o);
    return v;
}
#define XB_TMO      128
#define XB_XCNT(j)  (256  + 64 * (j))
#define XB_XSUB(j)  (1280 + 64 * (j))
#define XB_XGEN(j)  (2304 + 64 * (j))
#define XB_TOP      3328
#define XB_TOPGEN   3392
#define XCD_BAR_WORDS 3456
#define XB_SPIN_CAP (1u << 18)

__device__ __forceinline__ unsigned xb_ld(unsigned* p)              { return __hip_atomic_load(p, __ATOMIC_RELAXED, __HIP_MEMORY_SCOPE_AGENT); }
__device__ __forceinline__ unsigned xb_add(unsigned* p, unsigned v) { return __hip_atomic_fetch_add(p, v, __ATOMIC_RELAXED, __HIP_MEMORY_SCOPE_AGENT); }
__device__ __forceinline__ unsigned xb_xcc_id() { return (unsigned)__builtin_amdgcn_s_getreg((3 << 11) | 20) & 0xFu; }
#define XB_SPIN(cond, bar) do { unsigned _sp = 0; while (cond) { __builtin_amdgcn_s_sleep(1); \
    if ((++_sp & 255u) == 0u) { if (xb_ld(&(bar)[XB_TMO])) break; if (_sp > XB_SPIN_CAP) { atomicAdd(&(bar)[XB_TMO], 1u); break; } } } } while (0)

struct XcdBarrier {
    unsigned* bar; unsigned x;
    volatile LAS unsigned* st;
};

__device__ __forceinline__ XcdBarrier xcd_barrier_post(unsigned* bar, volatile LAS unsigned* st) {
    XcdBarrier b; b.bar = bar; b.x = xb_xcc_id(); b.st = st;
    if (threadIdx.x == 0) (void)xb_add(&bar[XB_XCNT(b.x)], 1u);
    return b;
}
__device__ __forceinline__ void xcd_barrier_complete(unsigned* bar, unsigned x, unsigned& nloc, unsigned& nx) {
    const unsigned G = gridDim.x * gridDim.y * gridDim.z;
    unsigned sum, cnt, mine, sp = 0u;
    for (;;) {
        sum = 0u; cnt = 0u; mine = 0u;
#pragma unroll
        for (unsigned j = 0; j < 16; ++j) { const unsigned c = xb_ld(&bar[XB_XCNT(j)]); sum += c; cnt += (c > 0u) ? 1u : 0u; mine = (j == x) ? c : mine; }
        if (sum == G) break;
        __builtin_amdgcn_s_sleep(1);
        if ((++sp & 255u) == 0u) { if (xb_ld(&bar[XB_TMO])) break; if (sp > XB_SPIN_CAP) { atomicAdd(&bar[XB_TMO], 1u); break; } }
    }
    nloc = mine > 0u ? mine : 1u; nx = cnt > 0u ? cnt : 1u;
}

__device__ __forceinline__ void xcd_barrier(const XcdBarrier& b) {
    asm volatile("s_waitcnt vmcnt(0)" ::: "memory");
    __syncthreads();
    if (threadIdx.x == 0) {
        unsigned* bar = b.bar;
        __builtin_amdgcn_s_waitcnt(0);
        unsigned nloc = b.st[0], nx = b.st[1];
        if (nloc == 0u) { xcd_barrier_complete(bar, b.x, nloc, nx); b.st[0] = nloc; b.st[1] = nx; }
        const unsigned old = xb_add(&bar[XB_XSUB(b.x)], 1u);
        const unsigned gen = old / nloc;
        if (old + 1u == (gen + 1u) * nloc) {
            __builtin_amdgcn_fence(__ATOMIC_RELEASE, "agent");
            asm volatile("s_waitcnt vmcnt(0)" ::: "memory");
            const unsigned og = xb_add(&bar[XB_TOP], 1u);
            const unsigned tg = og / nx;
            if (og + 1u == (tg + 1u) * nx) xb_add(&bar[XB_TOPGEN], 1u);
            else XB_SPIN(xb_ld(&bar[XB_TOPGEN]) == tg, bar);
            __builtin_amdgcn_fence(__ATOMIC_ACQUIRE, "agent");
            xb_add(&bar[XB_XGEN(b.x)], 1u);
            asm volatile("s_waitcnt vmcnt(0)" ::: "memory");
        } else {
            XB_SPIN(xb_ld(&bar[XB_XGEN(b.x)]) == gen, bar);
            __builtin_amdgcn_fence(__ATOMIC_ACQUIRE, "agent");
            asm volatile("s_waitcnt vmcnt(0)" ::: "memory");
        }
    }
    __syncthreads();
}

constexpr int NWAVES = 8;
constexpr int DM = 2048, MTOK = 16384, MP = 8192, FFH = 8192;
constexpr float EPS = 1e-6f;
constexpr size_t MiB = 1u << 20;
constexpr size_t WS_CTL = 0, CTL_ZERO_BYTES = 1 * MiB;
constexpr size_t WS_MOD = 2 * MiB;
constexpr size_t WS_TABW = 2 * MiB + 655360;
constexpr size_t WS_TABM = 2 * MiB + 720896;
constexpr size_t WS_SW = 3 * MiB;
constexpr size_t WS_W1T = 4 * MiB;
constexpr size_t WS_SCOL = 3 * MiB + 786432;
constexpr size_t WS_W2T = 132 * MiB;
constexpr size_t WS_WQKVT = 260 * MiB;
constexpr size_t WS_WWOT = 284 * MiB;
constexpr size_t WS_SCOLO = 3 * MiB + 786432 + 131072;
constexpr size_t WS_MWDT = 300 * MiB;
constexpr size_t WS_MWUQT = 304 * MiB;
constexpr size_t WS_MWUKVT = 307 * MiB;
constexpr size_t WS_MWOT = 309 * MiB;
constexpr size_t WS_GWINT = 317 * MiB;
constexpr size_t WS_GWOT = 342 * MiB;
constexpr size_t WS_CTXK = 350 * MiB;
constexpr size_t WS_CTXV = 352 * MiB;
constexpr size_t WS_X = 354 * MiB;
constexpr size_t WS_H = 482 * MiB;
constexpr size_t WS_AO = 546 * MiB;
constexpr size_t WS_SCR = 610 * MiB;
constexpr size_t WS_HID = WS_SCR;
constexpr size_t WS_WQ = WS_SCR, WS_WK = WS_SCR + 64 * MiB, WS_WV = WS_SCR + 80 * MiB;
constexpr size_t WS_MD = WS_SCR, WS_MCQ = WS_SCR + 64 * MiB, WS_MCKV = WS_SCR + 80 * MiB, WS_MKR = WS_SCR + 89 * MiB, WS_MQ = WS_SCR + 92 * MiB, WS_MKN = WS_SCR + 188 * MiB, WS_MV = WS_SCR + 256 * MiB;
constexpr size_t WS_GQ = WS_SCR, WS_GK = WS_SCR + 32 * MiB, WS_GV = WS_SCR + 64 * MiB, WS_GR = WS_SCR + 128 * MiB, WS_GU = WS_SCR + 192 * MiB,
                 WS_GQT = WS_SCR + 194 * MiB, WS_GKD = WS_SCR + 258 * MiB, WS_GAM = WS_SCR + 322 * MiB, WS_GDEC = WS_SCR + 338 * MiB, WS_GOF = WS_SCR + 340 * MiB, WS_GOB = WS_SCR + 468 * MiB;
constexpr size_t WS_PART = WS_SCR + 596 * MiB;
constexpr size_t WS_PMAX = WS_PART + 16 * MiB;
constexpr size_t WS_FROW = WS_PMAX + 16 * MiB;
constexpr size_t WS_H8 = WS_FROW + 1 * MiB;
constexpr size_t WS_GLS = WS_H8 + 32 * MiB;
constexpr size_t WS_GDS = WS_GLS + 24 * MiB;
constexpr size_t WS_AO8 = WS_GDS + 1 * MiB;
constexpr size_t WS_AROW = WS_AO8 + 32 * MiB;
constexpr size_t WS_END = WS_AROW + 1 * MiB;
constexpr size_t O_YP = 0, O_YS = 16777216, O_WK = 33554432, O_WV = 41943040, O_CKV = 50331648, O_KR = 52428800, O_GF = 52953088, O_GB = 69730304, O_END = 86507520;
constexpr int CW_BAR = 4096;
constexpr int RING_BYTES = 131072, MISC_OFF = 159744 + 320, LDS_BYTES = 163840;

struct Args {
    const float* in[32]; float* out; unsigned char* ws; int ph_lo, ph_hi, li, pad; unsigned long long rep_mask; int rep_n, pad2;
};
enum { I_XP = 0, I_XS, I_C, I_CWK, I_CWV, I_CCKV, I_CKR, I_SGF, I_SGB, I_CCTX, I_ADAW, I_ADAB, I_NORMG, I_WQKV, I_SINK, I_WWO, I_MWD, I_MQN, I_MWUQ, I_MKVN, I_MWUKV, I_MWO,
       I_GWIN, I_GWA1, I_GWA2, I_GBA, I_GNORM, I_GWO, I_W1, I_W2, I_FNORM };

__device__ __forceinline__ int cond_of_pm(int pm) { return pm < 32 ? 0 : (pm >> 4) - 1; }

__device__ __forceinline__ v4u pack8(const f32x4& a, const f32x4& b) { v4u w; w.x = cvtpk(a[0], a[1]); w.y = cvtpk(a[2], a[3]); w.z = cvtpk(b[0], b[1]); w.w = cvtpk(b[2], b[3]); return w; }

struct NormIn {
    const float* part; const float* sW; const LAS float* lrs; int pm0;
    __device__ __forceinline__ float rstd(int row, int pm) const {
        if (pm == pm0) return lrs[row & 255];
        const f32x4* pp = (const f32x4*)(part + (size_t)row * 32); f32x4 t = pp[0];
#pragma unroll
        for (int i = 1; i < 8; ++i) t += pp[i];
        return rsqrtf(((t[0] + t[1]) + (t[2] + t[3])) * (1.f / 2048.f) + EPS);
    }
    __device__ __forceinline__ const float* swp(int pm) const { return sW + (size_t)cond_of_pm(pm) * 8192; }
};

template <bool I8> struct EpiResidT {
    static constexpr bool PERM = true, AFTER_DRAIN = false;
    const float* xp; const float* xs; float* X; const float* gate; int first;
    const float* arow; const float* scol;
    bf16* H; const float* ng; const float* nsc; float* rss; float* rmx;
    __device__ __forceinline__ void operator()(const pg8::f32x4 (&acc)[2][2][4][2], const pg8::Unit& u, int wr, int wc, int fr, int fq) const {
        const int row0 = u.pm * 256 + wr * 64 + fr, col0 = u.pn * 256 + wc * 32 + 8 * fq, cond = cond_of_pm(u.pm);
        const float* gp = gate + (size_t)cond * 12288 + col0;
        f32x4 gv[2][2], av[2][2];
#pragma unroll
        for (int bj = 0; bj < 2; ++bj)
#pragma unroll
            for (int n = 0; n < 2; ++n) { gv[bj][n] = *(const f32x4*)(gp + bj * 128 + 4 * n); if constexpr (I8) gv[bj][n] = gv[bj][n] * *(const f32x4*)(scol + col0 + bj * 128 + 4 * n);
                av[bj][n] = H ? *(const f32x4*)(ng + col0 + bj * 128 + 4 * n) * (*(const f32x4*)(nsc + (size_t)cond * 12288 + col0 + bj * 128 + 4 * n) + 1.f) : (f32x4){0.f, 0.f, 0.f, 0.f}; }
        f32x4 xv[2][2][2];
#define ER_LOAD(r, buf) do { const int row_ = row0 + ((r) >> 2) * 128 + ((r) & 3) * 16; const float* sp_ = first ? (row_ < MP ? xp + (size_t)row_ * DM : xs + (size_t)(row_ - MP) * DM) : X + (size_t)row_ * DM; \
        _Pragma("unroll") for (int bj = 0; bj < 2; ++bj) { xv[buf][bj][0] = *(const f32x4*)(sp_ + col0 + bj * 128); xv[buf][bj][1] = *(const f32x4*)(sp_ + col0 + bj * 128 + 4); } } while (0)
        ER_LOAD(0, 0);
#pragma unroll
        for (int r = 0; r < 8; ++r) {
            if (r + 1 < 8) ER_LOAD(r + 1, (r + 1) & 1);
            SBAR();
            const int ai = r >> 2, m = r & 3, row = row0 + ai * 128 + m * 16;
            float* dp = X + (size_t)row * DM;
            float ar_ = 1.f; if constexpr (I8) ar_ = arow[row];
            float ss = 0.f, mx = 0.f;
#pragma unroll
            for (int bj = 0; bj < 2; ++bj) {
                const int c = col0 + bj * 128;
                f32x4 a0 = acc[ai][bj][m][0], a1 = acc[ai][bj][m][1];
                if constexpr (I8) { const pg8::i32x4 i0 = __builtin_bit_cast(pg8::i32x4, a0), i1 = __builtin_bit_cast(pg8::i32x4, a1);
                    a0 = (f32x4){(float)i0[0], (float)i0[1], (float)i0[2], (float)i0[3]} * ar_; a1 = (f32x4){(float)i1[0], (float)i1[1], (float)i1[2], (float)i1[3]} * ar_; }
                const f32x4 x0 = xv[r & 1][bj][0] + gv[bj][0] * a0, x1 = xv[r & 1][bj][1] + gv[bj][1] * a1;
                *(f32x4*)(dp + c) = x0; *(f32x4*)(dp + c + 4) = x1;
                if (H) { ss += (x0[0] * x0[0] + x0[1] * x0[1]) + (x0[2] * x0[2] + x0[3] * x0[3]) + (x1[0] * x1[0] + x1[1] * x1[1]) + (x1[2] * x1[2] + x1[3] * x1[3]);
                    const v4u hw = pack8(x0 * av[bj][0], x1 * av[bj][1]);
                    *(v4u*)(H + (size_t)row * DM + c) = hw;
                    if (rmx) {
#pragma unroll
                        for (int e = 0; e < 4; ++e) { mx = fmaxf(mx, fabsf(__builtin_bit_cast(float, hw[e] << 16))); mx = fmaxf(mx, fabsf(__builtin_bit_cast(float, hw[e] & 0xffff0000u))); } } }
            }
            if (H) { ss += __shfl_xor(ss, 16); ss += __shfl_xor(ss, 32);
                if (rmx) { mx = fmaxf(mx, __shfl_xor(mx, 16)); mx = fmaxf(mx, __shfl_xor(mx, 32)); }
                if (fq == 0) { rss[(size_t)row * 32 + u.pn * 4 + wc] = ss; if (rmx) rmx[(size_t)row * 32 + u.pn * 4 + wc] = mx; } }
            SBAR();
        }
#undef ER_LOAD
    }
};

struct EpiRelu2 {
    static constexpr bool PERM = true, AFTER_DRAIN = false;
    bf16* O; int ldc; NormIn ni;
    __device__ __forceinline__ void operator()(const pg8::f32x4 (&acc)[2][2][4][2], const pg8::Unit& u, int wr, int wc, int fr, int fq) const {
        const int row0 = u.pm * 256 + wr * 64 + fr, col0 = u.pn * 256 + wc * 32 + 8 * fq;
        const float* swp = ni.swp(u.pm) + col0; f32x4 sw[2][2];
#pragma unroll
        for (int bj = 0; bj < 2; ++bj)
#pragma unroll
            for (int n = 0; n < 2; ++n) sw[bj][n] = *(const f32x4*)(swp + bj * 128 + 4 * n);
#pragma unroll
        for (int ai = 0; ai < 2; ++ai)
#pragma unroll
            for (int m = 0; m < 4; ++m) {
                const int row = row0 + ai * 128 + m * 16; const float rs = ni.rstd(row, u.pm);
                bf16* rp = O + (size_t)row * ldc + col0;
#pragma unroll
                for (int bj = 0; bj < 2; ++bj) {
                    f32x4 a = acc[ai][bj][m][0] * rs + sw[bj][0], b = acc[ai][bj][m][1] * rs + sw[bj][1];
                    a = __builtin_elementwise_max(a, (f32x4){0.f, 0.f, 0.f, 0.f}); b = __builtin_elementwise_max(b, (f32x4){0.f, 0.f, 0.f, 0.f});
                    a = a * a; b = b * b;
                    *(v4u*)(rp + bj * 128) = pack8(a, b);
                }
            }
    }
};

typedef EpiResidT<false> EpiResid;

struct EpiRelu2I8 {
    static constexpr bool PERM = true, AFTER_DRAIN = false;
    bf16* O; int ldc; const float* frow; const float* scol; const float* sW;
    __device__ __forceinline__ void operator()(const pg8::f32x4 (&acc)[2][2][4][2], const pg8::Unit& u, int wr, int wc, int fr, int fq) const {
        const int row0 = u.pm * 256 + wr * 64 + fr, col0 = u.pn * 256 + wc * 32 + 8 * fq;
        const float* swp = sW + (size_t)cond_of_pm(u.pm) * 8192 + col0; f32x4 sw[2][2], sc[2][2];
#pragma unroll
        for (int bj = 0; bj < 2; ++bj)
#pragma unroll
            for (int n = 0; n < 2; ++n) { sw[bj][n] = *(const f32x4*)(swp + bj * 128 + 4 * n); sc[bj][n] = *(const f32x4*)(scol + col0 + bj * 128 + 4 * n); }
#pragma unroll
        for (int ai = 0; ai < 2; ++ai)
#pragma unroll
            for (int m = 0; m < 4; ++m) {
                const int row = row0 + ai * 128 + m * 16; const float fr_ = frow[row];
                bf16* rp = O + (size_t)row * ldc + col0;
#pragma unroll
                for (int bj = 0; bj < 2; ++bj) {
                    const pg8::i32x4 i0 = __builtin_bit_cast(pg8::i32x4, acc[ai][bj][m][0]), i1 = __builtin_bit_cast(pg8::i32x4, acc[ai][bj][m][1]);
                    f32x4 a = {(float)i0[0], (float)i0[1], (float)i0[2], (float)i0[3]}, b = {(float)i1[0], (float)i1[1], (float)i1[2], (float)i1[3]};
                    a = a * (sc[bj][0] * fr_) + sw[bj][0]; b = b * (sc[bj][1] * fr_) + sw[bj][1];
                    a = __builtin_elementwise_max(a, (f32x4){0.f, 0.f, 0.f, 0.f}); b = __builtin_elementwise_max(b, (f32x4){0.f, 0.f, 0.f, 0.f});
                    a = a * a; b = b * b;
                    *(v4u*)(rp + bj * 128) = pack8(a, b);
                }
            }
    }
};

struct EpiF32 {
    static constexpr bool PERM = true, AFTER_DRAIN = false;
    float* O; int ldc; NormIn ni;
    __device__ __forceinline__ void operator()(const pg8::f32x4 (&acc)[2][2][4][2], const pg8::Unit& u, int wr, int wc, int fr, int fq) const {
        const int row0 = u.pm * 256 + wr * 64 + fr, col0 = u.pn * 256 + wc * 32 + 8 * fq;
        const float* swp = ni.swp(u.pm) + col0; f32x4 sw[2][2];
#pragma unroll
        for (int bj = 0; bj < 2; ++bj)
#pragma unroll
            for (int n = 0; n < 2; ++n) sw[bj][n] = *(const f32x4*)(swp + bj * 128 + 4 * n);
#pragma unroll
        for (int ai = 0; ai < 2; ++ai)
#pragma unroll
            for (int m = 0; m < 4; ++m) {
                const int row = row0 + ai * 128 + m * 16; const float rs = ni.rstd(row, u.pm);
                float* rp = O + (size_t)row * ldc + col0;
#pragma unroll
                for (int bj = 0; bj < 2; ++bj) { *(f32x4*)(rp + bj * 128) = acc[ai][bj][m][0] * rs + sw[bj][0]; *(f32x4*)(rp + bj * 128 + 4) = acc[ai][bj][m][1] * rs + sw[bj][1]; }
            }
    }
};

struct EpiQkvWin {
    static constexpr bool PERM = true, AFTER_DRAIN = false;
    bf16 *Q, *K, *V; float* outk; float* outv; int j; const f32x2* tab; NormIn ni;
    __device__ __forceinline__ void operator()(const pg8::f32x4 (&acc)[2][2][4][2], const pg8::Unit& u, int wr, int wc, int fr, int fq) const {
        const int row0 = u.pm * 256 + wr * 64 + fr, cl = wc * 32 + 8 * fq;
        const int pn = u.pn; const bool sample = u.pm >= 32;
        const int ug = 4 * wc + fq, idx0 = (ug & 7) * 4, d1 = (ug < 8 ? 0 : 64) + idx0;
        const float* swp = ni.swp(u.pm) + u.pn * 256 + cl; f32x4 sw[2][2];
#pragma unroll
        for (int bj = 0; bj < 2; ++bj)
#pragma unroll
            for (int n = 0; n < 2; ++n) sw[bj][n] = *(const f32x4*)(swp + bj * 128 + 4 * n);
#pragma unroll
        for (int ai = 0; ai < 2; ++ai)
#pragma unroll
            for (int m = 0; m < 4; ++m) {
                const int row = row0 + ai * 128 + m * 16; const float rs = ni.rstd(row, u.pm);
                f32x4 cs0 = {1.f, 0.f, 1.f, 0.f}, cs1 = {1.f, 0.f, 1.f, 0.f};
                if (sample && pn < 10) { const int t = row & 4095, pos = (ug < 8) ? (t >> 6) : (t & 63); const f32x4* tp = (const f32x4*)(tab + pos * 32 + idx0); cs0 = tp[0]; cs1 = tp[1]; }
#pragma unroll
                for (int bj = 0; bj < 2; ++bj) {
                    f32x4 a = acc[ai][bj][m][0] * rs + sw[bj][0], b = acc[ai][bj][m][1] * rs + sw[bj][1];
                    if (pn < 10) {
                        if (sample) {
                            const f32x4 co = {cs0[0], cs0[2], cs1[0], cs1[2]}, si = {cs0[1], cs0[3], cs1[1], cs1[3]};
                            const f32x4 na = a * co - b * si, nb = b * co + a * si; a = na; b = nb;
                        }
                        if (pn < 8) { *(v4u*)(Q + (size_t)row * 2048 + pn * 256 + bj * 128 + cl) = pack8(a, b); }
                        else {
                            const int kvh = (pn - 8) * 2 + bj;
                            *(v4u*)(K + (size_t)row * 512 + kvh * 128 + cl) = pack8(a, b);
                            if (!sample) { float* op = outk + ((size_t)(u.pm * 2 + j) * 256 + (row & 255)) * 512 + kvh * 128 + d1; *(f32x4*)op = a; *(f32x4*)(op + 32) = b; }
                        }
                    } else {
                        const int kvh = (pn - 10) * 2 + bj;
                        *(v4u*)(V + (size_t)row * 512 + kvh * 128 + cl) = pack8(a, b);
                        if (!sample) { float* op = outv + ((size_t)(u.pm * 2 + j) * 256 + (row & 255)) * 512 + kvh * 128 + cl; *(f32x4*)op = a; *(f32x4*)(op + 4) = b; }
                    }
                }
            }
    }
};

struct EpiMlaQ {
    static constexpr bool PERM = true, AFTER_DRAIN = false;
    bf16* Q; const f32x2* tab;
    __device__ __forceinline__ void operator()(const pg8::f32x4 (&acc)[2][2][4][2], const pg8::Unit& u, int wr, int wc, int fr, int fq) const {
        const int row0 = u.pm * 256 + wr * 64 + fr, col0 = u.pn * 256 + wc * 32 + 8 * fq;
        const bool sample = u.pm >= 32;
#pragma unroll
        for (int bj = 0; bj < 2; ++bj) {
            const int c0 = col0 + bj * 128, p0 = c0 % 192; const bool isr = p0 >= 128; const int ug = isr ? ((p0 - 128) >> 3) : 0, idx0 = (ug & 3) * 4;
#pragma unroll
            for (int ai = 0; ai < 2; ++ai)
#pragma unroll
                for (int m = 0; m < 4; ++m) {
                    const int row = row0 + ai * 128 + m * 16;
                    f32x4 a = acc[ai][bj][m][0], b = acc[ai][bj][m][1];
                    if (sample) {
                        const int t = row & 4095, pos = (ug < 4) ? (t >> 6) : (t & 63); const f32x4* tp = (const f32x4*)(tab + pos * 16 + idx0); const f32x4 cs0 = tp[0], cs1 = tp[1];
                        const f32x4 co = {cs0[0], cs0[2], cs1[0], cs1[2]}, si = {cs0[1], cs0[3], cs1[1], cs1[3]};
                        const f32x4 na = a * co - b * si, nb = b * co + a * si;
                        if (isr) { a = na; b = nb; }
                    }
                    *(v4u*)(Q + (size_t)row * 3072 + c0) = pack8(a, b);
                }
        }
    }
};

struct EpiMlaKV {
    static constexpr bool PERM = true, AFTER_DRAIN = false;
    bf16 *KN, *V;
    __device__ __forceinline__ void operator()(const pg8::f32x4 (&acc)[2][2][4][2], const pg8::Unit& u, int wr, int wc, int fr, int fq) const {
        const int row0 = u.pm * 256 + wr * 64 + fr, cl = u.pn * 128 + wc * 32 + 8 * fq;
#pragma unroll
        for (int ai = 0; ai < 2; ++ai)
#pragma unroll
            for (int m = 0; m < 4; ++m) {
                const size_t ro = (size_t)(row0 + ai * 128 + m * 16) * 2048 + cl;
                *(v4u*)(KN + ro) = pack8(acc[ai][0][m][0], acc[ai][0][m][1]);
                *(v4u*)(V + ro) = pack8(acc[ai][1][m][0], acc[ai][1][m][1]);
            }
    }
};

struct EpiGlaIn {
    static constexpr bool PERM = true, AFTER_DRAIN = false;
    bf16 *q, *k, *v, *r; float* uo; NormIn ni;
    __device__ __forceinline__ void operator()(const pg8::f32x4 (&acc)[2][2][4][2], const pg8::Unit& u, int wr, int wc, int fr, int fq) const {
        const int row0 = u.pm * 256 + wr * 64 + fr, cl = wc * 32 + 8 * fq; const int pn = u.pn;
        const float* swp = ni.swp(u.pm) + pn * 256 + cl; f32x4 sw[2][2];
#pragma unroll
        for (int bj = 0; bj < 2; ++bj)
#pragma unroll
            for (int n = 0; n < 2; ++n) sw[bj][n] = *(const f32x4*)(swp + bj * 128 + 4 * n);
#pragma unroll
        for (int ai = 0; ai < 2; ++ai)
#pragma unroll
            for (int m = 0; m < 4; ++m) {
                const int row = row0 + ai * 128 + m * 16; const float rs = ni.rstd(row, u.pm);
#pragma unroll
                for (int bj = 0; bj < 2; ++bj) {
                    f32x4 a = acc[ai][bj][m][0] * rs + sw[bj][0], b = acc[ai][bj][m][1] * rs + sw[bj][1];
                    const int c = pn * 256 + bj * 128 + cl;
                    if (pn < 4) { a = a * 0.0625f; b = b * 0.0625f; *(v4u*)(q + (size_t)row * 1024 + c) = pack8(a, b); }
                    else if (pn < 8) { *(v4u*)(k + (size_t)row * 1024 + (c - 1024)) = pack8(a, b); }
                    else if (pn < 16) { *(v4u*)(v + (size_t)row * 2048 + (c - 2048)) = pack8(a, b); }
                    else if (pn < 24) { *(v4u*)(r + (size_t)row * 2048 + (c - 4096)) = pack8(a, b); }
                    else if (bj == 0 && wc == 0) { float* op = uo + (size_t)row * 32 + 8 * fq; *(f32x4*)op = a; *(f32x4*)(op + 4) = b; }
                }
            }
    }
};

struct Frame {
    LAS unsigned char* lds; unsigned char* ldsg;
    int tid, lane, wave, G, bx;
    const float* const* in; float* out; unsigned char* ws;
};
#define WSP(T, off) ((T*)(F.ws + (off)))
constexpr int LDS_RSTD_OFF = 131072;
__device__ __forceinline__ int prep_rstd(Frame& F, const pg8::StaticOrder& S, int site) {
    pg8::Unit u0; int pm0 = -1; if (S.next(0, u0)) pm0 = u0.pm;
    LAS float* lrs = (LAS float*)(F.lds + LDS_RSTD_OFF);
    if (pm0 >= 0 && F.tid < 256) { const int row = pm0 * 256 + F.tid; const f32x4* pp = (const f32x4*)(WSP(float, WS_PART) + ((size_t)site * MTOK + row) * 32); f32x4 t = pp[0];
#pragma unroll
        for (int i = 1; i < 8; ++i) t += pp[i];
        lrs[F.tid] = rsqrtf(((t[0] + t[1]) + (t[2] + t[3])) * (1.f / 2048.f) + EPS); }
    __syncthreads();
    return pm0;
}

__device__ __forceinline__ int perm_win(int p) { const int u = p >> 3, v = p & 7; return (u < 8 ? 0 : 64) + (u & 7) * 4 + (v & 3) + ((v & 4) ? 32 : 0); }
__device__ __forceinline__ int perm_mla(int p) { const int u = p >> 3, v = p & 7; return (u < 4 ? 0 : 32) + (u & 3) * 4 + (v & 3) + ((v & 4) ? 16 : 0); }
__device__ __forceinline__ int srcmap(int mode, int n) {
    if (mode == 1) { if (n >= 2560) return n; return (n & ~127) + perm_win(n & 127); }
    if (mode == 2) { if (n < 768) return n; if (n >= 832) return -1; return 768 + perm_mla(n - 768); }
    if (mode == 3) { const int hh = n / 192, p = n - hh * 192; if (p < 128) return n; return hh * 192 + 128 + perm_mla(p - 128); }
    return n;
}
#ifndef WMANT
#define WMANT 7
#endif
__device__ __forceinline__ unsigned f2bfw(float f) { constexpr int sh = 23 - WMANT; unsigned u = __builtin_bit_cast(unsigned, f); u += ((1u << sh) >> 1) - 1u + ((u >> sh) & 1u); u &= ~((1u << sh) - 1u); return u >> 16; }
__device__ __forceinline__ unsigned pk2w(float lo, float hi) { return f2bfw(lo) | (f2bfw(hi) << 16); }
__device__ __forceinline__ void tr_item(const float* W, int K, int Nsrc, int nblk, bf16* WT, int mode, LAS float* scr, int item, int lane) {
    const int kb = item / nblk, nb = item - kb * nblk, k0 = 64 * kb, n0 = 64 * nb;
    const int ln = (lane & 15) * 4, lk = lane >> 4;
    const int sc = srcmap(mode, n0 + ln);
    f32x4 v[16];
    const float* Wp = W + (size_t)(k0 + lk) * Nsrc + (sc >= 0 ? sc : 0);
#pragma unroll
    for (int i = 0; i < 16; ++i) v[i] = sc >= 0 ? __builtin_nontemporal_load((const f32x4*)(Wp + (size_t)(4 * i) * Nsrc)) : (f32x4){0.f, 0.f, 0.f, 0.f};
#pragma unroll
    for (int i = 0; i < 16; ++i) { LAS float* d = scr + (4 * i + lk) * 65 + ln; d[0] = v[i][0]; d[1] = v[i][1]; d[2] = v[i][2]; d[3] = v[i][3]; }
    LDS_WAIT(); asm volatile("" ::: "memory");
    const int c = lane & 7;
#pragma unroll
    for (int jj = 0; jj < 8; ++jj) { const int n = (lane >> 3) + 8 * jj; const LAS float* s = scr + (8 * c) * 65 + n;
        v4u o; o.x = pk2w(s[0 * 65], s[1 * 65]); o.y = pk2w(s[2 * 65], s[3 * 65]); o.z = pk2w(s[4 * 65], s[5 * 65]); o.w = pk2w(s[6 * 65], s[7 * 65]);
        *(GAS v4u*)(WT + (size_t)(n0 + n) * K + k0 + 8 * c) = o; }
    LDS_WAIT(); asm volatile("" ::: "memory");
}

__device__ __forceinline__ const float* wo_src(Frame& F, int lw) { return lw == 0 ? F.in[I_WWO] : (lw == 1 ? F.in[I_MWO] : (lw == 2 ? F.in[I_GWO] : F.in[I_WWO] + (size_t)2048 * 2048)); }
__device__ __forceinline__ void tr_item_q8(const float* W, int N, int nblk, signed char* Wq, const float* scol, LAS float* scr, int item, int lane) {
    constexpr int K = 2048;
    const int kb = item / nblk, nb = item - kb * nblk, k0 = 64 * kb, n0 = 64 * nb;
    const int ln = (lane & 15) * 4, lk = lane >> 4;
    f32x4 v[16];
    const float* Wp = W + (size_t)(k0 + lk) * N + n0 + ln;
#pragma unroll
    for (int i = 0; i < 16; ++i) v[i] = __builtin_nontemporal_load((const f32x4*)(Wp + (size_t)(4 * i) * N));
#pragma unroll
    for (int i = 0; i < 16; ++i) { LAS float* d = scr + (4 * i + lk) * 65 + ln; d[0] = v[i][0]; d[1] = v[i][1]; d[2] = v[i][2]; d[3] = v[i][3]; }
    LDS_WAIT(); asm volatile("" ::: "memory");
    const int c = lane & 7;
#pragma unroll
    for (int jj = 0; jj < 8; ++jj) { const int n = (lane >> 3) + 8 * jj; const LAS float* s = scr + (8 * c) * 65 + n; const float inv = 1.f / scol[n0 + n];
        unsigned b[8];
#pragma unroll
        for (int e = 0; e < 8; ++e) { int q = (int)rintf(s[e * 65] * inv); q = q > 127 ? 127 : (q < -127 ? -127 : q); b[e] = (unsigned)q & 0xffu; }
        v2u o; o.x = b[0] | (b[1] << 8) | (b[2] << 16) | (b[3] << 24); o.y = b[4] | (b[5] << 8) | (b[6] << 16) | (b[7] << 24);
        *(GAS v2u*)(Wq + (size_t)(n0 + n) * K + k0 + 8 * c) = o; }
    LDS_WAIT(); asm volatile("" ::: "memory");
}

__device__ __forceinline__ void q8w_item(Frame& F, const float* W, int N, int n0, signed char* Wq, float* scol) {
    const int tid = F.tid, lane = F.lane, wave = F.wave, cg = tid & 7, rq = tid >> 3;
    LAS unsigned char* T = F.lds; LAS float* red = (LAS float*)(F.lds + 32 * 2064);
    f32x4 v[8][4];
    const float* wp = W + (size_t)(4 * rq) * N + n0 + 4 * cg;
#pragma unroll
    for (int i = 0; i < 8; ++i)
#pragma unroll
        for (int j = 0; j < 4; ++j) v[i][j] = __builtin_nontemporal_load((const f32x4*)(wp + (size_t)(256 * i + j) * N));
    f32x4 m = {0.f, 0.f, 0.f, 0.f};
#pragma unroll
    for (int i = 0; i < 8; ++i)
#pragma unroll
        for (int j = 0; j < 4; ++j) m = __builtin_elementwise_max(m, __builtin_elementwise_abs(v[i][j]));
#pragma unroll
    for (int o = 8; o < 64; o <<= 1) { m[0] = fmaxf(m[0], __shfl_xor(m[0], o)); m[1] = fmaxf(m[1], __shfl_xor(m[1], o)); m[2] = fmaxf(m[2], __shfl_xor(m[2], o)); m[3] = fmaxf(m[3], __shfl_xor(m[3], o)); }
    if (lane < 8) *(LAS f32x4*)(red + wave * 32 + 4 * lane) = m;
    __syncthreads();
    f32x4 mm = *(const LAS f32x4*)(red + 4 * cg);
#pragma unroll
    for (int w8 = 1; w8 < 8; ++w8) mm = __builtin_elementwise_max(mm, *(const LAS f32x4*)(red + w8 * 32 + 4 * cg));
    f32x4 sc, inv;
#pragma unroll
    for (int c = 0; c < 4; ++c) { sc[c] = fmaxf(mm[c], 1e-30f) * (1.f / 127.f); inv[c] = 1.f / sc[c]; }
    if (tid < 8) *(f32x4*)(scol + n0 + 4 * cg) = sc;
#pragma unroll
    for (int i = 0; i < 8; ++i)
#pragma unroll
        for (int c = 0; c < 4; ++c) { unsigned b[4];
#pragma unroll
            for (int j = 0; j < 4; ++j) { int q = (int)rintf(v[i][j][c] * inv[c]); q = q > 127 ? 127 : (q < -127 ? -127 : q); b[j] = (unsigned)q & 0xffu; }
            *(LAS unsigned*)(T + (4 * cg + c) * 2064 + 256 * i + 4 * rq) = b[0] | (b[1] << 8) | (b[2] << 16) | (b[3] << 24); }
    __syncthreads();
    { const int row = tid >> 4, c16 = tid & 15; signed char* dp = Wq + (size_t)(n0 + row) * 2048;
#pragma unroll
      for (int j = 0; j < 8; ++j) { const int ch = c16 + 16 * j; *(v4u*)(dp + 16 * ch) = *(const LAS v4u*)(T + row * 2064 + 16 * ch); } }
    __syncthreads();
}

__device__ __forceinline__ void p0_prologue(Frame& F) {
    const int tid = F.tid, lane = F.lane, wave = F.wave;
    for (int it = F.bx; it < 192; it += F.G) {
        const int l = it / 48, nb = it - l * 48;
        LAS float* sl = (LAS float*)F.lds; LAS float* red = sl + 3 * 2048;
        for (int e = tid; e < 3 * 2048; e += 512) { const int c = e >> 11, k = e & 2047; const float v = (c == 0) ? F.in[I_CCTX][k] : F.in[I_C][(c - 1) * 2048 + k]; sl[e] = v / (1.f + __expf(-v)); }
        __syncthreads();
        const float* Wp = F.in[I_ADAW] + ((size_t)l * 2048 + wave * 256) * 12288 + nb * 256 + lane * 4;
        f32x4 a0 = {0.f, 0.f, 0.f, 0.f}, a1 = a0, a2 = a0;
        for (int k = 0; k < 256; k += 8) {
            f32x4 w[8];
#pragma unroll
            for (int jj = 0; jj < 8; ++jj) w[jj] = __builtin_nontemporal_load((const f32x4*)(Wp + (size_t)(k + jj) * 12288));
#pragma unroll
            for (int jj = 0; jj < 8; ++jj) { const int kk = wave * 256 + k + jj; a0 += w[jj] * sl[kk]; a1 += w[jj] * sl[2048 + kk]; a2 += w[jj] * sl[4096 + kk]; }
        }
        *(LAS f32x4*)(red + (wave * 3 + 0) * 256 + lane * 4) = a0; *(LAS f32x4*)(red + (wave * 3 + 1) * 256 + lane * 4) = a1; *(LAS f32x4*)(red + (wave * 3 + 2) * 256 + lane * 4) = a2;
        __syncthreads();
        for (int e = tid; e < 768; e += 512) { const int c = e >> 8, n = e & 255; float s = F.in[I_ADAB][l * 12288 + nb * 256 + n];
#pragma unroll
            for (int w8 = 0; w8 < 8; ++w8) s += red[(w8 * 3 + c) * 256 + n];
            WSP(float, WS_MOD)[(size_t)(l * 3 + c) * 12288 + nb * 256 + n] = s; }
        __syncthreads();
    }
    if (F.bx == F.G - 1) {
        for (int e = tid; e < 64 * 32; e += 512) { const int pos = e >> 5, i = e & 31; const float inv = exp2f(-(float)i * (13.287712379549449f / 32.f)); const float ang = (float)pos * inv;
            WSP(f32x2, WS_TABW)[e] = (f32x2){cosf(ang), sinf(ang)}; }
        for (int e = tid; e < 64 * 16; e += 512) { const int pos = e >> 4, i = e & 15; const float inv = exp2f(-(float)i * (13.287712379549449f / 16.f)); const float ang = (float)pos * inv;
            WSP(f32x2, WS_TABM)[e] = (f32x2){cosf(ang), sinf(ang)}; }
    }
    const int gt = F.bx * 512 + tid, NGT = F.G * 512;
    for (int e = gt; e < 2 * 2 * 512 * 512; e += NGT) {
        const int c = e & 511, pos = (e >> 9) & 511, b = (e >> 18) & 1, jj = e >> 19;
        const size_t sbase = (((size_t)b * 2 + jj) * 512 + pos) * 512;
        WSP(bf16, WS_CTXK)[e] = (bf16)f2bf(F.in[I_CWK][sbase + (c & ~127) + perm_win(c & 127)]);
        WSP(bf16, WS_CTXV)[e] = (bf16)f2bf(F.in[I_CWV][sbase + c]);
    }
    for (int e = gt; e < 256 * 2048; e += NGT) { const int n = e >> 11, k = e & 2047; float v = 0.f; if (n < 32) v = F.in[I_GWA1][((size_t)(n >> 4) * 2048 + k) * 16 + (n & 15)];
        WSP(bf16, WS_GWINT)[(size_t)(6144 + n) * 2048 + k] = (bf16)f2bf(v); }
    LAS float* scr = (LAS float*)(F.lds + wave * 16640);
    constexpr int C_W2 = 128 * 32, C_QKV = 32 * 48, C_MWD = 32 * 16, C_MUQ = 8 * 48, C_MUKV = 4 * 64, C_GWIN = 32 * 96;
    constexpr int NITEMS = 4 * C_W2 + 2 * C_QKV + C_MWD + C_MUQ + C_MUKV + C_GWIN;
    const bool bal = (F.G == 256);
    const int nslot = bal ? (F.bx < 192 ? 1 : 2) : 1;
    const int slot0 = bal ? (F.bx < 192 ? F.bx : 192 + (F.bx - 192) * 2) : F.bx;
    const int NVW = (bal ? 320 : F.G) * NWAVES;
    for (int sl = 0; sl < nslot; ++sl)
    for (int it = (slot0 + sl) * NWAVES + wave; it < NITEMS; it += NVW) {
        int r = it;
        if (r < 4 * C_W2) { const int l = r / C_W2; r -= l * C_W2; tr_item(F.in[I_W2] + (size_t)l * 8192 * 2048, 8192, 2048, 32, WSP(bf16, WS_W2T) + (size_t)l * 2048 * 8192, 0, scr, r, lane); continue; } r -= 4 * C_W2;
        if (r < 2 * C_QKV) { const int l = r / C_QKV; r -= l * C_QKV; tr_item(F.in[I_WQKV] + (size_t)l * 2048 * 3072, 2048, 3072, 48, WSP(bf16, WS_WQKVT) + (size_t)l * 3072 * 2048, 1, scr, r, lane); continue; } r -= 2 * C_QKV;
        if (r < C_MWD) { tr_item(F.in[I_MWD], 2048, 832, 16, WSP(bf16, WS_MWDT), 2, scr, r, lane); continue; } r -= C_MWD;
        if (r < C_MUQ) { tr_item(F.in[I_MWUQ], 512, 3072, 48, WSP(bf16, WS_MWUQT), 3, scr, r, lane); continue; } r -= C_MUQ;
        if (r < C_MUKV) { tr_item(F.in[I_MWUKV], 256, 4096, 64, WSP(bf16, WS_MWUKVT), 0, scr, r, lane); continue; } r -= C_MUKV;
        tr_item(F.in[I_GWIN], 2048, 6144, 96, WSP(bf16, WS_GWINT), 0, scr, r, lane);
    }
}

__device__ __forceinline__ const float* x_row(Frame& F, int L, int row) {
    return L == 0 ? (row < MP ? F.in[I_XP] + (size_t)row * DM : F.in[I_XS] + (size_t)(row - MP) * DM) : WSP(float, WS_X) + (size_t)row * DM;
}
__device__ __forceinline__ void p1_phase(Frame& F) {
    const int gw = F.bx * NWAVES + F.wave, NGW = F.G * NWAVES, lane = F.lane;
    for (int rb = gw; rb < MTOK / 8; rb += NGW) {
        const int row0 = rb * 8, cond = row0 < MP ? 0 : (row0 >> 12) - 1;
        const float* mv = WSP(float, WS_MOD) + (size_t)cond * 12288;
        const float* g = F.in[I_NORMG];
        f32x4 a[8];
#pragma unroll
        for (int jj = 0; jj < 8; ++jj) { const int col = 4 * lane + 256 * jj; a[jj] = *(const f32x4*)(g + col) * (*(const f32x4*)(mv + 2048 + col) + 1.f); }
#pragma unroll 1
        for (int r = 0; r < 8; r += 2) {
            f32x4 v[2][8];
#pragma unroll
            for (int q = 0; q < 2; ++q) { const float* xr = x_row(F, 0, row0 + r + q);
#pragma unroll
                for (int jj = 0; jj < 8; ++jj) v[q][jj] = *(const f32x4*)(xr + 4 * lane + 256 * jj); }
#pragma unroll
            for (int q = 0; q < 2; ++q) { const int row = row0 + r + q; float ss = 0.f;
#pragma unroll
                for (int jj = 0; jj < 8; ++jj) ss += (v[q][jj][0] * v[q][jj][0] + v[q][jj][1] * v[q][jj][1]) + (v[q][jj][2] * v[q][jj][2] + v[q][jj][3] * v[q][jj][3]);
                ss = wave_sum(ss);
                if (lane < 32) WSP(float, WS_PART)[(size_t)row * 32 + lane] = lane == 0 ? ss : 0.f;
                bf16* hr = WSP(bf16, WS_H) + (size_t)row * DM;
#pragma unroll
                for (int jj = 0; jj < 8; ++jj) { const f32x4 y = v[q][jj] * a[jj]; v2u w; w.x = cvtpk(y[0], y[1]); w.y = cvtpk(y[2], y[3]); *(v2u*)(hr + 4 * lane + 256 * jj) = w; } }
        }
    }
    __syncthreads();
    for (int it = F.bx; it < 1280; it += F.G) {
        if (it < 1024) { const int l = it >> 8, nb = it & 255; q8w_item(F, F.in[I_W1] + (size_t)l * 2048 * 8192, 8192, nb * 32, (signed char*)(F.ws + WS_W1T) + (size_t)l * 8192 * 2048, WSP(float, WS_SCOL) + l * 8192); }
        else { const int lw = (it - 1024) >> 6, nb = (it - 1024) & 63; q8w_item(F, wo_src(F, lw), 2048, nb * 32, (signed char*)(F.ws + WS_WWOT) + (size_t)lw * 2048 * 2048, WSP(float, WS_SCOLO) + lw * 2048); }
    }
    constexpr int NCH = 96 + 32 + 200 + 96;
    for (int ch = gw; ch < NCH; ch += NGW) {
        int c = ch, site = 0; const bf16* Wt = WSP(bf16, WS_WQKVT);
        if (c >= 96) { c -= 96; site = 2; Wt = WSP(bf16, WS_MWDT);
          if (c >= 32) { c -= 32; site = 4; Wt = WSP(bf16, WS_GWINT);
            if (c >= 200) { c -= 200; site = 6; Wt = WSP(bf16, WS_WQKVT) + (size_t)3072 * DM; } } }
        const int L = site >> 1, which = site & 1;
        const float* sv = WSP(float, WS_MOD) + (size_t)(L * 3) * 12288 + (which ? 3 * 2048 : 0);
        f32x4 s0[3][4], s1[3][4];
#pragma unroll
        for (int cc = 0; cc < 3; ++cc)
#pragma unroll
            for (int jj = 0; jj < 4; ++jj) { const float* sp = sv + (size_t)cc * 12288 + 8 * lane + 512 * jj; s0[cc][jj] = *(const f32x4*)sp; s1[cc][jj] = *(const f32x4*)(sp + 4); }
        float* so = WSP(float, WS_SW) + (size_t)site * 3 * 8192;
#pragma unroll 1
        for (int r2 = 0; r2 < 32; r2 += 2) {
            const bf16* wr0 = Wt + (size_t)(c * 32 + r2) * DM + 8 * lane; const bf16* wr1 = wr0 + DM;
            const v4u w00 = *(const v4u*)(wr0), w01 = *(const v4u*)(wr0 + 512), w02 = *(const v4u*)(wr0 + 1024), w03 = *(const v4u*)(wr0 + 1536);
            const v4u w10 = *(const v4u*)(wr1), w11 = *(const v4u*)(wr1 + 512), w12 = *(const v4u*)(wr1 + 1024), w13 = *(const v4u*)(wr1 + 1536);
            float a0 = 0.f, a1 = 0.f, a2 = 0.f, b0 = 0.f, b1 = 0.f, b2 = 0.f;
#define SW_ACC(W_, jj, d0_, d1_, d2_) do { const v4u q_ = (W_); \
                const f32x4 wa = {__builtin_bit_cast(float, q_[0] << 16), __builtin_bit_cast(float, q_[0] & 0xffff0000u), __builtin_bit_cast(float, q_[1] << 16), __builtin_bit_cast(float, q_[1] & 0xffff0000u)}; \
                const f32x4 wb = {__builtin_bit_cast(float, q_[2] << 16), __builtin_bit_cast(float, q_[2] & 0xffff0000u), __builtin_bit_cast(float, q_[3] << 16), __builtin_bit_cast(float, q_[3] & 0xffff0000u)}; \
                f32x4 t = wa * s0[0][jj] + wb * s1[0][jj]; d0_ += (t[0] + t[1]) + (t[2] + t[3]); \
                t = wa * s0[1][jj] + wb * s1[1][jj]; d1_ += (t[0] + t[1]) + (t[2] + t[3]); \
                t = wa * s0[2][jj] + wb * s1[2][jj]; d2_ += (t[0] + t[1]) + (t[2] + t[3]); } while (0)
            SW_ACC(w00, 0, a0, a1, a2); SW_ACC(w01, 1, a0, a1, a2); SW_ACC(w02, 2, a0, a1, a2); SW_ACC(w03, 3, a0, a1, a2);
            SW_ACC(w10, 0, b0, b1, b2); SW_ACC(w11, 1, b0, b1, b2); SW_ACC(w12, 2, b0, b1, b2); SW_ACC(w13, 3, b0, b1, b2);
#undef SW_ACC
#pragma unroll
            for (int o = 1; o < 64; o <<= 1) { a0 += __shfl_xor(a0, o); a1 += __shfl_xor(a1, o); a2 += __shfl_xor(a2, o); b0 += __shfl_xor(b0, o); b1 += __shfl_xor(b1, o); b2 += __shfl_xor(b2, o); }
            if (lane == 0) { const int n = c * 32 + r2; so[n] = a0; so[8192 + n] = a1; so[2 * 8192 + n] = a2; so[n + 1] = b0; so[8192 + n + 1] = b1; so[2 * 8192 + n + 1] = b2; }
        }
    }
}
__device__ __forceinline__ void q8_phase(Frame& F, int L, bool with_sw) {
    const int gw = F.bx * NWAVES + F.wave, NGW = F.G * NWAVES, lane = F.lane;
    const float* part = WSP(float, WS_PART) + (size_t)(2 * L + 1) * MTOK * 32; const float* pmax = WSP(float, WS_PMAX) + (size_t)(2 * L + 1) * MTOK * 32;
    const bf16* H = WSP(bf16, WS_H); signed char* H8 = (signed char*)(F.ws + WS_H8); float* frow = WSP(float, WS_FROW) + (size_t)L * MTOK;
    for (int row0 = gw; row0 < MTOK; row0 += 4 * NGW) {
        float ss[4], mx[4]; v4u w[4][4];
#pragma unroll
        for (int r = 0; r < 4; ++r) { const int row = row0 + r * NGW; const bool ok = row < MTOK && lane < 32;
            ss[r] = ok ? part[(size_t)row * 32 + lane] : 0.f; mx[r] = ok ? pmax[(size_t)row * 32 + lane] : 0.f; }
#pragma unroll
        for (int r = 0; r < 4; ++r) { const int row = row0 + r * NGW;
            if (row < MTOK) { const bf16* hr = H + (size_t)row * DM + 8 * lane;
#pragma unroll
                for (int jj = 0; jj < 4; ++jj) w[r][jj] = *(const v4u*)(hr + 512 * jj); } }
#pragma unroll
        for (int r = 0; r < 4; ++r) { const int row = row0 + r * NGW;
            if (row < MTOK) {
                float s1 = ss[r], m1 = mx[r];
#pragma unroll
                for (int o = 1; o < 64; o <<= 1) { s1 += __shfl_xor(s1, o); m1 = fmaxf(m1, __shfl_xor(m1, o)); }
                m1 = fmaxf(m1, 1e-30f);
                const float rstd = rsqrtf(s1 * (1.f / 2048.f) + EPS), scale = m1 * (1.f / 127.f), inv = 127.f / m1;
                if (lane == 0) frow[row] = rstd * scale;
                signed char* qr = H8 + (size_t)row * DM + 8 * lane;
#pragma unroll
                for (int jj = 0; jj < 4; ++jj) { unsigned b[8];
#pragma unroll
                    for (int e = 0; e < 4; ++e) { int q0 = (int)rintf(__builtin_bit_cast(float, w[r][jj][e] << 16) * inv), q1 = (int)rintf(__builtin_bit_cast(float, w[r][jj][e] & 0xffff0000u) * inv);
                        q0 = q0 > 127 ? 127 : (q0 < -127 ? -127 : q0); q1 = q1 > 127 ? 127 : (q1 < -127 ? -127 : q1); b[2 * e] = (unsigned)q0 & 0xffu; b[2 * e + 1] = (unsigned)q1 & 0xffu; }
                    v2u o; o.x = b[0] | (b[1] << 8) | (b[2] << 16) | (b[3] << 24); o.y = b[4] | (b[5] << 8) | (b[6] << 16) | (b[7] << 24);
                    *(v2u*)(qr + 512 * jj) = o; } } }
    }
    if (with_sw) {
        for (int ch = gw; ch < 4 * 512; ch += NGW) {
            const int l = ch >> 9, c = ch & 511;
            const signed char* Wq = (const signed char*)(F.ws + WS_W1T) + (size_t)l * 8192 * 2048;
            const float* sv = WSP(float, WS_MOD) + (size_t)(l * 3) * 12288 + 3 * 2048;
            f32x4 s0[3][4], s1[3][4];
#pragma unroll
            for (int cc = 0; cc < 3; ++cc)
#pragma unroll
                for (int jj = 0; jj < 4; ++jj) { const float* sp = sv + (size_t)cc * 12288 + 8 * lane + 512 * jj; s0[cc][jj] = *(const f32x4*)sp; s1[cc][jj] = *(const f32x4*)(sp + 4); }
            float* so = WSP(float, WS_SW) + (size_t)(2 * l + 1) * 3 * 8192; const float* scol = WSP(float, WS_SCOL) + l * 8192;
#pragma unroll 1
            for (int r = 0; r < 16; ++r) {
                const int n = c * 16 + r; const signed char* wr_ = Wq + (size_t)n * 2048 + 8 * lane;
                float d0 = 0.f, d1 = 0.f, d2 = 0.f;
#pragma unroll
                for (int jj = 0; jj < 4; ++jj) { const v2u w = *(const v2u*)(wr_ + 512 * jj);
                    const f32x4 wa = {(float)(int)(signed char)(w.x & 0xff), (float)(int)(signed char)((w.x >> 8) & 0xff), (float)(int)(signed char)((w.x >> 16) & 0xff), (float)(int)(signed char)(w.x >> 24)};
                    const f32x4 wb = {(float)(int)(signed char)(w.y & 0xff), (float)(int)(signed char)((w.y >> 8) & 0xff), (float)(int)(signed char)((w.y >> 16) & 0xff), (float)(int)(signed char)(w.y >> 24)};
                    f32x4 t = wa * s0[0][jj] + wb * s1[0][jj]; d0 += (t[0] + t[1]) + (t[2] + t[3]);
                    t = wa * s0[1][jj] + wb * s1[1][jj]; d1 += (t[0] + t[1]) + (t[2] + t[3]);
                    t = wa * s0[2][jj] + wb * s1[2][jj]; d2 += (t[0] + t[1]) + (t[2] + t[3]); }
#pragma unroll
                for (int o = 1; o < 64; o <<= 1) { d0 += __shfl_xor(d0, o); d1 += __shfl_xor(d1, o); d2 += __shfl_xor(d2, o); }
                if (lane == 0) { const float sc = scol[n]; so[n] = d0 * sc; so[8192 + n] = d1 * sc; so[2 * 8192 + n] = d2 * sc; }
            }
        }
    }
}
__device__ __forceinline__ void aoq_phase(Frame& F) {
    const int gw = F.bx * NWAVES + F.wave, NGW = F.G * NWAVES, lane = F.lane;
    const bf16* AO = WSP(bf16, WS_AO); signed char* A8 = (signed char*)(F.ws + WS_AO8); float* arow = WSP(float, WS_AROW);
    for (int row0 = gw; row0 < MTOK; row0 += 4 * NGW) {
        v4u w[4][4];
#pragma unroll
        for (int r = 0; r < 4; ++r) { const int row = row0 + r * NGW;
            if (row < MTOK) { const bf16* hr = AO + (size_t)row * DM + 8 * lane;
#pragma unroll
                for (int jj = 0; jj < 4; ++jj) w[r][jj] = *(const v4u*)(hr + 512 * jj); } }
#pragma unroll
        for (int r = 0; r < 4; ++r) { const int row = row0 + r * NGW;
            if (row < MTOK) { float mx = 0.f;
#pragma unroll
                for (int jj = 0; jj < 4; ++jj) {
#pragma unroll
                    for (int e = 0; e < 4; ++e) { mx = fmaxf(mx, fabsf(__builtin_bit_cast(float, w[r][jj][e] << 16))); mx = fmaxf(mx, fabsf(__builtin_bit_cast(float, w[r][jj][e] & 0xffff0000u))); } }
#pragma unroll
                for (int o = 1; o < 64; o <<= 1) mx = fmaxf(mx, __shfl_xor(mx, o));
                mx = fmaxf(mx, 1e-30f); const float inv = 127.f / mx;
                if (lane == 0) arow[row] = mx * (1.f / 127.f);
                signed char* qr = A8 + (size_t)row * DM + 8 * lane;
#pragma unroll
                for (int jj = 0; jj < 4; ++jj) { unsigned b[8];
#pragma unroll
                    for (int e = 0; e < 4; ++e) { int q0 = (int)rintf(__builtin_bit_cast(float, w[r][jj][e] << 16) * inv), q1 = (int)rintf(__builtin_bit_cast(float, w[r][jj][e] & 0xffff0000u) * inv);
                        b[2 * e] = (unsigned)q0 & 0xffu; b[2 * e + 1] = (unsigned)q1 & 0xffu; }
                    v2u o; o.x = b[0] | (b[1] << 8) | (b[2] << 16) | (b[3] << 24); o.y = b[4] | (b[5] << 8) | (b[6] << 16) | (b[7] << 24);
                    *(v2u*)(qr + 512 * jj) = o; } } }
    }
}
__device__ __forceinline__ void final_phase(Frame& F) {
    const int gw = F.bx * NWAVES + F.wave, NGW = F.G * NWAVES, lane = F.lane;
    const float* g = F.in[I_FNORM];
    for (int row0 = gw; row0 < MTOK; row0 += 2 * NGW) {
        f32x4 v[2][8];
#pragma unroll
        for (int r = 0; r < 2; ++r) { const int row = row0 + r * NGW;
            if (row < MTOK) { const float* xr = WSP(float, WS_X) + (size_t)row * DM;
#pragma unroll
                for (int jj = 0; jj < 8; ++jj) v[r][jj] = __builtin_nontemporal_load((const f32x4*)(xr + 4 * lane + 256 * jj)); } }
#pragma unroll
        for (int r = 0; r < 2; ++r) { const int row = row0 + r * NGW;
            if (row < MTOK) { float ss = 0.f;
#pragma unroll
                for (int jj = 0; jj < 8; ++jj) ss += (v[r][jj][0] * v[r][jj][0] + v[r][jj][1] * v[r][jj][1]) + (v[r][jj][2] * v[r][jj][2] + v[r][jj][3] * v[r][jj][3]);
                const float rstd = rsqrtf(wave_sum(ss) * (1.f / 2048.f) + EPS);
                float* orow = F.out + (size_t)row * DM;
#pragma unroll
                for (int jj = 0; jj < 8; ++jj) { const int col = 4 * lane + 256 * jj; *(f32x4*)(orow + col) = v[r][jj] * rstd * *(const f32x4*)(g + col); } } }
    }
}

namespace att {
constexpr int QBLK = 32, KVBLK = 64;
constexpr int SHM_V = 16384, SHM_K = 16384, SHM_KR = 8192;
constexpr int OFF_V = 0, OFF_K = 3 * SHM_V, OFF_KR = 3 * SHM_V + 3 * SHM_K, OFF_WS = OFF_KR + 3 * SHM_KR, OFF_QR = OFF_WS + NWAVES * 64 * 4, LDS_ATT = OFF_QR + NWAVES * 4096;
#define KSWZ(row, colB) ((row) * 256 + ((colB) ^ (((row) & 7) << 4)))
#define KRSWZ(row, chunk) ((row) * 128 + ((((chunk) ^ ((row) >> 1)) & 7) << 4))
__device__ __forceinline__ int crow(int r, int hi) { return (r & 3) + 8 * (r >> 2) + 4 * hi; }
template <int DQK> struct Cst { static constexpr float SCALE = DQK == 128 ? 0.088388347648318440f : 0.072168783648703220f; static constexpr float C = SCALE * 1.4426950408889634f; };
constexpr float THR = 8.f;

template <int DQK>
__device__ __forceinline__ void partialSM(f32x16& p0, f32x16& p1, float& m_reg, float& mn, float& alpha) {
    constexpr float C = Cst<DQK>::C, SCALE = Cst<DQK>::SCALE;
    float pmax = p0[0];
#pragma unroll
    for (int r = 1; r < 16; ++r) pmax = fmaxf(pmax, p0[r]);
#pragma unroll
    for (int r = 0; r < 16; ++r) pmax = fmaxf(pmax, p1[r]);
    { auto rr = __builtin_amdgcn_permlane32_swap(__float_as_uint(pmax), __float_as_uint(pmax), false, false);
      pmax = fmaxf(__uint_as_float(rr[0]), __uint_as_float(rr[1])); }
    if (__builtin_expect(__all(pmax - m_reg <= THR / SCALE), 1)) { mn = m_reg; alpha = 1.f; }
    else { mn = fmaxf(m_reg, pmax); alpha = __builtin_amdgcn_exp2f((m_reg - mn) * C); m_reg = mn; }
    const float mnC = -mn * C;
#pragma unroll
    for (int r = 0; r < 16; ++r) p0[r] = __builtin_amdgcn_exp2f(fmaf(p0[r], C, mnC));
#pragma unroll
    for (int r = 0; r < 16; ++r) p1[r] = __builtin_amdgcn_exp2f(fmaf(p1[r], C, mnC));
}
__device__ __forceinline__ void finishSM(f32x16& p0, f32x16& p1, float alpha, float& l_reg, bf16x8& pa0, bf16x8& pa1, bf16x8& pa2, bf16x8& pa3) {
    float ps = 0;
#pragma unroll
    for (int r = 0; r < 16; ++r) ps += p0[r];
#pragma unroll
    for (int r = 0; r < 16; ++r) ps += p1[r];
    { auto rr = __builtin_amdgcn_permlane32_swap(__float_as_uint(ps), __float_as_uint(ps), false, false);
      ps = __uint_as_float(rr[0]) + __uint_as_float(rr[1]); }
    l_reg = l_reg * alpha + ps;
#define PK4(P, BASE, OUT) do { unsigned a0 = cvtpk(P[BASE + 0], P[BASE + 1]), a1 = cvtpk(P[BASE + 2], P[BASE + 3]);   \
    unsigned b0 = cvtpk(P[BASE + 4], P[BASE + 5]), b1 = cvtpk(P[BASE + 6], P[BASE + 7]);                              \
    auto r0 = __builtin_amdgcn_permlane32_swap(a0, b0, false, false); auto r1 = __builtin_amdgcn_permlane32_swap(a1, b1, false, false); \
    v4u w = {r0[0], r1[0], r0[1], r1[1]}; OUT = *reinterpret_cast<bf16x8*>(&w); } while (0)
    PK4(p0, 0, pa0); PK4(p0, 8, pa1); PK4(p1, 0, pa2); PK4(p1, 8, pa3);
#undef PK4
}
__device__ __forceinline__ int v_st(int k, int c) { const int kk = (k & ~0xC) | ((k & 4) << 1) | ((k & 8) >> 1); return ((kk >> 3) * 4 + (c >> 5)) * 512 + ((kk & 7) * 32 + (c & 31)) * 2; }
__device__ __forceinline__ int v_rd_base(int lane) { return ((lane & 3) << 3) | (((lane >> 2) & 3) << 6) | (((lane >> 4) & 1) << 5) | (((lane >> 5) & 1) << 8); }
constexpr int v_rd_off(int d0, int ks, int half) { return d0 * 512 + ks * 4096 + half * 2048; }
template <int OFF> __device__ __forceinline__ s16x4 tr_read(int vb) {
    s16x4 r; asm volatile("ds_read_b64_tr_b16 %0, %1 offset:%2" : "=&v"(r) : "v"(vb), "i"(OFF) : "memory"); return r;
}
template <int D0> __device__ __forceinline__ void pv_one(f32x16& od, int vb, bf16x8 pa0, bf16x8 pa1, bf16x8 pa2, bf16x8 pa3) {
#define PKV(L, H) (bf16x8){L[0], L[1], L[2], L[3], H[0], H[1], H[2], H[3]}
    const s16x4 l0 = tr_read<v_rd_off(D0, 0, 0)>(vb), h0 = tr_read<v_rd_off(D0, 0, 1)>(vb), l1 = tr_read<v_rd_off(D0, 1, 0)>(vb), h1 = tr_read<v_rd_off(D0, 1, 1)>(vb);
    asm volatile("s_waitcnt lgkmcnt(0)" ::: "memory"); SBAR();
    od = __builtin_amdgcn_mfma_f32_32x32x16_bf16(pa0, PKV(l0, h0), od, 0, 0, 0);
    const s16x4 l2 = tr_read<v_rd_off(D0, 2, 0)>(vb), h2 = tr_read<v_rd_off(D0, 2, 1)>(vb);
    od = __builtin_amdgcn_mfma_f32_32x32x16_bf16(pa1, PKV(l1, h1), od, 0, 0, 0);
    const s16x4 l3 = tr_read<v_rd_off(D0, 3, 0)>(vb), h3 = tr_read<v_rd_off(D0, 3, 1)>(vb);
    asm volatile("s_waitcnt lgkmcnt(0)" ::: "memory"); SBAR();
    od = __builtin_amdgcn_mfma_f32_32x32x16_bf16(pa2, PKV(l2, h2), od, 0, 0, 0);
    od = __builtin_amdgcn_mfma_f32_32x32x16_bf16(pa3, PKV(l3, h3), od, 0, 0, 0);
#undef PKV
}

template <int D0> __device__ __forceinline__ void v_ld8(s16x4 (&f)[8], int vb) {
    f[0] = tr_read<v_rd_off(D0, 0, 0)>(vb); f[1] = tr_read<v_rd_off(D0, 0, 1)>(vb); f[2] = tr_read<v_rd_off(D0, 1, 0)>(vb); f[3] = tr_read<v_rd_off(D0, 1, 1)>(vb);
    f[4] = tr_read<v_rd_off(D0, 2, 0)>(vb); f[5] = tr_read<v_rd_off(D0, 2, 1)>(vb); f[6] = tr_read<v_rd_off(D0, 3, 0)>(vb); f[7] = tr_read<v_rd_off(D0, 3, 1)>(vb);
}
__device__ __forceinline__ void pv_mm(f32x16& od, const s16x4 (&f)[8], bf16x8 pa0, bf16x8 pa1, bf16x8 pa2, bf16x8 pa3) {
#define PKV(L, H) (bf16x8){L[0], L[1], L[2], L[3], H[0], H[1], H[2], H[3]}
    od = __builtin_amdgcn_mfma_f32_32x32x16_bf16(pa0, PKV(f[0], f[1]), od, 0, 0, 0);
    od = __builtin_amdgcn_mfma_f32_32x32x16_bf16(pa1, PKV(f[2], f[3]), od, 0, 0, 0);
    od = __builtin_amdgcn_mfma_f32_32x32x16_bf16(pa2, PKV(f[4], f[5]), od, 0, 0, 0);
    od = __builtin_amdgcn_mfma_f32_32x32x16_bf16(pa3, PKV(f[6], f[7]), od, 0, 0, 0);
#undef PKV
}
__device__ __forceinline__ void pv_all(f32x16 (&o)[4], int vb, bf16x8 pa0, bf16x8 pa1, bf16x8 pa2, bf16x8 pa3) {
    s16x4 A[8], B[8];
    v_ld8<0>(A, vb); v_ld8<1>(B, vb);
    asm volatile("s_waitcnt lgkmcnt(8)" ::: "memory"); SBAR(); pv_mm(o[0], A, pa0, pa1, pa2, pa3); SBAR();
    v_ld8<2>(A, vb);
    asm volatile("s_waitcnt lgkmcnt(8)" ::: "memory"); SBAR(); pv_mm(o[1], B, pa0, pa1, pa2, pa3); SBAR();
    v_ld8<3>(B, vb);
    asm volatile("s_waitcnt lgkmcnt(8)" ::: "memory"); SBAR(); pv_mm(o[2], A, pa0, pa1, pa2, pa3); SBAR();
    asm volatile("s_waitcnt lgkmcnt(0)" ::: "memory"); SBAR(); pv_mm(o[3], B, pa0, pa1, pa2, pa3); SBAR();
}

template <int DQK, bool MASKED>
__device__ __forceinline__ void attn_unit(const bf16* __restrict__ Qb, int ldq,
                                          const bf16* __restrict__ KA, const bf16* __restrict__ VA, const bf16* __restrict__ KRA, int nA,
                                          const bf16* __restrict__ KB, const bf16* __restrict__ VB, const bf16* __restrict__ KRB, int nB,
                                          int ldk, int qpos0, int kposB0, float sink_l2, bf16* __restrict__ Ob, char* lds) {
    constexpr int ND = 8;
    constexpr float C = Cst<DQK>::C;
    const int tid = threadIdx.x, wid = tid >> 6, lane = tid & 63, r32 = lane & 31, hi = lane >> 5;
    float* wsf = (float*)(lds + OFF_WS) + wid * 64; float* li_l = wsf; float* al_l = wsf + 32;
    float m_reg = -1e30f, l_reg = 0.f; f32x16 o[4] = {}; bf16x8 qr[ND];
    const bf16* Qw = Qb + (size_t)(wid * QBLK + r32) * ldq + hi * 8;
#pragma unroll
    for (int d0 = 0; d0 < ND; ++d0) qr[d0] = *reinterpret_cast<const bf16x8*>(Qw + d0 * 16);
    if constexpr (DQK == 192) {
#pragma unroll
        for (int dd = 0; dd < 4; ++dd) { const bf16x8 qv = *reinterpret_cast<const bf16x8*>(Qw + 128 + dd * 16); *(bf16x8*)(lds + OFF_QR + wid * 4096 + KRSWZ(r32, dd * 2 + hi)) = qv; }
    }
    const int vb0 = (int)(uintptr_t)(LAS char*)(lds + OFF_V) + v_rd_base(lane);
    const int NT = nA + nB;
    unsigned gok, gov, gor;
    { const int krow = 4 * wid + (lane >> 4); gok = (unsigned)(krow * ldk) * 2u + (unsigned)(((lane & 15) << 4) ^ ((krow & 7) << 4));
      const int kk = 8 * (wid >> 1) + ((lane & 31) >> 2), kv = (kk & ~0xC) | ((kk & 4) << 1) | ((kk & 8) >> 1), cv = 32 * (2 * (wid & 1) + (lane >> 5)) + ((lane & 3) << 3);
      gov = (unsigned)(kv * ldk + cv) * 2u;
      const int rrow = 8 * wid + (lane >> 3); gor = (unsigned)(rrow * 128 + ((((lane & 7) ^ (rrow >> 1)) & 7) << 4)); }
    const unsigned g32 = (unsigned)(32 * ldk) * 2u;
    LAS char* const L3 = (LAS char*)lds;
#define SLOAD(t, b) do { const bool inA_ = (t) < nA; const int tt_ = inA_ ? (t) : (t) - nA; const char* Kt_ = (const char*)((inA_ ? KA : KB) + (size_t)tt_ * 64 * ldk); const char* Vt_ = (const char*)((inA_ ? VA : VB) + (size_t)tt_ * 64 * ldk); \
    __builtin_amdgcn_global_load_lds((const unsigned*)(Kt_ + gok), (LAS unsigned*)(L3 + OFF_K + (b) * SHM_K + wid * 1024), 16, 0, 0); \
    __builtin_amdgcn_global_load_lds((const unsigned*)(Kt_ + gok + g32), (LAS unsigned*)(L3 + OFF_K + (b) * SHM_K + 8192 + wid * 1024), 16, 0, 0); \
    __builtin_amdgcn_global_load_lds((const unsigned*)(Vt_ + gov), (LAS unsigned*)(L3 + OFF_V + (b) * SHM_V + wid * 1024), 16, 0, 0); \
    __builtin_amdgcn_global_load_lds((const unsigned*)(Vt_ + gov + g32), (LAS unsigned*)(L3 + OFF_V + (b) * SHM_V + 8192 + wid * 1024), 16, 0, 0); \
    if constexpr (DQK == 192) { const char* Rt_ = (const char*)((inA_ ? KRA : KRB) + (size_t)tt_ * 64 * 64); \
        __builtin_amdgcn_global_load_lds((const unsigned*)(Rt_ + gor), (LAS unsigned*)(L3 + OFF_KR + (b) * SHM_KR + wid * 1024), 16, 0, 0); } } while (0)
#define KLD_(dg, A0, A1) _Pragma("unroll") for (int dd = 0; dd < 2; ++dd) { const int cb_ = (((dg) * 2 + dd) * 16 + hi * 8) * 2; const LAS char* ka_ = (const LAS char*)(uintptr_t)(unsigned)(kb0_ + (cb_ ^ sw_)); A0[dd] = *reinterpret_cast<const LAS bf16x8*>(ka_); A1[dd] = *reinterpret_cast<const LAS bf16x8*>(ka_ + 32 * 256); }
#define KMM_(dg, A0, A1, P0, P1) _Pragma("unroll") for (int dd = 0; dd < 2; ++dd) { P0 = __builtin_amdgcn_mfma_f32_32x32x16_bf16(A0[dd], qr[(dg) * 2 + dd], P0, 0, 0, 0); P1 = __builtin_amdgcn_mfma_f32_32x32x16_bf16(A1[dd], qr[(dg) * 2 + dd], P1, 0, 0, 0); }
#define RLD_(dg, A0, A1, QF) _Pragma("unroll") for (int dd = 0; dd < 2; ++dd) { const int ch_ = ((dg) * 2 + dd) * 2 + hi; const int so_ = ((ch_ ^ rs_) & 7) << 4; const LAS char* ra_ = (const LAS char*)(uintptr_t)(unsigned)(rb0_ + so_); \
        A0[dd] = *reinterpret_cast<const LAS bf16x8*>(ra_); A1[dd] = *reinterpret_cast<const LAS bf16x8*>(ra_ + 32 * 128); QF[dd] = *reinterpret_cast<const LAS bf16x8*>((const LAS char*)(uintptr_t)(unsigned)(qb0_ + so_)); }
#define RMM_(A0, A1, QF, P0, P1) _Pragma("unroll") for (int dd = 0; dd < 2; ++dd) { P0 = __builtin_amdgcn_mfma_f32_32x32x16_bf16(A0[dd], QF[dd], P0, 0, 0, 0); P1 = __builtin_amdgcn_mfma_f32_32x32x16_bf16(A1[dd], QF[dd], P1, 0, 0, 0); }
#define QKT(P0, P1, b) do { P0 = f32x16{}; P1 = f32x16{}; int kb0_ = (int)(uintptr_t)(LAS char*)(lds + OFF_K) + (b) * SHM_K + r32 * 256, sw_ = (r32 & 7) << 4; asm volatile("" : "+v"(kb0_), "+v"(sw_));   \
    bf16x8 xa0_[2], xa1_[2], xb0_[2], xb1_[2]; \
    KLD_(0, xa0_, xa1_); SBAR(); \
    KLD_(1, xb0_, xb1_); SBAR(); KMM_(0, xa0_, xa1_, P0, P1); SBAR(); \
    KLD_(2, xa0_, xa1_); SBAR(); KMM_(1, xb0_, xb1_, P0, P1); SBAR(); \
    KLD_(3, xb0_, xb1_); SBAR(); KMM_(2, xa0_, xa1_, P0, P1); SBAR(); \
    if constexpr (DQK == 192) { int rb0_ = (int)(uintptr_t)(LAS char*)(lds + OFF_KR) + (b) * SHM_KR + r32 * 128, rs_ = (r32 >> 1) & 7, qb0_ = (int)(uintptr_t)(LAS char*)(lds + OFF_QR) + wid * 4096 + r32 * 128; asm volatile("" : "+v"(rb0_), "+v"(rs_), "+v"(qb0_)); \
        bf16x8 qa_[2], qb_[2]; \
        RLD_(0, xa0_, xa1_, qa_); SBAR(); KMM_(3, xb0_, xb1_, P0, P1); SBAR(); \
        RLD_(1, xb0_, xb1_, qb_); SBAR(); RMM_(xa0_, xa1_, qa_, P0, P1); SBAR(); \
        RMM_(xb0_, xb1_, qb_, P0, P1); SBAR(); } \
    else { KMM_(3, xb0_, xb1_, P0, P1); SBAR(); } } while (0)
#define MASKT(P0, P1, t) do { if constexpr (MASKED) { if ((t) >= nA) { const int qp_ = qpos0 + wid * QBLK + r32, kb_ = kposB0 + ((t) - nA) * 64; \
    _Pragma("unroll") for (int r = 0; r < 16; ++r) { const int d_ = qp_ - (kb_ + crow(r, hi)); if (d_ > 128 || d_ < -128) P0[r] = -1e30f; const int d2_ = d_ - 32; if (d2_ > 128 || d2_ < -128) P1[r] = -1e30f; } } } } while (0)
#define RESC(a) do { if (__any((a) < 1.f)) { if (hi == 0) al_l[r32] = (a); LDS_WAIT(); \
    _Pragma("unroll") for (int r = 0; r < 16; ++r) { const float al_ = al_l[crow(r, hi)]; _Pragma("unroll") for (int d = 0; d < 4; ++d) o[d][r] *= al_; } } } while (0)
#define PV(b) do { pv_all(o, vb0 + (b) * SHM_V, pa0, pa1, pa2, pa3); } while (0)
    constexpr int NL = DQK == 192 ? 5 : 4;
    f32x16 p0, p1; float mn, al; bf16x8 pa0, pa1, pa2, pa3;
    SLOAD(0, 0); if (NT > 1) SLOAD(1, 1);
    int sc = 0;
    for (int t = 0; t < NT; ++t) {
        if (t + 1 < NT) { if constexpr (NL == 5) asm volatile("s_waitcnt vmcnt(5)" ::: "memory"); else asm volatile("s_waitcnt vmcnt(4)" ::: "memory"); } else { VM_WAIT(); }
        __syncthreads();
        const int sn = sc == 0 ? 2 : sc - 1;
        if (t + 2 < NT) SLOAD(t + 2, sn);
        SBAR(); QKT(p0, p1, sc); MASKT(p0, p1, t);
        partialSM<DQK>(p0, p1, m_reg, mn, al);
        RESC(al);
        finishSM(p0, p1, al, l_reg, pa0, pa1, pa2, pa3); SBAR();
        PV(sc);
        sc = sc == 2 ? 0 : sc + 1;
    }
    l_reg += __builtin_amdgcn_exp2f(sink_l2 - m_reg * C);
    if (hi == 0) li_l[r32] = l_reg; LDS_WAIT();
    int obase = (wid * QBLK + 4 * hi) * 2048 + r32; asm volatile("" : "+v"(obase));
#pragma unroll
    for (int r = 0; r < 16; ++r) { const float rl = __builtin_amdgcn_rcpf(li_l[crow(r, hi)]); const int ro = ((r & 3) + 8 * (r >> 2)) * 2048;
#pragma unroll
        for (int d0 = 0; d0 < 4; ++d0) *(bf16*)((char*)Ob + (unsigned)(obase + ro + d0 * 32) * 2u) = (bf16)f2bf(o[d0][r] * rl); }
    LDS_WAIT();
    __syncthreads();
#undef SLOAD
#undef QKT
#undef KLD_
#undef KMM_
#undef RLD_
#undef RMM_
#undef MASKT
#undef RESC
#undef PV
}
}

__device__ __forceinline__ void attn_win_phase(Frame& F, int j) {
    const bf16* Q = WSP(bf16, WS_WQ); const bf16* K = WSP(bf16, WS_WK); const bf16* V = WSP(bf16, WS_WV); bf16* O = WSP(bf16, WS_AO);
    const bf16* CK = WSP(bf16, WS_CTXK) + (size_t)j * 2 * 512 * 512; const bf16* CV = WSP(bf16, WS_CTXV) + (size_t)j * 2 * 512 * 512;
    for (int un = F.bx; un < 512; un += F.G) {
        const int h = un & 15, kvh = h >> 2; const float sink = F.in[I_SINK][j * 16 + h] * 1.4426950408889634f;
        const int qb = un >> 4, bs = qb >> 4, t0 = (qb & 15) * 256, row0 = MP + qb * 256;
        int kt0 = (t0 >> 6) - 2, kt1 = (t0 >> 6) + 5; if (kt0 < 0) kt0 = 0; if (kt1 > 63) kt1 = 63;
        const size_t kb = (size_t)(MP + bs * 4096 + kt0 * 64) * 512 + kvh * 128;
        att::attn_unit<128, true>(Q + (size_t)row0 * 2048 + h * 128, 2048, CK + (size_t)bs * 512 * 512 + kvh * 128, CV + (size_t)bs * 512 * 512 + kvh * 128, nullptr, 8,
                                 K + kb, V + kb, nullptr, kt1 - kt0 + 1, 512, t0, kt0 * 64, sink, O + (size_t)row0 * 2048 + h * 128, (char*)F.ldsg);
    }
    for (int un = F.bx; un < 512; un += F.G) {
        const int h = un & 15, kvh = h >> 2; const float sink = F.in[I_SINK][j * 16 + h] * 1.4426950408889634f;
        const int b = un >> 4, row0 = b * 256; const size_t kb = (size_t)row0 * 512 + kvh * 128;
        att::attn_unit<128, false>(Q + (size_t)row0 * 2048 + h * 128, 2048, nullptr, nullptr, nullptr, 0,
                                  K + kb, V + kb, nullptr, 4, 512, 0, 0, sink, O + (size_t)row0 * 2048 + h * 128, (char*)F.ldsg);
    }
}
__device__ __forceinline__ void attn_mla_phase(Frame& F) {
    const bf16* Q = WSP(bf16, WS_MQ); const bf16* KN = WSP(bf16, WS_MKN); const bf16* V = WSP(bf16, WS_MV); const bf16* KR = WSP(bf16, WS_MKR); bf16* O = WSP(bf16, WS_AO);
    for (int un = F.bx; un < 512; un += F.G) {
        const int h = un & 15, qb = un >> 4, bs = qb >> 4, row0 = MP + qb * 256;
        const size_t ra = (size_t)bs * 512, rb = (size_t)1024 + MP + bs * 4096;
        att::attn_unit<192, false>(Q + (size_t)row0 * 3072 + h * 192, 3072, KN + ra * 2048 + h * 128, V + ra * 2048 + h * 128, KR + ra * 64, 8,
                                  KN + rb * 2048 + h * 128, V + rb * 2048 + h * 128, KR + rb * 64, 64, 2048, 0, 0, -1e30f, O + (size_t)row0 * 2048 + h * 128, (char*)F.ldsg);
    }
    for (int un = F.bx; un < 512; un += F.G) {
        const int h = un & 15, b = un >> 4, row0 = b * 256; const size_t rb = (size_t)1024 + row0;
        att::attn_unit<192, false>(Q + (size_t)row0 * 3072 + h * 192, 3072, nullptr, nullptr, nullptr, 0,
                                  KN + rb * 2048 + h * 128, V + rb * 2048 + h * 128, KR + rb * 64, 4, 2048, 0, 0, -1e30f, O + (size_t)row0 * 2048 + h * 128, (char*)F.ldsg);
    }
}

__device__ __forceinline__ void mla_norm_phase(Frame& F) {
    const int gw = F.bx * NWAVES + F.wave, NGW = F.G * NWAVES, lane = F.lane;
    const float* D = WSP(float, WS_MD); bf16* CQ = WSP(bf16, WS_MCQ); bf16* CKV = WSP(bf16, WS_MCKV); bf16* KR = WSP(bf16, WS_MKR);
    const f32x2* tab = WSP(f32x2, WS_TABM);
    const float* qn = F.in[I_MQN]; const float* kvn = F.in[I_MKVN];
    for (int row = gw; row < MTOK; row += NGW) {
        const float* d = D + (size_t)row * 1024;
        {
            const f32x4 v0 = *(const f32x4*)(d + 4 * lane), v1 = *(const f32x4*)(d + 256 + 4 * lane);
            float ss = (v0[0] * v0[0] + v0[1] * v0[1]) + (v0[2] * v0[2] + v0[3] * v0[3]) + (v1[0] * v1[0] + v1[1] * v1[1]) + (v1[2] * v1[2] + v1[3] * v1[3]);
            const float rstd = rsqrtf(wave_sum(ss) * (1.f / 512.f) + EPS);
            const f32x4 y0 = v0 * rstd * *(const f32x4*)(qn + 4 * lane), y1 = v1 * rstd * *(const f32x4*)(qn + 256 + 4 * lane);
            v2u w; w.x = cvtpk(y0[0], y0[1]); w.y = cvtpk(y0[2], y0[3]); *(v2u*)(CQ + (size_t)row * 512 + 4 * lane) = w;
            w.x = cvtpk(y1[0], y1[1]); w.y = cvtpk(y1[2], y1[3]); *(v2u*)(CQ + (size_t)row * 512 + 256 + 4 * lane) = w;
        }
        {
            const f32x4 v0 = *(const f32x4*)(d + 512 + 4 * lane);
            float ss = (v0[0] * v0[0] + v0[1] * v0[1]) + (v0[2] * v0[2] + v0[3] * v0[3]);
            const float rstd = rsqrtf(wave_sum(ss) * (1.f / 256.f) + EPS);
            const f32x4 y0 = v0 * rstd * *(const f32x4*)(kvn + 4 * lane);
            v2u w; w.x = cvtpk(y0[0], y0[1]); w.y = cvtpk(y0[2], y0[3]); *(v2u*)(CKV + (size_t)(1024 + row) * 256 + 4 * lane) = w;
            if (row < MP) *(f32x4*)(F.out + O_CKV + (size_t)row * 256 + 4 * lane) = y0;
        }
        if (lane < 8) {
            const int ug = lane, idx0 = (ug & 3) * 4, d1 = (ug < 4 ? 0 : 32) + idx0;
            f32x4 a = *(const f32x4*)(d + 768 + 8 * ug), b = *(const f32x4*)(d + 768 + 8 * ug + 4);
            if (row < MP) { float* op = F.out + O_KR + (size_t)row * 64 + d1; *(f32x4*)op = a; *(f32x4*)(op + 16) = b; }
            else { const int t = row & 4095, pos = (ug < 4) ? (t >> 6) : (t & 63); const f32x4* tp = (const f32x4*)(tab + pos * 16 + idx0); const f32x4 cs0 = tp[0], cs1 = tp[1];
                const f32x4 co = {cs0[0], cs0[2], cs1[0], cs1[2]}, si = {cs0[1], cs0[3], cs1[1], cs1[3]};
                const f32x4 na = a * co - b * si, nb = b * co + a * si; a = na; b = nb; }
            *(v4u*)(KR + (size_t)(1024 + row) * 64 + 8 * ug) = pack8(a, b);
        }
    }
    const int gt = F.bx * 512 + F.tid, NGT = F.G * 512;
    for (int e = gt; e < 1024 * 256; e += NGT) CKV[e] = (bf16)f2bf(F.in[I_CCKV][e]);
    for (int e = gt; e < 1024 * 64; e += NGT) KR[e] = (bf16)f2bf(F.in[I_CKR][(e & ~63) + perm_mla(e & 63)]);
}

typedef short v4i16_t __attribute__((ext_vector_type(4)));
__device__ __forceinline__ s16x4 vtr(const LAS char* p) { return __builtin_bit_cast(s16x4, __builtin_amdgcn_ds_read_tr16_b64_v4i16((LAS v4i16_t*)p)); }
#define MFMA16(a, b, c) __builtin_amdgcn_mfma_f32_16x16x32_bf16((a), (b), (c), 0, 0, 0)
#define CAT8(L, H) (bf16x8){L[0], L[1], L[2], L[3], H[0], H[1], H[2], H[3]}
typedef __bf16 bf16x2_t __attribute__((ext_vector_type(2)));
typedef float f32x2_t __attribute__((ext_vector_type(2)));
__device__ __forceinline__ unsigned cvtpk2(float lo, float hi) { f32x2_t v = {lo, hi}; bf16x2_t b = __builtin_convertvector(v, bf16x2_t); return __builtin_bit_cast(unsigned, b); }

__device__ __forceinline__ void gla_u_phase(Frame& F) {
    const int lane = F.lane, wave = F.wave, tid = F.tid, cl = lane & 15, gq = lane >> 4;
    const bf16* H = WSP(bf16, WS_H); const bf16* Wt = WSP(bf16, WS_GWINT) + (size_t)6144 * DM;
    const float* part = WSP(float, WS_PART) + (size_t)4 * MTOK * 32; const float* sW = WSP(float, WS_SW) + (size_t)4 * 3 * 8192 + 6144;
    float* GU = WSP(float, WS_GU);
    LAS float* red = (LAS float*)F.lds;
    __syncthreads();
    for (int rb = F.bx; rb < MTOK / 64; rb += F.G) {
        const int row0 = rb * 64;
        f32x4 acc[4][2];
#pragma unroll
        for (int mi = 0; mi < 4; ++mi) { acc[mi][0] = (f32x4){0.f, 0.f, 0.f, 0.f}; acc[mi][1] = (f32x4){0.f, 0.f, 0.f, 0.f}; }
        const bf16* ap = H + (size_t)(row0 + cl) * DM + wave * 256 + 16 * gq;
        const bf16* bp = Wt + (size_t)cl * DM + wave * 256 + 16 * gq;
#pragma unroll
        for (int ks = 0; ks < 4; ++ks) {
            bf16x8 a[4][2], b[2][2];
#pragma unroll
            for (int mi = 0; mi < 4; ++mi) { a[mi][0] = *(const bf16x8*)(ap + (size_t)mi * 16 * DM + 64 * ks); a[mi][1] = *(const bf16x8*)(ap + (size_t)mi * 16 * DM + 64 * ks + 8); }
#pragma unroll
            for (int nj = 0; nj < 2; ++nj) { b[nj][0] = *(const bf16x8*)(bp + (size_t)nj * 16 * DM + 64 * ks); b[nj][1] = *(const bf16x8*)(bp + (size_t)nj * 16 * DM + 64 * ks + 8); }
#pragma unroll
            for (int mi = 0; mi < 4; ++mi)
#pragma unroll
                for (int nj = 0; nj < 2; ++nj) { acc[mi][nj] = MFMA16(a[mi][0], b[nj][0], acc[mi][nj]); acc[mi][nj] = MFMA16(a[mi][1], b[nj][1], acc[mi][nj]); }
        }
#pragma unroll
        for (int mi = 0; mi < 4; ++mi)
#pragma unroll
            for (int nj = 0; nj < 2; ++nj)
#pragma unroll
                for (int r = 0; r < 4; ++r) red[(wave * 64 + 16 * mi + 4 * gq + r) * 32 + 16 * nj + cl] = acc[mi][nj][r];
        __syncthreads();
        {
            const int rr = tid >> 3, c4 = (tid & 7) * 4, row = row0 + rr;
            f32x4 t = *(const LAS f32x4*)(red + rr * 32 + c4);
#pragma unroll
            for (int w = 1; w < 8; ++w) t += *(const LAS f32x4*)(red + (w * 64 + rr) * 32 + c4);
            const f32x4* pp = (const f32x4*)(part + (size_t)row * 32); f32x4 ps = pp[0];
#pragma unroll
            for (int i = 1; i < 8; ++i) ps += pp[i];
            const float rstd = rsqrtf(((ps[0] + ps[1]) + (ps[2] + ps[3])) * (1.f / 2048.f) + EPS);
            *(f32x4*)(GU + (size_t)row * 32 + c4) = t * rstd + *(const f32x4*)(sW + (size_t)cond_of_pm(row >> 8) * 8192 + c4);
        }
        __syncthreads();
    }
}
__device__ __forceinline__ void gla_prep_phase(Frame& F) {
    constexpr int PQ = 528, OQ = 0, OK_ = 64 * PQ, OKT = 2 * 64 * PQ, OUB = 3 * 64 * PQ, OHT = OUB + 4096, OAT = OHT + 2048;
    LAS char* L = (LAS char*)F.lds; const int tid = F.tid, lane = F.lane, wave = F.wave;
    const bf16* GQ = WSP(bf16, WS_GQ); const bf16* GK = WSP(bf16, WS_GK); const float* GU = WSP(float, WS_GU);
    v4u pq[4], pk[4]; f32x4 pu = {0.f, 0.f, 0.f, 0.f};
#define GLA_PREP_LOAD(UN) do { const int d_ = (UN) & 1, ch_ = (UN) >> 1, r0_ = (ch_ >> 2) * 64, h_ = ch_ & 3; \
        _Pragma("unroll") for (int i = 0; i < 4; ++i) { const int e = tid + 512 * i, row = e >> 5, cc = e & 31; const size_t go = (size_t)(r0_ + row) * 1024 + h_ * 256 + cc * 8; pq[i] = *(const v4u*)(GQ + go); pk[i] = *(const v4u*)(GK + go); } \
        if (tid < 256) pu = *(const f32x4*)(GU + (size_t)(r0_ + (tid >> 2)) * 32 + d_ * 16 + (tid & 3) * 4); } while (0)
    if (F.bx < 2048) GLA_PREP_LOAD(F.bx);
    float w[16]; float bias = 0.f; int cur_dh = -1;
#pragma unroll
    for (int r = 0; r < 16; ++r) w[r] = 0.f;
    for (int un = F.bx; un < 2048; un += F.G) {
        const int d = un & 1, ch = un >> 1, c = ch >> 2, h = ch & 3, row0 = c * 64;
        bf16* QT = WSP(bf16, WS_GQT) + (size_t)d * MTOK * 1024; bf16* KD = WSP(bf16, WS_GKD) + (size_t)d * MTOK * 1024;
        bf16* AM = WSP(bf16, WS_GAM) + ((size_t)d * 1024 + ch) * 4096; float* DEC = WSP(float, WS_GDEC) + ((size_t)d * 1024 + ch) * 256;
        if ((un & 7) != cur_dh) { cur_dh = un & 7; const int col = tid & 255;
#pragma unroll
            for (int r = 0; r < 16; ++r) w[r] = F.in[I_GWA2][((size_t)d * 16 + r) * 1024 + h * 256 + col] * 1.44269504f;
            bias = F.in[I_GBA][d * 1024 + h * 256 + col] * 1.44269504f; }
#pragma unroll
        for (int i = 0; i < 4; ++i) { const int e = tid + 512 * i, row = e >> 5, cc = e & 31;
            *(LAS v4u*)(L + OQ + row * PQ + cc * 16) = pq[i]; *(LAS v4u*)(L + OK_ + row * PQ + cc * 16) = pk[i]; }
        if (tid < 256) { const int row = tid >> 2, q4 = tid & 3; *(LAS f32x4*)(L + OUB + (row * 16 + q4 * 4) * 4) = pu; }
        __syncthreads();
        if (un + F.G < 2048) GLA_PREP_LOAD(un + F.G);
        {
            const int hf = tid >> 8, col = tid & 255;
            float g[32]; float tot = 0.f;
#pragma unroll
            for (int ii = 0; ii < 32; ++ii) { const int i = hf * 32 + ii; float z = bias;
#pragma unroll
                for (int q4 = 0; q4 < 4; ++q4) { const f32x4 uv = *(const LAS f32x4*)(L + OUB + (i * 16 + q4 * 4) * 4); z += uv[0] * w[4 * q4] + uv[1] * w[4 * q4 + 1] + uv[2] * w[4 * q4 + 2] + uv[3] * w[4 * q4 + 3]; }
                const float ls = fminf(z, 0.f) - __builtin_amdgcn_logf(1.f + __builtin_amdgcn_exp2f(-fabsf(z)));
                g[ii] = ls * 0.0625f; tot += g[ii]; }
            ((LAS float*)(L + OHT))[hf * 256 + col] = tot;
            __syncthreads();
            const float other = ((const LAS float*)(L + OHT))[(1 - hf) * 256 + col];
            const float T = tot + other, eT = __builtin_amdgcn_exp2f(T);
            float run = (d == 0) ? (hf == 1 ? other : 0.f) : (hf == 0 ? other : 0.f);
            if (hf == 0) DEC[col] = eT;
#pragma unroll
            for (int s = 0; s < 32; ++s) {
                const int ii = (d == 0) ? s : 31 - s;
                run += (d == 0) ? g[s] : g[31 - s];
                const int i = hf * 32 + ii;
                LAS bf16* qp = (LAS bf16*)(L + OQ + i * PQ) + col; LAS bf16* kp = (LAS bf16*)(L + OK_ + i * PQ) + col; LAS bf16* ktp = (LAS bf16*)(L + OKT + i * PQ) + col;
                const float qv = bf2f(*qp), kv = bf2f(*kp);
                const float kt = kv * __builtin_amdgcn_exp2f(-run);
                const unsigned wq = cvtpk(qv * __builtin_amdgcn_exp2f(run), kt), wk = cvtpk(kt * eT, 0.f);
                *qp = (bf16)(wq & 0xffffu); *ktp = (bf16)(wq >> 16); *kp = (bf16)(wk & 0xffffu);
            }
        }
        __syncthreads();
        {
            const int gq = lane >> 4, cl = lane & 15;
#pragma unroll
            for (int s2 = 0; s2 < 2; ++s2) {
                const int T16 = 2 * wave + s2, ti = T16 >> 2, tj = T16 & 3;
                f32x4 acc = {0.f, 0.f, 0.f, 0.f};
#pragma unroll
                for (int ks = 0; ks < 8; ++ks) {
                    const bf16x8 a = *(const LAS bf16x8*)(L + OQ + (16 * ti + cl) * PQ + (32 * ks + 8 * gq) * 2);
                    const bf16x8 b = *(const LAS bf16x8*)(L + OKT + (16 * tj + cl) * PQ + (32 * ks + 8 * gq) * 2);
                    acc = MFMA16(a, b, acc);
                }
                const int jcol = 16 * tj + cl;
#pragma unroll
                for (int r = 0; r < 4; ++r) { const int i = 16 * ti + 4 * gq + r; const bool keep = (d == 0) ? (jcol <= i) : (jcol >= i);
                    ((LAS bf16*)(L + OAT))[i * 64 + jcol] = (bf16)f2bf(keep ? acc[r] : 0.f); }
            }
        }
        __syncthreads();
#pragma unroll
        for (int i = 0; i < 4; ++i) { const int e = tid + 512 * i, row = e >> 5, cc = e & 31; const size_t go = (size_t)(row0 + row) * 1024 + h * 256 + cc * 8;
            *(v4u*)(QT + go) = *(const LAS v4u*)(L + OQ + row * PQ + cc * 16); *(v4u*)(KD + go) = *(const LAS v4u*)(L + OK_ + row * PQ + cc * 16); }
        *(v4u*)(AM + tid * 8) = *(const LAS v4u*)(L + OAT + tid * 16);
        __syncthreads();
    }
#undef GLA_PREP_LOAD
}

constexpr int GLA_NSEG = 4, GLA_SEGCH = 16;
template <bool LIGHT>
__device__ __forceinline__ void gla_scan_item(Frame& F, int seq, int h, int d, int sl, int seg) {
    constexpr int PQ = 528, PK = 544, PA = 136, PV = 288;
    constexpr int OQ = 0, OK_ = 64 * PQ, OA = OK_ + 64 * PK, OV = OA + 64 * PA, ODEC = OV + 64 * PV;
    LAS char* L = (LAS char*)F.lds; const int tid = F.tid, lane = F.lane, wave = F.wave, gq = lane >> 4, cl = lane & 15;
    const bool sample = seq >= 32; const int base = sample ? MP + (seq - 32) * 4096 : seq * 256, ntot = sample ? 64 : 4;
    const int p0 = sample ? seg * GLA_SEGCH : 0, nch = sample ? GLA_SEGCH : 4;
    const bf16* QT = WSP(bf16, WS_GQT) + (size_t)d * MTOK * 1024; const bf16* KD = WSP(bf16, WS_GKD) + (size_t)d * MTOK * 1024;
    const bf16* AM = WSP(bf16, WS_GAM) + (size_t)d * 1024 * 4096; const float* DEC = WSP(float, WS_GDEC) + (size_t)d * 1024 * 256;
    const bf16* GV = WSP(bf16, WS_GV); bf16* OD = WSP(bf16, d == 0 ? WS_GOF : WS_GOB);
    const int dvc = h * 512 + sl * 128;
    const int sidx = sample ? (((seq - 32) * 4 + h) * 2 + d) : 0;
    float* GLs = WSP(float, WS_GLS); float* GDS = WSP(float, WS_GDS);
    f32x4 S[16];
#pragma unroll
    for (int t = 0; t < 16; ++t) S[t] = (f32x4){0.f, 0.f, 0.f, 0.f};
    if (sample && !LIGHT) {
        { const float* s0 = F.in[d == 0 ? I_SGF : I_SGB] + ((size_t)((seq - 32) * 4 + h) * 256) * 512 + sl * 128 + 16 * wave;
          int lb = (4 * gq) * 512 + cl; asm volatile("" : "+v"(lb));
#pragma unroll
          for (int t = 0; t < 16; ++t)
#pragma unroll
            for (int r = 0; r < 4; ++r) S[t][r] = s0[(unsigned)(lb + (16 * t + r) * 512)]; }
        for (int g = 0; g < seg; ++g) {
            const float* Lg = GLs + ((size_t)(sidx * 3 + g) * 256) * 512 + sl * 128 + 16 * wave; const float* Dg = GDS + (size_t)(sidx * 3 + g) * 256;
            int lb = (4 * gq) * 512 + cl, db = 4 * gq; asm volatile("" : "+v"(lb), "+v"(db));
#pragma unroll
            for (int t = 0; t < 16; ++t) { const f32x4 dg = *(const f32x4*)(Dg + (unsigned)(db + 16 * t));
#pragma unroll
                for (int r = 0; r < 4; ++r) S[t][r] = S[t][r] * dg[r] + Lg[(unsigned)(lb + (16 * t + r) * 512)]; }
        }
    }
    float dprod = 1.f;
    v4u rq[LIGHT ? 1 : 4], rk[4], rv[2], ra; float rdec = 0.f;
    const int tr = tid >> 5, tc = tid & 31, vr = tid >> 4, vc = tid & 15;
    const unsigned goq = (unsigned)(tr * 1024 + h * 256 + tc * 8) * 2u, gov = (unsigned)(vr * 2048 + dvc + vc * 8) * 2u;
    LAS char* const lq = L + OQ + tr * PQ + tc * 16; LAS char* const lk = L + OK_ + tr * PK + tc * 16; LAS char* const lv = L + OV + vr * PV + vc * 16;
#define GLOAD1(ps) do { const int ci_ = d == 0 ? (ps) : ntot - 1 - (ps); const size_t rb_ = (size_t)(base + 64 * ci_) * 2048;   \
    _Pragma("unroll") for (int i = 0; i < 4; ++i) { if constexpr (!LIGHT) rq[i] = *(const v4u*)((const char*)QT + rb_ + goq + i * 16 * 2048); rk[i] = *(const v4u*)((const char*)KD + rb_ + goq + i * 16 * 2048); } } while (0)
#define GLOAD2(ps) do { const int ci_ = d == 0 ? (ps) : ntot - 1 - (ps); const int r0_ = base + 64 * ci_; const int chx_ = (r0_ >> 6) * 4 + h; \
    _Pragma("unroll") for (int i = 0; i < 2; ++i) rv[i] = *(const v4u*)((const char*)GV + (size_t)r0_ * 4096 + gov + i * 32 * 4096); \
    if constexpr (!LIGHT) ra = *(const v4u*)(AM + (size_t)chx_ * 4096 + tid * 8); if (tid < 256) rdec = DEC[(size_t)chx_ * 256 + tid]; } while (0)
#define LWRITE() do { \
    _Pragma("unroll") for (int i = 0; i < 4; ++i) { if constexpr (!LIGHT) *(LAS v4u*)(lq + i * 16 * PQ) = rq[i]; *(LAS v4u*)(lk + i * 16 * PK) = rk[i]; } \
    _Pragma("unroll") for (int i = 0; i < 2; ++i) *(LAS v4u*)(lv + i * 32 * PV) = rv[i]; \
    if constexpr (!LIGHT) { const int row = tid >> 3, cc = tid & 7; *(LAS v2u*)(L + OA + row * PA + cc * 16) = (v2u){ra.x, ra.y}; *(LAS v2u*)(L + OA + row * PA + cc * 16 + 8) = (v2u){ra.z, ra.w}; } \
    if (tid < 256) ((LAS float*)(L + ODEC))[tid] = rdec; } while (0)
    GLOAD1(p0); GLOAD2(p0);
    LWRITE();
    __syncthreads();
    for (int s = 0; s < nch; ++s) {
        const int ps = p0 + s, ci = d == 0 ? ps : ntot - 1 - ps, row0 = base + 64 * ci;
        if constexpr (LIGHT) dprod *= rdec;
        if (s + 1 < nch) { GLOAD1(ps + 1); GLOAD2(ps + 1); }
        bf16x8 vb[2];
#define LOADVB() do { _Pragma("unroll") for (int ks = 0; ks < 2; ++ks) { const LAS char* vp = L + OV + (32 * ks + 4 * gq + (cl >> 2)) * PV + 32 * wave + 8 * (cl & 3); \
            const s16x4 lo = vtr(vp), hi = vtr(vp + 16 * PV); vb[ks] = CAT8(lo, hi); } } while (0)
        SBAR(); LOADVB();
        if constexpr (!LIGHT) {
            f32x4 o[4];
#pragma unroll
            for (int ti = 0; ti < 4; ++ti) o[ti] = (f32x4){0.f, 0.f, 0.f, 0.f};
            const LAS char* qb_ = L + OQ + cl * PQ + 8 * gq; const LAS char* ab_ = L + OA + cl * PA + 8 * gq;
            int qh_ = (int)(uintptr_t)qb_ + 32, ah_ = (int)(uintptr_t)ab_ + 32; asm volatile("" : "+v"(qh_), "+v"(ah_));
#define OLD_(g, F) do { _Pragma("unroll") for (int ti = 0; ti < 4; ++ti) { const LAS char* ap = (g) < 8 ? qb_ + 16 * ti * PQ + 64 * (g) : ab_ + 16 * ti * PA + 64 * ((g) - 8); const LAS char* ah2 = (const LAS char*)(uintptr_t)(unsigned)((g) < 8 ? qh_ + 16 * ti * PQ + 64 * (g) : ah_ + 16 * ti * PA + 64 * ((g) - 8)); F[2 * ti] = *(const LAS s16x4*)ap; F[2 * ti + 1] = *(const LAS s16x4*)ah2; } } while (0)
#define OMM_(g, F) do { bf16x8 b_; if constexpr ((g) < 8) { constexpr int k2 = 2 * ((g) < 8 ? (g) : 0); v4u bw; bw.x = cvtpk2(S[k2][0], S[k2][1]); bw.y = cvtpk2(S[k2][2], S[k2][3]); bw.z = cvtpk2(S[k2 + 1][0], S[k2 + 1][1]); bw.w = cvtpk2(S[k2 + 1][2], S[k2 + 1][3]); b_ = __builtin_bit_cast(bf16x8, bw); } else b_ = vb[(g) < 8 ? 0 : (g) - 8]; \
                _Pragma("unroll") for (int ti = 0; ti < 4; ++ti) o[ti] = MFMA16(CAT8(F[2 * ti], F[2 * ti + 1]), b_, o[ti]); } while (0)
            s16x4 fa[8], fb[8], fc[8];
            OLD_(0, fa); OLD_(1, fb); SBAR();
            OLD_(2, fc); SBAR(); OMM_(0, fa); SBAR();
            OLD_(3, fa); SBAR(); OMM_(1, fb); SBAR();
            OLD_(4, fb); SBAR(); OMM_(2, fc); SBAR();
            OLD_(5, fc); SBAR(); OMM_(3, fa); SBAR();
            OLD_(6, fa); SBAR(); OMM_(4, fb); SBAR();
            OLD_(7, fb); SBAR(); OMM_(5, fc); SBAR();
            OLD_(8, fc); SBAR(); OMM_(6, fa); SBAR();
            OLD_(9, fa); SBAR(); OMM_(7, fb); SBAR();
            OMM_(8, fc); SBAR(); OMM_(9, fa); SBAR();
#undef OLD_
#undef OMM_
            { bf16* ODr = OD + (size_t)row0 * 2048 + dvc + 16 * wave; int ob = (4 * gq) * 2048 + cl; asm volatile("" : "+v"(ob));
#pragma unroll
              for (int ti = 0; ti < 4; ++ti)
#pragma unroll
                for (int r = 0; r < 4; r += 2) { const unsigned w2 = cvtpk2(o[ti][r], o[ti][r + 1]); ODr[(unsigned)(ob + (16 * ti + r) * 2048)] = (bf16)(w2 & 0xffffu); ODr[(unsigned)(ob + (16 * ti + r + 1) * 2048)] = (bf16)(w2 >> 16); } }
            SBAR();
        }
        {
            const LAS char* db_ = L + ODEC + 16 * gq; const LAS char* kb_ = L + OK_ + (4 * gq + (cl >> 2)) * PK + 8 * (cl & 3);
#define SLD_(t, DC, KF) do { DC = *(const LAS f32x4*)(db_ + 64 * (t)); KF[0] = vtr(kb_ + 32 * (t)); KF[1] = vtr(kb_ + 32 * (t) + 16 * PK); KF[2] = vtr(kb_ + 32 * (t) + 32 * PK); KF[3] = vtr(kb_ + 32 * (t) + 48 * PK); } while (0)
#define SMM_(t, DC, KF) do { S[t] = S[t] * DC; S[t] = MFMA16(CAT8(KF[0], KF[1]), vb[0], S[t]); S[t] = MFMA16(CAT8(KF[2], KF[3]), vb[1], S[t]); } while (0)
            f32x4 da, dbv, dcv; s16x4 ka[4], kbv[4], kc[4];
            SBAR(); SLD_(0, da, ka); SLD_(1, dbv, kbv); SBAR();
            SLD_(2, dcv, kc); SBAR(); SMM_(0, da, ka); SBAR();
            SLD_(3, da, ka); SBAR(); SMM_(1, dbv, kbv); SBAR();
            SLD_(4, dbv, kbv); SBAR(); SMM_(2, dcv, kc); SBAR();
            SLD_(5, dcv, kc); SBAR(); SMM_(3, da, ka); SBAR();
            SLD_(6, da, ka); SBAR(); SMM_(4, dbv, kbv); SBAR();
            SLD_(7, dbv, kbv); SBAR(); SMM_(5, dcv, kc); SBAR();
            SLD_(8, dcv, kc); SBAR(); SMM_(6, da, ka); SBAR();
            SLD_(9, da, ka); SBAR(); SMM_(7, dbv, kbv); SBAR();
            SLD_(10, dbv, kbv); SBAR(); SMM_(8, dcv, kc); SBAR();
            SLD_(11, dcv, kc); SBAR(); SMM_(9, da, ka); SBAR();
            SLD_(12, da, ka); SBAR(); SMM_(10, dbv, kbv); SBAR();
            SLD_(13, dbv, kbv); SBAR(); SMM_(11, dcv, kc); SBAR();
            SLD_(14, dcv, kc); SBAR(); SMM_(12, da, ka); SBAR();
            SLD_(15, da, ka); SBAR(); SMM_(13, dbv, kbv); SBAR();
            SMM_(14, dcv, kc); SBAR(); SMM_(15, da, ka); SBAR();
#undef SLD_
#undef SMM_
        }
        __syncthreads();
        if (s + 1 < nch) { LWRITE(); }
        __syncthreads();
    }
    if constexpr (LIGHT) {
        float* Lg = GLs + ((size_t)(sidx * 3 + seg) * 256) * 512 + sl * 128 + 16 * wave; int lb = (4 * gq) * 512 + cl; asm volatile("" : "+v"(lb));
#pragma unroll
        for (int t = 0; t < 16; ++t)
#pragma unroll
            for (int r = 0; r < 4; ++r) Lg[(unsigned)(lb + (16 * t + r) * 512)] = S[t][r];
        if (sl == 0 && tid < 256) { float* Dg = GDS + (size_t)(sidx * 3 + seg) * 256; Dg[tid] = dprod; }
    } else if (!sample) { float* so = F.out + (d == 0 ? O_GF : O_GB) + ((size_t)(seq * 4 + h) * 256) * 512 + sl * 128 + 16 * wave; int lb = (4 * gq) * 512 + cl; asm volatile("" : "+v"(lb));
#pragma unroll
        for (int t = 0; t < 16; ++t)
#pragma unroll
            for (int r = 0; r < 4; ++r) so[(unsigned)(lb + (16 * t + r) * 512)] = S[t][r];
    }
#undef GLOAD1
#undef GLOAD2
#undef LWRITE
#undef LOADVB
}
__device__ __forceinline__ int gla_item_of(int bx, int G) { return G == 256 ? (((bx & 7) + 8 * (bx >> 5)) << 2) + ((bx >> 3) & 3) : bx; }
__device__ __forceinline__ void gla_scanA_phase(Frame& F) {
    for (int it = gla_item_of(F.bx, F.G); it < 192; it += F.G) { const int sl = it & 3, g = (it >> 2) % 3, r = (it >> 2) / 3;
        gla_scan_item<true>(F, 32 + (r >> 3), (r >> 1) & 3, r & 1, sl, g); }
}
__device__ __forceinline__ void gla_scan_phase(Frame& F) {
    for (int it = gla_item_of(F.bx, F.G); it < 1280; it += F.G) {
        int seq, h, d, sl, g;
        if (it < 256) { const int r = it >> 4; sl = it & 3; g = (it >> 2) & 3; seq = 32 + (r >> 3); h = (r >> 1) & 3; d = r & 1; }
        else { const int i2 = it - 256; seq = i2 >> 5; h = (i2 >> 3) & 3; d = (i2 >> 2) & 1; sl = i2 & 3; g = 0; }
        gla_scan_item<false>(F, seq, h, d, sl, g);
    }
}
__device__ __forceinline__ void gla_post_phase(Frame& F) {
    const int gw = F.bx * NWAVES + F.wave, NGW = F.G * NWAVES, lane = F.lane;
    const bf16* OFp = WSP(bf16, WS_GOF); const bf16* OBp = WSP(bf16, WS_GOB); const bf16* GR = WSP(bf16, WS_GR); const float* gn = F.in[I_GNORM];
    signed char* A8 = (signed char*)(F.ws + WS_AO8); float* arow = WSP(float, WS_AROW);
#define UNPK4(w) (f32x4){__builtin_bit_cast(float, (w).x << 16), __builtin_bit_cast(float, (w).x & 0xffff0000u), __builtin_bit_cast(float, (w).y << 16), __builtin_bit_cast(float, (w).y & 0xffff0000u)}
    for (int row = gw; row < MTOK; row += NGW) {
        f32x4 ya[4], yb[4]; float mx = 0.f;
#pragma unroll
        for (int hh = 0; hh < 4; ++hh) {
            const size_t o0 = (size_t)row * 2048 + hh * 512 + 4 * lane;
            const v2u f0 = *(const v2u*)(OFp + o0), f1 = *(const v2u*)(OFp + o0 + 256), b0 = *(const v2u*)(OBp + o0), b1 = *(const v2u*)(OBp + o0 + 256);
            const f32x4 v0 = UNPK4(f0) + UNPK4(b0), v1 = UNPK4(f1) + UNPK4(b1);
            float ss = (v0[0] * v0[0] + v0[1] * v0[1]) + (v0[2] * v0[2] + v0[3] * v0[3]) + (v1[0] * v1[0] + v1[1] * v1[1]) + (v1[2] * v1[2] + v1[3] * v1[3]);
            const float rstd = rsqrtf(wave_sum(ss) * (1.f / 512.f) + EPS);
            const v2u r0 = *(const v2u*)(GR + o0), r1 = *(const v2u*)(GR + o0 + 256);
            f32x4 ra = UNPK4(r0), rb = UNPK4(r1);
#pragma unroll
            for (int i = 0; i < 4; ++i) { ra[i] = ra[i] / (1.f + __expf(-ra[i])); rb[i] = rb[i] / (1.f + __expf(-rb[i])); }
            ya[hh] = v0 * rstd * *(const f32x4*)(gn + 4 * lane) * ra; yb[hh] = v1 * rstd * *(const f32x4*)(gn + 256 + 4 * lane) * rb;
#pragma unroll
            for (int i = 0; i < 4; ++i) mx = fmaxf(mx, fmaxf(fabsf(ya[hh][i]), fabsf(yb[hh][i])));
        }
#pragma unroll
        for (int o = 1; o < 64; o <<= 1) mx = fmaxf(mx, __shfl_xor(mx, o));
        mx = fmaxf(mx, 1e-30f); const float inv = 127.f / mx;
        if (lane == 0) arow[row] = mx * (1.f / 127.f);
#pragma unroll
        for (int hh = 0; hh < 4; ++hh) {
            const size_t o0 = (size_t)row * 2048 + hh * 512 + 4 * lane;
            const f32x4 qa = ya[hh] * inv, qb = yb[hh] * inv;
            const unsigned wa = ((unsigned)(int)rintf(qa[0]) & 0xffu) | (((unsigned)(int)rintf(qa[1]) & 0xffu) << 8) | (((unsigned)(int)rintf(qa[2]) & 0xffu) << 16) | (((unsigned)(int)rintf(qa[3]) & 0xffu) << 24);
            const unsigned wb = ((unsigned)(int)rintf(qb[0]) & 0xffu) | (((unsigned)(int)rintf(qb[1]) & 0xffu) << 8) | (((unsigned)(int)rintf(qb[2]) & 0xffu) << 16) | (((unsigned)(int)rintf(qb[3]) & 0xffu) << 24);
            *(unsigned*)(A8 + o0) = wa; *(unsigned*)(A8 + o0 + 256) = wb;
        }
    }
#undef UNPK4
}

#ifndef MK_N_LAUNCHES
#define MK_N_LAUNCHES 1
#ifndef I8_SP2
#define I8_SP2 true
#endif
#ifndef I8_ALIGN
#define I8_ALIGN true
#endif
#ifndef PG8_ALIGN
#define PG8_ALIGN true
#endif
#ifndef PG8_SP2
#define PG8_SP2 true
#endif
#endif
constexpr int N_PHASES = 35;
__global__ void __launch_bounds__(NWAVES * 64, 2) mk_fwd(Args args) {
    extern __shared__ __attribute__((aligned(16))) unsigned char lds[];
    Frame F;
    F.lds = (LAS unsigned char*)lds; F.ldsg = lds;
    F.tid = threadIdx.x; F.lane = F.tid & 63; F.wave = __builtin_amdgcn_readfirstlane(F.tid >> 6);
    F.G = gridDim.x; F.bx = blockIdx.x;
    F.in = args.in; F.out = args.out; F.ws = args.ws;
    volatile LAS unsigned* MISC = (volatile LAS unsigned*)(F.lds + MISC_OFF);
    if (F.tid < 32) MISC[F.tid] = 0u;
    __syncthreads();
    const int lo = args.ph_lo, hi = args.ph_hi;
    const bool use_bar = (hi - lo) > 1;
    XcdBarrier bar; bar.bar = (unsigned*)(F.ws + WS_CTL) + CW_BAR + args.li * XCD_BAR_WORDS; bar.x = 0; bar.st = nullptr;
    if (use_bar) bar = xcd_barrier_post((unsigned*)(F.ws + WS_CTL) + CW_BAR + args.li * XCD_BAR_WORDS, MISC + 8);
#ifdef PH_ONLY
#define IN(k) ((k) == PH_ONLY && lo <= (k) && (k) < hi)
#else
#define IN(k) (lo <= (k) && (k) < hi)
#endif
#define SEAM(k) do { if (IN(k) && IN((k) + 1)) xcd_barrier(bar); } while (0)
    LAS unsigned char* ring = F.lds;

#ifndef PROBE_MASK
#define PROBE_MASK 0ull
#endif
    constexpr unsigned long long REP_MASK = PROBE_MASK;
#define PHASE(k, ...) if (IN(k)) { if (((REP_MASK >> (k)) & 1ull) != 0ull) { const bool dry_ = true; (void)dry_; __VA_ARGS__ xcd_barrier(bar); } { const bool dry_ = false; (void)dry_; __VA_ARGS__ } } SEAM(k);
#define GATE(L, q) (dry_ ? (const float*)(F.ws + WS_CTL + 524288) : WSP(float, WS_MOD) + (size_t)((L) * 3) * 12288 + (q) * 2048)
#define NORMIN(site) NormIn{WSP(float, WS_PART) + (size_t)(site) * MTOK * 32, WSP(float, WS_SW) + (size_t)(site) * 3 * 8192, (const LAS float*)(F.lds + LDS_RSTD_OFF), pm0_}
    PHASE(0, p0_prologue(F);)
    PHASE(1, p1_phase(F);)

#define GEMM_PHASE(EpiT, epi, Aptr, Bptr, M_, N_, K_) do { int kk_ = (K_); asm volatile("" : "+s"(kk_)); pg8::Gemm g{(const pg8::bf16_t*)(Aptr), (const pg8::bf16_t*)(Bptr), (M_), (N_), kk_}; pg8::StaticOrder S; S.init((M_), (N_), F.G, F.bx); \
        pg8::gemm_phase<EpiT, pg8::StaticOrder, PG8_ALIGN, PG8_SP2>(ring, g, S, epi); } while (0)

#ifndef FFN2_WGM
#define FFN2_WGM 4
#endif
#define GEMM_PHASE_W(EpiT, epi, Aptr, Bptr, M_, N_, K_, WGM_) do { int kk_ = (K_); asm volatile("" : "+s"(kk_)); pg8::Gemm g{(const pg8::bf16_t*)(Aptr), (const pg8::bf16_t*)(Bptr), (M_), (N_), kk_}; pg8::StaticOrder S; S.init((M_), (N_), F.G, F.bx, (WGM_)); \
        pg8::gemm_phase<EpiT, pg8::StaticOrder, PG8_ALIGN, PG8_SP2>(ring, g, S, epi); } while (0)
#define GEMM_PHASE_N(site, EpiT, EPI_INIT, Aptr, Bptr, M_, N_, K_) do { int kk_ = (K_); asm volatile("" : "+s"(kk_)); pg8::Gemm g{(const pg8::bf16_t*)(Aptr), (const pg8::bf16_t*)(Bptr), (M_), (N_), kk_}; pg8::StaticOrder S; S.init((M_), (N_), F.G, F.bx); \
        const int pm0_ = prep_rstd(F, S, (site)); EpiT E EPI_INIT; pg8::gemm_phase<EpiT, pg8::StaticOrder, PG8_ALIGN, PG8_SP2>(ring, g, S, E); } while (0)
#define ARGS(...) {__VA_ARGS__}
#ifndef RES_ALIGN
#define RES_ALIGN true
#endif
#define GEMM_PHASE_R(EpiT, epi, Aptr, Bptr, M_, N_, K_) do { int kk_ = (K_); asm volatile("" : "+s"(kk_)); pg8::Gemm g{(const pg8::bf16_t*)(Aptr), (const pg8::bf16_t*)(Bptr), (M_), (N_), kk_}; pg8::StaticOrder S; S.init((M_), (N_), F.G, F.bx); \
        pg8::gemm_phase<EpiT, pg8::StaticOrder, RES_ALIGN, PG8_SP2>(ring, g, S, epi); } while (0)
#define LAYER_TAIL(P, L) \
    PHASE((P), { EpiResidT<true> E{F.in[I_XP], F.in[I_XS], WSP(float, WS_X), GATE((L), 2), (L) == 0 ? 1 : 0, WSP(float, WS_AROW), WSP(float, WS_SCOLO) + (L) * 2048, dry_ ? (bf16*)nullptr : WSP(bf16, WS_H), F.in[I_NORMG] + (size_t)((L) * 2 + 1) * 2048, \
            WSP(float, WS_MOD) + (size_t)((L) * 3) * 12288 + 4 * 2048, WSP(float, WS_PART) + (size_t)(2 * (L) + 1) * MTOK * 32, WSP(float, WS_PMAX) + (size_t)(2 * (L) + 1) * MTOK * 32}; \
            int kk_ = 1024; asm volatile("" : "+s"(kk_)); pg8::Gemm g{(const pg8::bf16_t*)(F.ws + WS_AO8), (const pg8::bf16_t*)(F.ws + WS_WWOT + (size_t)(L) * 2048 * 2048), MTOK, DM, kk_}; pg8::StaticOrder S; S.init(MTOK, DM, F.G, F.bx); \
            pg8::gemm_phase<EpiResidT<true>, pg8::StaticOrder, PG8_ALIGN, PG8_SP2, true>(ring, g, S, E); }) \
    PHASE((P) + 1, q8_phase(F, (L), (L) == 0);) \
    PHASE((P) + 2, { EpiRelu2I8 E{WSP(bf16, WS_HID), FFH, WSP(float, WS_FROW) + (size_t)(L) * MTOK, WSP(float, WS_SCOL) + (L) * 8192, WSP(float, WS_SW) + (size_t)(2 * (L) + 1) * 3 * 8192}; \
            int kk_ = 1024; asm volatile("" : "+s"(kk_)); pg8::Gemm g{(const pg8::bf16_t*)(F.ws + WS_H8), (const pg8::bf16_t*)(F.ws + WS_W1T + (size_t)(L) * 8192 * 2048), MTOK, FFH, kk_}; pg8::StaticOrder S; S.init(MTOK, FFH, F.G, F.bx); \
            pg8::gemm_phase<EpiRelu2I8, pg8::StaticOrder, I8_ALIGN, I8_SP2, true>(ring, g, S, E); }) \
    PHASE((P) + 3, EpiResid E{F.in[I_XP], F.in[I_XS], WSP(float, WS_X), GATE((L), 5), 0, (const float*)nullptr, (const float*)nullptr, (dry_ || (L) == 3) ? (bf16*)nullptr : WSP(bf16, WS_H), F.in[I_NORMG] + (size_t)(((L) + 1) * 2) * 2048, \
            WSP(float, WS_MOD) + (size_t)(((L) + 1) * 3) * 12288 + 1 * 2048, WSP(float, WS_PART) + (size_t)(2 * ((L) + 1)) * MTOK * 32, (float*)nullptr}; GEMM_PHASE_W(EpiResid, E, WSP(bf16, WS_HID), WSP(bf16, WS_W2T) + (size_t)(L) * DM * FFH, MTOK, DM, FFH, FFN2_WGM);)

#define WIN_LAYER(P, L, J) \
    PHASE((P), GEMM_PHASE_N(2 * (L), EpiQkvWin, ARGS(WSP(bf16, WS_WQ), WSP(bf16, WS_WK), WSP(bf16, WS_WV), F.out + O_WK, F.out + O_WV, (J), WSP(f32x2, WS_TABW), NORMIN(2 * (L))), \
        WSP(bf16, WS_H), WSP(bf16, WS_WQKVT) + (size_t)(J) * 3072 * DM, MTOK, 3072, DM);) \
    PHASE((P) + 1, attn_win_phase(F, (J));) \
    PHASE((P) + 2, aoq_phase(F);) \
    LAYER_TAIL((P) + 3, (L))

    WIN_LAYER(2, 0, 0)
    PHASE(9, GEMM_PHASE_N(2, EpiF32, ARGS(WSP(float, WS_MD), 1024, NORMIN(2)), WSP(bf16, WS_H), WSP(bf16, WS_MWDT), MTOK, 1024, DM);)
    PHASE(10, mla_norm_phase(F);)
    PHASE(11, { EpiMlaQ E{WSP(bf16, WS_MQ), WSP(f32x2, WS_TABM)}; GEMM_PHASE(EpiMlaQ, E, WSP(bf16, WS_MCQ), WSP(bf16, WS_MWUQT), MTOK, 3072, 512); }
             { EpiMlaKV E{WSP(bf16, WS_MKN), WSP(bf16, WS_MV)}; GEMM_PHASE(EpiMlaKV, E, WSP(bf16, WS_MCKV), WSP(bf16, WS_MWUKVT), MTOK + 1024, 4096, 256); })
#ifdef PROBE_SLEEP
    if (IN(11)) { const unsigned long long t0_ = __builtin_amdgcn_s_memrealtime(); while (__builtin_amdgcn_s_memrealtime() - t0_ < (unsigned long long)PROBE_SLEEP * 100ull) __builtin_amdgcn_s_sleep(8); }
#endif
    PHASE(12, attn_mla_phase(F);)
    PHASE(13, aoq_phase(F);)
    LAYER_TAIL(14, 1)
    PHASE(18, GEMM_PHASE_N(4, EpiGlaIn, ARGS(WSP(bf16, WS_GQ), WSP(bf16, WS_GK), WSP(bf16, WS_GV), WSP(bf16, WS_GR), WSP(float, WS_GU), NORMIN(4)), WSP(bf16, WS_H), WSP(bf16, WS_GWINT), MTOK, 6144, DM); gla_u_phase(F);)
    PHASE(19, gla_prep_phase(F);)
    PHASE(20, gla_scanA_phase(F);)
    PHASE(21, gla_scan_phase(F);)
    PHASE(22, gla_post_phase(F);)
    LAYER_TAIL(23, 2)
    WIN_LAYER(27, 3, 1)
    PHASE(34, final_phase(F);)
#undef IN
#undef SEAM
}

extern "C" void kernel_launch(void* const* d_in, const int* in_sizes, int n_in, void* d_out, int out_size, void* d_ws, size_t ws_size, hipStream_t stream) {
    static int grid = 0;
    if (grid == 0) {
        if (n_in != 31 || (size_t)out_size != O_END || ws_size < WS_END) { fprintf(stderr, "kernel_launch: shape mismatch n_in %d out %d ws %zu (need %zu)\n", n_in, out_size, ws_size, (size_t)WS_END); grid = -1; return; }
        int dev = 0, cus = 0, per_cu = 0;
        if (hipGetDevice(&dev) != hipSuccess || hipDeviceGetAttribute(&cus, hipDeviceAttributeMultiprocessorCount, dev) != hipSuccess) { grid = -1; return; }
        if (hipFuncSetAttribute((const void*)mk_fwd, hipFuncAttributeMaxDynamicSharedMemorySize, LDS_BYTES) != hipSuccess) { fprintf(stderr, "kernel_launch: hipFuncSetAttribute failed\n"); grid = -1; return; }
        if (hipOccupancyMaxActiveBlocksPerMultiprocessor(&per_cu, (const void*)mk_fwd, NWAVES * 64, LDS_BYTES) != hipSuccess || per_cu < 1) fprintf(stderr, "kernel_launch: occupancy query says %d\n", per_cu);
        (void)hipGetLastError();
        grid = cus;
    }
    if (grid < 0) return;
    if (hipMemsetAsync((char*)d_ws + WS_CTL, 0, CTL_ZERO_BYTES, stream) != hipSuccess) return;
    Args a{};
    for (int i = 0; i < 31; ++i) a.in[i] = (const float*)d_in[i];
    a.in[31] = nullptr;
    a.out = (float*)d_out; a.ws = (unsigned char*)d_ws; a.pad = 0; a.rep_mask = 0ull; a.rep_n = 1; a.pad2 = 0;
#if MK_N_LAUNCHES == 1
    a.ph_lo = 0; a.ph_hi = N_PHASES; a.li = 0;
    hipLaunchKernelGGL(mk_fwd, dim3(grid), dim3(NWAVES * 64), LDS_BYTES, stream, a);
#else
    for (int p = 0; p < N_PHASES; ++p) { a.ph_lo = p; a.ph_hi = p + 1; a.li = 0; hipLaunchKernelGGL(mk_fwd, dim3(grid), dim3(NWAVES * 64), LDS_BYTES, stream, a); }
#endif
}
```

```cpp
#include <hip/hip_runtime.h>
#include <cstdio>
#include <cstdint>
namespace pg8 {
#define PG8_LAS __attribute__((address_space(3)))
typedef unsigned short bf16_t;
typedef short bf16x8 __attribute__((ext_vector_type(8)));
typedef float f32x4 __attribute__((ext_vector_type(4)));
typedef unsigned u32x4 __attribute__((ext_vector_type(4)));
constexpr int BM = 256, BK = 64, HALF = 128, HTB = HALF * BK * 2  , STAGE_BYTES = 8 * HTB, NXCD = 8, WGM = 8;

__host__ __device__ __forceinline__ int lds_byte(int r, int c) { const int st = (r >> 4) * 2 + (c >> 5), rr = r & 15, cc = c & 31, ob = rr * 64 + cc * 2; return st * 1024 + (ob ^ (((ob >> 9) & 1) << 5)); }
__host__ __device__ __forceinline__ void stage_rc(int b, int& R, int& C) { const int st = b / 1024, sb = b % 1024, swz = sb ^ (((sb >> 9) & 1) << 5); R = (st >> 1) * 16 + swz / 64; C = (st & 1) * 32 + (swz % 64) / 2; }
__host__ __device__ __forceinline__ int perm32(int rho) { const int n = rho >> 4, i = rho & 15; return 8 * (i >> 2) + 4 * n + (i & 3); }

struct Unit { int pm, pn; };
struct Gemm { const bf16_t* A; const bf16_t* Bt; int M, N, K; int atile; };

struct StaticOrder {
    int nM, nN, nwg, G, c, wgm;
    __host__ __device__ void init(int M, int N, int G_, int c_, int wgm_ = WGM) { nM = M / BM; nN = N / BM; nwg = nM * nN; G = G_; c = c_; wgm = wgm_; }
    __host__ __device__ bool next(int i, Unit& u) const {
        const long L = (long)i * G + c; if (L >= nwg) return false;
        int wgid = (int)L; { const int q = nwg / NXCD, r = nwg % NXCD, xcd = wgid % NXCD, off = wgid / NXCD; wgid = (xcd < r ? xcd * (q + 1) : r * (q + 1) + (xcd - r) * q) + off; }
        const int nig = wgm * nN, gid = wgid / nig, fm = gid * wgm, gsz = (nM - fm) < wgm ? (nM - fm) : wgm;
        u.pm = fm + ((wgid % nig) % gsz); u.pn = (wgid % nig) / gsz; return true;
    }
    __device__ __forceinline__ void a_ready(const Unit&) const {}
    __device__ __forceinline__ void done(const Unit&) const {}
};
__device__ __forceinline__ unsigned cvt_pk_bf16(float lo, float hi) { unsigned r; asm volatile("v_cvt_pk_bf16_f32 %0, %1, %2" : "=v"(r) : "v"(lo), "v"(hi)); return r; }
typedef float f32x2 __attribute__((ext_vector_type(2)));
typedef int i32x4 __attribute__((ext_vector_type(4)));
template <bool I8> __device__ __forceinline__ f32x4 mma16(bf16x8 b, bf16x8 a, f32x4 c) {
    if constexpr (I8) return __builtin_bit_cast(f32x4, __builtin_amdgcn_mfma_i32_16x16x64_i8(__builtin_bit_cast(i32x4, b), __builtin_bit_cast(i32x4, a), __builtin_bit_cast(i32x4, c), 0, 0, 0));
    else return __builtin_amdgcn_mfma_f32_16x16x32_bf16(b, a, c, 0, 0, 0);
}
template <class Epi, class Sched, bool ALIGN_EPI = false, bool SP2 = false, bool I8 = false>
__device__ __forceinline__ void gemm_phase(PG8_LAS unsigned char* lds, const Gemm g, const Sched& S, const Epi& E) {
    const int tid = threadIdx.x, wid = __builtin_amdgcn_readfirstlane(tid >> 6), lane = tid & 63, wr = wid >> 2, wc = wid & 3, fr = lane & 15, fq = lane >> 4;
    const int K = g.K, nt = K / BK;
    unsigned voffA[2], voffB[2];
#pragma unroll
    for (int i = 0; i < 2; ++i) { int R, C; stage_rc(tid * 16 + i * 8192, R, C); const int Rb = Epi::PERM ? ((R & ~31) + perm32(R & 31)) : R;
        voffA[i] = (unsigned)(R * (g.atile ? BK : K) + C) * 2u; voffB[i] = (unsigned)(Rb * K + C) * 2u; }
    const size_t kstep = (size_t)(BK * 2);
    const size_t hstep = (size_t)HALF * K * 2;
    const size_t tstep = 2 * hstep;
    const size_t kstepA = g.atile ? (size_t)(BM * BK * 2) : kstep, hstepA = g.atile ? (size_t)(HALF * BK * 2) : hstep;
    const unsigned ldsw = (unsigned)wid * 1024u;
    const int aoff = lds_byte(wr * 64 + fr, fq * 8), boff = lds_byte(wc * 32 + fr, fq * 8);
#define PG8_SA(b, h) (((b) * 2 + (h)) * HTB)
#define PG8_SB(b, h) ((4 + (b) * 2 + (h)) * HTB)
#define PG8_STAGE(bufoff, gbase, voff) do { _Pragma("unroll") for (int _i = 0; _i < 2; ++_i) \
        __builtin_amdgcn_global_load_lds((const unsigned*)((const char*)(gbase) + (voff)[_i]), (PG8_LAS unsigned*)(lds + (bufoff) + ldsw + _i * 8192), 16, 0, 0); } while (0)
#define PG8_LDA(dst, b, h) do { _Pragma("unroll") for (int m = 0; m < 4; ++m) _Pragma("unroll") for (int k = 0; k < 2; ++k) dst[m][k] = *(const PG8_LAS bf16x8*)(lds + PG8_SA(b, h) + aoff + m * 2048 + k * 1024); } while (0)
#define PG8_LDB(dst, b, h) do { _Pragma("unroll") for (int n = 0; n < 2; ++n) _Pragma("unroll") for (int k = 0; k < 2; ++k) dst[n][k] = *(const PG8_LAS bf16x8*)(lds + PG8_SB(b, h) + boff + n * 2048 + k * 1024); } while (0)
#define PG8_MMA(ai, bj, At, Bt) do { __builtin_amdgcn_s_setprio(1); _Pragma("unroll") for (int m = 0; m < 4; ++m) _Pragma("unroll") for (int n = 0; n < 2; ++n) _Pragma("unroll") for (int k = 0; k < 2; ++k) \
        acc[ai][bj][m][n] = mma16<I8>(Bt[n][k], At[m][k], acc[ai][bj][m][n]); __builtin_amdgcn_s_setprio(0); } while (0)
#define PG8_WAIT_V(n) asm volatile("s_waitcnt vmcnt(" #n ")" ::: "memory")
#define PG8_WAIT_L(n) asm volatile("s_waitcnt lgkmcnt(" #n ")" ::: "memory")
#define PG8_BAR __builtin_amdgcn_s_barrier()
#define PG8_SCHED __builtin_amdgcn_sched_barrier(0)
    Unit cur, nxt; int ui = 0;
    if (!S.next(0, cur)) return;
    f32x4 acc[2][2][4][2];
#pragma unroll
    for (int a = 0; a < 2; ++a)
#pragma unroll
        for (int b = 0; b < 2; ++b)
#pragma unroll
            for (int m = 0; m < 4; ++m)
#pragma unroll
                for (int n = 0; n < 2; ++n) acc[a][b][m][n] = (f32x4){0.f, 0.f, 0.f, 0.f};
    bf16x8 At[4][2], B0[2][2], B1[2][2];
    const char* cA = (const char*)g.A + (size_t)cur.pm * tstep; const char* cB = (const char*)g.Bt + (size_t)cur.pn * tstep;
    S.a_ready(cur);
    if constexpr (SP2) {
        PG8_STAGE(PG8_SB(0, 0), cB, voffB); PG8_STAGE(PG8_SB(0, 1), cB + hstep, voffB); PG8_STAGE(PG8_SA(0, 0), cA, voffA); PG8_STAGE(PG8_SA(0, 1), cA + hstepA, voffA);
        if (wr == 1) PG8_BAR;
        PG8_WAIT_V(2); PG8_BAR;
        PG8_STAGE(PG8_SB(1, 0), cB + kstep, voffB); PG8_STAGE(PG8_SA(1, 0), cA + kstepA, voffA); PG8_STAGE(PG8_SB(1, 1), cB + hstep + kstep, voffB);
        PG8_WAIT_V(6); PG8_BAR;
    } else {
        PG8_STAGE(PG8_SB(0, 0), cB, voffB); PG8_STAGE(PG8_SA(0, 0), cA, voffA); PG8_STAGE(PG8_SB(0, 1), cB + hstep, voffB); PG8_STAGE(PG8_SA(0, 1), cA + hstepA, voffA);
        if (wr == 1) PG8_BAR;
        PG8_WAIT_V(4); PG8_BAR;
        PG8_STAGE(PG8_SB(1, 0), cB + kstep, voffB); PG8_STAGE(PG8_SA(1, 0), cA + kstepA, voffA); PG8_STAGE(PG8_SB(1, 1), cB + hstep + kstep, voffB);
        PG8_WAIT_V(6); PG8_BAR;
    }
    for (;;) {
        const bool has_next = S.next(ui + 1, nxt);
        const char* nA = has_next ? (const char*)g.A + (size_t)nxt.pm * tstep : cA; const char* nB = has_next ? (const char*)g.Bt + (size_t)nxt.pn * tstep : cB;
        asm volatile(".p2align 8");
        for (int t = 0; t < nt; t += 2) {
            const bool last = (t == nt - 2);
            const char* a1 = cA + (size_t)(t + 1) * kstepA;
            const char* a2 = last ? nA : cA + (size_t)(t + 2) * kstepA; const char* b2 = last ? nB : cB + (size_t)(t + 2) * kstep;
            const char* a3 = a2 + kstepA; const char* b3 = b2 + kstep;
            if (last && has_next) S.a_ready(nxt);
            if constexpr (SP2) {
            PG8_LDB(B0, 0, 0); PG8_LDB(B1, 0, 1); PG8_SCHED; PG8_LDA(At, 0, 0); PG8_STAGE(PG8_SA(1, 1), a1 + hstepA, voffA);
            PG8_WAIT_V(8); PG8_WAIT_L(0); PG8_BAR; PG8_MMA(0, 0, At, B0); PG8_MMA(0, 1, At, B1); PG8_BAR; PG8_SCHED;
            PG8_LDA(At, 0, 1); PG8_STAGE(PG8_SB(0, 0), b2, voffB); PG8_STAGE(PG8_SB(0, 1), b2 + hstep, voffB); PG8_STAGE(PG8_SA(0, 0), a2, voffA);
            PG8_WAIT_V(8); PG8_WAIT_L(0); PG8_BAR; PG8_MMA(1, 0, At, B0); PG8_MMA(1, 1, At, B1); PG8_BAR; PG8_SCHED;
            PG8_LDB(B0, 1, 0); PG8_LDB(B1, 1, 1); PG8_SCHED; PG8_LDA(At, 1, 0); PG8_STAGE(PG8_SA(0, 1), a2 + hstepA, voffA);
            PG8_WAIT_V(8); PG8_WAIT_L(0); PG8_BAR; PG8_MMA(0, 0, At, B0); PG8_MMA(0, 1, At, B1); PG8_BAR; PG8_SCHED;
            PG8_LDA(At, 1, 1); PG8_STAGE(PG8_SB(1, 0), b3, voffB); PG8_STAGE(PG8_SB(1, 1), b3 + hstep, voffB); PG8_STAGE(PG8_SA(1, 0), a3, voffA);
            PG8_WAIT_V(8); PG8_WAIT_L(0); PG8_BAR; PG8_MMA(1, 0, At, B0); PG8_MMA(1, 1, At, B1); PG8_BAR; PG8_SCHED;
            } else {
            PG8_LDB(B0, 0, 0); PG8_SCHED; PG8_LDA(At, 0, 0); PG8_STAGE(PG8_SA(1, 1), a1 + hstepA, voffA);
            PG8_WAIT_L(8); PG8_BAR; PG8_WAIT_L(0); PG8_MMA(0, 0, At, B0); PG8_BAR; PG8_SCHED;
            PG8_LDB(B1, 0, 1); PG8_STAGE(PG8_SB(0, 0), b2, voffB);
            PG8_BAR; PG8_WAIT_L(0); PG8_MMA(0, 1, At, B1); PG8_BAR;
            PG8_LDA(At, 0, 1); PG8_STAGE(PG8_SA(0, 0), a2, voffA);
            PG8_BAR; PG8_WAIT_L(0); PG8_MMA(1, 0, At, B0); PG8_BAR; PG8_SCHED;
            PG8_STAGE(PG8_SB(0, 1), b2 + hstep, voffB);
            PG8_WAIT_V(6); PG8_BAR; PG8_MMA(1, 1, At, B1); PG8_BAR;
            PG8_LDB(B0, 1, 0); PG8_SCHED; PG8_LDA(At, 1, 0); PG8_STAGE(PG8_SA(0, 1), a2 + hstepA, voffA);
            PG8_WAIT_L(8); PG8_BAR; PG8_WAIT_L(0); PG8_MMA(0, 0, At, B0); PG8_BAR; PG8_SCHED;
            PG8_LDB(B1, 1, 1); PG8_STAGE(PG8_SB(1, 0), b3, voffB);
            PG8_BAR; PG8_WAIT_L(0); PG8_MMA(0, 1, At, B1); PG8_BAR;
            PG8_LDA(At, 1, 1); PG8_STAGE(PG8_SA(1, 0), a3, voffA);
            PG8_BAR; PG8_WAIT_L(0); PG8_MMA(1, 0, At, B0); PG8_BAR; PG8_SCHED;
            PG8_STAGE(PG8_SB(1, 1), b3 + hstep, voffB);
            PG8_WAIT_V(6); PG8_BAR; PG8_MMA(1, 1, At, B1); PG8_BAR;
            }
        }
        if constexpr (ALIGN_EPI) { if (wr == 0) PG8_BAR; }
        if constexpr (!Epi::AFTER_DRAIN) { E(acc, cur, wr, wc, fr, fq); S.done(cur); }
        if (!has_next) break;
#pragma unroll
        for (int a = 0; a < 2; ++a)
#pragma unroll
            for (int b = 0; b < 2; ++b)
#pragma unroll
                for (int m = 0; m < 4; ++m)
#pragma unroll
                    for (int n = 0; n < 2; ++n) acc[a][b][m][n] = (f32x4){0.f, 0.f, 0.f, 0.f};
        cur = nxt; cA = nA; cB = nB; ++ui;
        if constexpr (ALIGN_EPI) { if (wr == 1) PG8_BAR; }
    }
    PG8_WAIT_V(0);
    if constexpr (!ALIGN_EPI) { if (wr == 0) PG8_BAR; }
    PG8_BAR;
    if constexpr (Epi::AFTER_DRAIN) { E.fused(acc, cur, wr, wc, fr, fq, lds, wid, lane); S.done(cur); }
#undef PG8_SA
#undef PG8_SB
#undef PG8_STAGE
#undef PG8_LDA
#undef PG8_LDB
#undef PG8_MMA
#undef PG8_WAIT_V
#undef PG8_WAIT_L
#undef PG8_BAR
#undef PG8_SCHED
}
}

#define GAS __attribute__((address_space(1)))
#define LAS __attribute__((address_space(3)))
typedef unsigned short bf16;
typedef unsigned v4u __attribute__((ext_vector_type(4)));
typedef unsigned v2u __attribute__((ext_vector_type(2)));
typedef float f32x4 __attribute__((ext_vector_type(4)));
typedef float f32x2 __attribute__((ext_vector_type(2)));
typedef float f32x16 __attribute__((ext_vector_type(16)));
typedef short bf16x8 __attribute__((ext_vector_type(8)));
typedef short s16x4 __attribute__((ext_vector_type(4)));
typedef GAS unsigned gu32;
#define RLX_AGENT __ATOMIC_RELAXED, __HIP_MEMORY_SCOPE_AGENT
#define LDS_WAIT() asm volatile("s_waitcnt lgkmcnt(0)" ::: "memory")
#define VM_WAIT() asm volatile("s_waitcnt vmcnt(0)" ::: "memory")
#define SBAR() __builtin_amdgcn_sched_barrier(0)
__device__ __forceinline__ unsigned f2bf(float f) { unsigned u = __builtin_bit_cast(unsigned, f); return (u + 0x7fffu + ((u >> 16) & 1u)) >> 16; }
__device__ __forceinline__ unsigned pk2(float lo, float hi) { return f2bf(lo) | (f2bf(hi) << 16); }
__device__ __forceinline__ float bf2f(unsigned short b) { return __builtin_bit_cast(float, (unsigned)b << 16); }
__device__ __forceinline__ unsigned cvtpk(float lo, float hi) { unsigned r; asm volatile("v_cvt_pk_bf16_f32 %0, %1, %2" : "=v"(r) : "v"(lo), "v"(hi)); return r; }
__device__ __forceinline__ float wave_sum(float v) {
#pragma unroll
    for (int o = 1; o < 64; o <<= 1) v += __shfl_xor(v, o);
    return v;
}
#define XB_TMO      128
#define XB_XCNT(j)  (256  + 64 * (j))
#define XB_XSUB(j)  (1280 + 64 * (j))
#define XB_XGEN(j)  (2304 + 64 * (j))
#define XB_TOP      3328
#define XB_TOPGEN   3392
#define XCD_BAR_WORDS 3456
#define XB_SPIN_CAP (1u << 18)

__device__ __forceinline__ unsigned xb_ld(unsigned* p)              { return __hip_atomic_load(p, __ATOMIC_RELAXED, __HIP_MEMORY_SCOPE_AGENT); }
__device__ __forceinline__ unsigned xb_add(unsigned* p, unsigned v) { return __hip_atomic_fetch_add(p, v, __ATOMIC_RELAXED, __HIP_MEMORY_SCOPE_AGENT); }
__device__ __forceinline__ unsigned xb_xcc_id() { return (unsigned)__builtin_amdgcn_s_getreg((3 << 11) | 20) & 0xFu; }
#define XB_SPIN(cond, bar) do { unsigned _sp = 0; while (cond) { __builtin_amdgcn_s_sleep(1); \
    if ((++_sp & 255u) == 0u) { if (xb_ld(&(bar)[XB_TMO])) break; if (_sp > XB_SPIN_CAP) { atomicAdd(&(bar)[XB_TMO], 1u); break; } } } } while (0)

struct XcdBarrier {
    unsigned* bar; unsigned x;
    volatile LAS unsigned* st;
};

__device__ __forceinline__ XcdBarrier xcd_barrier_post(unsigned* bar, volatile LAS unsigned* st) {
    XcdBarrier b; b.bar = bar; b.x = xb_xcc_id(); b.st = st;
    if (threadIdx.x == 0) (void)xb_add(&bar[XB_XCNT(b.x)], 1u);
    return b;
}
__device__ __forceinline__ void xcd_barrier_complete(unsigned* bar, unsigned x, unsigned& nloc, unsigned& nx) {
    const unsigned G = gridDim.x * gridDim.y * gridDim.z;
    unsigned sum, cnt, mine, sp = 0u;
    for (;;) {
        sum = 0u; cnt = 0u; mine = 0u;
#pragma unroll
        for (unsigned j = 0; j < 16; ++j) { const unsigned c = xb_ld(&bar[XB_XCNT(j)]); sum += c; cnt += (c > 0u) ? 1u : 0u; mine = (j == x) ? c : mine; }
        if (sum == G) break;
        __builtin_amdgcn_s_sleep(1);
        if ((++sp & 255u) == 0u) { if (xb_ld(&bar[XB_TMO])) break; if (sp > XB_SPIN_CAP) { atomicAdd(&bar[XB_TMO], 1u); break; } }
    }
    nloc = mine > 0u ? mine : 1u; nx = cnt > 0u ? cnt : 1u;
}

__device__ __forceinline__ void xcd_barrier(const XcdBarrier& b) {
    asm volatile("s_waitcnt vmcnt(0)" ::: "memory");
    __syncthreads();
    if (threadIdx.x == 0) {
        unsigned* bar = b.bar;
        __builtin_amdgcn_s_waitcnt(0);
        unsigned nloc = b.st[0], nx = b.st[1];
        if (nloc == 0u) { xcd_barrier_complete(bar, b.x, nloc, nx); b.st[0] = nloc; b.st[1] = nx; }
        const unsigned old = xb_add(&bar[XB_XSUB(b.x)], 1u);
        const unsigned gen = old / nloc;
        if (old + 1u == (gen + 1u) * nloc) {
            __builtin_amdgcn_fence(__ATOMIC_RELEASE, "agent");
            asm volatile("s_waitcnt vmcnt(0)" ::: "memory");
            const unsigned og = xb_add(&bar[XB_TOP], 1u);
            const unsigned tg = og / nx;
            if (og + 1u == (tg + 1u) * nx) xb_add(&bar[XB_TOPGEN], 1u);
            else XB_SPIN(xb_ld(&bar[XB_TOPGEN]) == tg, bar);
            __builtin_amdgcn_fence(__ATOMIC_ACQUIRE, "agent");
            xb_add(&bar[XB_XGEN(b.x)], 1u);
            asm volatile("s_waitcnt vmcnt(0)" ::: "memory");
        } else {
            XB_SPIN(xb_ld(&bar[XB_XGEN(b.x)]) == gen, bar);
            __builtin_amdgcn_fence(__ATOMIC_ACQUIRE, "agent");
            asm volatile("s_waitcnt vmcnt(0)" ::: "memory");
        }
    }
    __syncthreads();
}

constexpr int NWAVES = 8;
constexpr int DM = 2048, MTOK = 16384, MP = 8192, FFH = 8192;
constexpr float EPS = 1e-6f;
constexpr size_t MiB = 1u << 20;
constexpr size_t WS_CTL = 0, CTL_ZERO_BYTES = 1 * MiB;
constexpr size_t WS_MOD = 2 * MiB;
constexpr size_t WS_TABW = 2 * MiB + 655360;
constexpr size_t WS_TABM = 2 * MiB + 720896;
constexpr size_t WS_SW = 3 * MiB;
constexpr size_t WS_W1T = 4 * MiB;
constexpr size_t WS_SCOL = 3 * MiB + 786432;
constexpr size_t WS_W2T = 132 * MiB;
constexpr size_t WS_WQKVT = 260 * MiB;
constexpr size_t WS_WWOT = 284 * MiB;
constexpr size_t WS_SCOLO = 3 * MiB + 786432 + 131072;
constexpr size_t WS_MWDT = 300 * MiB;
constexpr size_t WS_MWUQT = 304 * MiB;
constexpr size_t WS_MWUKVT = 307 * MiB;
constexpr size_t WS_MWOT = 309 * MiB;
constexpr size_t WS_GWINT = 317 * MiB;
constexpr size_t WS_GWOT = 342 * MiB;
constexpr size_t WS_CTXK = 350 * MiB;
constexpr size_t WS_CTXV = 352 * MiB;
constexpr size_t WS_X = 354 * MiB;
constexpr size_t WS_H = 482 * MiB;
constexpr size_t WS_AO = 546 * MiB;
constexpr size_t WS_SCR = 610 * MiB;
constexpr size_t WS_HID = WS_SCR;
constexpr size_t WS_WQ = WS_SCR, WS_WK = WS_SCR + 64 * MiB, WS_WV = WS_SCR + 80 * MiB;
constexpr size_t WS_MD = WS_SCR, WS_MCQ = WS_SCR + 64 * MiB, WS_MCKV = WS_SCR + 80 * MiB, WS_MKR = WS_SCR + 89 * MiB, WS_MQ = WS_SCR + 92 * MiB, WS_MKN = WS_SCR + 188 * MiB, WS_MV = WS_SCR + 256 * MiB;
constexpr size_t WS_GQ = WS_SCR, WS_GK = WS_SCR + 32 * MiB, WS_GV = WS_SCR + 64 * MiB, WS_GR = WS_SCR + 128 * MiB, WS_GU = WS_SCR + 192 * MiB,
                 WS_GQT = WS_SCR + 194 * MiB, WS_GKD = WS_SCR + 258 * MiB, WS_GAM = WS_SCR + 322 * MiB, WS_GDEC = WS_SCR + 338 * MiB, WS_GOF = WS_SCR + 340 * MiB, WS_GOB = WS_SCR + 468 * MiB;
constexpr size_t WS_PART = WS_SCR + 596 * MiB;
constexpr size_t WS_PMAX = WS_PART + 16 * MiB;
constexpr size_t WS_FROW = WS_PMAX + 16 * MiB;
constexpr size_t WS_H8 = WS_FROW + 1 * MiB;
constexpr size_t WS_GLS = WS_H8 + 32 * MiB;
constexpr size_t WS_GDS = WS_GLS + 24 * MiB;
constexpr size_t WS_AO8 = WS_GDS + 1 * MiB;
constexpr size_t WS_AROW = WS_AO8 + 32 * MiB;
constexpr size_t WS_END = WS_AROW + 1 * MiB;
constexpr size_t O_YP = 0, O_YS = 16777216, O_WK = 33554432, O_WV = 41943040, O_CKV = 50331648, O_KR = 52428800, O_GF = 52953088, O_GB = 69730304, O_END = 86507520;
constexpr int CW_BAR = 4096;
constexpr int RING_BYTES = 131072, MISC_OFF = 159744 + 320, LDS_BYTES = 163840;

struct Args {
    const float* in[32]; float* out; unsigned char* ws; int ph_lo, ph_hi, li, pad; unsigned long long rep_mask; int rep_n, pad2;
};
enum { I_XP = 0, I_XS, I_C, I_CWK, I_CWV, I_CCKV, I_CKR, I_SGF, I_SGB, I_CCTX, I_ADAW, I_ADAB, I_NORMG, I_WQKV, I_SINK, I_WWO, I_MWD, I_MQN, I_MWUQ, I_MKVN, I_MWUKV, I_MWO,
       I_GWIN, I_GWA1, I_GWA2, I_GBA, I_GNORM, I_GWO, I_W1, I_W2, I_FNORM };

__device__ __forceinline__ int cond_of_pm(int pm) { return pm < 32 ? 0 : (pm >> 4) - 1; }

__device__ __forceinline__ v4u pack8(const f32x4& a, const f32x4& b) { v4u w; w.x = cvtpk(a[0], a[1]); w.y = cvtpk(a[2], a[3]); w.z = cvtpk(b[0], b[1]); w.w = cvtpk(b[2], b[3]); return w; }

struct NormIn {
    const float* part; const float* sW; const LAS float* lrs; int pm0;
    __device__ __forceinline__ float rstd(int row, int pm) const {
        if (pm == pm0) return lrs[row & 255];
        const f32x4* pp = (const f32x4*)(part + (size_t)row * 32); f32x4 t = pp[0];
#pragma unroll
        for (int i = 1; i < 8; ++i) t += pp[i];
        return rsqrtf(((t[0] + t[1]) + (t[2] + t[3])) * (1.f / 2048.f) + EPS);
    }
    __device__ __forceinline__ const float* swp(int pm) const { return sW + (size_t)cond_of_pm(pm) * 8192; }
};

template <bool I8> struct EpiResidT {
    static constexpr bool PERM = true, AFTER_DRAIN = false;
    const float* xp; const float* xs; float* X; const float* gate; int first;
    const float* arow; const float* scol;
    bf16* H; const float* ng; const float* nsc; float* rss; float* rmx;
    __device__ __forceinline__ void operator()(const pg8::f32x4 (&acc)[2][2][4][2], const pg8::Unit& u, int wr, int wc, int fr, int fq) const {
        const int row0 = u.pm * 256 + wr * 64 + fr, col0 = u.pn * 256 + wc * 32 + 8 * fq, cond = cond_of_pm(u.pm);
        const float* gp = gate + (size_t)cond * 12288 + col0;
        f32x4 gv[2][2], av[2][2];
#pragma unroll
        for (int bj = 0; bj < 2; ++bj)
#pragma unroll
            for (int n = 0; n < 2; ++n) { gv[bj][n] = *(const f32x4*)(gp + bj * 128 + 4 * n); if constexpr (I8) gv[bj][n] = gv[bj][n] * *(const f32x4*)(scol + col0 + bj * 128 + 4 * n);
                av[bj][n] = H ? *(const f32x4*)(ng + col0 + bj * 128 + 4 * n) * (*(const f32x4*)(nsc + (size_t)cond * 12288 + col0 + bj * 128 + 4 * n) + 1.f) : (f32x4){0.f, 0.f, 0.f, 0.f}; }
        f32x4 xv[2][2][2];
#define ER_LOAD(r, buf) do { const int row_ = row0 + ((r) >> 2) * 128 + ((r) & 3) * 16; const float* sp_ = first ? (row_ < MP ? xp + (size_t)row_ * DM : xs + (size_t)(row_ - MP) * DM) : X + (size_t)row_ * DM; \
        _Pragma("unroll") for (int bj = 0; bj < 2; ++bj) { xv[buf][bj][0] = *(const f32x4*)(sp_ + col0 + bj * 128); xv[buf][bj][1] = *(const f32x4*)(sp_ + col0 + bj * 128 + 4); } } while (0)
        ER_LOAD(0, 0);
#pragma unroll
        for (int r = 0; r < 8; ++r) {
            if (r + 1 < 8) ER_LOAD(r + 1, (r + 1) & 1);
            SBAR();
            const int ai = r >> 2, m = r & 3, row = row0 + ai * 128 + m * 16;
            float* dp = X + (size_t)row * DM;
            float ar_ = 1.f; if constexpr (I8) ar_ = arow[row];
            float ss = 0.f, mx = 0.f;
#pragma unroll
            for (int bj = 0; bj < 2; ++bj) {
                const int c = col0 + bj * 128;
                f32x4 a0 = acc[ai][bj][m][0], a1 = acc[ai][bj][m][1];
                if constexpr (I8) { const pg8::i32x4 i0 = __builtin_bit_cast(pg8::i32x4, a0), i1 = __builtin_bit_cast(pg8::i32x4, a1);
                    a0 = (f32x4){(float)i0[0], (float)i0[1], (float)i0[2], (float)i0[3]} * ar_; a1 = (f32x4){(float)i1[0], (float)i1[1], (float)i1[2], (float)i1[3]} * ar_; }
                const f32x4 x0 = xv[r & 1][bj][0] + gv[bj][0] * a0, x1 = xv[r & 1][bj][1] + gv[bj][1] * a1;
                *(f32x4*)(dp + c) = x0; *(f32x4*)(dp + c + 4) = x1;
                if (H) { ss += (x0[0] * x0[0] + x0[1] * x0[1]) + (x0[2] * x0[2] + x0[3] * x0[3]) + (x1[0] * x1[0] + x1[1] * x1[1]) + (x1[2] * x1[2] + x1[3] * x1[3]);
                    const v4u hw = pack8(x0 * av[bj][0], x1 * av[bj][1]);
                    *(v4u*)(H + (size_t)row * DM + c) = hw;
                    if (rmx) {
#pragma unroll
                        for (int e = 0; e < 4; ++e) { mx = fmaxf(mx, fabsf(__builtin_bit_cast(float, hw[e] << 16))); mx = fmaxf(mx, fabsf(__builtin_bit_cast(float, hw[e] & 0xffff0000u))); } } }
            }
            if (H) { ss += __shfl_xor(ss, 16); ss += __shfl_xor(ss, 32);
                if (rmx) { mx = fmaxf(mx, __shfl_xor(mx, 16)); mx = fmaxf(mx, __shfl_xor(mx, 32)); }
                if (fq == 0) { rss[(size_t)row * 32 + u.pn * 4 + wc] = ss; if (rmx) rmx[(size_t)row * 32 + u.pn * 4 + wc] = mx; } }
            SBAR();
        }
#undef ER_LOAD
    }
};

struct EpiRelu2 {
    static constexpr bool PERM = true, AFTER_DRAIN = false;
    bf16* O; int ldc; NormIn ni;
    __device__ __forceinline__ void operator()(const pg8::f32x4 (&acc)[2][2][4][2], const pg8::Unit& u, int wr, int wc, int fr, int fq) const {
        const int row0 = u.pm * 256 + wr * 64 + fr, col0 = u.pn * 256 + wc * 32 + 8 * fq;
        const float* swp = ni.swp(u.pm) + col0; f32x4 sw[2][2];
#pragma unroll
        for (int bj = 0; bj < 2; ++bj)
#pragma unroll
            for (int n = 0; n < 2; ++n) sw[bj][n] = *(const f32x4*)(swp + bj * 128 + 4 * n);
#pragma unroll
        for (int ai = 0; ai < 2; ++ai)
#pragma unroll
            for (int m = 0; m < 4; ++m) {
                const int row = row0 + ai * 128 + m * 16; const float rs = ni.rstd(row, u.pm);
                bf16* rp = O + (size_t)row * ldc + col0;
#pragma unroll
                for (int bj = 0; bj < 2; ++bj) {
                    f32x4 a = acc[ai][bj][m][0] * rs + sw[bj][0], b = acc[ai][bj][m][1] * rs + sw[bj][1];
                    a = __builtin_elementwise_max(a, (f32x4){0.f, 0.f, 0.f, 0.f}); b = __builtin_elementwise_max(b, (f32x4){0.f, 0.f, 0.f, 0.f});
                    a = a * a; b = b * b;
                    *(v4u*)(rp + bj * 128) = pack8(a, b);
                }
            }
    }
};

typedef EpiResidT<false> EpiResid;

struct EpiRelu2I8 {
    static constexpr bool PERM = true, AFTER_DRAIN = false;
    bf16* O; int ldc; const float* frow; const float* scol; const float* sW;
    __device__ __forceinline__ void operator()(const pg8::f32x4 (&acc)[2][2][4][2], const pg8::Unit& u, int wr, int wc, int fr, int fq) const {
        const int row0 = u.pm * 256 + wr * 64 + fr, col0 = u.pn * 256 + wc * 32 + 8 * fq;
        const float* swp = sW + (size_t)cond_of_pm(u.pm) * 8192 + col0; f32x4 sw[2][2], sc[2][2];
#pragma unroll
        for (int bj = 0; bj < 2; ++bj)
#pragma unroll
            for (int n = 0; n < 2; ++n) { sw[bj][n] = *(const f32x4*)(swp + bj * 128 + 4 * n); sc[bj][n] = *(const f32x4*)(scol + col0 + bj * 128 + 4 * n); }
#pragma unroll
        for (int ai = 0; ai < 2; ++ai)
#pragma unroll
            for (int m = 0; m < 4; ++m) {
                const int row = row0 + ai * 128 + m * 16; const float fr_ = frow[row];
#pragma unroll
                for (int bj = 0; bj < 2; ++bj) {
                    const pg8::i32x4 i0 = __builtin_bit_cast(pg8::i32x4, acc[ai][bj][m][0]), i1 = __builtin_bit_cast(pg8::i32x4, acc[ai][bj][m][1]);
                    f32x4 a = {(float)i0[0], (float)i0[1], (float)i0[2], (float)i0[3]}, b = {(float)i1[0], (float)i1[1], (float)i1[2], (float)i1[3]};
                    a = a * (sc[bj][0] * fr_) + sw[bj][0]; b = b * (sc[bj][1] * fr_) + sw[bj][1];
                    a = __builtin_elementwise_max(a, (f32x4){0.f, 0.f, 0.f, 0.f}); b = __builtin_elementwise_max(b, (f32x4){0.f, 0.f, 0.f, 0.f});
                    a = a * a; b = b * b;
                    { const int col = col0 + bj * 128;
                      *(v4u*)(O + ((((size_t)(row >> 8) * (ldc >> 6) + (col >> 6)) * 256 + (row & 255)) << 6) + (col & 63)) = pack8(a, b); }
                }
            }
    }
};

struct EpiF32 {
    static constexpr bool PERM = true, AFTER_DRAIN = false;
    float* O; int ldc; NormIn ni;
    __device__ __forceinline__ void operator()(const pg8::f32x4 (&acc)[2][2][4][2], const pg8::Unit& u, int wr, int wc, int fr, int fq) const {
        const int row0 = u.pm * 256 + wr * 64 + fr, col0 = u.pn * 256 + wc * 32 + 8 * fq;
        const float* swp = ni.swp(u.pm) + col0; f32x4 sw[2][2];
#pragma unroll
        for (int bj = 0; bj < 2; ++bj)
#pragma unroll
            for (int n = 0; n < 2; ++n) sw[bj][n] = *(const f32x4*)(swp + bj * 128 + 4 * n);
#pragma unroll
        for (int ai = 0; ai < 2; ++ai)
#pragma unroll
            for (int m = 0; m < 4; ++m) {
                const int row = row0 + ai * 128 + m * 16; const float rs = ni.rstd(row, u.pm);
                float* rp = O + (size_t)row * ldc + col0;
#pragma unroll
                for (int bj = 0; bj < 2; ++bj) { *(f32x4*)(rp + bj * 128) = acc[ai][bj][m][0] * rs + sw[bj][0]; *(f32x4*)(rp + bj * 128 + 4) = acc[ai][bj][m][1] * rs + sw[bj][1]; }
            }
    }
};

struct EpiQkvWin {
    static constexpr bool PERM = true, AFTER_DRAIN = false;
    bf16 *Q, *K, *V; float* outk; float* outv; int j; const f32x2* tab; NormIn ni;
    __device__ __forceinline__ void operator()(const pg8::f32x4 (&acc)[2][2][4][2], const pg8::Unit& u, int wr, int wc, int fr, int fq) const {
        const int row0 = u.pm * 256 + wr * 64 + fr, cl = wc * 32 + 8 * fq;
        const int pn = u.pn; const bool sample = u.pm >= 32;
        const int ug = 4 * wc + fq, idx0 = (ug & 7) * 4, d1 = (ug < 8 ? 0 : 64) + idx0;
        const float* swp = ni.swp(u.pm) + u.pn * 256 + cl; f32x4 sw[2][2];
#pragma unroll
        for (int bj = 0; bj < 2; ++bj)
#pragma unroll
            for (int n = 0; n < 2; ++n) sw[bj][n] = *(const f32x4*)(swp + bj * 128 + 4 * n);
#pragma unroll
        for (int ai = 0; ai < 2; ++ai)
#pragma unroll
            for (int m = 0; m < 4; ++m) {
                const int row = row0 + ai * 128 + m * 16; const float rs = ni.rstd(row, u.pm);
                f32x4 cs0 = {1.f, 0.f, 1.f, 0.f}, cs1 = {1.f, 0.f, 1.f, 0.f};
                if (sample && pn < 10) { const int t = row & 4095, pos = (ug < 8) ? (t >> 6) : (t & 63); const f32x4* tp = (const f32x4*)(tab + pos * 32 + idx0); cs0 = tp[0]; cs1 = tp[1]; }
#pragma unroll
                for (int bj = 0; bj < 2; ++bj) {
                    f32x4 a = acc[ai][bj][m][0] * rs + sw[bj][0], b = acc[ai][bj][m][1] * rs + sw[bj][1];
                    if (pn < 10) {
                        if (sample) {
                            const f32x4 co = {cs0[0], cs0[2], cs1[0], cs1[2]}, si = {cs0[1], cs0[3], cs1[1], cs1[3]};
                            const f32x4 na = a * co - b * si, nb = b * co + a * si; a = na; b = nb;
                        }
                        if (pn < 8) { *(v4u*)(Q + (size_t)row * 2048 + pn * 256 + bj * 128 + cl) = pack8(a, b); }
                        else {
                            const int kvh = (pn - 8) * 2 + bj;
                            *(v4u*)(K + (size_t)row * 512 + kvh * 128 + cl) = pack8(a, b);
                            if (!sample) { float* op = outk + ((size_t)(u.pm * 2 + j) * 256 + (row & 255)) * 512 + kvh * 128 + d1; *(f32x4*)op = a; *(f32x4*)(op + 32) = b; }
                        }
                    } else {
                        const int kvh = (pn - 10) * 2 + bj;
                        *(v4u*)(V + (size_t)row * 512 + kvh * 128 + cl) = pack8(a, b);
                        if (!sample) { float* op = outv + ((size_t)(u.pm * 2 + j) * 256 + (row & 255)) * 512 + kvh * 128 + cl; *(f32x4*)op = a; *(f32x4*)(op + 4) = b; }
                    }
                }
            }
    }
};

struct EpiMlaQ {
    static constexpr bool PERM = true, AFTER_DRAIN = false;
    bf16* Q; const f32x2* tab;
    __device__ __forceinline__ void operator()(const pg8::f32x4 (&acc)[2][2][4][2], const pg8::Unit& u, int wr, int wc, int fr, int fq) const {
        const int row0 = u.pm * 256 + wr * 64 + fr, col0 = u.pn * 256 + wc * 32 + 8 * fq;
        const bool sample = u.pm >= 32;
#pragma unroll
        for (int bj = 0; bj < 2; ++bj) {
            const int c0 = col0 + bj * 128, p0 = c0 % 192; const bool isr = p0 >= 128; const int ug = isr ? ((p0 - 128) >> 3) : 0, idx0 = (ug & 3) * 4;
#pragma unroll
            for (int ai = 0; ai < 2; ++ai)
#pragma unroll
                for (int m = 0; m < 4; ++m) {
                    const int row = row0 + ai * 128 + m * 16;
                    f32x4 a = acc[ai][bj][m][0], b = acc[ai][bj][m][1];
                    if (sample) {
                        const int t = row & 4095, pos = (ug < 4) ? (t >> 6) : (t & 63); const f32x4* tp = (const f32x4*)(tab + pos * 16 + idx0); const f32x4 cs0 = tp[0], cs1 = tp[1];
                        const f32x4 co = {cs0[0], cs0[2], cs1[0], cs1[2]}, si = {cs0[1], cs0[3], cs1[1], cs1[3]};
                        const f32x4 na = a * co - b * si, nb = b * co + a * si;
                        if (isr) { a = na; b = nb; }
                    }
                    *(v4u*)(Q + (size_t)row * 3072 + c0) = pack8(a, b);
                }
        }
    }
};

struct EpiMlaKV {
    static constexpr bool PERM = true, AFTER_DRAIN = false;
    bf16 *KN, *V;
    __device__ __forceinline__ void operator()(const pg8::f32x4 (&acc)[2][2][4][2], const pg8::Unit& u, int wr, int wc, int fr, int fq) const {
        const int row0 = u.pm * 256 + wr * 64 + fr, cl = u.pn * 128 + wc * 32 + 8 * fq;
#pragma unroll
        for (int ai = 0; ai < 2; ++ai)
#pragma unroll
            for (int m = 0; m < 4; ++m) {
                const size_t ro = (size_t)(row0 + ai * 128 + m * 16) * 2048 + cl;
                *(v4u*)(KN + ro) = pack8(acc[ai][0][m][0], acc[ai][0][m][1]);
                *(v4u*)(V + ro) = pack8(acc[ai][1][m][0], acc[ai][1][m][1]);
            }
    }
};

struct EpiGlaIn {
    static constexpr bool PERM = true, AFTER_DRAIN = false;
    bf16 *q, *k, *v, *r; float* uo; NormIn ni;
    __device__ __forceinline__ void operator()(const pg8::f32x4 (&acc)[2][2][4][2], const pg8::Unit& u, int wr, int wc, int fr, int fq) const {
        const int row0 = u.pm * 256 + wr * 64 + fr, cl = wc * 32 + 8 * fq; const int pn = u.pn;
        const float* swp = ni.swp(u.pm) + pn * 256 + cl; f32x4 sw[2][2];
#pragma unroll
        for (int bj = 0; bj < 2; ++bj)
#pragma unroll
            for (int n = 0; n < 2; ++n) sw[bj][n] = *(const f32x4*)(swp + bj * 128 + 4 * n);
#pragma unroll
        for (int ai = 0; ai < 2; ++ai)
#pragma unroll
            for (int m = 0; m < 4; ++m) {
                const int row = row0 + ai * 128 + m * 16; const float rs = ni.rstd(row, u.pm);
#pragma unroll
                for (int bj = 0; bj < 2; ++bj) {
                    f32x4 a = acc[ai][bj][m][0] * rs + sw[bj][0], b = acc[ai][bj][m][1] * rs + sw[bj][1];
                    const int c = pn * 256 + bj * 128 + cl;
                    if (pn < 4) { a = a * 0.0625f; b = b * 0.0625f; *(v4u*)(q + (size_t)row * 1024 + c) = pack8(a, b); }
                    else if (pn < 8) { *(v4u*)(k + (size_t)row * 1024 + (c - 1024)) = pack8(a, b); }
                    else if (pn < 16) { *(v4u*)(v + (size_t)row * 2048 + (c - 2048)) = pack8(a, b); }
                    else if (pn < 24) { *(v4u*)(r + (size_t)row * 2048 + (c - 4096)) = pack8(a, b); }
                    else if (bj == 0 && wc == 0) { float* op = uo + (size_t)row * 32 + 8 * fq; *(f32x4*)op = a; *(f32x4*)(op + 4) = b; }
                }
            }
    }
};

struct Frame {
    LAS unsigned char* lds; unsigned char* ldsg;
    int tid, lane, wave, G, bx;
    const float* const* in; float* out; unsigned char* ws;
};
#define WSP(T, off) ((T*)(F.ws + (off)))
constexpr int LDS_RSTD_OFF = 131072;
__device__ __forceinline__ int prep_rstd(Frame& F, const pg8::StaticOrder& S, int site) {
    pg8::Unit u0; int pm0 = -1; if (S.next(0, u0)) pm0 = u0.pm;
    LAS float* lrs = (LAS float*)(F.lds + LDS_RSTD_OFF);
    if (pm0 >= 0 && F.tid < 256) { const int row = pm0 * 256 + F.tid; const f32x4* pp = (const f32x4*)(WSP(float, WS_PART) + ((size_t)site * MTOK + row) * 32); f32x4 t = pp[0];
#pragma unroll
        for (int i = 1; i < 8; ++i) t += pp[i];
        lrs[F.tid] = rsqrtf(((t[0] + t[1]) + (t[2] + t[3])) * (1.f / 2048.f) + EPS); }
    __syncthreads();
    return pm0;
}

__device__ __forceinline__ int perm_win(int p) { const int u = p >> 3, v = p & 7; return (u < 8 ? 0 : 64) + (u & 7) * 4 + (v & 3) + ((v & 4) ? 32 : 0); }
__device__ __forceinline__ int perm_mla(int p) { const int u = p >> 3, v = p & 7; return (u < 4 ? 0 : 32) + (u & 3) * 4 + (v & 3) + ((v & 4) ? 16 : 0); }
__device__ __forceinline__ int srcmap(int mode, int n) {
    if (mode == 1) { if (n >= 2560) return n; return (n & ~127) + perm_win(n & 127); }
    if (mode == 2) { if (n < 768) return n; if (n >= 832) return -1; return 768 + perm_mla(n - 768); }
    if (mode == 3) { const int hh = n / 192, p = n - hh * 192; if (p < 128) return n; return hh * 192 + 128 + perm_mla(p - 128); }
    return n;
}
#ifndef WMANT
#define WMANT 7
#endif
__device__ __forceinline__ unsigned f2bfw(float f) { constexpr int sh = 23 - WMANT; unsigned u = __builtin_bit_cast(unsigned, f); u += ((1u << sh) >> 1) - 1u + ((u >> sh) & 1u); u &= ~((1u << sh) - 1u); return u >> 16; }
__device__ __forceinline__ unsigned pk2w(float lo, float hi) { return f2bfw(lo) | (f2bfw(hi) << 16); }
__device__ __forceinline__ void tr_item(const float* W, int K, int Nsrc, int nblk, bf16* WT, int mode, LAS float* scr, int item, int lane) {
    const int kb = item / nblk, nb = item - kb * nblk, k0 = 64 * kb, n0 = 64 * nb;
    const int ln = (lane & 15) * 4, lk = lane >> 4;
    const int sc = srcmap(mode, n0 + ln);
    f32x4 v[16];
    const float* Wp = W + (size_t)(k0 + lk) * Nsrc + (sc >= 0 ? sc : 0);
#pragma unroll
    for (int i = 0; i < 16; ++i) v[i] = sc >= 0 ? __builtin_nontemporal_load((const f32x4*)(Wp + (size_t)(4 * i) * Nsrc)) : (f32x4){0.f, 0.f, 0.f, 0.f};
#pragma unroll
    for (int i = 0; i < 16; ++i) { LAS float* d = scr + (4 * i + lk) * 65 + ln; d[0] = v[i][0]; d[1] = v[i][1]; d[2] = v[i][2]; d[3] = v[i][3]; }
    LDS_WAIT(); asm volatile("" ::: "memory");
    const int c = lane & 7;
#pragma unroll
    for (int jj = 0; jj < 8; ++jj) { const int n = (lane >> 3) + 8 * jj; const LAS float* s = scr + (8 * c) * 65 + n;
        v4u o; o.x = pk2w(s[0 * 65], s[1 * 65]); o.y = pk2w(s[2 * 65], s[3 * 65]); o.z = pk2w(s[4 * 65], s[5 * 65]); o.w = pk2w(s[6 * 65], s[7 * 65]);
        *(GAS v4u*)(WT + (size_t)(n0 + n) * K + k0 + 8 * c) = o; }
    LDS_WAIT(); asm volatile("" ::: "memory");
}

__device__ __forceinline__ const float* wo_src(Frame& F, int lw) { return lw == 0 ? F.in[I_WWO] : (lw == 1 ? F.in[I_MWO] : (lw == 2 ? F.in[I_GWO] : F.in[I_WWO] + (size_t)2048 * 2048)); }
__device__ __forceinline__ void tr_item_q8(const float* W, int N, int nblk, signed char* Wq, const float* scol, LAS float* scr, int item, int lane) {
    constexpr int K = 2048;
    const int kb = item / nblk, nb = item - kb * nblk, k0 = 64 * kb, n0 = 64 * nb;
    const int ln = (lane & 15) * 4, lk = lane >> 4;
    f32x4 v[16];
    const float* Wp = W + (size_t)(k0 + lk) * N + n0 + ln;
#pragma unroll
    for (int i = 0; i < 16; ++i) v[i] = __builtin_nontemporal_load((const f32x4*)(Wp + (size_t)(4 * i) * N));
#pragma unroll
    for (int i = 0; i < 16; ++i) { LAS float* d = scr + (4 * i + lk) * 65 + ln; d[0] = v[i][0]; d[1] = v[i][1]; d[2] = v[i][2]; d[3] = v[i][3]; }
    LDS_WAIT(); asm volatile("" ::: "memory");
    const int c = lane & 7;
#pragma unroll
    for (int jj = 0; jj < 8; ++jj) { const int n = (lane >> 3) + 8 * jj; const LAS float* s = scr + (8 * c) * 65 + n; const float inv = 1.f / scol[n0 + n];
        unsigned b[8];
#pragma unroll
        for (int e = 0; e < 8; ++e) { int q = (int)rintf(s[e * 65] * inv); q = q > 127 ? 127 : (q < -127 ? -127 : q); b[e] = (unsigned)q & 0xffu; }
        v2u o; o.x = b[0] | (b[1] << 8) | (b[2] << 16) | (b[3] << 24); o.y = b[4] | (b[5] << 8) | (b[6] << 16) | (b[7] << 24);
        *(GAS v2u*)(Wq + (size_t)(n0 + n) * K + k0 + 8 * c) = o; }
    LDS_WAIT(); asm volatile("" ::: "memory");
}

__device__ __forceinline__ void q8w_item(Frame& F, const float* W, int N, int n0, signed char* Wq, float* scol) {
    const int tid = F.tid, lane = F.lane, wave = F.wave, cg = tid & 7, rq = tid >> 3;
    LAS unsigned char* T = F.lds; LAS float* red = (LAS float*)(F.lds + 32 * 2064);
    f32x4 v[8][4];
    const float* wp = W + (size_t)(4 * rq) * N + n0 + 4 * cg;
#pragma unroll
    for (int i = 0; i < 8; ++i)
#pragma unroll
        for (int j = 0; j < 4; ++j) v[i][j] = __builtin_nontemporal_load((const f32x4*)(wp + (size_t)(256 * i + j) * N));
    f32x4 m = {0.f, 0.f, 0.f, 0.f};
#pragma unroll
    for (int i = 0; i < 8; ++i)
#pragma unroll
        for (int j = 0; j < 4; ++j) m = __builtin_elementwise_max(m, __builtin_elementwise_abs(v[i][j]));
#pragma unroll
    for (int o = 8; o < 64; o <<= 1) { m[0] = fmaxf(m[0], __shfl_xor(m[0], o)); m[1] = fmaxf(m[1], __shfl_xor(m[1], o)); m[2] = fmaxf(m[2], __shfl_xor(m[2], o)); m[3] = fmaxf(m[3], __shfl_xor(m[3], o)); }
    if (lane < 8) *(LAS f32x4*)(red + wave * 32 + 4 * lane) = m;
    __syncthreads();
    f32x4 mm = *(const LAS f32x4*)(red + 4 * cg);
#pragma unroll
    for (int w8 = 1; w8 < 8; ++w8) mm = __builtin_elementwise_max(mm, *(const LAS f32x4*)(red + w8 * 32 + 4 * cg));
    f32x4 sc, inv;
#pragma unroll
    for (int c = 0; c < 4; ++c) { sc[c] = fmaxf(mm[c], 1e-30f) * (1.f / 127.f); inv[c] = 1.f / sc[c]; }
    if (tid < 8) *(f32x4*)(scol + n0 + 4 * cg) = sc;
#pragma unroll
    for (int i = 0; i < 8; ++i)
#pragma unroll
        for (int c = 0; c < 4; ++c) { unsigned b[4];
#pragma unroll
            for (int j = 0; j < 4; ++j) { int q = (int)rintf(v[i][j][c] * inv[c]); q = q > 127 ? 127 : (q < -127 ? -127 : q); b[j] = (unsigned)q & 0xffu; }
            *(LAS unsigned*)(T + (4 * cg + c) * 2064 + 256 * i + 4 * rq) = b[0] | (b[1] << 8) | (b[2] << 16) | (b[3] << 24); }
    __syncthreads();
    { const int row = tid >> 4, c16 = tid & 15; signed char* dp = Wq + (size_t)(n0 + row) * 2048;
#pragma unroll
      for (int j = 0; j < 8; ++j) { const int ch = c16 + 16 * j; *(v4u*)(dp + 16 * ch) = *(const LAS v4u*)(T + row * 2064 + 16 * ch); } }
    __syncthreads();
}

__device__ __forceinline__ void p0_prologue(Frame& F) {
    const int tid = F.tid, lane = F.lane, wave = F.wave;
    for (int it = F.bx; it < 192; it += F.G) {
        const int l = it / 48, nb = it - l * 48;
        LAS float* sl = (LAS float*)F.lds; LAS float* red = sl + 3 * 2048;
        for (int e = tid; e < 3 * 2048; e += 512) { const int c = e >> 11, k = e & 2047; const float v = (c == 0) ? F.in[I_CCTX][k] : F.in[I_C][(c - 1) * 2048 + k]; sl[e] = v / (1.f + __expf(-v)); }
        __syncthreads();
        const float* Wp = F.in[I_ADAW] + ((size_t)l * 2048 + wave * 256) * 12288 + nb * 256 + lane * 4;
        f32x4 a0 = {0.f, 0.f, 0.f, 0.f}, a1 = a0, a2 = a0;
        for (int k = 0; k < 256; k += 8) {
            f32x4 w[8];
#pragma unroll
            for (int jj = 0; jj < 8; ++jj) w[jj] = __builtin_nontemporal_load((const f32x4*)(Wp + (size_t)(k + jj) * 12288));
#pragma unroll
            for (int jj = 0; jj < 8; ++jj) { const int kk = wave * 256 + k + jj; a0 += w[jj] * sl[kk]; a1 += w[jj] * sl[2048 + kk]; a2 += w[jj] * sl[4096 + kk]; }
        }
        *(LAS f32x4*)(red + (wave * 3 + 0) * 256 + lane * 4) = a0; *(LAS f32x4*)(red + (wave * 3 + 1) * 256 + lane * 4) = a1; *(LAS f32x4*)(red + (wave * 3 + 2) * 256 + lane * 4) = a2;
        __syncthreads();
        for (int e = tid; e < 768; e += 512) { const int c = e >> 8, n = e & 255; float s = F.in[I_ADAB][l * 12288 + nb * 256 + n];
#pragma unroll
            for (int w8 = 0; w8 < 8; ++w8) s += red[(w8 * 3 + c) * 256 + n];
            WSP(float, WS_MOD)[(size_t)(l * 3 + c) * 12288 + nb * 256 + n] = s; }
        __syncthreads();
    }
    if (F.bx == F.G - 1) {
        for (int e = tid; e < 64 * 32; e += 512) { const int pos = e >> 5, i = e & 31; const float inv = exp2f(-(float)i * (13.287712379549449f / 32.f)); const float ang = (float)pos * inv;
            WSP(f32x2, WS_TABW)[e] = (f32x2){cosf(ang), sinf(ang)}; }
        for (int e = tid; e < 64 * 16; e += 512) { const int pos = e >> 4, i = e & 15; const float inv = exp2f(-(float)i * (13.287712379549449f / 16.f)); const float ang = (float)pos * inv;
            WSP(f32x2, WS_TABM)[e] = (f32x2){cosf(ang), sinf(ang)}; }
    }
    const int gt = F.bx * 512 + tid, NGT = F.G * 512;
    for (int e = gt; e < 2 * 2 * 512 * 512; e += NGT) {
        const int c = e & 511, pos = (e >> 9) & 511, b = (e >> 18) & 1, jj = e >> 19;
        const size_t sbase = (((size_t)b * 2 + jj) * 512 + pos) * 512;
        WSP(bf16, WS_CTXK)[e] = (bf16)f2bf(F.in[I_CWK][sbase + (c & ~127) + perm_win(c & 127)]);
        WSP(bf16, WS_CTXV)[e] = (bf16)f2bf(F.in[I_CWV][sbase + c]);
    }
    for (int e = gt; e < 256 * 2048; e += NGT) { const int n = e >> 11, k = e & 2047; float v = 0.f; if (n < 32) v = F.in[I_GWA1][((size_t)(n >> 4) * 2048 + k) * 16 + (n & 15)];
        WSP(bf16, WS_GWINT)[(size_t)(6144 + n) * 2048 + k] = (bf16)f2bf(v); }
    LAS float* scr = (LAS float*)(F.lds + wave * 16640);
    constexpr int C_W2 = 128 * 32, C_QKV = 32 * 48, C_MWD = 32 * 16, C_MUQ = 8 * 48, C_MUKV = 4 * 64, C_GWIN = 32 * 96;
    constexpr int NITEMS = 4 * C_W2 + 2 * C_QKV + C_MWD + C_MUQ + C_MUKV + C_GWIN;
    const bool bal = (F.G == 256);
    const int nslot = bal ? (F.bx < 192 ? 1 : 2) : 1;
    const int slot0 = bal ? (F.bx < 192 ? F.bx : 192 + (F.bx - 192) * 2) : F.bx;
    const int NVW = (bal ? 320 : F.G) * NWAVES;
    for (int sl = 0; sl < nslot; ++sl)
    for (int it = (slot0 + sl) * NWAVES + wave; it < NITEMS; it += NVW) {
        int r = it;
        if (r < 4 * C_W2) { const int l = r / C_W2; r -= l * C_W2; tr_item(F.in[I_W2] + (size_t)l * 8192 * 2048, 8192, 2048, 32, WSP(bf16, WS_W2T) + (size_t)l * 2048 * 8192, 0, scr, r, lane); continue; } r -= 4 * C_W2;
        if (r < 2 * C_QKV) { const int l = r / C_QKV; r -= l * C_QKV; tr_item(F.in[I_WQKV] + (size_t)l * 2048 * 3072, 2048, 3072, 48, WSP(bf16, WS_WQKVT) + (size_t)l * 3072 * 2048, 1, scr, r, lane); continue; } r -= 2 * C_QKV;
        if (r < C_MWD) { tr_item(F.in[I_MWD], 2048, 832, 16, WSP(bf16, WS_MWDT), 2, scr, r, lane); continue; } r -= C_MWD;
        if (r < C_MUQ) { tr_item(F.in[I_MWUQ], 512, 3072, 48, WSP(bf16, WS_MWUQT), 3, scr, r, lane); continue; } r -= C_MUQ;
        if (r < C_MUKV) { tr_item(F.in[I_MWUKV], 256, 4096, 64, WSP(bf16, WS_MWUKVT), 0, scr, r, lane); continue; } r -= C_MUKV;
        tr_item(F.in[I_GWIN], 2048, 6144, 96, WSP(bf16, WS_GWINT), 0, scr, r, lane);
    }
}

__device__ __forceinline__ const float* x_row(Frame& F, int L, int row) {
    return L == 0 ? (row < MP ? F.in[I_XP] + (size_t)row * DM : F.in[I_XS] + (size_t)(row - MP) * DM) : WSP(float, WS_X) + (size_t)row * DM;
}
__device__ __forceinline__ void p1_phase(Frame& F) {
    const int gw = F.bx * NWAVES + F.wave, NGW = F.G * NWAVES, lane = F.lane;
    for (int rb = gw; rb < MTOK / 8; rb += NGW) {
        const int row0 = rb * 8, cond = row0 < MP ? 0 : (row0 >> 12) - 1;
        const float* mv = WSP(float, WS_MOD) + (size_t)cond * 12288;
        const float* g = F.in[I_NORMG];
        f32x4 a[8];
#pragma unroll
        for (int jj = 0; jj < 8; ++jj) { const int col = 4 * lane + 256 * jj; a[jj] = *(const f32x4*)(g + col) * (*(const f32x4*)(mv + 2048 + col) + 1.f); }
#pragma unroll 1
        for (int r = 0; r < 8; r += 2) {
            f32x4 v[2][8];
#pragma unroll
            for (int q = 0; q < 2; ++q) { const float* xr = x_row(F, 0, row0 + r + q);
#pragma unroll
                for (int jj = 0; jj < 8; ++jj) v[q][jj] = *(const f32x4*)(xr + 4 * lane + 256 * jj); }
#pragma unroll
            for (int q = 0; q < 2; ++q) { const int row = row0 + r + q; float ss = 0.f;
#pragma unroll
                for (int jj = 0; jj < 8; ++jj) ss += (v[q][jj][0] * v[q][jj][0] + v[q][jj][1] * v[q][jj][1]) + (v[q][jj][2] * v[q][jj][2] + v[q][jj][3] * v[q][jj][3]);
                ss = wave_sum(ss);
                if (lane < 32) WSP(float, WS_PART)[(size_t)row * 32 + lane] = lane == 0 ? ss : 0.f;
                bf16* hr = WSP(bf16, WS_H) + (size_t)row * DM;
#pragma unroll
                for (int jj = 0; jj < 8; ++jj) { const f32x4 y = v[q][jj] * a[jj]; v2u w; w.x = cvtpk(y[0], y[1]); w.y = cvtpk(y[2], y[3]); *(v2u*)(hr + 4 * lane + 256 * jj) = w; } }
        }
    }
    __syncthreads();
    for (int it = F.bx; it < 1280; it += F.G) {
        if (it < 1024) { const int l = it >> 8, nb = it & 255; q8w_item(F, F.in[I_W1] + (size_t)l * 2048 * 8192, 8192, nb * 32, (signed char*)(F.ws + WS_W1T) + (size_t)l * 8192 * 2048, WSP(float, WS_SCOL) + l * 8192); }
        else { const int lw = (it - 1024) >> 6, nb = (it - 1024) & 63; q8w_item(F, wo_src(F, lw), 2048, nb * 32, (signed char*)(F.ws + WS_WWOT) + (size_t)lw * 2048 * 2048, WSP(float, WS_SCOLO) + lw * 2048); }
    }
    constexpr int NCH = 96 + 32 + 200 + 96;
    for (int ch = gw; ch < NCH; ch += NGW) {
        int c = ch, site = 0; const bf16* Wt = WSP(bf16, WS_WQKVT);
        if (c >= 96) { c -= 96; site = 2; Wt = WSP(bf16, WS_MWDT);
          if (c >= 32) { c -= 32; site = 4; Wt = WSP(bf16, WS_GWINT);
            if (c >= 200) { c -= 200; site = 6; Wt = WSP(bf16, WS_WQKVT) + (size_t)3072 * DM; } } }
        const int L = site >> 1, which = site & 1;
        const float* sv = WSP(float, WS_MOD) + (size_t)(L * 3) * 12288 + (which ? 3 * 2048 : 0);
        f32x4 s0[3][4], s1[3][4];
#pragma unroll
        for (int cc = 0; cc < 3; ++cc)
#pragma unroll
            for (int jj = 0; jj < 4; ++jj) { const float* sp = sv + (size_t)cc * 12288 + 8 * lane + 512 * jj; s0[cc][jj] = *(const f32x4*)sp; s1[cc][jj] = *(const f32x4*)(sp + 4); }
        float* so = WSP(float, WS_SW) + (size_t)site * 3 * 8192;
#pragma unroll 1
        for (int r2 = 0; r2 < 32; r2 += 2) {
            const bf16* wr0 = Wt + (size_t)(c * 32 + r2) * DM + 8 * lane; const bf16* wr1 = wr0 + DM;
            const v4u w00 = *(const v4u*)(wr0), w01 = *(const v4u*)(wr0 + 512), w02 = *(const v4u*)(wr0 + 1024), w03 = *(const v4u*)(wr0 + 1536);
            const v4u w10 = *(const v4u*)(wr1), w11 = *(const v4u*)(wr1 + 512), w12 = *(const v4u*)(wr1 + 1024), w13 = *(const v4u*)(wr1 + 1536);
            float a0 = 0.f, a1 = 0.f, a2 = 0.f, b0 = 0.f, b1 = 0.f, b2 = 0.f;
#define SW_ACC(W_, jj, d0_, d1_, d2_) do { const v4u q_ = (W_); \
                const f32x4 wa = {__builtin_bit_cast(float, q_[0] << 16), __builtin_bit_cast(float, q_[0] & 0xffff0000u), __builtin_bit_cast(float, q_[1] << 16), __builtin_bit_cast(float, q_[1] & 0xffff0000u)}; \
                const f32x4 wb = {__builtin_bit_cast(float, q_[2] << 16), __builtin_bit_cast(float, q_[2] & 0xffff0000u), __builtin_bit_cast(float, q_[3] << 16), __builtin_bit_cast(float, q_[3] & 0xffff0000u)}; \
                f32x4 t = wa * s0[0][jj] + wb * s1[0][jj]; d0_ += (t[0] + t[1]) + (t[2] + t[3]); \
                t = wa * s0[1][jj] + wb * s1[1][jj]; d1_ += (t[0] + t[1]) + (t[2] + t[3]); \
                t = wa * s0[2][jj] + wb * s1[2][jj]; d2_ += (t[0] + t[1]) + (t[2] + t[3]); } while (0)
            SW_ACC(w00, 0, a0, a1, a2); SW_ACC(w01, 1, a0, a1, a2); SW_ACC(w02, 2, a0, a1, a2); SW_ACC(w03, 3, a0, a1, a2);
            SW_ACC(w10, 0, b0, b1, b2); SW_ACC(w11, 1, b0, b1, b2); SW_ACC(w12, 2, b0, b1, b2); SW_ACC(w13, 3, b0, b1, b2);
#undef SW_ACC
#pragma unroll
            for (int o = 1; o < 64; o <<= 1) { a0 += __shfl_xor(a0, o); a1 += __shfl_xor(a1, o); a2 += __shfl_xor(a2, o); b0 += __shfl_xor(b0, o); b1 += __shfl_xor(b1, o); b2 += __shfl_xor(b2, o); }
            if (lane == 0) { const int n = c * 32 + r2; so[n] = a0; so[8192 + n] = a1; so[2 * 8192 + n] = a2; so[n + 1] = b0; so[8192 + n + 1] = b1; so[2 * 8192 + n + 1] = b2; }
        }
    }
}
__device__ __forceinline__ void q8_phase(Frame& F, int L, bool with_sw) {
    const int gw = F.bx * NWAVES + F.wave, NGW = F.G * NWAVES, lane = F.lane;
    const float* part = WSP(float, WS_PART) + (size_t)(2 * L + 1) * MTOK * 32; const float* pmax = WSP(float, WS_PMAX) + (size_t)(2 * L + 1) * MTOK * 32;
    const bf16* H = WSP(bf16, WS_H); signed char* H8 = (signed char*)(F.ws + WS_H8); float* frow = WSP(float, WS_FROW) + (size_t)L * MTOK;
    for (int row0 = gw; row0 < MTOK; row0 += 4 * NGW) {
        float ss[4], mx[4]; v4u w[4][4];
#pragma unroll
        for (int r = 0; r < 4; ++r) { const int row = row0 + r * NGW; const bool ok = row < MTOK && lane < 32;
            ss[r] = ok ? part[(size_t)row * 32 + lane] : 0.f; mx[r] = ok ? pmax[(size_t)row * 32 + lane] : 0.f; }
#pragma unroll
        for (int r = 0; r < 4; ++r) { const int row = row0 + r * NGW;
            if (row < MTOK) { const bf16* hr = H + (size_t)row * DM + 8 * lane;
#pragma unroll
                for (int jj = 0; jj < 4; ++jj) w[r][jj] = *(const v4u*)(hr + 512 * jj); } }
#pragma unroll
        for (int r = 0; r < 4; ++r) { const int row = row0 + r * NGW;
            if (row < MTOK) {
                float s1 = ss[r], m1 = mx[r];
#pragma unroll
                for (int o = 1; o < 64; o <<= 1) { s1 += __shfl_xor(s1, o); m1 = fmaxf(m1, __shfl_xor(m1, o)); }
                m1 = fmaxf(m1, 1e-30f);
                const float rstd = rsqrtf(s1 * (1.f / 2048.f) + EPS), scale = m1 * (1.f / 127.f), inv = 127.f / m1;
                if (lane == 0) frow[row] = rstd * scale;
                signed char* qr = H8 + (size_t)row * DM + 8 * lane;
#pragma unroll
                for (int jj = 0; jj < 4; ++jj) { unsigned b[8];
#pragma unroll
                    for (int e = 0; e < 4; ++e) { int q0 = (int)rintf(__builtin_bit_cast(float, w[r][jj][e] << 16) * inv), q1 = (int)rintf(__builtin_bit_cast(float, w[r][jj][e] & 0xffff0000u) * inv);
                        q0 = q0 > 127 ? 127 : (q0 < -127 ? -127 : q0); q1 = q1 > 127 ? 127 : (q1 < -127 ? -127 : q1); b[2 * e] = (unsigned)q0 & 0xffu; b[2 * e + 1] = (unsigned)q1 & 0xffu; }
                    v2u o; o.x = b[0] | (b[1] << 8) | (b[2] << 16) | (b[3] << 24); o.y = b[4] | (b[5] << 8) | (b[6] << 16) | (b[7] << 24);
                    *(v2u*)(qr + 512 * jj) = o; } } }
    }
    if (with_sw) {
        for (int ch = gw; ch < 4 * 512; ch += NGW) {
            const int l = ch >> 9, c = ch & 511;
            const signed char* Wq = (const signed char*)(F.ws + WS_W1T) + (size_t)l * 8192 * 2048;
            const float* sv = WSP(float, WS_MOD) + (size_t)(l * 3) * 12288 + 3 * 2048;
            f32x4 s0[3][4], s1[3][4];
#pragma unroll
            for (int cc = 0; cc < 3; ++cc)
#pragma unroll
                for (int jj = 0; jj < 4; ++jj) { const float* sp = sv + (size_t)cc * 12288 + 8 * lane + 512 * jj; s0[cc][jj] = *(const f32x4*)sp; s1[cc][jj] = *(const f32x4*)(sp + 4); }
            float* so = WSP(float, WS_SW) + (size_t)(2 * l + 1) * 3 * 8192; const float* scol = WSP(float, WS_SCOL) + l * 8192;
#pragma unroll 1
            for (int r = 0; r < 16; ++r) {
                const int n = c * 16 + r; const signed char* wr_ = Wq + (size_t)n * 2048 + 8 * lane;
                float d0 = 0.f, d1 = 0.f, d2 = 0.f;
#pragma unroll
                for (int jj = 0; jj < 4; ++jj) { const v2u w = *(const v2u*)(wr_ + 512 * jj);
                    const f32x4 wa = {(float)(int)(signed char)(w.x & 0xff), (float)(int)(signed char)((w.x >> 8) & 0xff), (float)(int)(signed char)((w.x >> 16) & 0xff), (float)(int)(signed char)(w.x >> 24)};
                    const f32x4 wb = {(float)(int)(signed char)(w.y & 0xff), (float)(int)(signed char)((w.y >> 8) & 0xff), (float)(int)(signed char)((w.y >> 16) & 0xff), (float)(int)(signed char)(w.y >> 24)};
                    f32x4 t = wa * s0[0][jj] + wb * s1[0][jj]; d0 += (t[0] + t[1]) + (t[2] + t[3]);
                    t = wa * s0[1][jj] + wb * s1[1][jj]; d1 += (t[0] + t[1]) + (t[2] + t[3]);
                    t = wa * s0[2][jj] + wb * s1[2][jj]; d2 += (t[0] + t[1]) + (t[2] + t[3]); }
#pragma unroll
                for (int o = 1; o < 64; o <<= 1) { d0 += __shfl_xor(d0, o); d1 += __shfl_xor(d1, o); d2 += __shfl_xor(d2, o); }
                if (lane == 0) { const float sc = scol[n]; so[n] = d0 * sc; so[8192 + n] = d1 * sc; so[2 * 8192 + n] = d2 * sc; }
            }
        }
    }
}
__device__ __forceinline__ void aoq_phase(Frame& F) {
    const int gw = F.bx * NWAVES + F.wave, NGW = F.G * NWAVES, lane = F.lane;
    const bf16* AO = WSP(bf16, WS_AO); signed char* A8 = (signed char*)(F.ws + WS_AO8); float* arow = WSP(float, WS_AROW);
    for (int row0 = gw; row0 < MTOK; row0 += 4 * NGW) {
        v4u w[4][4];
#pragma unroll
        for (int r = 0; r < 4; ++r) { const int row = row0 + r * NGW;
            if (row < MTOK) { const bf16* hr = AO + (size_t)row * DM + 8 * lane;
#pragma unroll
                for (int jj = 0; jj < 4; ++jj) w[r][jj] = *(const v4u*)(hr + 512 * jj); } }
#pragma unroll
        for (int r = 0; r < 4; ++r) { const int row = row0 + r * NGW;
            if (row < MTOK) { float mx = 0.f;
#pragma unroll
                for (int jj = 0; jj < 4; ++jj) {
#pragma unroll
                    for (int e = 0; e < 4; ++e) { mx = fmaxf(mx, fabsf(__builtin_bit_cast(float, w[r][jj][e] << 16))); mx = fmaxf(mx, fabsf(__builtin_bit_cast(float, w[r][jj][e] & 0xffff0000u))); } }
#pragma unroll
                for (int o = 1; o < 64; o <<= 1) mx = fmaxf(mx, __shfl_xor(mx, o));
                mx = fmaxf(mx, 1e-30f); const float inv = 127.f / mx;
                if (lane == 0) arow[row] = mx * (1.f / 127.f);
                signed char* qr = A8 + (size_t)row * DM + 8 * lane;
#pragma unroll
                for (int jj = 0; jj < 4; ++jj) { unsigned b[8];
#pragma unroll
                    for (int e = 0; e < 4; ++e) { int q0 = (int)rintf(__builtin_bit_cast(float, w[r][jj][e] << 16) * inv), q1 = (int)rintf(__builtin_bit_cast(float, w[r][jj][e] & 0xffff0000u) * inv);
                        b[2 * e] = (unsigned)q0 & 0xffu; b[2 * e + 1] = (unsigned)q1 & 0xffu; }
                    v2u o; o.x = b[0] | (b[1] << 8) | (b[2] << 16) | (b[3] << 24); o.y = b[4] | (b[5] << 8) | (b[6] << 16) | (b[7] << 24);
                    *(v2u*)(qr + 512 * jj) = o; } } }
    }
}
__device__ __forceinline__ void final_phase(Frame& F) {
    const int gw = F.bx * NWAVES + F.wave, NGW = F.G * NWAVES, lane = F.lane;
    const float* g = F.in[I_FNORM];
    for (int row0 = gw; row0 < MTOK; row0 += 2 * NGW) {
        f32x4 v[2][8];
#pragma unroll
        for (int r = 0; r < 2; ++r) { const int row = row0 + r * NGW;
            if (row < MTOK) { const float* xr = WSP(float, WS_X) + (size_t)row * DM;
#pragma unroll
                for (int jj = 0; jj < 8; ++jj) v[r][jj] = __builtin_nontemporal_load((const f32x4*)(xr + 4 * lane + 256 * jj)); } }
#pragma unroll
        for (int r = 0; r < 2; ++r) { const int row = row0 + r * NGW;
            if (row < MTOK) { float ss = 0.f;
#pragma unroll
                for (int jj = 0; jj < 8; ++jj) ss += (v[r][jj][0] * v[r][jj][0] + v[r][jj][1] * v[r][jj][1]) + (v[r][jj][2] * v[r][jj][2] + v[r][jj][3] * v[r][jj][3]);
                const float rstd = rsqrtf(wave_sum(ss) * (1.f / 2048.f) + EPS);
                float* orow = F.out + (size_t)row * DM;
#pragma unroll
                for (int jj = 0; jj < 8; ++jj) { const int col = 4 * lane + 256 * jj; *(f32x4*)(orow + col) = v[r][jj] * rstd * *(const f32x4*)(g + col); } } }
    }
}

namespace att {
constexpr int QBLK = 32, KVBLK = 64;
constexpr int SHM_V = 16384, SHM_K = 16384, SHM_KR = 8192;
constexpr int OFF_V = 0, OFF_K = 3 * SHM_V, OFF_KR = 3 * SHM_V + 3 * SHM_K, OFF_WS = OFF_KR + 3 * SHM_KR, OFF_QR = OFF_WS + NWAVES * 64 * 4, LDS_ATT = OFF_QR + NWAVES * 4096;
#define KSWZ(row, colB) ((row) * 256 + ((colB) ^ (((row) & 7) << 4)))
#define KRSWZ(row, chunk) ((row) * 128 + ((((chunk) ^ ((row) >> 1)) & 7) << 4))
__device__ __forceinline__ int crow(int r, int hi) { return (r & 3) + 8 * (r >> 2) + 4 * hi; }
template <int DQK> struct Cst { static constexpr float SCALE = DQK == 128 ? 0.088388347648318440f : 0.072168783648703220f; static constexpr float C = SCALE * 1.4426950408889634f; };
constexpr float THR = 8.f;

template <int DQK>
__device__ __forceinline__ void partialSM(f32x16& p0, f32x16& p1, float& m_reg, float& mn, float& alpha) {
    constexpr float C = Cst<DQK>::C, SCALE = Cst<DQK>::SCALE;
    float pmax = p0[0];
#pragma unroll
    for (int r = 1; r < 16; ++r) pmax = fmaxf(pmax, p0[r]);
#pragma unroll
    for (int r = 0; r < 16; ++r) pmax = fmaxf(pmax, p1[r]);
    { auto rr = __builtin_amdgcn_permlane32_swap(__float_as_uint(pmax), __float_as_uint(pmax), false, false);
      pmax = fmaxf(__uint_as_float(rr[0]), __uint_as_float(rr[1])); }
    if (__builtin_expect(__all(pmax - m_reg <= THR / SCALE), 1)) { mn = m_reg; alpha = 1.f; }
    else { mn = fmaxf(m_reg, pmax); alpha = __builtin_amdgcn_exp2f((m_reg - mn) * C); m_reg = mn; }
    const float mnC = -mn * C;
#pragma unroll
    for (int r = 0; r < 16; ++r) p0[r] = __builtin_amdgcn_exp2f(fmaf(p0[r], C, mnC));
#pragma unroll
    for (int r = 0; r < 16; ++r) p1[r] = __builtin_amdgcn_exp2f(fmaf(p1[r], C, mnC));
}
__device__ __forceinline__ void finishSM(f32x16& p0, f32x16& p1, float alpha, float& l_reg, bf16x8& pa0, bf16x8& pa1, bf16x8& pa2, bf16x8& pa3) {
    float ps = 0;
#pragma unroll
    for (int r = 0; r < 16; ++r) ps += p0[r];
#pragma unroll
    for (int r = 0; r < 16; ++r) ps += p1[r];
    { auto rr = __builtin_amdgcn_permlane32_swap(__float_as_uint(ps), __float_as_uint(ps), false, false);
      ps = __uint_as_float(rr[0]) + __uint_as_float(rr[1]); }
    l_reg = l_reg * alpha + ps;
#define PK4(P, BASE, OUT) do { unsigned a0 = cvtpk(P[BASE + 0], P[BASE + 1]), a1 = cvtpk(P[BASE + 2], P[BASE + 3]);   \
    unsigned b0 = cvtpk(P[BASE + 4], P[BASE + 5]), b1 = cvtpk(P[BASE + 6], P[BASE + 7]);                              \
    auto r0 = __builtin_amdgcn_permlane32_swap(a0, b0, false, false); auto r1 = __builtin_amdgcn_permlane32_swap(a1, b1, false, false); \
    v4u w = {r0[0], r1[0], r0[1], r1[1]}; OUT = *reinterpret_cast<bf16x8*>(&w); } while (0)
    PK4(p0, 0, pa0); PK4(p0, 8, pa1); PK4(p1, 0, pa2); PK4(p1, 8, pa3);
#undef PK4
}
__device__ __forceinline__ int v_st(int k, int c) { const int kk = (k & ~0xC) | ((k & 4) << 1) | ((k & 8) >> 1); return ((kk >> 3) * 4 + (c >> 5)) * 512 + ((kk & 7) * 32 + (c & 31)) * 2; }
__device__ __forceinline__ int v_rd_base(int lane) { return ((lane & 3) << 3) | (((lane >> 2) & 3) << 6) | (((lane >> 4) & 1) << 5) | (((lane >> 5) & 1) << 8); }
constexpr int v_rd_off(int d0, int ks, int half) { return d0 * 512 + ks * 4096 + half * 2048; }
template <int OFF> __device__ __forceinline__ s16x4 tr_read(int vb) {
    s16x4 r; asm volatile("ds_read_b64_tr_b16 %0, %1 offset:%2" : "=&v"(r) : "v"(vb), "i"(OFF) : "memory"); return r;
}
template <int D0> __device__ __forceinline__ void pv_one(f32x16& od, int vb, bf16x8 pa0, bf16x8 pa1, bf16x8 pa2, bf16x8 pa3) {
#define PKV(L, H) (bf16x8){L[0], L[1], L[2], L[3], H[0], H[1], H[2], H[3]}
    const s16x4 l0 = tr_read<v_rd_off(D0, 0, 0)>(vb), h0 = tr_read<v_rd_off(D0, 0, 1)>(vb), l1 = tr_read<v_rd_off(D0, 1, 0)>(vb), h1 = tr_read<v_rd_off(D0, 1, 1)>(vb);
    asm volatile("s_waitcnt lgkmcnt(0)" ::: "memory"); SBAR();
    od = __builtin_amdgcn_mfma_f32_32x32x16_bf16(pa0, PKV(l0, h0), od, 0, 0, 0);
    const s16x4 l2 = tr_read<v_rd_off(D0, 2, 0)>(vb), h2 = tr_read<v_rd_off(D0, 2, 1)>(vb);
    od = __builtin_amdgcn_mfma_f32_32x32x16_bf16(pa1, PKV(l1, h1), od, 0, 0, 0);
    const s16x4 l3 = tr_read<v_rd_off(D0, 3, 0)>(vb), h3 = tr_read<v_rd_off(D0, 3, 1)>(vb);
    asm volatile("s_waitcnt lgkmcnt(0)" ::: "memory"); SBAR();
    od = __builtin_amdgcn_mfma_f32_32x32x16_bf16(pa2, PKV(l2, h2), od, 0, 0, 0);
    od = __builtin_amdgcn_mfma_f32_32x32x16_bf16(pa3, PKV(l3, h3), od, 0, 0, 0);
#undef PKV
}

template <int D0> __device__ __forceinline__ void v_ld8(s16x4 (&f)[8], int vb) {
    f[0] = tr_read<v_rd_off(D0, 0, 0)>(vb); f[1] = tr_read<v_rd_off(D0, 0, 1)>(vb); f[2] = tr_read<v_rd_off(D0, 1, 0)>(vb); f[3] = tr_read<v_rd_off(D0, 1, 1)>(vb);
    f[4] = tr_read<v_rd_off(D0, 2, 0)>(vb); f[5] = tr_read<v_rd_off(D0, 2, 1)>(vb); f[6] = tr_read<v_rd_off(D0, 3, 0)>(vb); f[7] = tr_read<v_rd_off(D0, 3, 1)>(vb);
}
__device__ __forceinline__ void pv_mm(f32x16& od, const s16x4 (&f)[8], bf16x8 pa0, bf16x8 pa1, bf16x8 pa2, bf16x8 pa3) {
#define PKV(L, H) (bf16x8){L[0], L[1], L[2], L[3], H[0], H[1], H[2], H[3]}
    od = __builtin_amdgcn_mfma_f32_32x32x16_bf16(pa0, PKV(f[0], f[1]), od, 0, 0, 0);
    od = __builtin_amdgcn_mfma_f32_32x32x16_bf16(pa1, PKV(f[2], f[3]), od, 0, 0, 0);
    od = __builtin_amdgcn_mfma_f32_32x32x16_bf16(pa2, PKV(f[4], f[5]), od, 0, 0, 0);
    od = __builtin_amdgcn_mfma_f32_32x32x16_bf16(pa3, PKV(f[6], f[7]), od, 0, 0, 0);
#undef PKV
}
__device__ __forceinline__ void pv_all(f32x16 (&o)[4], int vb, bf16x8 pa0, bf16x8 pa1, bf16x8 pa2, bf16x8 pa3) {
    s16x4 A[8], B[8];
    v_ld8<0>(A, vb); v_ld8<1>(B, vb);
    asm volatile("s_waitcnt lgkmcnt(8)" ::: "memory"); SBAR(); pv_mm(o[0], A, pa0, pa1, pa2, pa3); SBAR();
    v_ld8<2>(A, vb);
    asm volatile("s_waitcnt lgkmcnt(8)" ::: "memory"); SBAR(); pv_mm(o[1], B, pa0, pa1, pa2, pa3); SBAR();
    v_ld8<3>(B, vb);
    asm volatile("s_waitcnt lgkmcnt(8)" ::: "memory"); SBAR(); pv_mm(o[2], A, pa0, pa1, pa2, pa3); SBAR();
    asm volatile("s_waitcnt lgkmcnt(0)" ::: "memory"); SBAR(); pv_mm(o[3], B, pa0, pa1, pa2, pa3); SBAR();
}

template <int DQK, bool MASKED>
__device__ __forceinline__ void attn_unit(const bf16* __restrict__ Qb, int ldq,
                                          const bf16* __restrict__ KA, const bf16* __restrict__ VA, const bf16* __restrict__ KRA, int nA,
                                          const bf16* __restrict__ KB, const bf16* __restrict__ VB, const bf16* __restrict__ KRB, int nB,
                                          int ldk, int qpos0, int kposB0, float sink_l2, bf16* __restrict__ Ob, char* lds) {
    constexpr int ND = 8;
    constexpr float C = Cst<DQK>::C;
    const int tid = threadIdx.x, wid = tid >> 6, lane = tid & 63, r32 = lane & 31, hi = lane >> 5;
    float* wsf = (float*)(lds + OFF_WS) + wid * 64; float* li_l = wsf; float* al_l = wsf + 32;
    float m_reg = -1e30f, l_reg = 0.f; f32x16 o[4] = {}; bf16x8 qr[ND];
    const bf16* Qw = Qb + (size_t)(wid * QBLK + r32) * ldq + hi * 8;
#pragma unroll
    for (int d0 = 0; d0 < ND; ++d0) qr[d0] = *reinterpret_cast<const bf16x8*>(Qw + d0 * 16);
    if constexpr (DQK == 192) {
#pragma unroll
        for (int dd = 0; dd < 4; ++dd) { const bf16x8 qv = *reinterpret_cast<const bf16x8*>(Qw + 128 + dd * 16); *(bf16x8*)(lds + OFF_QR + wid * 4096 + KRSWZ(r32, dd * 2 + hi)) = qv; }
    }
    const int vb0 = (int)(uintptr_t)(LAS char*)(lds + OFF_V) + v_rd_base(lane);
    const int NT = nA + nB;
    unsigned gok, gov, gor;
    { const int krow = 4 * wid + (lane >> 4); gok = (unsigned)(krow * ldk) * 2u + (unsigned)(((lane & 15) << 4) ^ ((krow & 7) << 4));
      const int kk = 8 * (wid >> 1) + ((lane & 31) >> 2), kv = (kk & ~0xC) | ((kk & 4) << 1) | ((kk & 8) >> 1), cv = 32 * (2 * (wid & 1) + (lane >> 5)) + ((lane & 3) << 3);
      gov = (unsigned)(kv * ldk + cv) * 2u;
      const int rrow = 8 * wid + (lane >> 3); gor = (unsigned)(rrow * 128 + ((((lane & 7) ^ (rrow >> 1)) & 7) << 4)); }
    const unsigned g32 = (unsigned)(32 * ldk) * 2u;
    LAS char* const L3 = (LAS char*)lds;
#define SLOAD(t, b) do { const bool inA_ = (t) < nA; const int tt_ = inA_ ? (t) : (t) - nA; const char* Kt_ = (const char*)((inA_ ? KA : KB) + (size_t)tt_ * 64 * ldk); const char* Vt_ = (const char*)((inA_ ? VA : VB) + (size_t)tt_ * 64 * ldk); \
    __builtin_amdgcn_global_load_lds((const unsigned*)(Kt_ + gok), (LAS unsigned*)(L3 + OFF_K + (b) * SHM_K + wid * 1024), 16, 0, 0); \
    __builtin_amdgcn_global_load_lds((const unsigned*)(Kt_ + gok + g32), (LAS unsigned*)(L3 + OFF_K + (b) * SHM_K + 8192 + wid * 1024), 16, 0, 0); \
    __builtin_amdgcn_global_load_lds((const unsigned*)(Vt_ + gov), (LAS unsigned*)(L3 + OFF_V + (b) * SHM_V + wid * 1024), 16, 0, 0); \
    __builtin_amdgcn_global_load_lds((const unsigned*)(Vt_ + gov + g32), (LAS unsigned*)(L3 + OFF_V + (b) * SHM_V + 8192 + wid * 1024), 16, 0, 0); \
    if constexpr (DQK == 192) { const char* Rt_ = (const char*)((inA_ ? KRA : KRB) + (size_t)tt_ * 64 * 64); \
        __builtin_amdgcn_global_load_lds((const unsigned*)(Rt_ + gor), (LAS unsigned*)(L3 + OFF_KR + (b) * SHM_KR + wid * 1024), 16, 0, 0); } } while (0)
#define KLD_(dg, A0, A1) _Pragma("unroll") for (int dd = 0; dd < 2; ++dd) { const int cb_ = (((dg) * 2 + dd) * 16 + hi * 8) * 2; const LAS char* ka_ = (const LAS char*)(uintptr_t)(unsigned)(kb0_ + (cb_ ^ sw_)); A0[dd] = *reinterpret_cast<const LAS bf16x8*>(ka_); A1[dd] = *reinterpret_cast<const LAS bf16x8*>(ka_ + 32 * 256); }
#define KMM_(dg, A0, A1, P0, P1) _Pragma("unroll") for (int dd = 0; dd < 2; ++dd) { P0 = __builtin_amdgcn_mfma_f32_32x32x16_bf16(A0[dd], qr[(dg) * 2 + dd], P0, 0, 0, 0); P1 = __builtin_amdgcn_mfma_f32_32x32x16_bf16(A1[dd], qr[(dg) * 2 + dd], P1, 0, 0, 0); }
#define RLD_(dg, A0, A1, QF) _Pragma("unroll") for (int dd = 0; dd < 2; ++dd) { const int ch_ = ((dg) * 2 + dd) * 2 + hi; const int so_ = ((ch_ ^ rs_) & 7) << 4; const LAS char* ra_ = (const LAS char*)(uintptr_t)(unsigned)(rb0_ + so_); \
        A0[dd] = *reinterpret_cast<const LAS bf16x8*>(ra_); A1[dd] = *reinterpret_cast<const LAS bf16x8*>(ra_ + 32 * 128); QF[dd] = *reinterpret_cast<const LAS bf16x8*>((const LAS char*)(uintptr_t)(unsigned)(qb0_ + so_)); }
#define RMM_(A0, A1, QF, P0, P1) _Pragma("unroll") for (int dd = 0; dd < 2; ++dd) { P0 = __builtin_amdgcn_mfma_f32_32x32x16_bf16(A0[dd], QF[dd], P0, 0, 0, 0); P1 = __builtin_amdgcn_mfma_f32_32x32x16_bf16(A1[dd], QF[dd], P1, 0, 0, 0); }
#define QKT(P0, P1, b) do { P0 = f32x16{}; P1 = f32x16{}; int kb0_ = (int)(uintptr_t)(LAS char*)(lds + OFF_K) + (b) * SHM_K + r32 * 256, sw_ = (r32 & 7) << 4; asm volatile("" : "+v"(kb0_), "+v"(sw_));   \
    bf16x8 xa0_[2], xa1_[2], xb0_[2], xb1_[2]; \
    KLD_(0, xa0_, xa1_); SBAR(); \
    KLD_(1, xb0_, xb1_); SBAR(); KMM_(0, xa0_, xa1_, P0, P1); SBAR(); \
    KLD_(2, xa0_, xa1_); SBAR(); KMM_(1, xb0_, xb1_, P0, P1); SBAR(); \
    KLD_(3, xb0_, xb1_); SBAR(); KMM_(2, xa0_, xa1_, P0, P1); SBAR(); \
    if constexpr (DQK == 192) { int rb0_ = (int)(uintptr_t)(LAS char*)(lds + OFF_KR) + (b) * SHM_KR + r32 * 128, rs_ = (r32 >> 1) & 7, qb0_ = (int)(uintptr_t)(LAS char*)(lds + OFF_QR) + wid * 4096 + r32 * 128; asm volatile("" : "+v"(rb0_), "+v"(rs_), "+v"(qb0_)); \
        bf16x8 qa_[2], qb_[2]; \
        RLD_(0, xa0_, xa1_, qa_); SBAR(); KMM_(3, xb0_, xb1_, P0, P1); SBAR(); \
        RLD_(1, xb0_, xb1_, qb_); SBAR(); RMM_(xa0_, xa1_, qa_, P0, P1); SBAR(); \
        RMM_(xb0_, xb1_, qb_, P0, P1); SBAR(); } \
    else { KMM_(3, xb0_, xb1_, P0, P1); SBAR(); } } while (0)
#define MASKT(P0, P1, t) do { if constexpr (MASKED) { if ((t) >= nA) { const int qp_ = qpos0 + wid * QBLK + r32, kb_ = kposB0 + ((t) - nA) * 64; \
    _Pragma("unroll") for (int r = 0; r < 16; ++r) { const int d_ = qp_ - (kb_ + crow(r, hi)); if (d_ > 128 || d_ < -128) P0[r] = -1e30f; const int d2_ = d_ - 32; if (d2_ > 128 || d2_ < -128) P1[r] = -1e30f; } } } } while (0)
#define RESC(a) do { if (__any((a) < 1.f)) { if (hi == 0) al_l[r32] = (a); LDS_WAIT(); \
    _Pragma("unroll") for (int r = 0; r < 16; ++r) { const float al_ = al_l[crow(r, hi)]; _Pragma("unroll") for (int d = 0; d < 4; ++d) o[d][r] *= al_; } } } while (0)
#define PV(b) do { pv_all(o, vb0 + (b) * SHM_V, pa0, pa1, pa2, pa3); } while (0)
    constexpr int NL = DQK == 192 ? 5 : 4;
    f32x16 p0, p1; float mn, al; bf16x8 pa0, pa1, pa2, pa3;
    SLOAD(0, 0); if (NT > 1) SLOAD(1, 1);
    int sc = 0;
    for (int t = 0; t < NT; ++t) {
        if (t + 1 < NT) { if constexpr (NL == 5) asm volatile("s_waitcnt vmcnt(5)" ::: "memory"); else asm volatile("s_waitcnt vmcnt(4)" ::: "memory"); } else { VM_WAIT(); }
        __syncthreads();
        const int sn = sc == 0 ? 2 : sc - 1;
        if (t + 2 < NT) SLOAD(t + 2, sn);
        SBAR(); QKT(p0, p1, sc); MASKT(p0, p1, t);
        partialSM<DQK>(p0, p1, m_reg, mn, al);
        RESC(al);
        finishSM(p0, p1, al, l_reg, pa0, pa1, pa2, pa3); SBAR();
        PV(sc);
        sc = sc == 2 ? 0 : sc + 1;
    }
    l_reg += __builtin_amdgcn_exp2f(sink_l2 - m_reg * C);
    if (hi == 0) li_l[r32] = l_reg; LDS_WAIT();
    int obase = (wid * QBLK + 4 * hi) * 2048 + r32; asm volatile("" : "+v"(obase));
#pragma unroll
    for (int r = 0; r < 16; ++r) { const float rl = __builtin_amdgcn_rcpf(li_l[crow(r, hi)]); const int ro = ((r & 3) + 8 * (r >> 2)) * 2048;
#pragma unroll
        for (int d0 = 0; d0 < 4; ++d0) *(bf16*)((char*)Ob + (unsigned)(obase + ro + d0 * 32) * 2u) = (bf16)f2bf(o[d0][r] * rl); }
    LDS_WAIT();
    __syncthreads();
#undef SLOAD
#undef QKT
#undef KLD_
#undef KMM_
#undef RLD_
#undef RMM_
#undef MASKT
#undef RESC
#undef PV
}
}

__device__ __forceinline__ void attn_win_phase(Frame& F, int j) {
    const bf16* Q = WSP(bf16, WS_WQ); const bf16* K = WSP(bf16, WS_WK); const bf16* V = WSP(bf16, WS_WV); bf16* O = WSP(bf16, WS_AO);
    const bf16* CK = WSP(bf16, WS_CTXK) + (size_t)j * 2 * 512 * 512; const bf16* CV = WSP(bf16, WS_CTXV) + (size_t)j * 2 * 512 * 512;
    for (int un = F.bx; un < 512; un += F.G) {
        const int h = un & 15, kvh = h >> 2; const float sink = F.in[I_SINK][j * 16 + h] * 1.4426950408889634f;
        const int qb = un >> 4, bs = qb >> 4, t0 = (qb & 15) * 256, row0 = MP + qb * 256;
        int kt0 = (t0 >> 6) - 2, kt1 = (t0 >> 6) + 5; if (kt0 < 0) kt0 = 0; if (kt1 > 63) kt1 = 63;
        const size_t kb = (size_t)(MP + bs * 4096 + kt0 * 64) * 512 + kvh * 128;
        att::attn_unit<128, true>(Q + (size_t)row0 * 2048 + h * 128, 2048, CK + (size_t)bs * 512 * 512 + kvh * 128, CV + (size_t)bs * 512 * 512 + kvh * 128, nullptr, 8,
                                 K + kb, V + kb, nullptr, kt1 - kt0 + 1, 512, t0, kt0 * 64, sink, O + (size_t)row0 * 2048 + h * 128, (char*)F.ldsg);
    }
    for (int un = F.bx; un < 512; un += F.G) {
        const int h = un & 15, kvh = h >> 2; const float sink = F.in[I_SINK][j * 16 + h] * 1.4426950408889634f;
        const int b = un >> 4, row0 = b * 256; const size_t kb = (size_t)row0 * 512 + kvh * 128;
        att::attn_unit<128, false>(Q + (size_t)row0 * 2048 + h * 128, 2048, nullptr, nullptr, nullptr, 0,
                                  K + kb, V + kb, nullptr, 4, 512, 0, 0, sink, O + (size_t)row0 * 2048 + h * 128, (char*)F.ldsg);
    }
}
__device__ __forceinline__ void attn_mla_phase(Frame& F) {
    const bf16* Q = WSP(bf16, WS_MQ); const bf16* KN = WSP(bf16, WS_MKN); const bf16* V = WSP(bf16, WS_MV); const bf16* KR = WSP(bf16, WS_MKR); bf16* O = WSP(bf16, WS_AO);
    for (int un = F.bx; un < 512; un += F.G) {
        const int h = un & 15, qb = un >> 4, bs = qb >> 4, row0 = MP + qb * 256;
        const size_t ra = (size_t)bs * 512, rb = (size_t)1024 + MP + bs * 4096;
        att::attn_unit<192, false>(Q + (size_t)row0 * 3072 + h * 192, 3072, KN + ra * 2048 + h * 128, V + ra * 2048 + h * 128, KR + ra * 64, 8,
                                  KN + rb * 2048 + h * 128, V + rb * 2048 + h * 128, KR + rb * 64, 64, 2048, 0, 0, -1e30f, O + (size_t)row0 * 2048 + h * 128, (char*)F.ldsg);
    }
    for (int un = F.bx; un < 512; un += F.G) {
        const int h = un & 15, b = un >> 4, row0 = b * 256; const size_t rb = (size_t)1024 + row0;
        att::attn_unit<192, false>(Q + (size_t)row0 * 3072 + h * 192, 3072, nullptr, nullptr, nullptr, 0,
                                  KN + rb * 2048 + h * 128, V + rb * 2048 + h * 128, KR + rb * 64, 4, 2048, 0, 0, -1e30f, O + (size_t)row0 * 2048 + h * 128, (char*)F.ldsg);
    }
}

__device__ __forceinline__ void mla_norm_phase(Frame& F) {
    const int gw = F.bx * NWAVES + F.wave, NGW = F.G * NWAVES, lane = F.lane;
    const float* D = WSP(float, WS_MD); bf16* CQ = WSP(bf16, WS_MCQ); bf16* CKV = WSP(bf16, WS_MCKV); bf16* KR = WSP(bf16, WS_MKR);
    const f32x2* tab = WSP(f32x2, WS_TABM);
    const float* qn = F.in[I_MQN]; const float* kvn = F.in[I_MKVN];
    for (int row = gw; row < MTOK; row += NGW) {
        const float* d = D + (size_t)row * 1024;
        {
            const f32x4 v0 = *(const f32x4*)(d + 4 * lane), v1 = *(const f32x4*)(d + 256 + 4 * lane);
            float ss = (v0[0] * v0[0] + v0[1] * v0[1]) + (v0[2] * v0[2] + v0[3] * v0[3]) + (v1[0] * v1[0] + v1[1] * v1[1]) + (v1[2] * v1[2] + v1[3] * v1[3]);
            const float rstd = rsqrtf(wave_sum(ss) * (1.f / 512.f) + EPS);
            const f32x4 y0 = v0 * rstd * *(const f32x4*)(qn + 4 * lane), y1 = v1 * rstd * *(const f32x4*)(qn + 256 + 4 * lane);
            v2u w; w.x = cvtpk(y0[0], y0[1]); w.y = cvtpk(y0[2], y0[3]); *(v2u*)(CQ + (size_t)row * 512 + 4 * lane) = w;
            w.x = cvtpk(y1[0], y1[1]); w.y = cvtpk(y1[2], y1[3]); *(v2u*)(CQ + (size_t)row * 512 + 256 + 4 * lane) = w;
        }
        {
            const f32x4 v0 = *(const f32x4*)(d + 512 + 4 * lane);
            float ss = (v0[0] * v0[0] + v0[1] * v0[1]) + (v0[2] * v0[2] + v0[3] * v0[3]);
            const float rstd = rsqrtf(wave_sum(ss) * (1.f / 256.f) + EPS);
            const f32x4 y0 = v0 * rstd * *(const f32x4*)(kvn + 4 * lane);
            v2u w; w.x = cvtpk(y0[0], y0[1]); w.y = cvtpk(y0[2], y0[3]); *(v2u*)(CKV + (size_t)(1024 + row) * 256 + 4 * lane) = w;
            if (row < MP) *(f32x4*)(F.out + O_CKV + (size_t)row * 256 + 4 * lane) = y0;
        }
        if (lane < 8) {
            const int ug = lane, idx0 = (ug & 3) * 4, d1 = (ug < 4 ? 0 : 32) + idx0;
            f32x4 a = *(const f32x4*)(d + 768 + 8 * ug), b = *(const f32x4*)(d + 768 + 8 * ug + 4);
            if (row < MP) { float* op = F.out + O_KR + (size_t)row * 64 + d1; *(f32x4*)op = a; *(f32x4*)(op + 16) = b; }
            else { const int t = row & 4095, pos = (ug < 4) ? (t >> 6) : (t & 63); const f32x4* tp = (const f32x4*)(tab + pos * 16 + idx0); const f32x4 cs0 = tp[0], cs1 = tp[1];
                const f32x4 co = {cs0[0], cs0[2], cs1[0], cs1[2]}, si = {cs0[1], cs0[3], cs1[1], cs1[3]};
                const f32x4 na = a * co - b * si, nb = b * co + a * si; a = na; b = nb; }
            *(v4u*)(KR + (size_t)(1024 + row) * 64 + 8 * ug) = pack8(a, b);
        }
    }
    const int gt = F.bx * 512 + F.tid, NGT = F.G * 512;
    for (int e = gt; e < 1024 * 256; e += NGT) CKV[e] = (bf16)f2bf(F.in[I_CCKV][e]);
    for (int e = gt; e < 1024 * 64; e += NGT) KR[e] = (bf16)f2bf(F.in[I_CKR][(e & ~63) + perm_mla(e & 63)]);
}

typedef short v4i16_t __attribute__((ext_vector_type(4)));
__device__ __forceinline__ s16x4 vtr(const LAS char* p) { return __builtin_bit_cast(s16x4, __builtin_amdgcn_ds_read_tr16_b64_v4i16((LAS v4i16_t*)p)); }
#define MFMA16(a, b, c) __builtin_amdgcn_mfma_f32_16x16x32_bf16((a), (b), (c), 0, 0, 0)
#define CAT8(L, H) (bf16x8){L[0], L[1], L[2], L[3], H[0], H[1], H[2], H[3]}
typedef __bf16 bf16x2_t __attribute__((ext_vector_type(2)));
typedef float f32x2_t __attribute__((ext_vector_type(2)));
__device__ __forceinline__ unsigned cvtpk2(float lo, float hi) { f32x2_t v = {lo, hi}; bf16x2_t b = __builtin_convertvector(v, bf16x2_t); return __builtin_bit_cast(unsigned, b); }

__device__ __forceinline__ void gla_u_phase(Frame& F) {
    const int lane = F.lane, wave = F.wave, tid = F.tid, cl = lane & 15, gq = lane >> 4;
    const bf16* H = WSP(bf16, WS_H); const bf16* Wt = WSP(bf16, WS_GWINT) + (size_t)6144 * DM;
    const float* part = WSP(float, WS_PART) + (size_t)4 * MTOK * 32; const float* sW = WSP(float, WS_SW) + (size_t)4 * 3 * 8192 + 6144;
    float* GU = WSP(float, WS_GU);
    LAS float* red = (LAS float*)F.lds;
    __syncthreads();
    for (int rb = F.bx; rb < MTOK / 64; rb += F.G) {
        const int row0 = rb * 64;
        f32x4 acc[4][2];
#pragma unroll
        for (int mi = 0; mi < 4; ++mi) { acc[mi][0] = (f32x4){0.f, 0.f, 0.f, 0.f}; acc[mi][1] = (f32x4){0.f, 0.f, 0.f, 0.f}; }
        const bf16* ap = H + (size_t)(row0 + cl) * DM + wave * 256 + 16 * gq;
        const bf16* bp = Wt + (size_t)cl * DM + wave * 256 + 16 * gq;
#pragma unroll
        for (int ks = 0; ks < 4; ++ks) {
            bf16x8 a[4][2], b[2][2];
#pragma unroll
            for (int mi = 0; mi < 4; ++mi) { a[mi][0] = *(const bf16x8*)(ap + (size_t)mi * 16 * DM + 64 * ks); a[mi][1] = *(const bf16x8*)(ap + (size_t)mi * 16 * DM + 64 * ks + 8); }
#pragma unroll
            for (int nj = 0; nj < 2; ++nj) { b[nj][0] = *(const bf16x8*)(bp + (size_t)nj * 16 * DM + 64 * ks); b[nj][1] = *(const bf16x8*)(bp + (size_t)nj * 16 * DM + 64 * ks + 8); }
#pragma unroll
            for (int mi = 0; mi < 4; ++mi)
#pragma unroll
                for (int nj = 0; nj < 2; ++nj) { acc[mi][nj] = MFMA16(a[mi][0], b[nj][0], acc[mi][nj]); acc[mi][nj] = MFMA16(a[mi][1], b[nj][1], acc[mi][nj]); }
        }
#pragma unroll
        for (int mi = 0; mi < 4; ++mi)
#pragma unroll
            for (int nj = 0; nj < 2; ++nj)
#pragma unroll
                for (int r = 0; r < 4; ++r) red[(wave * 64 + 16 * mi + 4 * gq + r) * 32 + 16 * nj + cl] = acc[mi][nj][r];
        __syncthreads();
        {
            const int rr = tid >> 3, c4 = (tid & 7) * 4, row = row0 + rr;
            f32x4 t = *(const LAS f32x4*)(red + rr * 32 + c4);
#pragma unroll
            for (int w = 1; w < 8; ++w) t += *(const LAS f32x4*)(red + (w * 64 + rr) * 32 + c4);
            const f32x4* pp = (const f32x4*)(part + (size_t)row * 32); f32x4 ps = pp[0];
#pragma unroll
            for (int i = 1; i < 8; ++i) ps += pp[i];
            const float rstd = rsqrtf(((ps[0] + ps[1]) + (ps[2] + ps[3])) * (1.f / 2048.f) + EPS);
            *(f32x4*)(GU + (size_t)row * 32 + c4) = t * rstd + *(const f32x4*)(sW + (size_t)cond_of_pm(row >> 8) * 8192 + c4);
        }
        __syncthreads();
    }
}
__device__ __forceinline__ void gla_prep_phase(Frame& F) {
    constexpr int PQ = 528, OQ = 0, OK_ = 64 * PQ, OKT = 2 * 64 * PQ, OUB = 3 * 64 * PQ, OHT = OUB + 4096, OAT = OHT + 2048;
    LAS char* L = (LAS char*)F.lds; const int tid = F.tid, lane = F.lane, wave = F.wave;
    const bf16* GQ = WSP(bf16, WS_GQ); const bf16* GK = WSP(bf16, WS_GK); const float* GU = WSP(float, WS_GU);
    v4u pq[4], pk[4]; f32x4 pu = {0.f, 0.f, 0.f, 0.f};
#define GLA_PREP_LOAD(UN) do { const int d_ = (UN) & 1, ch_ = (UN) >> 1, r0_ = (ch_ >> 2) * 64, h_ = ch_ & 3; \
        _Pragma("unroll") for (int i = 0; i < 4; ++i) { const int e = tid + 512 * i, row = e >> 5, cc = e & 31; const size_t go = (size_t)(r0_ + row) * 1024 + h_ * 256 + cc * 8; pq[i] = *(const v4u*)(GQ + go); pk[i] = *(const v4u*)(GK + go); } \
        if (tid < 256) pu = *(const f32x4*)(GU + (size_t)(r0_ + (tid >> 2)) * 32 + d_ * 16 + (tid & 3) * 4); } while (0)
    if (F.bx < 2048) GLA_PREP_LOAD(F.bx);
    float w[16]; float bias = 0.f; int cur_dh = -1;
#pragma unroll
    for (int r = 0; r < 16; ++r) w[r] = 0.f;
    for (int un = F.bx; un < 2048; un += F.G) {
        const int d = un & 1, ch = un >> 1, c = ch >> 2, h = ch & 3, row0 = c * 64;
        bf16* QT = WSP(bf16, WS_GQT) + (size_t)d * MTOK * 1024; bf16* KD = WSP(bf16, WS_GKD) + (size_t)d * MTOK * 1024;
        bf16* AM = WSP(bf16, WS_GAM) + ((size_t)d * 1024 + ch) * 4096; float* DEC = WSP(float, WS_GDEC) + ((size_t)d * 1024 + ch) * 256;
        if ((un & 7) != cur_dh) { cur_dh = un & 7; const int col = tid & 255;
#pragma unroll
            for (int r = 0; r < 16; ++r) w[r] = F.in[I_GWA2][((size_t)d * 16 + r) * 1024 + h * 256 + col] * 1.44269504f;
            bias = F.in[I_GBA][d * 1024 + h * 256 + col] * 1.44269504f; }
#pragma unroll
        for (int i = 0; i < 4; ++i) { const int e = tid + 512 * i, row = e >> 5, cc = e & 31;
            *(LAS v4u*)(L + OQ + row * PQ + cc * 16) = pq[i]; *(LAS v4u*)(L + OK_ + row * PQ + cc * 16) = pk[i]; }
        if (tid < 256) { const int row = tid >> 2, q4 = tid & 3; *(LAS f32x4*)(L + OUB + (row * 16 + q4 * 4) * 4) = pu; }
        __syncthreads();
        if (un + F.G < 2048) GLA_PREP_LOAD(un + F.G);
        {
            const int hf = tid >> 8, col = tid & 255;
            float g[32]; float tot = 0.f;
#pragma unroll
            for (int ii = 0; ii < 32; ++ii) { const int i = hf * 32 + ii; float z = bias;
#pragma unroll
                for (int q4 = 0; q4 < 4; ++q4) { const f32x4 uv = *(const LAS f32x4*)(L + OUB + (i * 16 + q4 * 4) * 4); z += uv[0] * w[4 * q4] + uv[1] * w[4 * q4 + 1] + uv[2] * w[4 * q4 + 2] + uv[3] * w[4 * q4 + 3]; }
                const float ls = fminf(z, 0.f) - __builtin_amdgcn_logf(1.f + __builtin_amdgcn_exp2f(-fabsf(z)));
                g[ii] = ls * 0.0625f; tot += g[ii]; }
            ((LAS float*)(L + OHT))[hf * 256 + col] = tot;
            __syncthreads();
            const float other = ((const LAS float*)(L + OHT))[(1 - hf) * 256 + col];
            const float T = tot + other, eT = __builtin_amdgcn_exp2f(T);
            float run = (d == 0) ? (hf == 1 ? other : 0.f) : (hf == 0 ? other : 0.f);
            if (hf == 0) DEC[col] = eT;
#pragma unroll
            for (int s = 0; s < 32; ++s) {
                const int ii = (d == 0) ? s : 31 - s;
                run += (d == 0) ? g[s] : g[31 - s];
                const int i = hf * 32 + ii;
                LAS bf16* qp = (LAS bf16*)(L + OQ + i * PQ) + col; LAS bf16* kp = (LAS bf16*)(L + OK_ + i * PQ) + col; LAS bf16* ktp = (LAS bf16*)(L + OKT + i * PQ) + col;
                const float qv = bf2f(*qp), kv = bf2f(*kp);
                const float kt = kv * __builtin_amdgcn_exp2f(-run);
                const unsigned wq = cvtpk(qv * __builtin_amdgcn_exp2f(run), kt), wk = cvtpk(kt * eT, 0.f);
                *qp = (bf16)(wq & 0xffffu); *ktp = (bf16)(wq >> 16); *kp = (bf16)(wk & 0xffffu);
            }
        }
        __syncthreads();
        {
            const int gq = lane >> 4, cl = lane & 15;
#pragma unroll
            for (int s2 = 0; s2 < 2; ++s2) {
                const int T16 = 2 * wave + s2, ti = T16 >> 2, tj = T16 & 3;
                f32x4 acc = {0.f, 0.f, 0.f, 0.f};
#pragma unroll
                for (int ks = 0; ks < 8; ++ks) {
                    const bf16x8 a = *(const LAS bf16x8*)(L + OQ + (16 * ti + cl) * PQ + (32 * ks + 8 * gq) * 2);
                    const bf16x8 b = *(const LAS bf16x8*)(L + OKT + (16 * tj + cl) * PQ + (32 * ks + 8 * gq) * 2);
                    acc = MFMA16(a, b, acc);
                }
                const int jcol = 16 * tj + cl;
#pragma unroll
                for (int r = 0; r < 4; ++r) { const int i = 16 * ti + 4 * gq + r; const bool keep = (d == 0) ? (jcol <= i) : (jcol >= i);
                    ((LAS bf16*)(L + OAT))[i * 64 + jcol] = (bf16)f2bf(keep ? acc[r] : 0.f); }
            }
        }
        __syncthreads();
#pragma unroll
        for (int i = 0; i < 4; ++i) { const int e = tid + 512 * i, row = e >> 5, cc = e & 31; const size_t go = (size_t)(row0 + row) * 1024 + h * 256 + cc * 8;
            *(v4u*)(QT + go) = *(const LAS v4u*)(L + OQ + row * PQ + cc * 16); *(v4u*)(KD + go) = *(const LAS v4u*)(L + OK_ + row * PQ + cc * 16); }
        *(v4u*)(AM + tid * 8) = *(const LAS v4u*)(L + OAT + tid * 16);
        __syncthreads();
    }
#undef GLA_PREP_LOAD
}

constexpr int GLA_NSEG = 4, GLA_SEGCH = 16;
template <bool LIGHT>
__device__ __forceinline__ void gla_scan_item(Frame& F, int seq, int h, int d, int sl, int seg) {
    constexpr int PQ = 528, PK = 544, PA = 136, PV = 288;
    constexpr int OQ = 0, OK_ = 64 * PQ, OA = OK_ + 64 * PK, OV = OA + 64 * PA, ODEC = OV + 64 * PV;
    LAS char* L = (LAS char*)F.lds; const int tid = F.tid, lane = F.lane, wave = F.wave, gq = lane >> 4, cl = lane & 15;
    const bool sample = seq >= 32; const int base = sample ? MP + (seq - 32) * 4096 : seq * 256, ntot = sample ? 64 : 4;
    const int p0 = sample ? seg * GLA_SEGCH : 0, nch = sample ? GLA_SEGCH : 4;
    const bf16* QT = WSP(bf16, WS_GQT) + (size_t)d * MTOK * 1024; const bf16* KD = WSP(bf16, WS_GKD) + (size_t)d * MTOK * 1024;
    const bf16* AM = WSP(bf16, WS_GAM) + (size_t)d * 1024 * 4096; const float* DEC = WSP(float, WS_GDEC) + (size_t)d * 1024 * 256;
    const bf16* GV = WSP(bf16, WS_GV); bf16* OD = WSP(bf16, d == 0 ? WS_GOF : WS_GOB);
    const int dvc = h * 512 + sl * 128;
    const int sidx = sample ? (((seq - 32) * 4 + h) * 2 + d) : 0;
    float* GLs = WSP(float, WS_GLS); float* GDS = WSP(float, WS_GDS);
    f32x4 S[16];
#pragma unroll
    for (int t = 0; t < 16; ++t) S[t] = (f32x4){0.f, 0.f, 0.f, 0.f};
    if (sample && !LIGHT) {
        { const float* s0 = F.in[d == 0 ? I_SGF : I_SGB] + ((size_t)((seq - 32) * 4 + h) * 256) * 512 + sl * 128 + 16 * wave;
          int lb = (4 * gq) * 512 + cl; asm volatile("" : "+v"(lb));
#pragma unroll
          for (int t = 0; t < 16; ++t)
#pragma unroll
            for (int r = 0; r < 4; ++r) S[t][r] = s0[(unsigned)(lb + (16 * t + r) * 512)]; }
        for (int g = 0; g < seg; ++g) {
            const float* Lg = GLs + ((size_t)(sidx * 3 + g) * 256) * 512 + sl * 128 + 16 * wave; const float* Dg = GDS + (size_t)(sidx * 3 + g) * 256;
            int lb = (4 * gq) * 512 + cl, db = 4 * gq; asm volatile("" : "+v"(lb), "+v"(db));
#pragma unroll
            for (int t = 0; t < 16; ++t) { const f32x4 dg = *(const f32x4*)(Dg + (unsigned)(db + 16 * t));
#pragma unroll
                for (int r = 0; r < 4; ++r) S[t][r] = S[t][r] * dg[r] + Lg[(unsigned)(lb + (16 * t + r) * 512)]; }
        }
    }
    float dprod = 1.f;
    v4u rq[LIGHT ? 1 : 4], rk[4], rv[2], ra; float rdec = 0.f;
    const int tr = tid >> 5, tc = tid & 31, vr = tid >> 4, vc = tid & 15;
    const unsigned goq = (unsigned)(tr * 1024 + h * 256 + tc * 8) * 2u, gov = (unsigned)(vr * 2048 + dvc + vc * 8) * 2u;
    LAS char* const lq = L + OQ + tr * PQ + tc * 16; LAS char* const lk = L + OK_ + tr * PK + tc * 16; LAS char* const lv = L + OV + vr * PV + vc * 16;
#define GLOAD1(ps) do { const int ci_ = d == 0 ? (ps) : ntot - 1 - (ps); const size_t rb_ = (size_t)(base + 64 * ci_) * 2048;   \
    _Pragma("unroll") for (int i = 0; i < 4; ++i) { if constexpr (!LIGHT) rq[i] = *(const v4u*)((const char*)QT + rb_ + goq + i * 16 * 2048); rk[i] = *(const v4u*)((const char*)KD + rb_ + goq + i * 16 * 2048); } } while (0)
#define GLOAD2(ps) do { const int ci_ = d == 0 ? (ps) : ntot - 1 - (ps); const int r0_ = base + 64 * ci_; const int chx_ = (r0_ >> 6) * 4 + h; \
    _Pragma("unroll") for (int i = 0; i < 2; ++i) rv[i] = *(const v4u*)((const char*)GV + (size_t)r0_ * 4096 + gov + i * 32 * 4096); \
    if constexpr (!LIGHT) ra = *(const v4u*)(AM + (size_t)chx_ * 4096 + tid * 8); if (tid < 256) rdec = DEC[(size_t)chx_ * 256 + tid]; } while (0)
#define LWRITE() do { \
    _Pragma("unroll") for (int i = 0; i < 4; ++i) { if constexpr (!LIGHT) *(LAS v4u*)(lq + i * 16 * PQ) = rq[i]; *(LAS v4u*)(lk + i * 16 * PK) = rk[i]; } \
    _Pragma("unroll") for (int i = 0; i < 2; ++i) *(LAS v4u*)(lv + i * 32 * PV) = rv[i]; \
    if constexpr (!LIGHT) { const int row = tid >> 3, cc = tid & 7; *(LAS v2u*)(L + OA + row * PA + cc * 16) = (v2u){ra.x, ra.y}; *(LAS v2u*)(L + OA + row * PA + cc * 16 + 8) = (v2u){ra.z, ra.w}; } \
    if (tid < 256) ((LAS float*)(L + ODEC))[tid] = rdec; } while (0)
    GLOAD1(p0); GLOAD2(p0);
    LWRITE();
    __syncthreads();
    for (int s = 0; s < nch; ++s) {
        const int ps = p0 + s, ci = d == 0 ? ps : ntot - 1 - ps, row0 = base + 64 * ci;
        if constexpr (LIGHT) dprod *= rdec;
        if (s + 1 < nch) { GLOAD1(ps + 1); GLOAD2(ps + 1); }
        bf16x8 vb[2];
#define LOADVB() do { _Pragma("unroll") for (int ks = 0; ks < 2; ++ks) { const LAS char* vp = L + OV + (32 * ks + 4 * gq + (cl >> 2)) * PV + 32 * wave + 8 * (cl & 3); \
            const s16x4 lo = vtr(vp), hi = vtr(vp + 16 * PV); vb[ks] = CAT8(lo, hi); } } while (0)
        SBAR(); LOADVB();
        if constexpr (!LIGHT) {
            f32x4 o[4];
#pragma unroll
            for (int ti = 0; ti < 4; ++ti) o[ti] = (f32x4){0.f, 0.f, 0.f, 0.f};
            const LAS char* qb_ = L + OQ + cl * PQ + 8 * gq; const LAS char* ab_ = L + OA + cl * PA + 8 * gq;
            int qh_ = (int)(uintptr_t)qb_ + 32, ah_ = (int)(uintptr_t)ab_ + 32; asm volatile("" : "+v"(qh_), "+v"(ah_));
#define OLD_(g, F) do { _Pragma("unroll") for (int ti = 0; ti < 4; ++ti) { const LAS char* ap = (g) < 8 ? qb_ + 16 * ti * PQ + 64 * (g) : ab_ + 16 * ti * PA + 64 * ((g) - 8); const LAS char* ah2 = (const LAS char*)(uintptr_t)(unsigned)((g) < 8 ? qh_ + 16 * ti * PQ + 64 * (g) : ah_ + 16 * ti * PA + 64 * ((g) - 8)); F[2 * ti] = *(const LAS s16x4*)ap; F[2 * ti + 1] = *(const LAS s16x4*)ah2; } } while (0)
#define OMM_(g, F) do { bf16x8 b_; if constexpr ((g) < 8) { constexpr int k2 = 2 * ((g) < 8 ? (g) : 0); v4u bw; bw.x = cvtpk2(S[k2][0], S[k2][1]); bw.y = cvtpk2(S[k2][2], S[k2][3]); bw.z = cvtpk2(S[k2 + 1][0], S[k2 + 1][1]); bw.w = cvtpk2(S[k2 + 1][2], S[k2 + 1][3]); b_ = __builtin_bit_cast(bf16x8, bw); } else b_ = vb[(g) < 8 ? 0 : (g) - 8]; \
                _Pragma("unroll") for (int ti = 0; ti < 4; ++ti) o[ti] = MFMA16(CAT8(F[2 * ti], F[2 * ti + 1]), b_, o[ti]); } while (0)
            s16x4 fa[8], fb[8], fc[8];
            OLD_(0, fa); OLD_(1, fb); SBAR();
            OLD_(2, fc); SBAR(); OMM_(0, fa); SBAR();
            OLD_(3, fa); SBAR(); OMM_(1, fb); SBAR();
            OLD_(4, fb); SBAR(); OMM_(2, fc); SBAR();
            OLD_(5, fc); SBAR(); OMM_(3, fa); SBAR();
            OLD_(6, fa); SBAR(); OMM_(4, fb); SBAR();
            OLD_(7, fb); SBAR(); OMM_(5, fc); SBAR();
            OLD_(8, fc); SBAR(); OMM_(6, fa); SBAR();
            OLD_(9, fa); SBAR(); OMM_(7, fb); SBAR();
            OMM_(8, fc); SBAR(); OMM_(9, fa); SBAR();
#undef OLD_
#undef OMM_
            { bf16* ODr = OD + (size_t)row0 * 2048 + dvc + 16 * wave; int ob = (4 * gq) * 2048 + cl; asm volatile("" : "+v"(ob));
#pragma unroll
              for (int ti = 0; ti < 4; ++ti)
#pragma unroll
                for (int r = 0; r < 4; r += 2) { const unsigned w2 = cvtpk2(o[ti][r], o[ti][r + 1]); ODr[(unsigned)(ob + (16 * ti + r) * 2048)] = (bf16)(w2 & 0xffffu); ODr[(unsigned)(ob + (16 * ti + r + 1) * 2048)] = (bf16)(w2 >> 16); } }
            SBAR();
        }
        {
            const LAS char* db_ = L + ODEC + 16 * gq; const LAS char* kb_ = L + OK_ + (4 * gq + (cl >> 2)) * PK + 8 * (cl & 3);
#define SLD_(t, DC, KF) do { DC = *(const LAS f32x4*)(db_ + 64 * (t)); KF[0] = vtr(kb_ + 32 * (t)); KF[1] = vtr(kb_ + 32 * (t) + 16 * PK); KF[2] = vtr(kb_ + 32 * (t) + 32 * PK); KF[3] = vtr(kb_ + 32 * (t) + 48 * PK); } while (0)
#define SMM_(t, DC, KF) do { S[t] = S[t] * DC; S[t] = MFMA16(CAT8(KF[0], KF[1]), vb[0], S[t]); S[t] = MFMA16(CAT8(KF[2], KF[3]), vb[1], S[t]); } while (0)
            f32x4 da, dbv, dcv; s16x4 ka[4], kbv[4], kc[4];
            SBAR(); SLD_(0, da, ka); SLD_(1, dbv, kbv); SBAR();
            SLD_(2, dcv, kc); SBAR(); SMM_(0, da, ka); SBAR();
            SLD_(3, da, ka); SBAR(); SMM_(1, dbv, kbv); SBAR();
            SLD_(4, dbv, kbv); SBAR(); SMM_(2, dcv, kc); SBAR();
            SLD_(5, dcv, kc); SBAR(); SMM_(3, da, ka); SBAR();
            SLD_(6, da, ka); SBAR(); SMM_(4, dbv, kbv); SBAR();
            SLD_(7, dbv, kbv); SBAR(); SMM_(5, dcv, kc); SBAR();
            SLD_(8, dcv, kc); SBAR(); SMM_(6, da, ka); SBAR();
            SLD_(9, da, ka); SBAR(); SMM_(7, dbv, kbv); SBAR();
            SLD_(10, dbv, kbv); SBAR(); SMM_(8, dcv, kc); SBAR();
            SLD_(11, dcv, kc); SBAR(); SMM_(9, da, ka); SBAR();
            SLD_(12, da, ka); SBAR(); SMM_(10, dbv, kbv); SBAR();
            SLD_(13, dbv, kbv); SBAR(); SMM_(11, dcv, kc); SBAR();
            SLD_(14, dcv, kc); SBAR(); SMM_(12, da, ka); SBAR();
            SLD_(15, da, ka); SBAR(); SMM_(13, dbv, kbv); SBAR();
            SMM_(14, dcv, kc); SBAR(); SMM_(15, da, ka); SBAR();
#undef SLD_
#undef SMM_
        }
        __syncthreads();
        if (s + 1 < nch) { LWRITE(); }
        __syncthreads();
    }
    if constexpr (LIGHT) {
        float* Lg = GLs + ((size_t)(sidx * 3 + seg) * 256) * 512 + sl * 128 + 16 * wave; int lb = (4 * gq) * 512 + cl; asm volatile("" : "+v"(lb));
#pragma unroll
        for (int t = 0; t < 16; ++t)
#pragma unroll
            for (int r = 0; r < 4; ++r) Lg[(unsigned)(lb + (16 * t + r) * 512)] = S[t][r];
        if (sl == 0 && tid < 256) { float* Dg = GDS + (size_t)(sidx * 3 + seg) * 256; Dg[tid] = dprod; }
    } else if (!sample) { float* so = F.out + (d == 0 ? O_GF : O_GB) + ((size_t)(seq * 4 + h) * 256) * 512 + sl * 128 + 16 * wave; int lb = (4 * gq) * 512 + cl; asm volatile("" : "+v"(lb));
#pragma unroll
        for (int t = 0; t < 16; ++t)
#pragma unroll
            for (int r = 0; r < 4; ++r) so[(unsigned)(lb + (16 * t + r) * 512)] = S[t][r];
    }
#undef GLOAD1
#undef GLOAD2
#undef LWRITE
#undef LOADVB
}
__device__ __forceinline__ int gla_item_of(int bx, int G) { return G == 256 ? (((bx & 7) + 8 * (bx >> 5)) << 2) + ((bx >> 3) & 3) : bx; }
__device__ __forceinline__ void gla_scanA_phase(Frame& F) {
    for (int it = gla_item_of(F.bx, F.G); it < 192; it += F.G) { const int sl = it & 3, g = (it >> 2) % 3, r = (it >> 2) / 3;
        gla_scan_item<true>(F, 32 + (r >> 3), (r >> 1) & 3, r & 1, sl, g); }
}
__device__ __forceinline__ void gla_scan_phase(Frame& F) {
    for (int it = gla_item_of(F.bx, F.G); it < 1280; it += F.G) {
        int seq, h, d, sl, g;
        if (it < 256) { const int r = it >> 4; sl = it & 3; g = (it >> 2) & 3; seq = 32 + (r >> 3); h = (r >> 1) & 3; d = r & 1; }
        else { const int i2 = it - 256; seq = i2 >> 5; h = (i2 >> 3) & 3; d = (i2 >> 2) & 1; sl = i2 & 3; g = 0; }
        gla_scan_item<false>(F, seq, h, d, sl, g);
    }
}
__device__ __forceinline__ void gla_post_phase(Frame& F) {
    const int gw = F.bx * NWAVES + F.wave, NGW = F.G * NWAVES, lane = F.lane;
    const bf16* OFp = WSP(bf16, WS_GOF); const bf16* OBp = WSP(bf16, WS_GOB); const bf16* GR = WSP(bf16, WS_GR); const float* gn = F.in[I_GNORM];
    signed char* A8 = (signed char*)(F.ws + WS_AO8); float* arow = WSP(float, WS_AROW);
#define UNPK4(w) (f32x4){__builtin_bit_cast(float, (w).x << 16), __builtin_bit_cast(float, (w).x & 0xffff0000u), __builtin_bit_cast(float, (w).y << 16), __builtin_bit_cast(float, (w).y & 0xffff0000u)}
    for (int row = gw; row < MTOK; row += NGW) {
        f32x4 ya[4], yb[4]; float mx = 0.f;
#pragma unroll
        for (int hh = 0; hh < 4; ++hh) {
            const size_t o0 = (size_t)row * 2048 + hh * 512 + 4 * lane;
            const v2u f0 = *(const v2u*)(OFp + o0), f1 = *(const v2u*)(OFp + o0 + 256), b0 = *(const v2u*)(OBp + o0), b1 = *(const v2u*)(OBp + o0 + 256);
            const f32x4 v0 = UNPK4(f0) + UNPK4(b0), v1 = UNPK4(f1) + UNPK4(b1);
            float ss = (v0[0] * v0[0] + v0[1] * v0[1]) + (v0[2] * v0[2] + v0[3] * v0[3]) + (v1[0] * v1[0] + v1[1] * v1[1]) + (v1[2] * v1[2] + v1[3] * v1[3]);
            const float rstd = rsqrtf(wave_sum(ss) * (1.f / 512.f) + EPS);
            const v2u r0 = *(const v2u*)(GR + o0), r1 = *(const v2u*)(GR + o0 + 256);
            f32x4 ra = UNPK4(r0), rb = UNPK4(r1);
#pragma unroll
            for (int i = 0; i < 4; ++i) { ra[i] = ra[i] / (1.f + __expf(-ra[i])); rb[i] = rb[i] / (1.f + __expf(-rb[i])); }
            ya[hh] = v0 * rstd * *(const f32x4*)(gn + 4 * lane) * ra; yb[hh] = v1 * rstd * *(const f32x4*)(gn + 256 + 4 * lane) * rb;
#pragma unroll
            for (int i = 0; i < 4; ++i) mx = fmaxf(mx, fmaxf(fabsf(ya[hh][i]), fabsf(yb[hh][i])));
        }
#pragma unroll
        for (int o = 1; o < 64; o <<= 1) mx = fmaxf(mx, __shfl_xor(mx, o));
        mx = fmaxf(mx, 1e-30f); const float inv = 127.f / mx;
        if (lane == 0) arow[row] = mx * (1.f / 127.f);
#pragma unroll
        for (int hh = 0; hh < 4; ++hh) {
            const size_t o0 = (size_t)row * 2048 + hh * 512 + 4 * lane;
            const f32x4 qa = ya[hh] * inv, qb = yb[hh] * inv;
            const unsigned wa = ((unsigned)(int)rintf(qa[0]) & 0xffu) | (((unsigned)(int)rintf(qa[1]) & 0xffu) << 8) | (((unsigned)(int)rintf(qa[2]) & 0xffu) << 16) | (((unsigned)(int)rintf(qa[3]) & 0xffu) << 24);
            const unsigned wb = ((unsigned)(int)rintf(qb[0]) & 0xffu) | (((unsigned)(int)rintf(qb[1]) & 0xffu) << 8) | (((unsigned)(int)rintf(qb[2]) & 0xffu) << 16) | (((unsigned)(int)rintf(qb[3]) & 0xffu) << 24);
            *(unsigned*)(A8 + o0) = wa; *(unsigned*)(A8 + o0 + 256) = wb;
        }
    }
#undef UNPK4
}

#ifndef MK_N_LAUNCHES
#define MK_N_LAUNCHES 1
#ifndef I8_SP2
#define I8_SP2 true
#endif
#ifndef I8_ALIGN
#define I8_ALIGN true
#endif
#ifndef PG8_ALIGN
#define PG8_ALIGN true
#endif
#ifndef PG8_SP2
#define PG8_SP2 true
#endif
#endif
constexpr int N_PHASES = 35;
__global__ void __launch_bounds__(NWAVES * 64, 2) mk_fwd(Args args) {
    extern __shared__ __attribute__((aligned(16))) unsigned char lds[];
    Frame F;
    F.lds = (LAS unsigned char*)lds; F.ldsg = lds;
    F.tid = threadIdx.x; F.lane = F.tid & 63; F.wave = __builtin_amdgcn_readfirstlane(F.tid >> 6);
    F.G = gridDim.x; F.bx = blockIdx.x;
    F.in = args.in; F.out = args.out; F.ws = args.ws;
    volatile LAS unsigned* MISC = (volatile LAS unsigned*)(F.lds + MISC_OFF);
    if (F.tid < 32) MISC[F.tid] = 0u;
    __syncthreads();
    const int lo = args.ph_lo, hi = args.ph_hi;
    const bool use_bar = (hi - lo) > 1;
    XcdBarrier bar; bar.bar = (unsigned*)(F.ws + WS_CTL) + CW_BAR + args.li * XCD_BAR_WORDS; bar.x = 0; bar.st = nullptr;
    if (use_bar) bar = xcd_barrier_post((unsigned*)(F.ws + WS_CTL) + CW_BAR + args.li * XCD_BAR_WORDS, MISC + 8);
#ifdef PH_ONLY
#define IN(k) ((k) == PH_ONLY && lo <= (k) && (k) < hi)
#else
#define IN(k) (lo <= (k) && (k) < hi)
#endif
#define SEAM(k) do { if (IN(k) && IN((k) + 1)) xcd_barrier(bar); } while (0)
    LAS unsigned char* ring = F.lds;

#ifndef PROBE_MASK
#define PROBE_MASK 0ull
#endif
    constexpr unsigned long long REP_MASK = PROBE_MASK;
#define PHASE(k, ...) if (IN(k)) { if (((REP_MASK >> (k)) & 1ull) != 0ull) { const bool dry_ = true; (void)dry_; __VA_ARGS__ xcd_barrier(bar); } { const bool dry_ = false; (void)dry_; __VA_ARGS__ } } SEAM(k);
#define GATE(L, q) (dry_ ? (const float*)(F.ws + WS_CTL + 524288) : WSP(float, WS_MOD) + (size_t)((L) * 3) * 12288 + (q) * 2048)
#define NORMIN(site) NormIn{WSP(float, WS_PART) + (size_t)(site) * MTOK * 32, WSP(float, WS_SW) + (size_t)(site) * 3 * 8192, (const LAS float*)(F.lds + LDS_RSTD_OFF), pm0_}
    PHASE(0, p0_prologue(F);)
    PHASE(1, p1_phase(F);)

#define GEMM_PHASE(EpiT, epi, Aptr, Bptr, M_, N_, K_) do { int kk_ = (K_); asm volatile("" : "+s"(kk_)); pg8::Gemm g{(const pg8::bf16_t*)(Aptr), (const pg8::bf16_t*)(Bptr), (M_), (N_), kk_}; pg8::StaticOrder S; S.init((M_), (N_), F.G, F.bx); \
        pg8::gemm_phase<EpiT, pg8::StaticOrder, PG8_ALIGN, PG8_SP2>(ring, g, S, epi); } while (0)

#ifndef FFN2_WGM
#define FFN2_WGM 4
#endif
#define GEMM_PHASE_W(EpiT, epi, Aptr, Bptr, M_, N_, K_, WGM_) do { int kk_ = (K_); asm volatile("" : "+s"(kk_)); pg8::Gemm g{(const pg8::bf16_t*)(Aptr), (const pg8::bf16_t*)(Bptr), (M_), (N_), kk_, 1}; pg8::StaticOrder S; S.init((M_), (N_), F.G, F.bx, (WGM_)); \
        pg8::gemm_phase<EpiT, pg8::StaticOrder, PG8_ALIGN, PG8_SP2>(ring, g, S, epi); } while (0)
#define GEMM_PHASE_N(site, EpiT, EPI_INIT, Aptr, Bptr, M_, N_, K_) do { int kk_ = (K_); asm volatile("" : "+s"(kk_)); pg8::Gemm g{(const pg8::bf16_t*)(Aptr), (const pg8::bf16_t*)(Bptr), (M_), (N_), kk_}; pg8::StaticOrder S; S.init((M_), (N_), F.G, F.bx); \
        const int pm0_ = prep_rstd(F, S, (site)); EpiT E EPI_INIT; pg8::gemm_phase<EpiT, pg8::StaticOrder, PG8_ALIGN, PG8_SP2>(ring, g, S, E); } while (0)
#define ARGS(...) {__VA_ARGS__}
#ifndef RES_ALIGN
#define RES_ALIGN true
#endif
#define GEMM_PHASE_R(EpiT, epi, Aptr, Bptr, M_, N_, K_) do { int kk_ = (K_); asm volatile("" : "+s"(kk_)); pg8::Gemm g{(const pg8::bf16_t*)(Aptr), (const pg8::bf16_t*)(Bptr), (M_), (N_), kk_}; pg8::StaticOrder S; S.init((M_), (N_), F.G, F.bx); \
        pg8::gemm_phase<EpiT, pg8::StaticOrder, RES_ALIGN, PG8_SP2>(ring, g, S, epi); } while (0)
#define LAYER_TAIL(P, L) \
    PHASE((P), { EpiResidT<true> E{F.in[I_XP], F.in[I_XS], WSP(float, WS_X), GATE((L), 2), (L) == 0 ? 1 : 0, WSP(float, WS_AROW), WSP(float, WS_SCOLO) + (L) * 2048, dry_ ? (bf16*)nullptr : WSP(bf16, WS_H), F.in[I_NORMG] + (size_t)((L) * 2 + 1) * 2048, \
            WSP(float, WS_MOD) + (size_t)((L) * 3) * 12288 + 4 * 2048, WSP(float, WS_PART) + (size_t)(2 * (L) + 1) * MTOK * 32, WSP(float, WS_PMAX) + (size_t)(2 * (L) + 1) * MTOK * 32}; \
            int kk_ = 1024; asm volatile("" : "+s"(kk_)); pg8::Gemm g{(const pg8::bf16_t*)(F.ws + WS_AO8), (const pg8::bf16_t*)(F.ws + WS_WWOT + (size_t)(L) * 2048 * 2048), MTOK, DM, kk_}; pg8::StaticOrder S; S.init(MTOK, DM, F.G, F.bx); \
            pg8::gemm_phase<EpiResidT<true>, pg8::StaticOrder, PG8_ALIGN, PG8_SP2, true>(ring, g, S, E); }) \
    PHASE((P) + 1, q8_phase(F, (L), (L) == 0);) \
    PHASE((P) + 2, { EpiRelu2I8 E{WSP(bf16, WS_HID), FFH, WSP(float, WS_FROW) + (size_t)(L) * MTOK, WSP(float, WS_SCOL) + (L) * 8192, WSP(float, WS_SW) + (size_t)(2 * (L) + 1) * 3 * 8192}; \
            int kk_ = 1024; asm volatile("" : "+s"(kk_)); pg8::Gemm g{(const pg8::bf16_t*)(F.ws + WS_H8), (const pg8::bf16_t*)(F.ws + WS_W1T + (size_t)(L) * 8192 * 2048), MTOK, FFH, kk_}; pg8::StaticOrder S; S.init(MTOK, FFH, F.G, F.bx); \
            pg8::gemm_phase<EpiRelu2I8, pg8::StaticOrder, I8_ALIGN, I8_SP2, true>(ring, g, S, E); }) \
    PHASE((P) + 3, EpiResid E{F.in[I_XP], F.in[I_XS], WSP(float, WS_X), GATE((L), 5), 0, (const float*)nullptr, (const float*)nullptr, (dry_ || (L) == 3) ? (bf16*)nullptr : WSP(bf16, WS_H), F.in[I_NORMG] + (size_t)(((L) + 1) * 2) * 2048, \
            WSP(float, WS_MOD) + (size_t)(((L) + 1) * 3) * 12288 + 1 * 2048, WSP(float, WS_PART) + (size_t)(2 * ((L) + 1)) * MTOK * 32, (float*)nullptr}; GEMM_PHASE_W(EpiResid, E, WSP(bf16, WS_HID), WSP(bf16, WS_W2T) + (size_t)(L) * DM * FFH, MTOK, DM, FFH, FFN2_WGM);)

#define WIN_LAYER(P, L, J) \
    PHASE((P), GEMM_PHASE_N(2 * (L), EpiQkvWin, ARGS(WSP(bf16, WS_WQ), WSP(bf16, WS_WK), WSP(bf16, WS_WV), F.out + O_WK, F.out + O_WV, (J), WSP(f32x2, WS_TABW), NORMIN(2 * (L))), \
        WSP(bf16, WS_H), WSP(bf16, WS_WQKVT) + (size_t)(J) * 3072 * DM, MTOK, 3072, DM);) \
    PHASE((P) + 1, attn_win_phase(F, (J));) \
    PHASE((P) + 2, aoq_phase(F);) \
    LAYER_TAIL((P) + 3, (L))

    WIN_LAYER(2, 0, 0)
    PHASE(9, GEMM_PHASE_N(2, EpiF32, ARGS(WSP(float, WS_MD), 1024, NORMIN(2)), WSP(bf16, WS_H), WSP(bf16, WS_MWDT), MTOK, 1024, DM);)
    PHASE(10, mla_norm_phase(F);)
    PHASE(11, { EpiMlaQ E{WSP(bf16, WS_MQ), WSP(f32x2, WS_TABM)}; GEMM_PHASE(EpiMlaQ, E, WSP(bf16, WS_MCQ), WSP(bf16, WS_MWUQT), MTOK, 3072, 512); }
             { EpiMlaKV E{WSP(bf16, WS_MKN), WSP(bf16, WS_MV)}; GEMM_PHASE(EpiMlaKV, E, WSP(bf16, WS_MCKV), WSP(bf16, WS_MWUKVT), MTOK + 1024, 4096, 256); })
#ifdef PROBE_SLEEP
    if (IN(11)) { const unsigned long long t0_ = __builtin_amdgcn_s_memrealtime(); while (__builtin_amdgcn_s_memrealtime() - t0_ < (unsigned long long)PROBE_SLEEP * 100ull) __builtin_amdgcn_s_sleep(8); }
#endif
    PHASE(12, attn_mla_phase(F);)
    PHASE(13, aoq_phase(F);)
    LAYER_TAIL(14, 1)
    PHASE(18, GEMM_PHASE_N(4, EpiGlaIn, ARGS(WSP(bf16, WS_GQ), WSP(bf16, WS_GK), WSP(bf16, WS_GV), WSP(bf16, WS_GR), WSP(float, WS_GU), NORMIN(4)), WSP(bf16, WS_H), WSP(bf16, WS_GWINT), MTOK, 6144, DM); gla_u_phase(F);)
    PHASE(19, gla_prep_phase(F);)
    PHASE(20, gla_scanA_phase(F);)
    PHASE(21, gla_scan_phase(F);)
    PHASE(22, gla_post_phase(F);)
    LAYER_TAIL(23, 2)
    WIN_LAYER(27, 3, 1)
    PHASE(34, final_phase(F);)
#undef IN
#undef SEAM
}

extern "C" void kernel_launch(void* const* d_in, const int* in_sizes, int n_in, void* d_out, int out_size, void* d_ws, size_t ws_size, hipStream_t stream) {
    static int grid = 0;
    if (grid == 0) {
        if (n_in != 31 || (size_t)out_size != O_END || ws_size < WS_END) { fprintf(stderr, "kernel_launch: shape mismatch n_in %d out %d ws %zu (need %zu)\n", n_in, out_size, ws_size, (size_t)WS_END); grid = -1; return; }
        int dev = 0, cus = 0, per_cu = 0;
        if (hipGetDevice(&dev) != hipSuccess || hipDeviceGetAttribute(&cus, hipDeviceAttributeMultiprocessorCount, dev) != hipSuccess) { grid = -1; return; }
        if (hipFuncSetAttribute((const void*)mk_fwd, hipFuncAttributeMaxDynamicSharedMemorySize, LDS_BYTES) != hipSuccess) { fprintf(stderr, "kernel_launch: hipFuncSetAttribute failed\n"); grid = -1; return; }
        if (hipOccupancyMaxActiveBlocksPerMultiprocessor(&per_cu, (const void*)mk_fwd, NWAVES * 64, LDS_BYTES) != hipSuccess || per_cu < 1) fprintf(stderr, "kernel_launch: occupancy query says %d\n", per_cu);
        (void)hipGetLastError();
        grid = cus;
    }
    if (grid < 0) return;
    if (hipMemsetAsync((char*)d_ws + WS_CTL, 0, CTL_ZERO_BYTES, stream) != hipSuccess) return;
    Args a{};
    for (int i = 0; i < 31; ++i) a.in[i] = (const float*)d_in[i];
    a.in[31] = nullptr;
    a.out = (float*)d_out; a.ws = (unsigned char*)d_ws; a.pad = 0; a.rep_mask = 0ull; a.rep_n = 1; a.pad2 = 0;
#if MK_N_LAUNCHES == 1
    a.ph_lo = 0; a.ph_hi = N_PHASES; a.li = 0;
    hipLaunchKernelGGL(mk_fwd, dim3(grid), dim3(NWAVES * 64), LDS_BYTES, stream, a);
#else
    for (int p = 0; p < N_PHASES; ++p) { a.ph_lo = p; a.ph_hi = p + 1; a.li = 0; hipLaunchKernelGGL(mk_fwd, dim3(grid), dim3(NWAVES * 64), LDS_BYTES, stream, a); }
#endif
}
```

```cpp
#include <hip/hip_runtime.h>
#include <cstdio>
#include <cstdint>
namespace pg8 {
#define PG8_LAS __attribute__((address_space(3)))
typedef unsigned short bf16_t;
typedef short bf16x8 __attribute__((ext_vector_type(8)));
typedef float f32x4 __attribute__((ext_vector_type(4)));
typedef unsigned u32x4 __attribute__((ext_vector_type(4)));
constexpr int BM = 256, BK = 64, HALF = 128, HTB = HALF * BK * 2  , STAGE_BYTES = 8 * HTB, NXCD = 8, WGM = 8;

__host__ __device__ __forceinline__ int lds_byte(int r, int c) { const int st = (r >> 4) * 2 + (c >> 5), rr = r & 15, cc = c & 31, ob = rr * 64 + cc * 2; return st * 1024 + (ob ^ (((ob >> 9) & 1) << 5)); }
__host__ __device__ __forceinline__ void stage_rc(int b, int& R, int& C) { const int st = b / 1024, sb = b % 1024, swz = sb ^ (((sb >> 9) & 1) << 5); R = (st >> 1) * 16 + swz / 64; C = (st & 1) * 32 + (swz % 64) / 2; }
__host__ __device__ __forceinline__ int perm32(int rho) { const int n = rho >> 4, i = rho & 15; return 8 * (i >> 2) + 4 * n + (i & 3); }

struct Unit { int pm, pn; };
struct Gemm { const bf16_t* A; const bf16_t* Bt; int M, N, K; int atile; };

struct StaticOrder {
    int nM, nN, nwg, G, c, wgm;
    __host__ __device__ void init(int M, int N, int G_, int c_, int wgm_ = WGM) { nM = M / BM; nN = N / BM; nwg = nM * nN; G = G_; c = c_; wgm = wgm_; }
    __host__ __device__ bool next(int i, Unit& u) const {
        const long L = (long)i * G + c; if (L >= nwg) return false;
        int wgid = (int)L; { const int q = nwg / NXCD, r = nwg % NXCD, xcd = wgid % NXCD, off = wgid / NXCD; wgid = (xcd < r ? xcd * (q + 1) : r * (q + 1) + (xcd - r) * q) + off; }
        const int nig = wgm * nN, gid = wgid / nig, fm = gid * wgm, gsz = (nM - fm) < wgm ? (nM - fm) : wgm;
        u.pm = fm + ((wgid % nig) % gsz); u.pn = (wgid % nig) / gsz; return true;
    }
    __device__ __forceinline__ void a_ready(const Unit&) const {}
    __device__ __forceinline__ void done(const Unit&) const {}
};
struct SwapOrder : StaticOrder { __host__ __device__ bool next(int i, Unit& u) const { const bool ok = StaticOrder::next(i, u); u.pm ^= 4; return ok; } };
__device__ __forceinline__ unsigned cvt_pk_bf16(float lo, float hi) { unsigned r; asm volatile("v_cvt_pk_bf16_f32 %0, %1, %2" : "=v"(r) : "v"(lo), "v"(hi)); return r; }
typedef float f32x2 __attribute__((ext_vector_type(2)));
typedef int i32x4 __attribute__((ext_vector_type(4)));
template <bool I8> __device__ __forceinline__ f32x4 mma16(bf16x8 b, bf16x8 a, f32x4 c) {
    if constexpr (I8) return __builtin_bit_cast(f32x4, __builtin_amdgcn_mfma_i32_16x16x64_i8(__builtin_bit_cast(i32x4, b), __builtin_bit_cast(i32x4, a), __builtin_bit_cast(i32x4, c), 0, 0, 0));
    else return __builtin_amdgcn_mfma_f32_16x16x32_bf16(b, a, c, 0, 0, 0);
}
template <class Epi, class Sched, bool ALIGN_EPI = false, bool SP2 = false, bool I8 = false>
__device__ __forceinline__ void gemm_phase(PG8_LAS unsigned char* lds, const Gemm g, const Sched& S, const Epi& E) {
    const int tid = threadIdx.x, wid = __builtin_amdgcn_readfirstlane(tid >> 6), lane = tid & 63, wr = wid >> 2, wc = wid & 3, fr = lane & 15, fq = lane >> 4;
    const int K = g.K, nt = K / BK;
    unsigned voffA[2], voffB[2];
#pragma unroll
    for (int i = 0; i < 2; ++i) { int R, C; stage_rc(tid * 16 + i * 8192, R, C); const int Rb = Epi::PERM ? ((R & ~31) + perm32(R & 31)) : R;
        voffA[i] = (unsigned)(R * (g.atile ? BK : K) + C) * 2u; voffB[i] = (unsigned)(Rb * K + C) * 2u; }
    const size_t kstep = (size_t)(BK * 2);
    const size_t hstep = (size_t)HALF * K * 2;
    const size_t tstep = 2 * hstep;
    const size_t kstepA = g.atile ? (size_t)(BM * BK * 2) : kstep, hstepA = g.atile ? (size_t)(HALF * BK * 2) : hstep;
    const unsigned ldsw = (unsigned)wid * 1024u;
    const int aoff = lds_byte(wr * 64 + fr, fq * 8), boff = lds_byte(wc * 32 + fr, fq * 8);
#define PG8_SA(b, h) (((b) * 2 + (h)) * HTB)
#define PG8_SB(b, h) ((4 + (b) * 2 + (h)) * HTB)
#define PG8_STAGE(bufoff, gbase, voff) do { _Pragma("unroll") for (int _i = 0; _i < 2; ++_i) \
        __builtin_amdgcn_global_load_lds((const unsigned*)((const char*)(gbase) + (voff)[_i]), (PG8_LAS unsigned*)(lds + (bufoff) + ldsw + _i * 8192), 16, 0, 0); } while (0)
#define PG8_LDA(dst, b, h) do { _Pragma("unroll") for (int m = 0; m < 4; ++m) _Pragma("unroll") for (int k = 0; k < 2; ++k) dst[m][k] = *(const PG8_LAS bf16x8*)(lds + PG8_SA(b, h) + aoff + m * 2048 + k * 1024); } while (0)
#define PG8_LDB(dst, b, h) do { _Pragma("unroll") for (int n = 0; n < 2; ++n) _Pragma("unroll") for (int k = 0; k < 2; ++k) dst[n][k] = *(const PG8_LAS bf16x8*)(lds + PG8_SB(b, h) + boff + n * 2048 + k * 1024); } while (0)
#define PG8_MMA(ai, bj, At, Bt) do { __builtin_amdgcn_s_setprio(1); _Pragma("unroll") for (int m = 0; m < 4; ++m) _Pragma("unroll") for (int n = 0; n < 2; ++n) _Pragma("unroll") for (int k = 0; k < 2; ++k) \
        acc[ai][bj][m][n] = mma16<I8>(Bt[n][k], At[m][k], acc[ai][bj][m][n]); __builtin_amdgcn_s_setprio(0); } while (0)
#define PG8_WAIT_V(n) asm volatile("s_waitcnt vmcnt(" #n ")" ::: "memory")
#define PG8_WAIT_L(n) asm volatile("s_waitcnt lgkmcnt(" #n ")" ::: "memory")
#define PG8_BAR __builtin_amdgcn_s_barrier()
#define PG8_SCHED __builtin_amdgcn_sched_barrier(0)
    Unit cur, nxt; int ui = 0;
    if (!S.next(0, cur)) return;
    f32x4 acc[2][2][4][2];
#pragma unroll
    for (int a = 0; a < 2; ++a)
#pragma unroll
        for (int b = 0; b < 2; ++b)
#pragma unroll
            for (int m = 0; m < 4; ++m)
#pragma unroll
                for (int n = 0; n < 2; ++n) acc[a][b][m][n] = (f32x4){0.f, 0.f, 0.f, 0.f};
    bf16x8 At[4][2], B0[2][2], B1[2][2];
    const char* cA = (const char*)g.A + (size_t)cur.pm * tstep; const char* cB = (const char*)g.Bt + (size_t)cur.pn * tstep;
    S.a_ready(cur);
    if constexpr (SP2) {
        PG8_STAGE(PG8_SB(0, 0), cB, voffB); PG8_STAGE(PG8_SB(0, 1), cB + hstep, voffB); PG8_STAGE(PG8_SA(0, 0), cA, voffA); PG8_STAGE(PG8_SA(0, 1), cA + hstepA, voffA);
        if (wr == 1) PG8_BAR;
        PG8_WAIT_V(2); PG8_BAR;
        PG8_STAGE(PG8_SB(1, 0), cB + kstep, voffB); PG8_STAGE(PG8_SA(1, 0), cA + kstepA, voffA); PG8_STAGE(PG8_SB(1, 1), cB + hstep + kstep, voffB);
        PG8_WAIT_V(6); PG8_BAR;
    } else {
        PG8_STAGE(PG8_SB(0, 0), cB, voffB); PG8_STAGE(PG8_SA(0, 0), cA, voffA); PG8_STAGE(PG8_SB(0, 1), cB + hstep, voffB); PG8_STAGE(PG8_SA(0, 1), cA + hstepA, voffA);
        if (wr == 1) PG8_BAR;
        PG8_WAIT_V(4); PG8_BAR;
        PG8_STAGE(PG8_SB(1, 0), cB + kstep, voffB); PG8_STAGE(PG8_SA(1, 0), cA + kstepA, voffA); PG8_STAGE(PG8_SB(1, 1), cB + hstep + kstep, voffB);
        PG8_WAIT_V(6); PG8_BAR;
    }
    for (;;) {
        const bool has_next = S.next(ui + 1, nxt);
        const char* nA = has_next ? (const char*)g.A + (size_t)nxt.pm * tstep : cA; const char* nB = has_next ? (const char*)g.Bt + (size_t)nxt.pn * tstep : cB;
        asm volatile(".p2align 8");
        for (int t = 0; t < nt; t += 2) {
            const bool last = (t == nt - 2);
            const char* a1 = cA + (size_t)(t + 1) * kstepA;
            const char* a2 = last ? nA : cA + (size_t)(t + 2) * kstepA; const char* b2 = last ? nB : cB + (size_t)(t + 2) * kstep;
            const char* a3 = a2 + kstepA; const char* b3 = b2 + kstep;
            if (last && has_next) S.a_ready(nxt);
            if constexpr (SP2) {
            PG8_LDB(B0, 0, 0); PG8_LDB(B1, 0, 1); PG8_SCHED; PG8_LDA(At, 0, 0); PG8_STAGE(PG8_SA(1, 1), a1 + hstepA, voffA);
            PG8_WAIT_V(8); PG8_WAIT_L(0); PG8_BAR; PG8_MMA(0, 0, At, B0); PG8_MMA(0, 1, At, B1); PG8_BAR; PG8_SCHED;
            PG8_LDA(At, 0, 1); PG8_STAGE(PG8_SB(0, 0), b2, voffB); PG8_STAGE(PG8_SB(0, 1), b2 + hstep, voffB); PG8_STAGE(PG8_SA(0, 0), a2, voffA);
            PG8_WAIT_V(8); PG8_WAIT_L(0); PG8_BAR; PG8_MMA(1, 0, At, B0); PG8_MMA(1, 1, At, B1); PG8_BAR; PG8_SCHED;
            PG8_LDB(B0, 1, 0); PG8_LDB(B1, 1, 1); PG8_SCHED; PG8_LDA(At, 1, 0); PG8_STAGE(PG8_SA(0, 1), a2 + hstepA, voffA);
            PG8_WAIT_V(8); PG8_WAIT_L(0); PG8_BAR; PG8_MMA(0, 0, At, B0); PG8_MMA(0, 1, At, B1); PG8_BAR; PG8_SCHED;
            PG8_LDA(At, 1, 1); PG8_STAGE(PG8_SB(1, 0), b3, voffB); PG8_STAGE(PG8_SB(1, 1), b3 + hstep, voffB); PG8_STAGE(PG8_SA(1, 0), a3, voffA);
            PG8_WAIT_V(8); PG8_WAIT_L(0); PG8_BAR; PG8_MMA(1, 0, At, B0); PG8_MMA(1, 1, At, B1); PG8_BAR; PG8_SCHED;
            } else {
            PG8_LDB(B0, 0, 0); PG8_SCHED; PG8_LDA(At, 0, 0); PG8_STAGE(PG8_SA(1, 1), a1 + hstepA, voffA);
            PG8_WAIT_L(8); PG8_BAR; PG8_WAIT_L(0); PG8_MMA(0, 0, At, B0); PG8_BAR; PG8_SCHED;
            PG8_LDB(B1, 0, 1); PG8_STAGE(PG8_SB(0, 0), b2, voffB);
            PG8_BAR; PG8_WAIT_L(0); PG8_MMA(0, 1, At, B1); PG8_BAR;
            PG8_LDA(At, 0, 1); PG8_STAGE(PG8_SA(0, 0), a2, voffA);
            PG8_BAR; PG8_WAIT_L(0); PG8_MMA(1, 0, At, B0); PG8_BAR; PG8_SCHED;
            PG8_STAGE(PG8_SB(0, 1), b2 + hstep, voffB);
            PG8_WAIT_V(6); PG8_BAR; PG8_MMA(1, 1, At, B1); PG8_BAR;
            PG8_LDB(B0, 1, 0); PG8_SCHED; PG8_LDA(At, 1, 0); PG8_STAGE(PG8_SA(0, 1), a2 + hstepA, voffA);
            PG8_WAIT_L(8); PG8_BAR; PG8_WAIT_L(0); PG8_MMA(0, 0, At, B0); PG8_BAR; PG8_SCHED;
            PG8_LDB(B1, 1, 1); PG8_STAGE(PG8_SB(1, 0), b3, voffB);
            PG8_BAR; PG8_WAIT_L(0); PG8_MMA(0, 1, At, B1); PG8_BAR;
            PG8_LDA(At, 1, 1); PG8_STAGE(PG8_SA(1, 0), a3, voffA);
            PG8_BAR; PG8_WAIT_L(0); PG8_MMA(1, 0, At, B0); PG8_BAR; PG8_SCHED;
            PG8_STAGE(PG8_SB(1, 1), b3 + hstep, voffB);
            PG8_WAIT_V(6); PG8_BAR; PG8_MMA(1, 1, At, B1); PG8_BAR;
            }
        }
        if constexpr (ALIGN_EPI) { if (wr == 0) PG8_BAR; }
        if constexpr (!Epi::AFTER_DRAIN) { E(acc, cur, wr, wc, fr, fq); S.done(cur); }
        if (!has_next) break;
#pragma unroll
        for (int a = 0; a < 2; ++a)
#pragma unroll
            for (int b = 0; b < 2; ++b)
#pragma unroll
                for (int m = 0; m < 4; ++m)
#pragma unroll
                    for (int n = 0; n < 2; ++n) acc[a][b][m][n] = (f32x4){0.f, 0.f, 0.f, 0.f};
        cur = nxt; cA = nA; cB = nB; ++ui;
        if constexpr (ALIGN_EPI) { if (wr == 1) PG8_BAR; }
    }
    PG8_WAIT_V(0);
    if constexpr (!ALIGN_EPI) { if (wr == 0) PG8_BAR; }
    PG8_BAR;
    if constexpr (Epi::AFTER_DRAIN) { E.fused(acc, cur, wr, wc, fr, fq, lds, wid, lane); S.done(cur); }
#undef PG8_SA
#undef PG8_SB
#undef PG8_STAGE
#undef PG8_LDA
#undef PG8_LDB
#undef PG8_MMA
#undef PG8_WAIT_V
#undef PG8_WAIT_L
#undef PG8_BAR
#undef PG8_SCHED
}
}

#define GAS __attribute__((address_space(1)))
#define LAS __attribute__((address_space(3)))
typedef unsigned short bf16;
typedef unsigned v4u __attribute__((ext_vector_type(4)));
typedef unsigned v2u __attribute__((ext_vector_type(2)));
typedef float f32x4 __attribute__((ext_vector_type(4)));
typedef float f32x2 __attribute__((ext_vector_type(2)));
typedef float f32x16 __attribute__((ext_vector_type(16)));
typedef short bf16x8 __attribute__((ext_vector_type(8)));
typedef short s16x4 __attribute__((ext_vector_type(4)));
typedef GAS unsigned gu32;
#define RLX_AGENT __ATOMIC_RELAXED, __HIP_MEMORY_SCOPE_AGENT
#define LDS_WAIT() asm volatile("s_waitcnt lgkmcnt(0)" ::: "memory")
#define VM_WAIT() asm volatile("s_waitcnt vmcnt(0)" ::: "memory")
#define SBAR() __builtin_amdgcn_sched_barrier(0)
__device__ __forceinline__ unsigned f2bf(float f) { unsigned u = __builtin_bit_cast(unsigned, f); return (u + 0x7fffu + ((u >> 16) & 1u)) >> 16; }
__device__ __forceinline__ unsigned pk2(float lo, float hi) { return f2bf(lo) | (f2bf(hi) << 16); }
__device__ __forceinline__ float bf2f(unsigned short b) { return __builtin_bit_cast(float, (unsigned)b << 16); }
__device__ __forceinline__ unsigned cvtpk(float lo, float hi) { unsigned r; asm volatile("v_cvt_pk_bf16_f32 %0, %1, %2" : "=v"(r) : "v"(lo), "v"(hi)); return r; }
__device__ __forceinline__ float wave_sum(float v) {
#pragma unroll
    for (int o = 1; o < 64; o <<= 1) v += __shfl_xor(v, o);
    return v;
}
#define XB_TMO      128
#define XB_XCNT(j)  (256  + 64 * (j))
#define XB_XSUB(j)  (1280 + 64 * (j))
#define XB_XGEN(j)  (2304 + 64 * (j))
#define XB_TOP      3328
#define XB_TOPGEN   3392
#define XCD_BAR_WORDS 3456
#define XB_SPIN_CAP (1u << 18)

__device__ __forceinline__ unsigned xb_ld(unsigned* p)              { return __hip_atomic_load(p, __ATOMIC_RELAXED, __HIP_MEMORY_SCOPE_AGENT); }
__device__ __forceinline__ unsigned xb_add(unsigned* p, unsigned v) { return __hip_atomic_fetch_add(p, v, __ATOMIC_RELAXED, __HIP_MEMORY_SCOPE_AGENT); }
__device__ __forceinline__ unsigned xb_xcc_id() { return (unsigned)__builtin_amdgcn_s_getreg((3 << 11) | 20) & 0xFu; }
#define XB_SPIN(cond, bar) do { unsigned _sp = 0; while (cond) { __builtin_amdgcn_s_sleep(1); \
    if ((++_sp & 255u) == 0u) { if (xb_ld(&(bar)[XB_TMO])) break; if (_sp > XB_SPIN_CAP) { atomicAdd(&(bar)[XB_TMO], 1u); break; } } } } while (0)

struct XcdBarrier {
    unsigned* bar; unsigned x;
    volatile LAS unsigned* st;
};

__device__ __forceinline__ XcdBarrier xcd_barrier_post(unsigned* bar, volatile LAS unsigned* st) {
    XcdBarrier b; b.bar = bar; b.x = xb_xcc_id(); b.st = st;
    if (threadIdx.x == 0) (void)xb_add(&bar[XB_XCNT(b.x)], 1u);
    return b;
}
__device__ __forceinline__ void xcd_barrier_complete(unsigned* bar, unsigned x, unsigned& nloc, unsigned& nx) {
    const unsigned G = gridDim.x * gridDim.y * gridDim.z;
    unsigned sum, cnt, mine, sp = 0u;
    for (;;) {
        sum = 0u; cnt = 0u; mine = 0u;
#pragma unroll
        for (unsigned j = 0; j < 16; ++j) { const unsigned c = xb_ld(&bar[XB_XCNT(j)]); sum += c; cnt += (c > 0u) ? 1u : 0u; mine = (j == x) ? c : mine; }
        if (sum == G) break;
        __builtin_amdgcn_s_sleep(1);
        if ((++sp & 255u) == 0u) { if (xb_ld(&bar[XB_TMO])) break; if (sp > XB_SPIN_CAP) { atomicAdd(&bar[XB_TMO], 1u); break; } }
    }
    nloc = mine > 0u ? mine : 1u; nx = cnt > 0u ? cnt : 1u;
}

__device__ __forceinline__ void xcd_barrier(const XcdBarrier& b) {
    asm volatile("s_waitcnt vmcnt(0)" ::: "memory");
    __syncthreads();
    if (threadIdx.x == 0) {
        unsigned* bar = b.bar;
        __builtin_amdgcn_s_waitcnt(0);
        unsigned nloc = b.st[0], nx = b.st[1];
        if (nloc == 0u) { xcd_barrier_complete(bar, b.x, nloc, nx); b.st[0] = nloc; b.st[1] = nx; }
        const unsigned old = xb_add(&bar[XB_XSUB(b.x)], 1u);
        const unsigned gen = old / nloc;
        if (old + 1u == (gen + 1u) * nloc) {
            __builtin_amdgcn_fence(__ATOMIC_RELEASE, "agent");
            asm volatile("s_waitcnt vmcnt(0)" ::: "memory");
            const unsigned og = xb_add(&bar[XB_TOP], 1u);
            const unsigned tg = og / nx;
            if (og + 1u == (tg + 1u) * nx) xb_add(&bar[XB_TOPGEN], 1u);
            else XB_SPIN(xb_ld(&bar[XB_TOPGEN]) == tg, bar);
            __builtin_amdgcn_fence(__ATOMIC_ACQUIRE, "agent");
            xb_add(&bar[XB_XGEN(b.x)], 1u);
            asm volatile("s_waitcnt vmcnt(0)" ::: "memory");
        } else {
            XB_SPIN(xb_ld(&bar[XB_XGEN(b.x)]) == gen, bar);
            __builtin_amdgcn_fence(__ATOMIC_ACQUIRE, "agent");
            asm volatile("s_waitcnt vmcnt(0)" ::: "memory");
        }
    }
    __syncthreads();
}

constexpr int NWAVES = 8;
constexpr int DM = 2048, MTOK = 16384, MP = 8192, FFH = 8192;
constexpr float EPS = 1e-6f;
constexpr size_t MiB = 1u << 20;
constexpr size_t WS_CTL = 0, CTL_ZERO_BYTES = 1 * MiB;
constexpr size_t WS_MOD = 2 * MiB;
constexpr size_t WS_TABW = 2 * MiB + 655360;
constexpr size_t WS_TABM = 2 * MiB + 720896;
constexpr size_t WS_SW = 3 * MiB;
constexpr size_t WS_W1T = 4 * MiB;
constexpr size_t WS_SCOL = 3 * MiB + 786432;
constexpr size_t WS_W2T = 132 * MiB;
constexpr size_t WS_WQKVT = 260 * MiB;
constexpr size_t WS_WWOT = 284 * MiB;
constexpr size_t WS_SCOLO = 3 * MiB + 786432 + 131072;
constexpr size_t WS_MWDT = 300 * MiB;
constexpr size_t WS_MWUQT = 304 * MiB;
constexpr size_t WS_MWUKVT = 307 * MiB;
constexpr size_t WS_MWOT = 309 * MiB;
constexpr size_t WS_GWINT = 317 * MiB;
constexpr size_t WS_GWOT = 342 * MiB;
constexpr size_t WS_CTXK = 350 * MiB;
constexpr size_t WS_CTXV = 352 * MiB;
constexpr size_t WS_X = 354 * MiB;
constexpr size_t WS_H = 482 * MiB;
constexpr size_t WS_AO = 546 * MiB;
constexpr size_t WS_SCR = 610 * MiB;
constexpr size_t WS_HID = WS_SCR;
constexpr size_t WS_WQ = WS_SCR, WS_WK = WS_SCR + 64 * MiB, WS_WV = WS_SCR + 80 * MiB;
constexpr size_t WS_MD = WS_SCR, WS_MCQ = WS_SCR + 64 * MiB, WS_MCKV = WS_SCR + 80 * MiB, WS_MKR = WS_SCR + 89 * MiB, WS_MQ = WS_SCR + 92 * MiB, WS_MKN = WS_SCR + 188 * MiB, WS_MV = WS_SCR + 256 * MiB;
constexpr size_t WS_GQ = WS_SCR, WS_GK = WS_SCR + 32 * MiB, WS_GV = WS_SCR + 64 * MiB, WS_GR = WS_SCR + 128 * MiB, WS_GU = WS_SCR + 192 * MiB,
                 WS_GQT = WS_SCR + 194 * MiB, WS_GKD = WS_SCR + 258 * MiB, WS_GAM = WS_SCR + 322 * MiB, WS_GDEC = WS_SCR + 338 * MiB, WS_GOF = WS_SCR + 340 * MiB, WS_GOB = WS_SCR + 468 * MiB;
constexpr size_t WS_PART = WS_SCR + 596 * MiB;
constexpr size_t WS_PMAX = WS_PART + 16 * MiB;
constexpr size_t WS_FROW = WS_PMAX + 16 * MiB;
constexpr size_t WS_H8 = WS_FROW + 1 * MiB;
constexpr size_t WS_GLS = WS_H8 + 32 * MiB;
constexpr size_t WS_GDS = WS_GLS + 24 * MiB;
constexpr size_t WS_AO8 = WS_GDS + 1 * MiB;
constexpr size_t WS_AROW = WS_AO8 + 32 * MiB;
constexpr size_t WS_END = WS_AROW + 1 * MiB;
constexpr size_t O_YP = 0, O_YS = 16777216, O_WK = 33554432, O_WV = 41943040, O_CKV = 50331648, O_KR = 52428800, O_GF = 52953088, O_GB = 69730304, O_END = 86507520;
constexpr int CW_BAR = 4096;
constexpr int RING_BYTES = 131072, MISC_OFF = 159744 + 320, LDS_BYTES = 163840;

struct Args {
    const float* in[32]; float* out; unsigned char* ws; int ph_lo, ph_hi, li, pad; unsigned long long rep_mask; int rep_n, pad2;
};
enum { I_XP = 0, I_XS, I_C, I_CWK, I_CWV, I_CCKV, I_CKR, I_SGF, I_SGB, I_CCTX, I_ADAW, I_ADAB, I_NORMG, I_WQKV, I_SINK, I_WWO, I_MWD, I_MQN, I_MWUQ, I_MKVN, I_MWUKV, I_MWO,
       I_GWIN, I_GWA1, I_GWA2, I_GBA, I_GNORM, I_GWO, I_W1, I_W2, I_FNORM };

__device__ __forceinline__ int cond_of_pm(int pm) { return pm < 32 ? 0 : (pm >> 4) - 1; }

__device__ __forceinline__ v4u pack8(const f32x4& a, const f32x4& b) { v4u w; w.x = cvtpk(a[0], a[1]); w.y = cvtpk(a[2], a[3]); w.z = cvtpk(b[0], b[1]); w.w = cvtpk(b[2], b[3]); return w; }

struct NormIn {
    const float* part; const float* sW; const LAS float* lrs; int pm0;
    __device__ __forceinline__ float rstd(int row, int pm) const {
        if (pm == pm0) return lrs[row & 255];
        const f32x4* pp = (const f32x4*)(part + (size_t)row * 32); f32x4 t = pp[0];
#pragma unroll
        for (int i = 1; i < 8; ++i) t += pp[i];
        return rsqrtf(((t[0] + t[1]) + (t[2] + t[3])) * (1.f / 2048.f) + EPS);
    }
    __device__ __forceinline__ const float* swp(int pm) const { return sW + (size_t)cond_of_pm(pm) * 8192; }
};

template <bool I8> struct EpiResidT {
    static constexpr bool PERM = true, AFTER_DRAIN = false;
    const float* xp; const float* xs; float* X; const float* gate; int first;
    const float* arow; const float* scol;
    bf16* H; const float* ng; const float* nsc; float* rss; float* rmx;
    __device__ __forceinline__ void operator()(const pg8::f32x4 (&acc)[2][2][4][2], const pg8::Unit& u, int wr, int wc, int fr, int fq) const {
        const int row0 = u.pm * 256 + wr * 64 + fr, col0 = u.pn * 256 + wc * 32 + 8 * fq, cond = cond_of_pm(u.pm);
        const float* gp = gate + (size_t)cond * 12288 + col0;
        f32x4 gv[2][2], av[2][2];
#pragma unroll
        for (int bj = 0; bj < 2; ++bj)
#pragma unroll
            for (int n = 0; n < 2; ++n) { gv[bj][n] = *(const f32x4*)(gp + bj * 128 + 4 * n); if constexpr (I8) gv[bj][n] = gv[bj][n] * *(const f32x4*)(scol + col0 + bj * 128 + 4 * n);
                av[bj][n] = H ? *(const f32x4*)(ng + col0 + bj * 128 + 4 * n) * (*(const f32x4*)(nsc + (size_t)cond * 12288 + col0 + bj * 128 + 4 * n) + 1.f) : (f32x4){0.f, 0.f, 0.f, 0.f}; }
        f32x4 xv[2][2][2];
#define ER_LOAD(r, buf) do { const int row_ = row0 + ((r) >> 2) * 128 + ((r) & 3) * 16; const float* sp_ = first ? (row_ < MP ? xp + (size_t)row_ * DM : xs + (size_t)(row_ - MP) * DM) : X + (size_t)row_ * DM; \
        _Pragma("unroll") for (int bj = 0; bj < 2; ++bj) { xv[buf][bj][0] = *(const f32x4*)(sp_ + col0 + bj * 128); xv[buf][bj][1] = *(const f32x4*)(sp_ + col0 + bj * 128 + 4); } } while (0)
        ER_LOAD(0, 0);
#pragma unroll
        for (int r = 0; r < 8; ++r) {
            if (r + 1 < 8) ER_LOAD(r + 1, (r + 1) & 1);
            SBAR();
            const int ai = r >> 2, m = r & 3, row = row0 + ai * 128 + m * 16;
            float* dp = X + (size_t)row * DM;
            float ar_ = 1.f; if constexpr (I8) ar_ = arow[row];
            float ss = 0.f, mx = 0.f;
#pragma unroll
            for (int bj = 0; bj < 2; ++bj) {
                const int c = col0 + bj * 128;
                f32x4 a0 = acc[ai][bj][m][0], a1 = acc[ai][bj][m][1];
                if constexpr (I8) { const pg8::i32x4 i0 = __builtin_bit_cast(pg8::i32x4, a0), i1 = __builtin_bit_cast(pg8::i32x4, a1);
                    a0 = (f32x4){(float)i0[0], (float)i0[1], (float)i0[2], (float)i0[3]} * ar_; a1 = (f32x4){(float)i1[0], (float)i1[1], (float)i1[2], (float)i1[3]} * ar_; }
                const f32x4 x0 = xv[r & 1][bj][0] + gv[bj][0] * a0, x1 = xv[r & 1][bj][1] + gv[bj][1] * a1;
                *(f32x4*)(dp + c) = x0; *(f32x4*)(dp + c + 4) = x1;
                if (H) { ss += (x0[0] * x0[0] + x0[1] * x0[1]) + (x0[2] * x0[2] + x0[3] * x0[3]) + (x1[0] * x1[0] + x1[1] * x1[1]) + (x1[2] * x1[2] + x1[3] * x1[3]);
                    const v4u hw = pack8(x0 * av[bj][0], x1 * av[bj][1]);
                    *(v4u*)(H + (size_t)row * DM + c) = hw;
                    if (rmx) {
#pragma unroll
                        for (int e = 0; e < 4; ++e) { mx = fmaxf(mx, fabsf(__builtin_bit_cast(float, hw[e] << 16))); mx = fmaxf(mx, fabsf(__builtin_bit_cast(float, hw[e] & 0xffff0000u))); } } }
            }
            if (H) { ss += __shfl_xor(ss, 16); ss += __shfl_xor(ss, 32);
                if (rmx) { mx = fmaxf(mx, __shfl_xor(mx, 16)); mx = fmaxf(mx, __shfl_xor(mx, 32)); }
                if (fq == 0) { rss[(size_t)row * 32 + u.pn * 4 + wc] = ss; if (rmx) rmx[(size_t)row * 32 + u.pn * 4 + wc] = mx; } }
            SBAR();
        }
#undef ER_LOAD
    }
};

struct EpiRelu2 {
    static constexpr bool PERM = true, AFTER_DRAIN = false;
    bf16* O; int ldc; NormIn ni;
    __device__ __forceinline__ void operator()(const pg8::f32x4 (&acc)[2][2][4][2], const pg8::Unit& u, int wr, int wc, int fr, int fq) const {
        const int row0 = u.pm * 256 + wr * 64 + fr, col0 = u.pn * 256 + wc * 32 + 8 * fq;
        const float* swp = ni.swp(u.pm) + col0; f32x4 sw[2][2];
#pragma unroll
        for (int bj = 0; bj < 2; ++bj)
#pragma unroll
            for (int n = 0; n < 2; ++n) sw[bj][n] = *(const f32x4*)(swp + bj * 128 + 4 * n);
#pragma unroll
        for (int ai = 0; ai < 2; ++ai)
#pragma unroll
            for (int m = 0; m < 4; ++m) {
                const int row = row0 + ai * 128 + m * 16; const float rs = ni.rstd(row, u.pm);
                bf16* rp = O + (size_t)row * ldc + col0;
#pragma unroll
                for (int bj = 0; bj < 2; ++bj) {
                    f32x4 a = acc[ai][bj][m][0] * rs + sw[bj][0], b = acc[ai][bj][m][1] * rs + sw[bj][1];
                    a = __builtin_elementwise_max(a, (f32x4){0.f, 0.f, 0.f, 0.f}); b = __builtin_elementwise_max(b, (f32x4){0.f, 0.f, 0.f, 0.f});
                    a = a * a; b = b * b;
                    *(v4u*)(rp + bj * 128) = pack8(a, b);
                }
            }
    }
};

typedef EpiResidT<false> EpiResid;

struct EpiRelu2I8 {
    static constexpr bool PERM = true, AFTER_DRAIN = false;
    bf16* O; int ldc; const float* frow; const float* scol; const float* sW;
    __device__ __forceinline__ void operator()(const pg8::f32x4 (&acc)[2][2][4][2], const pg8::Unit& u, int wr, int wc, int fr, int fq) const {
        const int row0 = u.pm * 256 + wr * 64 + fr, col0 = u.pn * 256 + wc * 32 + 8 * fq;
        const float* swp = sW + (size_t)cond_of_pm(u.pm) * 8192 + col0; f32x4 sw[2][2], sc[2][2];
#pragma unroll
        for (int bj = 0; bj < 2; ++bj)
#pragma unroll
            for (int n = 0; n < 2; ++n) { sw[bj][n] = *(const f32x4*)(swp + bj * 128 + 4 * n); sc[bj][n] = *(const f32x4*)(scol + col0 + bj * 128 + 4 * n); }
#pragma unroll
        for (int ai = 0; ai < 2; ++ai)
#pragma unroll
            for (int m = 0; m < 4; ++m) {
                const int row = row0 + ai * 128 + m * 16; const float fr_ = frow[row];
#pragma unroll
                for (int bj = 0; bj < 2; ++bj) {
                    const pg8::i32x4 i0 = __builtin_bit_cast(pg8::i32x4, acc[ai][bj][m][0]), i1 = __builtin_bit_cast(pg8::i32x4, acc[ai][bj][m][1]);
                    f32x4 a = {(float)i0[0], (float)i0[1], (float)i0[2], (float)i0[3]}, b = {(float)i1[0], (float)i1[1], (float)i1[2], (float)i1[3]};
                    a = a * (sc[bj][0] * fr_) + sw[bj][0]; b = b * (sc[bj][1] * fr_) + sw[bj][1];
                    a = __builtin_elementwise_max(a, (f32x4){0.f, 0.f, 0.f, 0.f}); b = __builtin_elementwise_max(b, (f32x4){0.f, 0.f, 0.f, 0.f});
                    a = a * a; b = b * b;
                    { const int col = col0 + bj * 128;
                      *(v4u*)(O + ((((size_t)(row >> 8) * (ldc >> 6) + (col >> 6)) * 256 + (row & 255)) << 6) + (col & 63)) = pack8(a, b); }
                }
            }
    }
};

struct EpiF32 {
    static constexpr bool PERM = true, AFTER_DRAIN = false;
    float* O; int ldc; NormIn ni;
    __device__ __forceinline__ void operator()(const pg8::f32x4 (&acc)[2][2][4][2], const pg8::Unit& u, int wr, int wc, int fr, int fq) const {
        const int row0 = u.pm * 256 + wr * 64 + fr, col0 = u.pn * 256 + wc * 32 + 8 * fq;
        const float* swp = ni.swp(u.pm) + col0; f32x4 sw[2][2];
#pragma unroll
        for (int bj = 0; bj < 2; ++bj)
#pragma unroll
            for (int n = 0; n < 2; ++n) sw[bj][n] = *(const f32x4*)(swp + bj * 128 + 4 * n);
#pragma unroll
        for (int ai = 0; ai < 2; ++ai)
#pragma unroll
            for (int m = 0; m < 4; ++m) {
                const int row = row0 + ai * 128 + m * 16; const float rs = ni.rstd(row, u.pm);
                float* rp = O + (size_t)row * ldc + col0;
#pragma unroll
                for (int bj = 0; bj < 2; ++bj) { *(f32x4*)(rp + bj * 128) = acc[ai][bj][m][0] * rs + sw[bj][0]; *(f32x4*)(rp + bj * 128 + 4) = acc[ai][bj][m][1] * rs + sw[bj][1]; }
            }
    }
};

struct EpiQkvWin {
    static constexpr bool PERM = true, AFTER_DRAIN = false;
    bf16 *Q, *K, *V; float* outk; float* outv; int j; const f32x2* tab; NormIn ni;
    __device__ __forceinline__ void operator()(const pg8::f32x4 (&acc)[2][2][4][2], const pg8::Unit& u, int wr, int wc, int fr, int fq) const {
        const int row0 = u.pm * 256 + wr * 64 + fr, cl = wc * 32 + 8 * fq;
        const int pn = u.pn; const bool sample = u.pm >= 32;
        const int ug = 4 * wc + fq, idx0 = (ug & 7) * 4, d1 = (ug < 8 ? 0 : 64) + idx0;
        const float* swp = ni.swp(u.pm) + u.pn * 256 + cl; f32x4 sw[2][2];
#pragma unroll
        for (int bj = 0; bj < 2; ++bj)
#pragma unroll
            for (int n = 0; n < 2; ++n) sw[bj][n] = *(const f32x4*)(swp + bj * 128 + 4 * n);
#pragma unroll
        for (int ai = 0; ai < 2; ++ai)
#pragma unroll
            for (int m = 0; m < 4; ++m) {
                const int row = row0 + ai * 128 + m * 16; const float rs = ni.rstd(row, u.pm);
                f32x4 cs0 = {1.f, 0.f, 1.f, 0.f}, cs1 = {1.f, 0.f, 1.f, 0.f};
                if (sample && pn < 10) { const int t = row & 4095, pos = (ug < 8) ? (t >> 6) : (t & 63); const f32x4* tp = (const f32x4*)(tab + pos * 32 + idx0); cs0 = tp[0]; cs1 = tp[1]; }
#pragma unroll
                for (int bj = 0; bj < 2; ++bj) {
                    f32x4 a = acc[ai][bj][m][0] * rs + sw[bj][0], b = acc[ai][bj][m][1] * rs + sw[bj][1];
                    if (pn < 10) {
                        if (sample) {
                            const f32x4 co = {cs0[0], cs0[2], cs1[0], cs1[2]}, si = {cs0[1], cs0[3], cs1[1], cs1[3]};
                            const f32x4 na = a * co - b * si, nb = b * co + a * si; a = na; b = nb;
                        }
                        if (pn < 8) { *(v4u*)(Q + (size_t)row * 2048 + pn * 256 + bj * 128 + cl) = pack8(a, b); }
                        else {
                            const int kvh = (pn - 8) * 2 + bj;
                            *(v4u*)(K + (size_t)row * 512 + kvh * 128 + cl) = pack8(a, b);
                            if (!sample) { float* op = outk + ((size_t)(u.pm * 2 + j) * 256 + (row & 255)) * 512 + kvh * 128 + d1; *(f32x4*)op = a; *(f32x4*)(op + 32) = b; }
                        }
                    } else {
                        const int kvh = (pn - 10) * 2 + bj;
                        *(v4u*)(V + (size_t)row * 512 + kvh * 128 + cl) = pack8(a, b);
                        if (!sample) { float* op = outv + ((size_t)(u.pm * 2 + j) * 256 + (row & 255)) * 512 + kvh * 128 + cl; *(f32x4*)op = a; *(f32x4*)(op + 4) = b; }
                    }
                }
            }
    }
};

struct EpiMlaQ {
    static constexpr bool PERM = true, AFTER_DRAIN = false;
    bf16* Q; const f32x2* tab;
    __device__ __forceinline__ void operator()(const pg8::f32x4 (&acc)[2][2][4][2], const pg8::Unit& u, int wr, int wc, int fr, int fq) const {
        const int row0 = u.pm * 256 + wr * 64 + fr, col0 = u.pn * 256 + wc * 32 + 8 * fq;
        const bool sample = u.pm >= 32;
#pragma unroll
        for (int bj = 0; bj < 2; ++bj) {
            const int c0 = col0 + bj * 128, p0 = c0 % 192; const bool isr = p0 >= 128; const int ug = isr ? ((p0 - 128) >> 3) : 0, idx0 = (ug & 3) * 4;
#pragma unroll
            for (int ai = 0; ai < 2; ++ai)
#pragma unroll
                for (int m = 0; m < 4; ++m) {
                    const int row = row0 + ai * 128 + m * 16;
                    f32x4 a = acc[ai][bj][m][0], b = acc[ai][bj][m][1];
                    if (sample) {
                        const int t = row & 4095, pos = (ug < 4) ? (t >> 6) : (t & 63); const f32x4* tp = (const f32x4*)(tab + pos * 16 + idx0); const f32x4 cs0 = tp[0], cs1 = tp[1];
                        const f32x4 co = {cs0[0], cs0[2], cs1[0], cs1[2]}, si = {cs0[1], cs0[3], cs1[1], cs1[3]};
                        const f32x4 na = a * co - b * si, nb = b * co + a * si;
                        if (isr) { a = na; b = nb; }
                    }
                    *(v4u*)(Q + (size_t)row * 3072 + c0) = pack8(a, b);
                }
        }
    }
};

struct EpiMlaKV {
    static constexpr bool PERM = true, AFTER_DRAIN = false;
    bf16 *KN, *V;
    __device__ __forceinline__ void operator()(const pg8::f32x4 (&acc)[2][2][4][2], const pg8::Unit& u, int wr, int wc, int fr, int fq) const {
        const int row0 = u.pm * 256 + wr * 64 + fr, cl = u.pn * 128 + wc * 32 + 8 * fq;
#pragma unroll
        for (int ai = 0; ai < 2; ++ai)
#pragma unroll
            for (int m = 0; m < 4; ++m) {
                const size_t ro = (size_t)(row0 + ai * 128 + m * 16) * 2048 + cl;
                *(v4u*)(KN + ro) = pack8(acc[ai][0][m][0], acc[ai][0][m][1]);
                *(v4u*)(V + ro) = pack8(acc[ai][1][m][0], acc[ai][1][m][1]);
            }
    }
};

struct EpiGlaIn {
    static constexpr bool PERM = true, AFTER_DRAIN = false;
    bf16 *q, *k, *v, *r; float* uo; NormIn ni;
    __device__ __forceinline__ void operator()(const pg8::f32x4 (&acc)[2][2][4][2], const pg8::Unit& u, int wr, int wc, int fr, int fq) const {
        const int row0 = u.pm * 256 + wr * 64 + fr, cl = wc * 32 + 8 * fq; const int pn = u.pn;
        const float* swp = ni.swp(u.pm) + pn * 256 + cl; f32x4 sw[2][2];
#pragma unroll
        for (int bj = 0; bj < 2; ++bj)
#pragma unroll
            for (int n = 0; n < 2; ++n) sw[bj][n] = *(const f32x4*)(swp + bj * 128 + 4 * n);
#pragma unroll
        for (int ai = 0; ai < 2; ++ai)
#pragma unroll
            for (int m = 0; m < 4; ++m) {
                const int row = row0 + ai * 128 + m * 16; const float rs = ni.rstd(row, u.pm);
#pragma unroll
                for (int bj = 0; bj < 2; ++bj) {
                    f32x4 a = acc[ai][bj][m][0] * rs + sw[bj][0], b = acc[ai][bj][m][1] * rs + sw[bj][1];
                    const int c = pn * 256 + bj * 128 + cl;
                    if (pn < 4) { a = a * 0.0625f; b = b * 0.0625f; *(v4u*)(q + (size_t)row * 1024 + c) = pack8(a, b); }
                    else if (pn < 8) { *(v4u*)(k + (size_t)row * 1024 + (c - 1024)) = pack8(a, b); }
                    else if (pn < 16) { *(v4u*)(v + (size_t)row * 2048 + (c - 2048)) = pack8(a, b); }
                    else if (pn < 24) { *(v4u*)(r + (size_t)row * 2048 + (c - 4096)) = pack8(a, b); }
                    else if (bj == 0 && wc == 0) { float* op = uo + (size_t)row * 32 + 8 * fq; *(f32x4*)op = a; *(f32x4*)(op + 4) = b; }
                }
            }
    }
};

struct Frame {
    LAS unsigned char* lds; unsigned char* ldsg;
    int tid, lane, wave, G, bx;
    const float* const* in; float* out; unsigned char* ws;
};
#define WSP(T, off) ((T*)(F.ws + (off)))
constexpr int LDS_RSTD_OFF = 131072;
__device__ __forceinline__ int prep_rstd(Frame& F, const pg8::StaticOrder& S, int site) {
    pg8::Unit u0; int pm0 = -1; if (S.next(0, u0)) pm0 = u0.pm;
    LAS float* lrs = (LAS float*)(F.lds + LDS_RSTD_OFF);
    if (pm0 >= 0 && F.tid < 256) { const int row = pm0 * 256 + F.tid; const f32x4* pp = (const f32x4*)(WSP(float, WS_PART) + ((size_t)site * MTOK + row) * 32); f32x4 t = pp[0];
#pragma unroll
        for (int i = 1; i < 8; ++i) t += pp[i];
        lrs[F.tid] = rsqrtf(((t[0] + t[1]) + (t[2] + t[3])) * (1.f / 2048.f) + EPS); }
    __syncthreads();
    return pm0;
}

__device__ __forceinline__ int perm_win(int p) { const int u = p >> 3, v = p & 7; return (u < 8 ? 0 : 64) + (u & 7) * 4 + (v & 3) + ((v & 4) ? 32 : 0); }
__device__ __forceinline__ int perm_mla(int p) { const int u = p >> 3, v = p & 7; return (u < 4 ? 0 : 32) + (u & 3) * 4 + (v & 3) + ((v & 4) ? 16 : 0); }
__device__ __forceinline__ int srcmap(int mode, int n) {
    if (mode == 1) { if (n >= 2560) return n; return (n & ~127) + perm_win(n & 127); }
    if (mode == 2) { if (n < 768) return n; if (n >= 832) return -1; return 768 + perm_mla(n - 768); }
    if (mode == 3) { const int hh = n / 192, p = n - hh * 192; if (p < 128) return n; return hh * 192 + 128 + perm_mla(p - 128); }
    return n;
}
#ifndef WMANT
#define WMANT 7
#endif
__device__ __forceinline__ unsigned f2bfw(float f) { constexpr int sh = 23 - WMANT; unsigned u = __builtin_bit_cast(unsigned, f); u += ((1u << sh) >> 1) - 1u + ((u >> sh) & 1u); u &= ~((1u << sh) - 1u); return u >> 16; }
__device__ __forceinline__ unsigned pk2w(float lo, float hi) { return f2bfw(lo) | (f2bfw(hi) << 16); }
__device__ __forceinline__ void tr_item(const float* W, int K, int Nsrc, int nblk, bf16* WT, int mode, LAS float* scr, int item, int lane) {
    const int kb = item / nblk, nb = item - kb * nblk, k0 = 64 * kb, n0 = 64 * nb;
    const int ln = (lane & 15) * 4, lk = lane >> 4;
    const int sc = srcmap(mode, n0 + ln);
    f32x4 v[16];
    const float* Wp = W + (size_t)(k0 + lk) * Nsrc + (sc >= 0 ? sc : 0);
#pragma unroll
    for (int i = 0; i < 16; ++i) v[i] = sc >= 0 ? __builtin_nontemporal_load((const f32x4*)(Wp + (size_t)(4 * i) * Nsrc)) : (f32x4){0.f, 0.f, 0.f, 0.f};
#pragma unroll
    for (int i = 0; i < 16; ++i) { LAS float* d = scr + (4 * i + lk) * 65 + ln; d[0] = v[i][0]; d[1] = v[i][1]; d[2] = v[i][2]; d[3] = v[i][3]; }
    LDS_WAIT(); asm volatile("" ::: "memory");
    const int c = lane & 7;
#pragma unroll
    for (int jj = 0; jj < 8; ++jj) { const int n = (lane >> 3) + 8 * jj; const LAS float* s = scr + (8 * c) * 65 + n;
        v4u o; o.x = pk2w(s[0 * 65], s[1 * 65]); o.y = pk2w(s[2 * 65], s[3 * 65]); o.z = pk2w(s[4 * 65], s[5 * 65]); o.w = pk2w(s[6 * 65], s[7 * 65]);
        *(GAS v4u*)(WT + (size_t)(n0 + n) * K + k0 + 8 * c) = o; }
    LDS_WAIT(); asm volatile("" ::: "memory");
}

__device__ __forceinline__ const float* wo_src(Frame& F, int lw) { return lw == 0 ? F.in[I_WWO] : (lw == 1 ? F.in[I_MWO] : (lw == 2 ? F.in[I_GWO] : F.in[I_WWO] + (size_t)2048 * 2048)); }
__device__ __forceinline__ void tr_item_q8(const float* W, int N, int nblk, signed char* Wq, const float* scol, LAS float* scr, int item, int lane) {
    constexpr int K = 2048;
    const int kb = item / nblk, nb = item - kb * nblk, k0 = 64 * kb, n0 = 64 * nb;
    const int ln = (lane & 15) * 4, lk = lane >> 4;
    f32x4 v[16];
    const float* Wp = W + (size_t)(k0 + lk) * N + n0 + ln;
#pragma unroll
    for (int i = 0; i < 16; ++i) v[i] = __builtin_nontemporal_load((const f32x4*)(Wp + (size_t)(4 * i) * N));
#pragma unroll
    for (int i = 0; i < 16; ++i) { LAS float* d = scr + (4 * i + lk) * 65 + ln; d[0] = v[i][0]; d[1] = v[i][1]; d[2] = v[i][2]; d[3] = v[i][3]; }
    LDS_WAIT(); asm volatile("" ::: "memory");
    const int c = lane & 7;
#pragma unroll
    for (int jj = 0; jj < 8; ++jj) { const int n = (lane >> 3) + 8 * jj; const LAS float* s = scr + (8 * c) * 65 + n; const float inv = 1.f / scol[n0 + n];
        unsigned b[8];
#pragma unroll
        for (int e = 0; e < 8; ++e) { int q = (int)rintf(s[e * 65] * inv); q = q > 127 ? 127 : (q < -127 ? -127 : q); b[e] = (unsigned)q & 0xffu; }
        v2u o; o.x = b[0] | (b[1] << 8) | (b[2] << 16) | (b[3] << 24); o.y = b[4] | (b[5] << 8) | (b[6] << 16) | (b[7] << 24);
        *(GAS v2u*)(Wq + (size_t)(n0 + n) * K + k0 + 8 * c) = o; }
    LDS_WAIT(); asm volatile("" ::: "memory");
}

__device__ __forceinline__ void q8w_item(Frame& F, const float* W, int N, int n0, signed char* Wq, float* scol) {
    const int tid = F.tid, lane = F.lane, wave = F.wave, cg = tid & 7, rq = tid >> 3;
    LAS unsigned char* T = F.lds; LAS float* red = (LAS float*)(F.lds + 32 * 2064);
    f32x4 v[8][4];
    const float* wp = W + (size_t)(4 * rq) * N + n0 + 4 * cg;
#pragma unroll
    for (int i = 0; i < 8; ++i)
#pragma unroll
        for (int j = 0; j < 4; ++j) v[i][j] = __builtin_nontemporal_load((const f32x4*)(wp + (size_t)(256 * i + j) * N));
    f32x4 m = {0.f, 0.f, 0.f, 0.f};
#pragma unroll
    for (int i = 0; i < 8; ++i)
#pragma unroll
        for (int j = 0; j < 4; ++j) m = __builtin_elementwise_max(m, __builtin_elementwise_abs(v[i][j]));
#pragma unroll
    for (int o = 8; o < 64; o <<= 1) { m[0] = fmaxf(m[0], __shfl_xor(m[0], o)); m[1] = fmaxf(m[1], __shfl_xor(m[1], o)); m[2] = fmaxf(m[2], __shfl_xor(m[2], o)); m[3] = fmaxf(m[3], __shfl_xor(m[3], o)); }
    if (lane < 8) *(LAS f32x4*)(red + wave * 32 + 4 * lane) = m;
    __syncthreads();
    f32x4 mm = *(const LAS f32x4*)(red + 4 * cg);
#pragma unroll
    for (int w8 = 1; w8 < 8; ++w8) mm = __builtin_elementwise_max(mm, *(const LAS f32x4*)(red + w8 * 32 + 4 * cg));
    f32x4 sc, inv;
#pragma unroll
    for (int c = 0; c < 4; ++c) { sc[c] = fmaxf(mm[c], 1e-30f) * (1.f / 127.f); inv[c] = 1.f / sc[c]; }
    if (tid < 8) *(f32x4*)(scol + n0 + 4 * cg) = sc;
#pragma unroll
    for (int i = 0; i < 8; ++i)
#pragma unroll
        for (int c = 0; c < 4; ++c) { unsigned b[4];
#pragma unroll
            for (int j = 0; j < 4; ++j) { int q = (int)rintf(v[i][j][c] * inv[c]); q = q > 127 ? 127 : (q < -127 ? -127 : q); b[j] = (unsigned)q & 0xffu; }
            *(LAS unsigned*)(T + (4 * cg + c) * 2064 + 256 * i + 4 * rq) = b[0] | (b[1] << 8) | (b[2] << 16) | (b[3] << 24); }
    __syncthreads();
    { const int row = tid >> 4, c16 = tid & 15; signed char* dp = Wq + (size_t)(n0 + row) * 2048;
#pragma unroll
      for (int j = 0; j < 8; ++j) { const int ch = c16 + 16 * j; *(v4u*)(dp + 16 * ch) = *(const LAS v4u*)(T + row * 2064 + 16 * ch); } }
    __syncthreads();
}

__device__ __forceinline__ void p0_prologue(Frame& F) {
    const int tid = F.tid, lane = F.lane, wave = F.wave;
    for (int it = F.bx; it < 192; it += F.G) {
        const int l = it / 48, nb = it - l * 48;
        LAS float* sl = (LAS float*)F.lds; LAS float* red = sl + 3 * 2048;
        for (int e = tid; e < 3 * 2048; e += 512) { const int c = e >> 11, k = e & 2047; const float v = (c == 0) ? F.in[I_CCTX][k] : F.in[I_C][(c - 1) * 2048 + k]; sl[e] = v / (1.f + __expf(-v)); }
        __syncthreads();
        const float* Wp = F.in[I_ADAW] + ((size_t)l * 2048 + wave * 256) * 12288 + nb * 256 + lane * 4;
        f32x4 a0 = {0.f, 0.f, 0.f, 0.f}, a1 = a0, a2 = a0;
        for (int k = 0; k < 256; k += 8) {
            f32x4 w[8];
#pragma unroll
            for (int jj = 0; jj < 8; ++jj) w[jj] = __builtin_nontemporal_load((const f32x4*)(Wp + (size_t)(k + jj) * 12288));
#pragma unroll
            for (int jj = 0; jj < 8; ++jj) { const int kk = wave * 256 + k + jj; a0 += w[jj] * sl[kk]; a1 += w[jj] * sl[2048 + kk]; a2 += w[jj] * sl[4096 + kk]; }
        }
        *(LAS f32x4*)(red + (wave * 3 + 0) * 256 + lane * 4) = a0; *(LAS f32x4*)(red + (wave * 3 + 1) * 256 + lane * 4) = a1; *(LAS f32x4*)(red + (wave * 3 + 2) * 256 + lane * 4) = a2;
        __syncthreads();
        for (int e = tid; e < 768; e += 512) { const int c = e >> 8, n = e & 255; float s = F.in[I_ADAB][l * 12288 + nb * 256 + n];
#pragma unroll
            for (int w8 = 0; w8 < 8; ++w8) s += red[(w8 * 3 + c) * 256 + n];
            WSP(float, WS_MOD)[(size_t)(l * 3 + c) * 12288 + nb * 256 + n] = s; }
        __syncthreads();
    }
    if (F.bx == F.G - 1) {
        for (int e = tid; e < 64 * 32; e += 512) { const int pos = e >> 5, i = e & 31; const float inv = exp2f(-(float)i * (13.287712379549449f / 32.f)); const float ang = (float)pos * inv;
            WSP(f32x2, WS_TABW)[e] = (f32x2){cosf(ang), sinf(ang)}; }
        for (int e = tid; e < 64 * 16; e += 512) { const int pos = e >> 4, i = e & 15; const float inv = exp2f(-(float)i * (13.287712379549449f / 16.f)); const float ang = (float)pos * inv;
            WSP(f32x2, WS_TABM)[e] = (f32x2){cosf(ang), sinf(ang)}; }
    }
    const int gt = F.bx * 512 + tid, NGT = F.G * 512;
    for (int e = gt; e < 2 * 2 * 512 * 512; e += NGT) {
        const int c = e & 511, pos = (e >> 9) & 511, b = (e >> 18) & 1, jj = e >> 19;
        const size_t sbase = (((size_t)b * 2 + jj) * 512 + pos) * 512;
        WSP(bf16, WS_CTXK)[e] = (bf16)f2bf(F.in[I_CWK][sbase + (c & ~127) + perm_win(c & 127)]);
        WSP(bf16, WS_CTXV)[e] = (bf16)f2bf(F.in[I_CWV][sbase + c]);
    }
    for (int e = gt; e < 256 * 2048; e += NGT) { const int n = e >> 11, k = e & 2047; float v = 0.f; if (n < 32) v = F.in[I_GWA1][((size_t)(n >> 4) * 2048 + k) * 16 + (n & 15)];
        WSP(bf16, WS_GWINT)[(size_t)(6144 + n) * 2048 + k] = (bf16)f2bf(v); }
    LAS float* scr = (LAS float*)(F.lds + wave * 16640);
    constexpr int C_W2 = 128 * 32, C_QKV = 32 * 48, C_MWD = 32 * 16, C_MUQ = 8 * 48, C_MUKV = 4 * 64, C_GWIN = 32 * 96;
    constexpr int NITEMS = 4 * C_W2 + 2 * C_QKV + C_MWD + C_MUQ + C_MUKV + C_GWIN;
    const bool bal = (F.G == 256);
    const int nslot = bal ? (F.bx < 192 ? 1 : 2) : 1;
    const int slot0 = bal ? (F.bx < 192 ? F.bx : 192 + (F.bx - 192) * 2) : F.bx;
    const int NVW = (bal ? 320 : F.G) * NWAVES;
    for (int sl = 0; sl < nslot; ++sl)
    for (int it = (slot0 + sl) * NWAVES + wave; it < NITEMS; it += NVW) {
        int r = it;
        if (r < 4 * C_W2) { const int l = r / C_W2; r -= l * C_W2; tr_item(F.in[I_W2] + (size_t)l * 8192 * 2048, 8192, 2048, 32, WSP(bf16, WS_W2T) + (size_t)l * 2048 * 8192, 0, scr, r, lane); continue; } r -= 4 * C_W2;
        if (r < 2 * C_QKV) { const int l = r / C_QKV; r -= l * C_QKV; tr_item(F.in[I_WQKV] + (size_t)l * 2048 * 3072, 2048, 3072, 48, WSP(bf16, WS_WQKVT) + (size_t)l * 3072 * 2048, 1, scr, r, lane); continue; } r -= 2 * C_QKV;
        if (r < C_MWD) { tr_item(F.in[I_MWD], 2048, 832, 16, WSP(bf16, WS_MWDT), 2, scr, r, lane); continue; } r -= C_MWD;
        if (r < C_MUQ) { tr_item(F.in[I_MWUQ], 512, 3072, 48, WSP(bf16, WS_MWUQT), 3, scr, r, lane); continue; } r -= C_MUQ;
        if (r < C_MUKV) { tr_item(F.in[I_MWUKV], 256, 4096, 64, WSP(bf16, WS_MWUKVT), 0, scr, r, lane); continue; } r -= C_MUKV;
        tr_item(F.in[I_GWIN], 2048, 6144, 96, WSP(bf16, WS_GWINT), 0, scr, r, lane);
    }
}

__device__ __forceinline__ const float* x_row(Frame& F, int L, int row) {
    return L == 0 ? (row < MP ? F.in[I_XP] + (size_t)row * DM : F.in[I_XS] + (size_t)(row - MP) * DM) : WSP(float, WS_X) + (size_t)row * DM;
}
__device__ __forceinline__ void p1_phase(Frame& F) {
    const int gw = F.bx * NWAVES + F.wave, NGW = F.G * NWAVES, lane = F.lane;
    for (int rb = gw; rb < MTOK / 8; rb += NGW) {
        const int row0 = rb * 8, cond = row0 < MP ? 0 : (row0 >> 12) - 1;
        const float* mv = WSP(float, WS_MOD) + (size_t)cond * 12288;
        const float* g = F.in[I_NORMG];
        f32x4 a[8];
#pragma unroll
        for (int jj = 0; jj < 8; ++jj) { const int col = 4 * lane + 256 * jj; a[jj] = *(const f32x4*)(g + col) * (*(const f32x4*)(mv + 2048 + col) + 1.f); }
#pragma unroll 1
        for (int r = 0; r < 8; r += 2) {
            f32x4 v[2][8];
#pragma unroll
            for (int q = 0; q < 2; ++q) { const float* xr = x_row(F, 0, row0 + r + q);
#pragma unroll
                for (int jj = 0; jj < 8; ++jj) v[q][jj] = *(const f32x4*)(xr + 4 * lane + 256 * jj); }
#pragma unroll
            for (int q = 0; q < 2; ++q) { const int row = row0 + r + q; float ss = 0.f;
#pragma unroll
                for (int jj = 0; jj < 8; ++jj) ss += (v[q][jj][0] * v[q][jj][0] + v[q][jj][1] * v[q][jj][1]) + (v[q][jj][2] * v[q][jj][2] + v[q][jj][3] * v[q][jj][3]);
                ss = wave_sum(ss);
                if (lane < 32) WSP(float, WS_PART)[(size_t)row * 32 + lane] = lane == 0 ? ss : 0.f;
                bf16* hr = WSP(bf16, WS_H) + (size_t)row * DM;
#pragma unroll
                for (int jj = 0; jj < 8; ++jj) { const f32x4 y = v[q][jj] * a[jj]; v2u w; w.x = cvtpk(y[0], y[1]); w.y = cvtpk(y[2], y[3]); *(v2u*)(hr + 4 * lane + 256 * jj) = w; } }
        }
    }
    __syncthreads();
    for (int it = F.bx; it < 1280; it += F.G) {
        if (it < 1024) { const int l = it >> 8, nb = it & 255; q8w_item(F, F.in[I_W1] + (size_t)l * 2048 * 8192, 8192, nb * 32, (signed char*)(F.ws + WS_W1T) + (size_t)l * 8192 * 2048, WSP(float, WS_SCOL) + l * 8192); }
        else { const int lw = (it - 1024) >> 6, nb = (it - 1024) & 63; q8w_item(F, wo_src(F, lw), 2048, nb * 32, (signed char*)(F.ws + WS_WWOT) + (size_t)lw * 2048 * 2048, WSP(float, WS_SCOLO) + lw * 2048); }
    }
    constexpr int NCH = 96 + 32 + 200 + 96;
    for (int ch = gw; ch < NCH; ch += NGW) {
        int c = ch, site = 0; const bf16* Wt = WSP(bf16, WS_WQKVT);
        if (c >= 96) { c -= 96; site = 2; Wt = WSP(bf16, WS_MWDT);
          if (c >= 32) { c -= 32; site = 4; Wt = WSP(bf16, WS_GWINT);
            if (c >= 200) { c -= 200; site = 6; Wt = WSP(bf16, WS_WQKVT) + (size_t)3072 * DM; } } }
        const int L = site >> 1, which = site & 1;
        const float* sv = WSP(float, WS_MOD) + (size_t)(L * 3) * 12288 + (which ? 3 * 2048 : 0);
        f32x4 s0[3][4], s1[3][4];
#pragma unroll
        for (int cc = 0; cc < 3; ++cc)
#pragma unroll
            for (int jj = 0; jj < 4; ++jj) { const float* sp = sv + (size_t)cc * 12288 + 8 * lane + 512 * jj; s0[cc][jj] = *(const f32x4*)sp; s1[cc][jj] = *(const f32x4*)(sp + 4); }
        float* so = WSP(float, WS_SW) + (size_t)site * 3 * 8192;
#pragma unroll 1
        for (int r2 = 0; r2 < 32; r2 += 2) {
            const bf16* wr0 = Wt + (size_t)(c * 32 + r2) * DM + 8 * lane; const bf16* wr1 = wr0 + DM;
            const v4u w00 = *(const v4u*)(wr0), w01 = *(const v4u*)(wr0 + 512), w02 = *(const v4u*)(wr0 + 1024), w03 = *(const v4u*)(wr0 + 1536);
            const v4u w10 = *(const v4u*)(wr1), w11 = *(const v4u*)(wr1 + 512), w12 = *(const v4u*)(wr1 + 1024), w13 = *(const v4u*)(wr1 + 1536);
            float a0 = 0.f, a1 = 0.f, a2 = 0.f, b0 = 0.f, b1 = 0.f, b2 = 0.f;
#define SW_ACC(W_, jj, d0_, d1_, d2_) do { const v4u q_ = (W_); \
                const f32x4 wa = {__builtin_bit_cast(float, q_[0] << 16), __builtin_bit_cast(float, q_[0] & 0xffff0000u), __builtin_bit_cast(float, q_[1] << 16), __builtin_bit_cast(float, q_[1] & 0xffff0000u)}; \
                const f32x4 wb = {__builtin_bit_cast(float, q_[2] << 16), __builtin_bit_cast(float, q_[2] & 0xffff0000u), __builtin_bit_cast(float, q_[3] << 16), __builtin_bit_cast(float, q_[3] & 0xffff0000u)}; \
                f32x4 t = wa * s0[0][jj] + wb * s1[0][jj]; d0_ += (t[0] + t[1]) + (t[2] + t[3]); \
                t = wa * s0[1][jj] + wb * s1[1][jj]; d1_ += (t[0] + t[1]) + (t[2] + t[3]); \
                t = wa * s0[2][jj] + wb * s1[2][jj]; d2_ += (t[0] + t[1]) + (t[2] + t[3]); } while (0)
            SW_ACC(w00, 0, a0, a1, a2); SW_ACC(w01, 1, a0, a1, a2); SW_ACC(w02, 2, a0, a1, a2); SW_ACC(w03, 3, a0, a1, a2);
            SW_ACC(w10, 0, b0, b1, b2); SW_ACC(w11, 1, b0, b1, b2); SW_ACC(w12, 2, b0, b1, b2); SW_ACC(w13, 3, b0, b1, b2);
#undef SW_ACC
#pragma unroll
            for (int o = 1; o < 64; o <<= 1) { a0 += __shfl_xor(a0, o); a1 += __shfl_xor(a1, o); a2 += __shfl_xor(a2, o); b0 += __shfl_xor(b0, o); b1 += __shfl_xor(b1, o); b2 += __shfl_xor(b2, o); }
            if (lane == 0) { const int n = c * 32 + r2; so[n] = a0; so[8192 + n] = a1; so[2 * 8192 + n] = a2; so[n + 1] = b0; so[8192 + n + 1] = b1; so[2 * 8192 + n + 1] = b2; }
        }
    }
}
__device__ __forceinline__ void q8_phase(Frame& F, int L, bool with_sw) {
    const int gw = F.bx * NWAVES + F.wave, NGW = F.G * NWAVES, lane = F.lane;
    const float* part = WSP(float, WS_PART) + (size_t)(2 * L + 1) * MTOK * 32; const float* pmax = WSP(float, WS_PMAX) + (size_t)(2 * L + 1) * MTOK * 32;
    const bf16* H = WSP(bf16, WS_H); signed char* H8 = (signed char*)(F.ws + WS_H8); float* frow = WSP(float, WS_FROW) + (size_t)L * MTOK;
    for (int row0 = gw; row0 < MTOK; row0 += 4 * NGW) {
        float ss[4], mx[4]; v4u w[4][4];
#pragma unroll
        for (int r = 0; r < 4; ++r) { const int row = row0 + r * NGW; const bool ok = row < MTOK && lane < 32;
            ss[r] = ok ? part[(size_t)row * 32 + lane] : 0.f; mx[r] = ok ? pmax[(size_t)row * 32 + lane] : 0.f; }
#pragma unroll
        for (int r = 0; r < 4; ++r) { const int row = row0 + r * NGW;
            if (row < MTOK) { const bf16* hr = H + (size_t)row * DM + 8 * lane;
#pragma unroll
                for (int jj = 0; jj < 4; ++jj) w[r][jj] = *(const v4u*)(hr + 512 * jj); } }
#pragma unroll
        for (int r = 0; r < 4; ++r) { const int row = row0 + r * NGW;
            if (row < MTOK) {
                float s1 = ss[r], m1 = mx[r];
#pragma unroll
                for (int o = 1; o < 64; o <<= 1) { s1 += __shfl_xor(s1, o); m1 = fmaxf(m1, __shfl_xor(m1, o)); }
                m1 = fmaxf(m1, 1e-30f);
                const float rstd = rsqrtf(s1 * (1.f / 2048.f) + EPS), scale = m1 * (1.f / 127.f), inv = 127.f / m1;
                if (lane == 0) frow[row] = rstd * scale;
                signed char* qr = H8 + (size_t)row * DM + 8 * lane;
#pragma unroll
                for (int jj = 0; jj < 4; ++jj) { unsigned b[8];
#pragma unroll
                    for (int e = 0; e < 4; ++e) { int q0 = (int)rintf(__builtin_bit_cast(float, w[r][jj][e] << 16) * inv), q1 = (int)rintf(__builtin_bit_cast(float, w[r][jj][e] & 0xffff0000u) * inv);
                        q0 = q0 > 127 ? 127 : (q0 < -127 ? -127 : q0); q1 = q1 > 127 ? 127 : (q1 < -127 ? -127 : q1); b[2 * e] = (unsigned)q0 & 0xffu; b[2 * e + 1] = (unsigned)q1 & 0xffu; }
                    v2u o; o.x = b[0] | (b[1] << 8) | (b[2] << 16) | (b[3] << 24); o.y = b[4] | (b[5] << 8) | (b[6] << 16) | (b[7] << 24);
                    *(v2u*)(qr + 512 * jj) = o; } } }
    }
    if (with_sw) {
        for (int ch = gw; ch < 4 * 512; ch += NGW) {
            const int l = ch >> 9, c = ch & 511;
            const signed char* Wq = (const signed char*)(F.ws + WS_W1T) + (size_t)l * 8192 * 2048;
            const float* sv = WSP(float, WS_MOD) + (size_t)(l * 3) * 12288 + 3 * 2048;
            f32x4 s0[3][4], s1[3][4];
#pragma unroll
            for (int cc = 0; cc < 3; ++cc)
#pragma unroll
                for (int jj = 0; jj < 4; ++jj) { const float* sp = sv + (size_t)cc * 12288 + 8 * lane + 512 * jj; s0[cc][jj] = *(const f32x4*)sp; s1[cc][jj] = *(const f32x4*)(sp + 4); }
            float* so = WSP(float, WS_SW) + (size_t)(2 * l + 1) * 3 * 8192; const float* scol = WSP(float, WS_SCOL) + l * 8192;
#pragma unroll 1
            for (int r = 0; r < 16; ++r) {
                const int n = c * 16 + r; const signed char* wr_ = Wq + (size_t)n * 2048 + 8 * lane;
                float d0 = 0.f, d1 = 0.f, d2 = 0.f;
#pragma unroll
                for (int jj = 0; jj < 4; ++jj) { const v2u w = *(const v2u*)(wr_ + 512 * jj);
                    const f32x4 wa = {(float)(int)(signed char)(w.x & 0xff), (float)(int)(signed char)((w.x >> 8) & 0xff), (float)(int)(signed char)((w.x >> 16) & 0xff), (float)(int)(signed char)(w.x >> 24)};
                    const f32x4 wb = {(float)(int)(signed char)(w.y & 0xff), (float)(int)(signed char)((w.y >> 8) & 0xff), (float)(int)(signed char)((w.y >> 16) & 0xff), (float)(int)(signed char)(w.y >> 24)};
                    f32x4 t = wa * s0[0][jj] + wb * s1[0][jj]; d0 += (t[0] + t[1]) + (t[2] + t[3]);
                    t = wa * s0[1][jj] + wb * s1[1][jj]; d1 += (t[0] + t[1]) + (t[2] + t[3]);
                    t = wa * s0[2][jj] + wb * s1[2][jj]; d2 += (t[0] + t[1]) + (t[2] + t[3]); }
#pragma unroll
                for (int o = 1; o < 64; o <<= 1) { d0 += __shfl_xor(d0, o); d1 += __shfl_xor(d1, o); d2 += __shfl_xor(d2, o); }
                if (lane == 0) { const float sc = scol[n]; so[n] = d0 * sc; so[8192 + n] = d1 * sc; so[2 * 8192 + n] = d2 * sc; }
            }
        }
    }
}
__device__ __forceinline__ void aoq_phase(Frame& F) {
    const int gw = F.bx * NWAVES + F.wave, NGW = F.G * NWAVES, lane = F.lane;
    const bf16* AO = WSP(bf16, WS_AO); signed char* A8 = (signed char*)(F.ws + WS_AO8); float* arow = WSP(float, WS_AROW);
    for (int row0 = gw; row0 < MTOK; row0 += 4 * NGW) {
        v4u w[4][4];
#pragma unroll
        for (int r = 0; r < 4; ++r) { const int row = row0 + r * NGW;
            if (row < MTOK) { const bf16* hr = AO + (size_t)row * DM + 8 * lane;
#pragma unroll
                for (int jj = 0; jj < 4; ++jj) w[r][jj] = *(const v4u*)(hr + 512 * jj); } }
#pragma unroll
        for (int r = 0; r < 4; ++r) { const int row = row0 + r * NGW;
            if (row < MTOK) { float mx = 0.f;
#pragma unroll
                for (int jj = 0; jj < 4; ++jj) {
#pragma unroll
                    for (int e = 0; e < 4; ++e) { mx = fmaxf(mx, fabsf(__builtin_bit_cast(float, w[r][jj][e] << 16))); mx = fmaxf(mx, fabsf(__builtin_bit_cast(float, w[r][jj][e] & 0xffff0000u))); } }
#pragma unroll
                for (int o = 1; o < 64; o <<= 1) mx = fmaxf(mx, __shfl_xor(mx, o));
                mx = fmaxf(mx, 1e-30f); const float inv = 127.f / mx;
                if (lane == 0) arow[row] = mx * (1.f / 127.f);
                signed char* qr = A8 + (size_t)row * DM + 8 * lane;
#pragma unroll
                for (int jj = 0; jj < 4; ++jj) { unsigned b[8];
#pragma unroll
                    for (int e = 0; e < 4; ++e) { int q0 = (int)rintf(__builtin_bit_cast(float, w[r][jj][e] << 16) * inv), q1 = (int)rintf(__builtin_bit_cast(float, w[r][jj][e] & 0xffff0000u) * inv);
                        b[2 * e] = (unsigned)q0 & 0xffu; b[2 * e + 1] = (unsigned)q1 & 0xffu; }
                    v2u o; o.x = b[0] | (b[1] << 8) | (b[2] << 16) | (b[3] << 24); o.y = b[4] | (b[5] << 8) | (b[6] << 16) | (b[7] << 24);
                    *(v2u*)(qr + 512 * jj) = o; } } }
    }
}
__device__ __forceinline__ void final_phase(Frame& F) {
    const int gw = F.bx * NWAVES + F.wave, NGW = F.G * NWAVES, lane = F.lane;
    const float* g = F.in[I_FNORM];
    for (int row0 = gw; row0 < MTOK; row0 += 2 * NGW) {
        f32x4 v[2][8];
#pragma unroll
        for (int r = 0; r < 2; ++r) { const int row = row0 + r * NGW;
            if (row < MTOK) { const float* xr = WSP(float, WS_X) + (size_t)row * DM;
#pragma unroll
                for (int jj = 0; jj < 8; ++jj) v[r][jj] = __builtin_nontemporal_load((const f32x4*)(xr + 4 * lane + 256 * jj)); } }
#pragma unroll
        for (int r = 0; r < 2; ++r) { const int row = row0 + r * NGW;
            if (row < MTOK) { float ss = 0.f;
#pragma unroll
                for (int jj = 0; jj < 8; ++jj) ss += (v[r][jj][0] * v[r][jj][0] + v[r][jj][1] * v[r][jj][1]) + (v[r][jj][2] * v[r][jj][2] + v[r][jj][3] * v[r][jj][3]);
                const float rstd = rsqrtf(wave_sum(ss) * (1.f / 2048.f) + EPS);
                float* orow = F.out + (size_t)row * DM;
#pragma unroll
                for (int jj = 0; jj < 8; ++jj) { const int col = 4 * lane + 256 * jj; *(f32x4*)(orow + col) = v[r][jj] * rstd * *(const f32x4*)(g + col); } } }
    }
}

namespace att {
constexpr int QBLK = 32, KVBLK = 64;
constexpr int SHM_V = 16384, SHM_K = 16384, SHM_KR = 8192;
constexpr int OFF_V = 0, OFF_K = 3 * SHM_V, OFF_KR = 3 * SHM_V + 3 * SHM_K, OFF_WS = OFF_KR + 3 * SHM_KR, OFF_QR = OFF_WS + NWAVES * 64 * 4, LDS_ATT = OFF_QR + NWAVES * 4096;
#define KSWZ(row, colB) ((row) * 256 + ((colB) ^ (((row) & 7) << 4)))
#define KRSWZ(row, chunk) ((row) * 128 + ((((chunk) ^ ((row) >> 1)) & 7) << 4))
__device__ __forceinline__ int crow(int r, int hi) { return (r & 3) + 8 * (r >> 2) + 4 * hi; }
template <int DQK> struct Cst { static constexpr float SCALE = DQK == 128 ? 0.088388347648318440f : 0.072168783648703220f; static constexpr float C = SCALE * 1.4426950408889634f; };
constexpr float THR = 8.f;

template <int DQK>
__device__ __forceinline__ void partialSM(f32x16& p0, f32x16& p1, float& m_reg, float& mn, float& alpha) {
    constexpr float C = Cst<DQK>::C, SCALE = Cst<DQK>::SCALE;
    float pmax = p0[0];
#pragma unroll
    for (int r = 1; r < 16; ++r) pmax = fmaxf(pmax, p0[r]);
#pragma unroll
    for (int r = 0; r < 16; ++r) pmax = fmaxf(pmax, p1[r]);
    { auto rr = __builtin_amdgcn_permlane32_swap(__float_as_uint(pmax), __float_as_uint(pmax), false, false);
      pmax = fmaxf(__uint_as_float(rr[0]), __uint_as_float(rr[1])); }
    if (__builtin_expect(__all(pmax - m_reg <= THR / SCALE), 1)) { mn = m_reg; alpha = 1.f; }
    else { mn = fmaxf(m_reg, pmax); alpha = __builtin_amdgcn_exp2f((m_reg - mn) * C); m_reg = mn; }
    const float mnC = -mn * C;
#pragma unroll
    for (int r = 0; r < 16; ++r) p0[r] = __builtin_amdgcn_exp2f(fmaf(p0[r], C, mnC));
#pragma unroll
    for (int r = 0; r < 16; ++r) p1[r] = __builtin_amdgcn_exp2f(fmaf(p1[r], C, mnC));
}
__device__ __forceinline__ void finishSM(f32x16& p0, f32x16& p1, float alpha, float& l_reg, bf16x8& pa0, bf16x8& pa1, bf16x8& pa2, bf16x8& pa3) {
    float ps = 0;
#pragma unroll
    for (int r = 0; r < 16; ++r) ps += p0[r];
#pragma unroll
    for (int r = 0; r < 16; ++r) ps += p1[r];
    { auto rr = __builtin_amdgcn_permlane32_swap(__float_as_uint(ps), __float_as_uint(ps), false, false);
      ps = __uint_as_float(rr[0]) + __uint_as_float(rr[1]); }
    l_reg = l_reg * alpha + ps;
#define PK4(P, BASE, OUT) do { unsigned a0 = cvtpk(P[BASE + 0], P[BASE + 1]), a1 = cvtpk(P[BASE + 2], P[BASE + 3]);   \
    unsigned b0 = cvtpk(P[BASE + 4], P[BASE + 5]), b1 = cvtpk(P[BASE + 6], P[BASE + 7]);                              \
    auto r0 = __builtin_amdgcn_permlane32_swap(a0, b0, false, false); auto r1 = __builtin_amdgcn_permlane32_swap(a1, b1, false, false); \
    v4u w = {r0[0], r1[0], r0[1], r1[1]}; OUT = *reinterpret_cast<bf16x8*>(&w); } while (0)
    PK4(p0, 0, pa0); PK4(p0, 8, pa1); PK4(p1, 0, pa2); PK4(p1, 8, pa3);
#undef PK4
}
__device__ __forceinline__ int v_st(int k, int c) { const int kk = (k & ~0xC) | ((k & 4) << 1) | ((k & 8) >> 1); return ((kk >> 3) * 4 + (c >> 5)) * 512 + ((kk & 7) * 32 + (c & 31)) * 2; }
__device__ __forceinline__ int v_rd_base(int lane) { return ((lane & 3) << 3) | (((lane >> 2) & 3) << 6) | (((lane >> 4) & 1) << 5) | (((lane >> 5) & 1) << 8); }
constexpr int v_rd_off(int d0, int ks, int half) { return d0 * 512 + ks * 4096 + half * 2048; }
template <int OFF> __device__ __forceinline__ s16x4 tr_read(int vb) {
    s16x4 r; asm volatile("ds_read_b64_tr_b16 %0, %1 offset:%2" : "=&v"(r) : "v"(vb), "i"(OFF) : "memory"); return r;
}
template <int D0> __device__ __forceinline__ void pv_one(f32x16& od, int vb, bf16x8 pa0, bf16x8 pa1, bf16x8 pa2, bf16x8 pa3) {
#define PKV(L, H) (bf16x8){L[0], L[1], L[2], L[3], H[0], H[1], H[2], H[3]}
    const s16x4 l0 = tr_read<v_rd_off(D0, 0, 0)>(vb), h0 = tr_read<v_rd_off(D0, 0, 1)>(vb), l1 = tr_read<v_rd_off(D0, 1, 0)>(vb), h1 = tr_read<v_rd_off(D0, 1, 1)>(vb);
    asm volatile("s_waitcnt lgkmcnt(0)" ::: "memory"); SBAR();
    od = __builtin_amdgcn_mfma_f32_32x32x16_bf16(pa0, PKV(l0, h0), od, 0, 0, 0);
    const s16x4 l2 = tr_read<v_rd_off(D0, 2, 0)>(vb), h2 = tr_read<v_rd_off(D0, 2, 1)>(vb);
    od = __builtin_amdgcn_mfma_f32_32x32x16_bf16(pa1, PKV(l1, h1), od, 0, 0, 0);
    const s16x4 l3 = tr_read<v_rd_off(D0, 3, 0)>(vb), h3 = tr_read<v_rd_off(D0, 3, 1)>(vb);
    asm volatile("s_waitcnt lgkmcnt(0)" ::: "memory"); SBAR();
    od = __builtin_amdgcn_mfma_f32_32x32x16_bf16(pa2, PKV(l2, h2), od, 0, 0, 0);
    od = __builtin_amdgcn_mfma_f32_32x32x16_bf16(pa3, PKV(l3, h3), od, 0, 0, 0);
#undef PKV
}

template <int D0> __device__ __forceinline__ void v_ld8(s16x4 (&f)[8], int vb) {
    f[0] = tr_read<v_rd_off(D0, 0, 0)>(vb); f[1] = tr_read<v_rd_off(D0, 0, 1)>(vb); f[2] = tr_read<v_rd_off(D0, 1, 0)>(vb); f[3] = tr_read<v_rd_off(D0, 1, 1)>(vb);
    f[4] = tr_read<v_rd_off(D0, 2, 0)>(vb); f[5] = tr_read<v_rd_off(D0, 2, 1)>(vb); f[6] = tr_read<v_rd_off(D0, 3, 0)>(vb); f[7] = tr_read<v_rd_off(D0, 3, 1)>(vb);
}
__device__ __forceinline__ void pv_mm(f32x16& od, const s16x4 (&f)[8], bf16x8 pa0, bf16x8 pa1, bf16x8 pa2, bf16x8 pa3) {
#define PKV(L, H) (bf16x8){L[0], L[1], L[2], L[3], H[0], H[1], H[2], H[3]}
    od = __builtin_amdgcn_mfma_f32_32x32x16_bf16(pa0, PKV(f[0], f[1]), od, 0, 0, 0);
    od = __builtin_amdgcn_mfma_f32_32x32x16_bf16(pa1, PKV(f[2], f[3]), od, 0, 0, 0);
    od = __builtin_amdgcn_mfma_f32_32x32x16_bf16(pa2, PKV(f[4], f[5]), od, 0, 0, 0);
    od = __builtin_amdgcn_mfma_f32_32x32x16_bf16(pa3, PKV(f[6], f[7]), od, 0, 0, 0);
#undef PKV
}
__device__ __forceinline__ void pv_all(f32x16 (&o)[4], int vb, bf16x8 pa0, bf16x8 pa1, bf16x8 pa2, bf16x8 pa3) {
    s16x4 A[8], B[8];
    v_ld8<0>(A, vb); v_ld8<1>(B, vb);
    asm volatile("s_waitcnt lgkmcnt(8)" ::: "memory"); SBAR(); pv_mm(o[0], A, pa0, pa1, pa2, pa3); SBAR();
    v_ld8<2>(A, vb);
    asm volatile("s_waitcnt lgkmcnt(8)" ::: "memory"); SBAR(); pv_mm(o[1], B, pa0, pa1, pa2, pa3); SBAR();
    v_ld8<3>(B, vb);
    asm volatile("s_waitcnt lgkmcnt(8)" ::: "memory"); SBAR(); pv_mm(o[2], A, pa0, pa1, pa2, pa3); SBAR();
    asm volatile("s_waitcnt lgkmcnt(0)" ::: "memory"); SBAR(); pv_mm(o[3], B, pa0, pa1, pa2, pa3); SBAR();
}

template <int DQK, bool MASKED>
__device__ __forceinline__ void attn_unit(const bf16* __restrict__ Qb, int ldq,
                                          const bf16* __restrict__ KA, const bf16* __restrict__ VA, const bf16* __restrict__ KRA, int nA,
                                          const bf16* __restrict__ KB, const bf16* __restrict__ VB, const bf16* __restrict__ KRB, int nB,
                                          int ldk, int qpos0, int kposB0, float sink_l2, bf16* __restrict__ Ob, char* lds) {
    constexpr int ND = 8;
    constexpr float C = Cst<DQK>::C;
    const int tid = threadIdx.x, wid = tid >> 6, lane = tid & 63, r32 = lane & 31, hi = lane >> 5;
    float* wsf = (float*)(lds + OFF_WS) + wid * 64; float* li_l = wsf; float* al_l = wsf + 32;
    float m_reg = -1e30f, l_reg = 0.f; f32x16 o[4] = {}; bf16x8 qr[ND];
    const bf16* Qw = Qb + (size_t)(wid * QBLK + r32) * ldq + hi * 8;
#pragma unroll
    for (int d0 = 0; d0 < ND; ++d0) qr[d0] = *reinterpret_cast<const bf16x8*>(Qw + d0 * 16);
    if constexpr (DQK == 192) {
#pragma unroll
        for (int dd = 0; dd < 4; ++dd) { const bf16x8 qv = *reinterpret_cast<const bf16x8*>(Qw + 128 + dd * 16); *(bf16x8*)(lds + OFF_QR + wid * 4096 + KRSWZ(r32, dd * 2 + hi)) = qv; }
    }
    const int vb0 = (int)(uintptr_t)(LAS char*)(lds + OFF_V) + v_rd_base(lane);
    const int NT = nA + nB;
    unsigned gok, gov, gor;
    { const int krow = 4 * wid + (lane >> 4); gok = (unsigned)(krow * ldk) * 2u + (unsigned)(((lane & 15) << 4) ^ ((krow & 7) << 4));
      const int kk = 8 * (wid >> 1) + ((lane & 31) >> 2), kv = (kk & ~0xC) | ((kk & 4) << 1) | ((kk & 8) >> 1), cv = 32 * (2 * (wid & 1) + (lane >> 5)) + ((lane & 3) << 3);
      gov = (unsigned)(kv * ldk + cv) * 2u;
      const int rrow = 8 * wid + (lane >> 3); gor = (unsigned)(rrow * 128 + ((((lane & 7) ^ (rrow >> 1)) & 7) << 4)); }
    const unsigned g32 = (unsigned)(32 * ldk) * 2u;
    LAS char* const L3 = (LAS char*)lds;
#define SLOAD(t, b) do { const bool inA_ = (t) < nA; const int tt_ = inA_ ? (t) : (t) - nA; const char* Kt_ = (const char*)((inA_ ? KA : KB) + (size_t)tt_ * 64 * ldk); const char* Vt_ = (const char*)((inA_ ? VA : VB) + (size_t)tt_ * 64 * ldk); \
    __builtin_amdgcn_global_load_lds((const unsigned*)(Kt_ + gok), (LAS unsigned*)(L3 + OFF_K + (b) * SHM_K + wid * 1024), 16, 0, 0); \
    __builtin_amdgcn_global_load_lds((const unsigned*)(Kt_ + gok + g32), (LAS unsigned*)(L3 + OFF_K + (b) * SHM_K + 8192 + wid * 1024), 16, 0, 0); \
    __builtin_amdgcn_global_load_lds((const unsigned*)(Vt_ + gov), (LAS unsigned*)(L3 + OFF_V + (b) * SHM_V + wid * 1024), 16, 0, 0); \
    __builtin_amdgcn_global_load_lds((const unsigned*)(Vt_ + gov + g32), (LAS unsigned*)(L3 + OFF_V + (b) * SHM_V + 8192 + wid * 1024), 16, 0, 0); \
    if constexpr (DQK == 192) { const char* Rt_ = (const char*)((inA_ ? KRA : KRB) + (size_t)tt_ * 64 * 64); \
        __builtin_amdgcn_global_load_lds((const unsigned*)(Rt_ + gor), (LAS unsigned*)(L3 + OFF_KR + (b) * SHM_KR + wid * 1024), 16, 0, 0); } } while (0)
#define KLD_(dg, A0, A1) _Pragma("unroll") for (int dd = 0; dd < 2; ++dd) { const int cb_ = (((dg) * 2 + dd) * 16 + hi * 8) * 2; const LAS char* ka_ = (const LAS char*)(uintptr_t)(unsigned)(kb0_ + (cb_ ^ sw_)); A0[dd] = *reinterpret_cast<const LAS bf16x8*>(ka_); A1[dd] = *reinterpret_cast<const LAS bf16x8*>(ka_ + 32 * 256); }
#define KMM_(dg, A0, A1, P0, P1) _Pragma("unroll") for (int dd = 0; dd < 2; ++dd) { P0 = __builtin_amdgcn_mfma_f32_32x32x16_bf16(A0[dd], qr[(dg) * 2 + dd], P0, 0, 0, 0); P1 = __builtin_amdgcn_mfma_f32_32x32x16_bf16(A1[dd], qr[(dg) * 2 + dd], P1, 0, 0, 0); }
#define RLD_(dg, A0, A1, QF) _Pragma("unroll") for (int dd = 0; dd < 2; ++dd) { const int ch_ = ((dg) * 2 + dd) * 2 + hi; const int so_ = ((ch_ ^ rs_) & 7) << 4; const LAS char* ra_ = (const LAS char*)(uintptr_t)(unsigned)(rb0_ + so_); \
        A0[dd] = *reinterpret_cast<const LAS bf16x8*>(ra_); A1[dd] = *reinterpret_cast<const LAS bf16x8*>(ra_ + 32 * 128); QF[dd] = *reinterpret_cast<const LAS bf16x8*>((const LAS char*)(uintptr_t)(unsigned)(qb0_ + so_)); }
#define RMM_(A0, A1, QF, P0, P1) _Pragma("unroll") for (int dd = 0; dd < 2; ++dd) { P0 = __builtin_amdgcn_mfma_f32_32x32x16_bf16(A0[dd], QF[dd], P0, 0, 0, 0); P1 = __builtin_amdgcn_mfma_f32_32x32x16_bf16(A1[dd], QF[dd], P1, 0, 0, 0); }
#define QKT(P0, P1, b) do { P0 = f32x16{}; P1 = f32x16{}; int kb0_ = (int)(uintptr_t)(LAS char*)(lds + OFF_K) + (b) * SHM_K + r32 * 256, sw_ = (r32 & 7) << 4; asm volatile("" : "+v"(kb0_), "+v"(sw_));   \
    bf16x8 xa0_[2], xa1_[2], xb0_[2], xb1_[2]; \
    KLD_(0, xa0_, xa1_); SBAR(); \
    KLD_(1, xb0_, xb1_); SBAR(); KMM_(0, xa0_, xa1_, P0, P1); SBAR(); \
    KLD_(2, xa0_, xa1_); SBAR(); KMM_(1, xb0_, xb1_, P0, P1); SBAR(); \
    KLD_(3, xb0_, xb1_); SBAR(); KMM_(2, xa0_, xa1_, P0, P1); SBAR(); \
    if constexpr (DQK == 192) { int rb0_ = (int)(uintptr_t)(LAS char*)(lds + OFF_KR) + (b) * SHM_KR + r32 * 128, rs_ = (r32 >> 1) & 7, qb0_ = (int)(uintptr_t)(LAS char*)(lds + OFF_QR) + wid * 4096 + r32 * 128; asm volatile("" : "+v"(rb0_), "+v"(rs_), "+v"(qb0_)); \
        bf16x8 qa_[2], qb_[2]; \
        RLD_(0, xa0_, xa1_, qa_); SBAR(); KMM_(3, xb0_, xb1_, P0, P1); SBAR(); \
        RLD_(1, xb0_, xb1_, qb_); SBAR(); RMM_(xa0_, xa1_, qa_, P0, P1); SBAR(); \
        RMM_(xb0_, xb1_, qb_, P0, P1); SBAR(); } \
    else { KMM_(3, xb0_, xb1_, P0, P1); SBAR(); } } while (0)
#define MASKT(P0, P1, t) do { if constexpr (MASKED) { if ((t) >= nA) { const int qp_ = qpos0 + wid * QBLK + r32, kb_ = kposB0 + ((t) - nA) * 64; \
    _Pragma("unroll") for (int r = 0; r < 16; ++r) { const int d_ = qp_ - (kb_ + crow(r, hi)); if (d_ > 128 || d_ < -128) P0[r] = -1e30f; const int d2_ = d_ - 32; if (d2_ > 128 || d2_ < -128) P1[r] = -1e30f; } } } } while (0)
#define RESC(a) do { if (__any((a) < 1.f)) { if (hi == 0) al_l[r32] = (a); LDS_WAIT(); \
    _Pragma("unroll") for (int r = 0; r < 16; ++r) { const float al_ = al_l[crow(r, hi)]; _Pragma("unroll") for (int d = 0; d < 4; ++d) o[d][r] *= al_; } } } while (0)
#define PV(b) do { pv_all(o, vb0 + (b) * SHM_V, pa0, pa1, pa2, pa3); } while (0)
    constexpr int NL = DQK == 192 ? 5 : 4;
    f32x16 p0, p1; float mn, al; bf16x8 pa0, pa1, pa2, pa3;
    SLOAD(0, 0); if (NT > 1) SLOAD(1, 1);
    int sc = 0;
    for (int t = 0; t < NT; ++t) {
        if (t + 1 < NT) { if constexpr (NL == 5) asm volatile("s_waitcnt vmcnt(5)" ::: "memory"); else asm volatile("s_waitcnt vmcnt(4)" ::: "memory"); } else { VM_WAIT(); }
        __syncthreads();
        const int sn = sc == 0 ? 2 : sc - 1;
        if (t + 2 < NT) SLOAD(t + 2, sn);
        SBAR(); QKT(p0, p1, sc); MASKT(p0, p1, t);
        partialSM<DQK>(p0, p1, m_reg, mn, al);
        RESC(al);
        finishSM(p0, p1, al, l_reg, pa0, pa1, pa2, pa3); SBAR();
        PV(sc);
        sc = sc == 2 ? 0 : sc + 1;
    }
    l_reg += __builtin_amdgcn_exp2f(sink_l2 - m_reg * C);
    if (hi == 0) li_l[r32] = l_reg; LDS_WAIT();
    int obase = (wid * QBLK + 4 * hi) * 2048 + r32; asm volatile("" : "+v"(obase));
#pragma unroll
    for (int r = 0; r < 16; ++r) { const float rl = __builtin_amdgcn_rcpf(li_l[crow(r, hi)]); const int ro = ((r & 3) + 8 * (r >> 2)) * 2048;
#pragma unroll
        for (int d0 = 0; d0 < 4; ++d0) *(bf16*)((char*)Ob + (unsigned)(obase + ro + d0 * 32) * 2u) = (bf16)f2bf(o[d0][r] * rl); }
    LDS_WAIT();
    __syncthreads();
#undef SLOAD
#undef QKT
#undef KLD_
#undef KMM_
#undef RLD_
#undef RMM_
#undef MASKT
#undef RESC
#undef PV
}
}

__device__ __forceinline__ void attn_win_phase(Frame& F, int j) {
    const bf16* Q = WSP(bf16, WS_WQ); const bf16* K = WSP(bf16, WS_WK); const bf16* V = WSP(bf16, WS_WV); bf16* O = WSP(bf16, WS_AO);
    const bf16* CK = WSP(bf16, WS_CTXK) + (size_t)j * 2 * 512 * 512; const bf16* CV = WSP(bf16, WS_CTXV) + (size_t)j * 2 * 512 * 512;
    for (int un = F.bx; un < 512; un += F.G) {
        const int h = un & 15, kvh = h >> 2; const float sink = F.in[I_SINK][j * 16 + h] * 1.4426950408889634f;
        const int qb = un >> 4, bs = qb >> 4, t0 = (qb & 15) * 256, row0 = MP + qb * 256;
        int kt0 = (t0 >> 6) - 2, kt1 = (t0 >> 6) + 5; if (kt0 < 0) kt0 = 0; if (kt1 > 63) kt1 = 63;
        const size_t kb = (size_t)(MP + bs * 4096 + kt0 * 64) * 512 + kvh * 128;
        att::attn_unit<128, true>(Q + (size_t)row0 * 2048 + h * 128, 2048, CK + (size_t)bs * 512 * 512 + kvh * 128, CV + (size_t)bs * 512 * 512 + kvh * 128, nullptr, 8,
                                 K + kb, V + kb, nullptr, kt1 - kt0 + 1, 512, t0, kt0 * 64, sink, O + (size_t)row0 * 2048 + h * 128, (char*)F.ldsg);
    }
    for (int un = F.bx; un < 512; un += F.G) {
        const int h = un & 15, kvh = h >> 2; const float sink = F.in[I_SINK][j * 16 + h] * 1.4426950408889634f;
        const int b = un >> 4, row0 = b * 256; const size_t kb = (size_t)row0 * 512 + kvh * 128;
        att::attn_unit<128, false>(Q + (size_t)row0 * 2048 + h * 128, 2048, nullptr, nullptr, nullptr, 0,
                                  K + kb, V + kb, nullptr, 4, 512, 0, 0, sink, O + (size_t)row0 * 2048 + h * 128, (char*)F.ldsg);
    }
}
__device__ __forceinline__ void attn_mla_phase(Frame& F) {
    const bf16* Q = WSP(bf16, WS_MQ); const bf16* KN = WSP(bf16, WS_MKN); const bf16* V = WSP(bf16, WS_MV); const bf16* KR = WSP(bf16, WS_MKR); bf16* O = WSP(bf16, WS_AO);
    for (int un = F.bx; un < 512; un += F.G) {
        const int h = un & 15, qb = un >> 4, bs = qb >> 4, row0 = MP + qb * 256;
        const size_t ra = (size_t)bs * 512, rb = (size_t)1024 + MP + bs * 4096;
        att::attn_unit<192, false>(Q + (size_t)row0 * 3072 + h * 192, 3072, KN + ra * 2048 + h * 128, V + ra * 2048 + h * 128, KR + ra * 64, 8,
                                  KN + rb * 2048 + h * 128, V + rb * 2048 + h * 128, KR + rb * 64, 64, 2048, 0, 0, -1e30f, O + (size_t)row0 * 2048 + h * 128, (char*)F.ldsg);
    }
    for (int un = F.bx; un < 512; un += F.G) {
        const int h = un & 15, b = un >> 4, row0 = b * 256; const size_t rb = (size_t)1024 + row0;
        att::attn_unit<192, false>(Q + (size_t)row0 * 3072 + h * 192, 3072, nullptr, nullptr, nullptr, 0,
                                  KN + rb * 2048 + h * 128, V + rb * 2048 + h * 128, KR + rb * 64, 4, 2048, 0, 0, -1e30f, O + (size_t)row0 * 2048 + h * 128, (char*)F.ldsg);
    }
}

__device__ __forceinline__ void mla_norm_phase(Frame& F) {
    const int gw = F.bx * NWAVES + F.wave, NGW = F.G * NWAVES, lane = F.lane;
    const float* D = WSP(float, WS_MD); bf16* CQ = WSP(bf16, WS_MCQ); bf16* CKV = WSP(bf16, WS_MCKV); bf16* KR = WSP(bf16, WS_MKR);
    const f32x2* tab = WSP(f32x2, WS_TABM);
    const float* qn = F.in[I_MQN]; const float* kvn = F.in[I_MKVN];
    for (int row = gw; row < MTOK; row += NGW) {
        const float* d = D + (size_t)row * 1024;
        {
            const f32x4 v0 = *(const f32x4*)(d + 4 * lane), v1 = *(const f32x4*)(d + 256 + 4 * lane);
            float ss = (v0[0] * v0[0] + v0[1] * v0[1]) + (v0[2] * v0[2] + v0[3] * v0[3]) + (v1[0] * v1[0] + v1[1] * v1[1]) + (v1[2] * v1[2] + v1[3] * v1[3]);
            const float rstd = rsqrtf(wave_sum(ss) * (1.f / 512.f) + EPS);
            const f32x4 y0 = v0 * rstd * *(const f32x4*)(qn + 4 * lane), y1 = v1 * rstd * *(const f32x4*)(qn + 256 + 4 * lane);
            v2u w; w.x = cvtpk(y0[0], y0[1]); w.y = cvtpk(y0[2], y0[3]); *(v2u*)(CQ + (size_t)row * 512 + 4 * lane) = w;
            w.x = cvtpk(y1[0], y1[1]); w.y = cvtpk(y1[2], y1[3]); *(v2u*)(CQ + (size_t)row * 512 + 256 + 4 * lane) = w;
        }
        {
            const f32x4 v0 = *(const f32x4*)(d + 512 + 4 * lane);
            float ss = (v0[0] * v0[0] + v0[1] * v0[1]) + (v0[2] * v0[2] + v0[3] * v0[3]);
            const float rstd = rsqrtf(wave_sum(ss) * (1.f / 256.f) + EPS);
            const f32x4 y0 = v0 * rstd * *(const f32x4*)(kvn + 4 * lane);
            v2u w; w.x = cvtpk(y0[0], y0[1]); w.y = cvtpk(y0[2], y0[3]); *(v2u*)(CKV + (size_t)(1024 + row) * 256 + 4 * lane) = w;
            if (row < MP) *(f32x4*)(F.out + O_CKV + (size_t)row * 256 + 4 * lane) = y0;
        }
        if (lane < 8) {
            const int ug = lane, idx0 = (ug & 3) * 4, d1 = (ug < 4 ? 0 : 32) + idx0;
            f32x4 a = *(const f32x4*)(d + 768 + 8 * ug), b = *(const f32x4*)(d + 768 + 8 * ug + 4);
            if (row < MP) { float* op = F.out + O_KR + (size_t)row * 64 + d1; *(f32x4*)op = a; *(f32x4*)(op + 16) = b; }
            else { const int t = row & 4095, pos = (ug < 4) ? (t >> 6) : (t & 63); const f32x4* tp = (const f32x4*)(tab + pos * 16 + idx0); const f32x4 cs0 = tp[0], cs1 = tp[1];
                const f32x4 co = {cs0[0], cs0[2], cs1[0], cs1[2]}, si = {cs0[1], cs0[3], cs1[1], cs1[3]};
                const f32x4 na = a * co - b * si, nb = b * co + a * si; a = na; b = nb; }
            *(v4u*)(KR + (size_t)(1024 + row) * 64 + 8 * ug) = pack8(a, b);
        }
    }
    const int gt = F.bx * 512 + F.tid, NGT = F.G * 512;
    for (int e = gt; e < 1024 * 256; e += NGT) CKV[e] = (bf16)f2bf(F.in[I_CCKV][e]);
    for (int e = gt; e < 1024 * 64; e += NGT) KR[e] = (bf16)f2bf(F.in[I_CKR][(e & ~63) + perm_mla(e & 63)]);
}

typedef short v4i16_t __attribute__((ext_vector_type(4)));
__device__ __forceinline__ s16x4 vtr(const LAS char* p) { return __builtin_bit_cast(s16x4, __builtin_amdgcn_ds_read_tr16_b64_v4i16((LAS v4i16_t*)p)); }
#define MFMA16(a, b, c) __builtin_amdgcn_mfma_f32_16x16x32_bf16((a), (b), (c), 0, 0, 0)
#define CAT8(L, H) (bf16x8){L[0], L[1], L[2], L[3], H[0], H[1], H[2], H[3]}
typedef __bf16 bf16x2_t __attribute__((ext_vector_type(2)));
typedef float f32x2_t __attribute__((ext_vector_type(2)));
__device__ __forceinline__ unsigned cvtpk2(float lo, float hi) { f32x2_t v = {lo, hi}; bf16x2_t b = __builtin_convertvector(v, bf16x2_t); return __builtin_bit_cast(unsigned, b); }

__device__ __forceinline__ void gla_u_phase(Frame& F) {
    const int lane = F.lane, wave = F.wave, tid = F.tid, cl = lane & 15, gq = lane >> 4;
    const bf16* H = WSP(bf16, WS_H); const bf16* Wt = WSP(bf16, WS_GWINT) + (size_t)6144 * DM;
    const float* part = WSP(float, WS_PART) + (size_t)4 * MTOK * 32; const float* sW = WSP(float, WS_SW) + (size_t)4 * 3 * 8192 + 6144;
    float* GU = WSP(float, WS_GU);
    LAS float* red = (LAS float*)F.lds;
    __syncthreads();
    for (int rb = F.bx; rb < MTOK / 64; rb += F.G) {
        const int row0 = rb * 64;
        f32x4 acc[4][2];
#pragma unroll
        for (int mi = 0; mi < 4; ++mi) { acc[mi][0] = (f32x4){0.f, 0.f, 0.f, 0.f}; acc[mi][1] = (f32x4){0.f, 0.f, 0.f, 0.f}; }
        const bf16* ap = H + (size_t)(row0 + cl) * DM + wave * 256 + 16 * gq;
        const bf16* bp = Wt + (size_t)cl * DM + wave * 256 + 16 * gq;
#pragma unroll
        for (int ks = 0; ks < 4; ++ks) {
            bf16x8 a[4][2], b[2][2];
#pragma unroll
            for (int mi = 0; mi < 4; ++mi) { a[mi][0] = *(const bf16x8*)(ap + (size_t)mi * 16 * DM + 64 * ks); a[mi][1] = *(const bf16x8*)(ap + (size_t)mi * 16 * DM + 64 * ks + 8); }
#pragma unroll
            for (int nj = 0; nj < 2; ++nj) { b[nj][0] = *(const bf16x8*)(bp + (size_t)nj * 16 * DM + 64 * ks); b[nj][1] = *(const bf16x8*)(bp + (size_t)nj * 16 * DM + 64 * ks + 8); }
#pragma unroll
            for (int mi = 0; mi < 4; ++mi)
#pragma unroll
                for (int nj = 0; nj < 2; ++nj) { acc[mi][nj] = MFMA16(a[mi][0], b[nj][0], acc[mi][nj]); acc[mi][nj] = MFMA16(a[mi][1], b[nj][1], acc[mi][nj]); }
        }
#pragma unroll
        for (int mi = 0; mi < 4; ++mi)
#pragma unroll
            for (int nj = 0; nj < 2; ++nj)
#pragma unroll
                for (int r = 0; r < 4; ++r) red[(wave * 64 + 16 * mi + 4 * gq + r) * 32 + 16 * nj + cl] = acc[mi][nj][r];
        __syncthreads();
        {
            const int rr = tid >> 3, c4 = (tid & 7) * 4, row = row0 + rr;
            f32x4 t = *(const LAS f32x4*)(red + rr * 32 + c4);
#pragma unroll
            for (int w = 1; w < 8; ++w) t += *(const LAS f32x4*)(red + (w * 64 + rr) * 32 + c4);
            const f32x4* pp = (const f32x4*)(part + (size_t)row * 32); f32x4 ps = pp[0];
#pragma unroll
            for (int i = 1; i < 8; ++i) ps += pp[i];
            const float rstd = rsqrtf(((ps[0] + ps[1]) + (ps[2] + ps[3])) * (1.f / 2048.f) + EPS);
            *(f32x4*)(GU + (size_t)row * 32 + c4) = t * rstd + *(const f32x4*)(sW + (size_t)cond_of_pm(row >> 8) * 8192 + c4);
        }
        __syncthreads();
    }
}
__device__ __forceinline__ void gla_prep_phase(Frame& F) {
    constexpr int PQ = 528, OQ = 0, OK_ = 64 * PQ, OKT = 2 * 64 * PQ, OUB = 3 * 64 * PQ, OHT = OUB + 4096, OAT = OHT + 2048;
    LAS char* L = (LAS char*)F.lds; const int tid = F.tid, lane = F.lane, wave = F.wave;
    const bf16* GQ = WSP(bf16, WS_GQ); const bf16* GK = WSP(bf16, WS_GK); const float* GU = WSP(float, WS_GU);
    v4u pq[4], pk[4]; f32x4 pu = {0.f, 0.f, 0.f, 0.f};
#define GLA_PREP_LOAD(UN) do { const int d_ = (UN) & 1, ch_ = (UN) >> 1, r0_ = (ch_ >> 2) * 64, h_ = ch_ & 3; \
        _Pragma("unroll") for (int i = 0; i < 4; ++i) { const int e = tid + 512 * i, row = e >> 5, cc = e & 31; const size_t go = (size_t)(r0_ + row) * 1024 + h_ * 256 + cc * 8; pq[i] = *(const v4u*)(GQ + go); pk[i] = *(const v4u*)(GK + go); } \
        if (tid < 256) pu = *(const f32x4*)(GU + (size_t)(r0_ + (tid >> 2)) * 32 + d_ * 16 + (tid & 3) * 4); } while (0)
    if (F.bx < 2048) GLA_PREP_LOAD(F.bx);
    float w[16]; float bias = 0.f; int cur_dh = -1;
#pragma unroll
    for (int r = 0; r < 16; ++r) w[r] = 0.f;
    for (int un = F.bx; un < 2048; un += F.G) {
        const int d = un & 1, ch = un >> 1, c = ch >> 2, h = ch & 3, row0 = c * 64;
        bf16* QT = WSP(bf16, WS_GQT) + (size_t)d * MTOK * 1024; bf16* KD = WSP(bf16, WS_GKD) + (size_t)d * MTOK * 1024;
        bf16* AM = WSP(bf16, WS_GAM) + ((size_t)d * 1024 + ch) * 4096; float* DEC = WSP(float, WS_GDEC) + ((size_t)d * 1024 + ch) * 256;
        if ((un & 7) != cur_dh) { cur_dh = un & 7; const int col = tid & 255;
#pragma unroll
            for (int r = 0; r < 16; ++r) w[r] = F.in[I_GWA2][((size_t)d * 16 + r) * 1024 + h * 256 + col] * 1.44269504f;
            bias = F.in[I_GBA][d * 1024 + h * 256 + col] * 1.44269504f; }
#pragma unroll
        for (int i = 0; i < 4; ++i) { const int e = tid + 512 * i, row = e >> 5, cc = e & 31;
            *(LAS v4u*)(L + OQ + row * PQ + cc * 16) = pq[i]; *(LAS v4u*)(L + OK_ + row * PQ + cc * 16) = pk[i]; }
        if (tid < 256) { const int row = tid >> 2, q4 = tid & 3; *(LAS f32x4*)(L + OUB + (row * 16 + q4 * 4) * 4) = pu; }
        __syncthreads();
        if (un + F.G < 2048) GLA_PREP_LOAD(un + F.G);
        {
            const int hf = tid >> 8, col = tid & 255;
            float g[32]; float tot = 0.f;
#pragma unroll
            for (int ii = 0; ii < 32; ++ii) { const int i = hf * 32 + ii; float z = bias;
#pragma unroll
                for (int q4 = 0; q4 < 4; ++q4) { const f32x4 uv = *(const LAS f32x4*)(L + OUB + (i * 16 + q4 * 4) * 4); z += uv[0] * w[4 * q4] + uv[1] * w[4 * q4 + 1] + uv[2] * w[4 * q4 + 2] + uv[3] * w[4 * q4 + 3]; }
                const float ls = fminf(z, 0.f) - __builtin_amdgcn_logf(1.f + __builtin_amdgcn_exp2f(-fabsf(z)));
                g[ii] = ls * 0.0625f; tot += g[ii]; }
            ((LAS float*)(L + OHT))[hf * 256 + col] = tot;
            __syncthreads();
            const float other = ((const LAS float*)(L + OHT))[(1 - hf) * 256 + col];
            const float T = tot + other, eT = __builtin_amdgcn_exp2f(T);
            float run = (d == 0) ? (hf == 1 ? other : 0.f) : (hf == 0 ? other : 0.f);
            if (hf == 0) DEC[col] = eT;
#pragma unroll
            for (int s = 0; s < 32; ++s) {
                const int ii = (d == 0) ? s : 31 - s;
                run += (d == 0) ? g[s] : g[31 - s];
                const int i = hf * 32 + ii;
                LAS bf16* qp = (LAS bf16*)(L + OQ + i * PQ) + col; LAS bf16* kp = (LAS bf16*)(L + OK_ + i * PQ) + col; LAS bf16* ktp = (LAS bf16*)(L + OKT + i * PQ) + col;
                const float qv = bf2f(*qp), kv = bf2f(*kp);
                const float kt = kv * __builtin_amdgcn_exp2f(-run);
                const unsigned wq = cvtpk(qv * __builtin_amdgcn_exp2f(run), kt), wk = cvtpk(kt * eT, 0.f);
                *qp = (bf16)(wq & 0xffffu); *ktp = (bf16)(wq >> 16); *kp = (bf16)(wk & 0xffffu);
            }
        }
        __syncthreads();
        {
            const int gq = lane >> 4, cl = lane & 15;
#pragma unroll
            for (int s2 = 0; s2 < 2; ++s2) {
                const int T16 = 2 * wave + s2, ti = T16 >> 2, tj = T16 & 3;
                f32x4 acc = {0.f, 0.f, 0.f, 0.f};
#pragma unroll
                for (int ks = 0; ks < 8; ++ks) {
                    const bf16x8 a = *(const LAS bf16x8*)(L + OQ + (16 * ti + cl) * PQ + (32 * ks + 8 * gq) * 2);
                    const bf16x8 b = *(const LAS bf16x8*)(L + OKT + (16 * tj + cl) * PQ + (32 * ks + 8 * gq) * 2);
                    acc = MFMA16(a, b, acc);
                }
                const int jcol = 16 * tj + cl;
#pragma unroll
                for (int r = 0; r < 4; ++r) { const int i = 16 * ti + 4 * gq + r; const bool keep = (d == 0) ? (jcol <= i) : (jcol >= i);
                    ((LAS bf16*)(L + OAT))[i * 64 + jcol] = (bf16)f2bf(keep ? acc[r] : 0.f); }
            }
        }
        __syncthreads();
#pragma unroll
        for (int i = 0; i < 4; ++i) { const int e = tid + 512 * i, row = e >> 5, cc = e & 31; const size_t go = (size_t)(row0 + row) * 1024 + h * 256 + cc * 8;
            *(v4u*)(QT + go) = *(const LAS v4u*)(L + OQ + row * PQ + cc * 16); *(v4u*)(KD + go) = *(const LAS v4u*)(L + OK_ + row * PQ + cc * 16); }
        *(v4u*)(AM + tid * 8) = *(const LAS v4u*)(L + OAT + tid * 16);
        __syncthreads();
    }
#undef GLA_PREP_LOAD
}

constexpr int GLA_NSEG = 4, GLA_SEGCH = 16;
template <bool LIGHT>
__device__ __forceinline__ void gla_scan_item(Frame& F, int seq, int h, int d, int sl, int seg) {
    constexpr int PQ = 528, PK = 544, PA = 136, PV = 288;
    constexpr int OQ = 0, OK_ = 64 * PQ, OA = OK_ + 64 * PK, OV = OA + 64 * PA, ODEC = OV + 64 * PV;
    LAS char* L = (LAS char*)F.lds; const int tid = F.tid, lane = F.lane, wave = F.wave, gq = lane >> 4, cl = lane & 15;
    const bool sample = seq >= 32; const int base = sample ? MP + (seq - 32) * 4096 : seq * 256, ntot = sample ? 64 : 4;
    const int p0 = sample ? seg * GLA_SEGCH : 0, nch = sample ? GLA_SEGCH : 4;
    const bf16* QT = WSP(bf16, WS_GQT) + (size_t)d * MTOK * 1024; const bf16* KD = WSP(bf16, WS_GKD) + (size_t)d * MTOK * 1024;
    const bf16* AM = WSP(bf16, WS_GAM) + (size_t)d * 1024 * 4096; const float* DEC = WSP(float, WS_GDEC) + (size_t)d * 1024 * 256;
    const bf16* GV = WSP(bf16, WS_GV); bf16* OD = WSP(bf16, d == 0 ? WS_GOF : WS_GOB);
    const int dvc = h * 512 + sl * 128;
    const int sidx = sample ? (((seq - 32) * 4 + h) * 2 + d) : 0;
    float* GLs = WSP(float, WS_GLS); float* GDS = WSP(float, WS_GDS);
    f32x4 S[16];
#pragma unroll
    for (int t = 0; t < 16; ++t) S[t] = (f32x4){0.f, 0.f, 0.f, 0.f};
    if (sample && !LIGHT) {
        { const float* s0 = F.in[d == 0 ? I_SGF : I_SGB] + ((size_t)((seq - 32) * 4 + h) * 256) * 512 + sl * 128 + 16 * wave;
          int lb = (4 * gq) * 512 + cl; asm volatile("" : "+v"(lb));
#pragma unroll
          for (int t = 0; t < 16; ++t)
#pragma unroll
            for (int r = 0; r < 4; ++r) S[t][r] = s0[(unsigned)(lb + (16 * t + r) * 512)]; }
        for (int g = 0; g < seg; ++g) {
            const float* Lg = GLs + ((size_t)(sidx * 3 + g) * 256) * 512 + sl * 128 + 16 * wave; const float* Dg = GDS + (size_t)(sidx * 3 + g) * 256;
            int lb = (4 * gq) * 512 + cl, db = 4 * gq; asm volatile("" : "+v"(lb), "+v"(db));
#pragma unroll
            for (int t = 0; t < 16; ++t) { const f32x4 dg = *(const f32x4*)(Dg + (unsigned)(db + 16 * t));
#pragma unroll
                for (int r = 0; r < 4; ++r) S[t][r] = S[t][r] * dg[r] + Lg[(unsigned)(lb + (16 * t + r) * 512)]; }
        }
    }
    float dprod = 1.f;
    v4u rq[LIGHT ? 1 : 4], rk[4], rv[2], ra; float rdec = 0.f;
    const int tr = tid >> 5, tc = tid & 31, vr = tid >> 4, vc = tid & 15;
    const unsigned goq = (unsigned)(tr * 1024 + h * 256 + tc * 8) * 2u, gov = (unsigned)(vr * 2048 + dvc + vc * 8) * 2u;
    LAS char* const lq = L + OQ + tr * PQ + tc * 16; LAS char* const lk = L + OK_ + tr * PK + tc * 16; LAS char* const lv = L + OV + vr * PV + vc * 16;
#define GLOAD1(ps) do { const int ci_ = d == 0 ? (ps) : ntot - 1 - (ps); const size_t rb_ = (size_t)(base + 64 * ci_) * 2048;   \
    _Pragma("unroll") for (int i = 0; i < 4; ++i) { if constexpr (!LIGHT) rq[i] = *(const v4u*)((const char*)QT + rb_ + goq + i * 16 * 2048); rk[i] = *(const v4u*)((const char*)KD + rb_ + goq + i * 16 * 2048); } } while (0)
#define GLOAD2(ps) do { const int ci_ = d == 0 ? (ps) : ntot - 1 - (ps); const int r0_ = base + 64 * ci_; const int chx_ = (r0_ >> 6) * 4 + h; \
    _Pragma("unroll") for (int i = 0; i < 2; ++i) rv[i] = *(const v4u*)((const char*)GV + (size_t)r0_ * 4096 + gov + i * 32 * 4096); \
    if constexpr (!LIGHT) ra = *(const v4u*)(AM + (size_t)chx_ * 4096 + tid * 8); if (tid < 256) rdec = DEC[(size_t)chx_ * 256 + tid]; } while (0)
#define LWRITE() do { \
    _Pragma("unroll") for (int i = 0; i < 4; ++i) { if constexpr (!LIGHT) *(LAS v4u*)(lq + i * 16 * PQ) = rq[i]; *(LAS v4u*)(lk + i * 16 * PK) = rk[i]; } \
    _Pragma("unroll") for (int i = 0; i < 2; ++i) *(LAS v4u*)(lv + i * 32 * PV) = rv[i]; \
    if constexpr (!LIGHT) { const int row = tid >> 3, cc = tid & 7; *(LAS v2u*)(L + OA + row * PA + cc * 16) = (v2u){ra.x, ra.y}; *(LAS v2u*)(L + OA + row * PA + cc * 16 + 8) = (v2u){ra.z, ra.w}; } \
    if (tid < 256) ((LAS float*)(L + ODEC))[tid] = rdec; } while (0)
    GLOAD1(p0); GLOAD2(p0);
    LWRITE();
    __syncthreads();
    for (int s = 0; s < nch; ++s) {
        const int ps = p0 + s, ci = d == 0 ? ps : ntot - 1 - ps, row0 = base + 64 * ci;
        if constexpr (LIGHT) dprod *= rdec;
        if (s + 1 < nch) { GLOAD1(ps + 1); GLOAD2(ps + 1); }
        bf16x8 vb[2];
#define LOADVB() do { _Pragma("unroll") for (int ks = 0; ks < 2; ++ks) { const LAS char* vp = L + OV + (32 * ks + 4 * gq + (cl >> 2)) * PV + 32 * wave + 8 * (cl & 3); \
            const s16x4 lo = vtr(vp), hi = vtr(vp + 16 * PV); vb[ks] = CAT8(lo, hi); } } while (0)
        SBAR(); LOADVB();
        if constexpr (!LIGHT) {
            f32x4 o[4];
#pragma unroll
            for (int ti = 0; ti < 4; ++ti) o[ti] = (f32x4){0.f, 0.f, 0.f, 0.f};
            const LAS char* qb_ = L + OQ + cl * PQ + 8 * gq; const LAS char* ab_ = L + OA + cl * PA + 8 * gq;
            int qh_ = (int)(uintptr_t)qb_ + 32, ah_ = (int)(uintptr_t)ab_ + 32; asm volatile("" : "+v"(qh_), "+v"(ah_));
#define OLD_(g, F) do { _Pragma("unroll") for (int ti = 0; ti < 4; ++ti) { const LAS char* ap = (g) < 8 ? qb_ + 16 * ti * PQ + 64 * (g) : ab_ + 16 * ti * PA + 64 * ((g) - 8); const LAS char* ah2 = (const LAS char*)(uintptr_t)(unsigned)((g) < 8 ? qh_ + 16 * ti * PQ + 64 * (g) : ah_ + 16 * ti * PA + 64 * ((g) - 8)); F[2 * ti] = *(const LAS s16x4*)ap; F[2 * ti + 1] = *(const LAS s16x4*)ah2; } } while (0)
#define OMM_(g, F) do { bf16x8 b_; if constexpr ((g) < 8) { constexpr int k2 = 2 * ((g) < 8 ? (g) : 0); v4u bw; bw.x = cvtpk2(S[k2][0], S[k2][1]); bw.y = cvtpk2(S[k2][2], S[k2][3]); bw.z = cvtpk2(S[k2 + 1][0], S[k2 + 1][1]); bw.w = cvtpk2(S[k2 + 1][2], S[k2 + 1][3]); b_ = __builtin_bit_cast(bf16x8, bw); } else b_ = vb[(g) < 8 ? 0 : (g) - 8]; \
                _Pragma("unroll") for (int ti = 0; ti < 4; ++ti) o[ti] = MFMA16(CAT8(F[2 * ti], F[2 * ti + 1]), b_, o[ti]); } while (0)
            s16x4 fa[8], fb[8], fc[8];
            OLD_(0, fa); OLD_(1, fb); SBAR();
            OLD_(2, fc); SBAR(); OMM_(0, fa); SBAR();
            OLD_(3, fa); SBAR(); OMM_(1, fb); SBAR();
            OLD_(4, fb); SBAR(); OMM_(2, fc); SBAR();
            OLD_(5, fc); SBAR(); OMM_(3, fa); SBAR();
            OLD_(6, fa); SBAR(); OMM_(4, fb); SBAR();
            OLD_(7, fb); SBAR(); OMM_(5, fc); SBAR();
            OLD_(8, fc); SBAR(); OMM_(6, fa); SBAR();
            OLD_(9, fa); SBAR(); OMM_(7, fb); SBAR();
            OMM_(8, fc); SBAR(); OMM_(9, fa); SBAR();
#undef OLD_
#undef OMM_
            { bf16* ODr = OD + (size_t)row0 * 2048 + dvc + 16 * wave; int ob = (4 * gq) * 2048 + cl; asm volatile("" : "+v"(ob));
#pragma unroll
              for (int ti = 0; ti < 4; ++ti)
#pragma unroll
                for (int r = 0; r < 4; r += 2) { const unsigned w2 = cvtpk2(o[ti][r], o[ti][r + 1]); ODr[(unsigned)(ob + (16 * ti + r) * 2048)] = (bf16)(w2 & 0xffffu); ODr[(unsigned)(ob + (16 * ti + r + 1) * 2048)] = (bf16)(w2 >> 16); } }
            SBAR();
        }
        {
            const LAS char* db_ = L + ODEC + 16 * gq; const LAS char* kb_ = L + OK_ + (4 * gq + (cl >> 2)) * PK + 8 * (cl & 3);
#define SLD_(t, DC, KF) do { DC = *(const LAS f32x4*)(db_ + 64 * (t)); KF[0] = vtr(kb_ + 32 * (t)); KF[1] = vtr(kb_ + 32 * (t) + 16 * PK); KF[2] = vtr(kb_ + 32 * (t) + 32 * PK); KF[3] = vtr(kb_ + 32 * (t) + 48 * PK); } while (0)
#define SMM_(t, DC, KF) do { S[t] = S[t] * DC; S[t] = MFMA16(CAT8(KF[0], KF[1]), vb[0], S[t]); S[t] = MFMA16(CAT8(KF[2], KF[3]), vb[1], S[t]); } while (0)
            f32x4 da, dbv, dcv; s16x4 ka[4], kbv[4], kc[4];
            SBAR(); SLD_(0, da, ka); SLD_(1, dbv, kbv); SBAR();
            SLD_(2, dcv, kc); SBAR(); SMM_(0, da, ka); SBAR();
            SLD_(3, da, ka); SBAR(); SMM_(1, dbv, kbv); SBAR();
            SLD_(4, dbv, kbv); SBAR(); SMM_(2, dcv, kc); SBAR();
            SLD_(5, dcv, kc); SBAR(); SMM_(3, da, ka); SBAR();
            SLD_(6, da, ka); SBAR(); SMM_(4, dbv, kbv); SBAR();
            SLD_(7, dbv, kbv); SBAR(); SMM_(5, dcv, kc); SBAR();
            SLD_(8, dcv, kc); SBAR(); SMM_(6, da, ka); SBAR();
            SLD_(9, da, ka); SBAR(); SMM_(7, dbv, kbv); SBAR();
            SLD_(10, dbv, kbv); SBAR(); SMM_(8, dcv, kc); SBAR();
            SLD_(11, dcv, kc); SBAR(); SMM_(9, da, ka); SBAR();
            SLD_(12, da, ka); SBAR(); SMM_(10, dbv, kbv); SBAR();
            SLD_(13, dbv, kbv); SBAR(); SMM_(11, dcv, kc); SBAR();
            SLD_(14, dcv, kc); SBAR(); SMM_(12, da, ka); SBAR();
            SLD_(15, da, ka); SBAR(); SMM_(13, dbv, kbv); SBAR();
            SMM_(14, dcv, kc); SBAR(); SMM_(15, da, ka); SBAR();
#undef SLD_
#undef SMM_
        }
        __syncthreads();
        if (s + 1 < nch) { LWRITE(); }
        __syncthreads();
    }
    if constexpr (LIGHT) {
        float* Lg = GLs + ((size_t)(sidx * 3 + seg) * 256) * 512 + sl * 128 + 16 * wave; int lb = (4 * gq) * 512 + cl; asm volatile("" : "+v"(lb));
#pragma unroll
        for (int t = 0; t < 16; ++t)
#pragma unroll
            for (int r = 0; r < 4; ++r) Lg[(unsigned)(lb + (16 * t + r) * 512)] = S[t][r];
        if (sl == 0 && tid < 256) { float* Dg = GDS + (size_t)(sidx * 3 + seg) * 256; Dg[tid] = dprod; }
    } else if (!sample) { float* so = F.out + (d == 0 ? O_GF : O_GB) + ((size_t)(seq * 4 + h) * 256) * 512 + sl * 128 + 16 * wave; int lb = (4 * gq) * 512 + cl; asm volatile("" : "+v"(lb));
#pragma unroll
        for (int t = 0; t < 16; ++t)
#pragma unroll
            for (int r = 0; r < 4; ++r) so[(unsigned)(lb + (16 * t + r) * 512)] = S[t][r];
    }
#undef GLOAD1
#undef GLOAD2
#undef LWRITE
#undef LOADVB
}
__device__ __forceinline__ int gla_item_of(int bx, int G) { return G == 256 ? (((bx & 7) + 8 * (bx >> 5)) << 2) + ((bx >> 3) & 3) : bx; }
__device__ __forceinline__ void gla_scanA_phase(Frame& F) {
    for (int it = gla_item_of(F.bx, F.G); it < 192; it += F.G) { const int sl = it & 3, g = (it >> 2) % 3, r = (it >> 2) / 3;
        gla_scan_item<true>(F, 32 + (r >> 3), (r >> 1) & 3, r & 1, sl, g); }
}
__device__ __forceinline__ void gla_scan_phase(Frame& F) {
    for (int it = gla_item_of(F.bx, F.G); it < 1280; it += F.G) {
        int seq, h, d, sl, g;
        if (it < 256) { const int r = it >> 4; sl = it & 3; g = (it >> 2) & 3; seq = 32 + (r >> 3); h = (r >> 1) & 3; d = r & 1; }
        else { const int i2 = it - 256; seq = i2 >> 5; h = (i2 >> 3) & 3; d = (i2 >> 2) & 1; sl = i2 & 3; g = 0; }
        gla_scan_item<false>(F, seq, h, d, sl, g);
    }
}
__device__ __forceinline__ void gla_post_phase(Frame& F) {
    const int gw = F.bx * NWAVES + F.wave, NGW = F.G * NWAVES, lane = F.lane;
    const bf16* OFp = WSP(bf16, WS_GOF); const bf16* OBp = WSP(bf16, WS_GOB); const bf16* GR = WSP(bf16, WS_GR); const float* gn = F.in[I_GNORM];
    signed char* A8 = (signed char*)(F.ws + WS_AO8); float* arow = WSP(float, WS_AROW);
#define UNPK4(w) (f32x4){__builtin_bit_cast(float, (w).x << 16), __builtin_bit_cast(float, (w).x & 0xffff0000u), __builtin_bit_cast(float, (w).y << 16), __builtin_bit_cast(float, (w).y & 0xffff0000u)}
    for (int row = gw; row < MTOK; row += NGW) {
        f32x4 ya[4], yb[4]; float mx = 0.f;
#pragma unroll
        for (int hh = 0; hh < 4; ++hh) {
            const size_t o0 = (size_t)row * 2048 + hh * 512 + 4 * lane;
            const v2u f0 = *(const v2u*)(OFp + o0), f1 = *(const v2u*)(OFp + o0 + 256), b0 = *(const v2u*)(OBp + o0), b1 = *(const v2u*)(OBp + o0 + 256);
            const f32x4 v0 = UNPK4(f0) + UNPK4(b0), v1 = UNPK4(f1) + UNPK4(b1);
            float ss = (v0[0] * v0[0] + v0[1] * v0[1]) + (v0[2] * v0[2] + v0[3] * v0[3]) + (v1[0] * v1[0] + v1[1] * v1[1]) + (v1[2] * v1[2] + v1[3] * v1[3]);
            const float rstd = rsqrtf(wave_sum(ss) * (1.f / 512.f) + EPS);
            const v2u r0 = *(const v2u*)(GR + o0), r1 = *(const v2u*)(GR + o0 + 256);
            f32x4 ra = UNPK4(r0), rb = UNPK4(r1);
#pragma unroll
            for (int i = 0; i < 4; ++i) { ra[i] = ra[i] / (1.f + __expf(-ra[i])); rb[i] = rb[i] / (1.f + __expf(-rb[i])); }
            ya[hh] = v0 * rstd * *(const f32x4*)(gn + 4 * lane) * ra; yb[hh] = v1 * rstd * *(const f32x4*)(gn + 256 + 4 * lane) * rb;
#pragma unroll
            for (int i = 0; i < 4; ++i) mx = fmaxf(mx, fmaxf(fabsf(ya[hh][i]), fabsf(yb[hh][i])));
        }
#pragma unroll
        for (int o = 1; o < 64; o <<= 1) mx = fmaxf(mx, __shfl_xor(mx, o));
        mx = fmaxf(mx, 1e-30f); const float inv = 127.f / mx;
        if (lane == 0) arow[row] = mx * (1.f / 127.f);
#pragma unroll
        for (int hh = 0; hh < 4; ++hh) {
            const size_t o0 = (size_t)row * 2048 + hh * 512 + 4 * lane;
            const f32x4 qa = ya[hh] * inv, qb = yb[hh] * inv;
            const unsigned wa = ((unsigned)(int)rintf(qa[0]) & 0xffu) | (((unsigned)(int)rintf(qa[1]) & 0xffu) << 8) | (((unsigned)(int)rintf(qa[2]) & 0xffu) << 16) | (((unsigned)(int)rintf(qa[3]) & 0xffu) << 24);
            const unsigned wb = ((unsigned)(int)rintf(qb[0]) & 0xffu) | (((unsigned)(int)rintf(qb[1]) & 0xffu) << 8) | (((unsigned)(int)rintf(qb[2]) & 0xffu) << 16) | (((unsigned)(int)rintf(qb[3]) & 0xffu) << 24);
            *(unsigned*)(A8 + o0) = wa; *(unsigned*)(A8 + o0 + 256) = wb;
        }
    }
#undef UNPK4
}

#ifndef MK_N_LAUNCHES
#define MK_N_LAUNCHES 1
#ifndef I8_SP2
#define I8_SP2 true
#endif
#ifndef I8_ALIGN
#define I8_ALIGN true
#endif
#ifndef PG8_ALIGN
#define PG8_ALIGN true
#endif
#ifndef PG8_SP2
#define PG8_SP2 true
#endif
#endif
constexpr int N_PHASES = 35;
__global__ void __launch_bounds__(NWAVES * 64, 2) mk_fwd(Args args) {
    extern __shared__ __attribute__((aligned(16))) unsigned char lds[];
    Frame F;
    F.lds = (LAS unsigned char*)lds; F.ldsg = lds;
    F.tid = threadIdx.x; F.lane = F.tid & 63; F.wave = __builtin_amdgcn_readfirstlane(F.tid >> 6);
    F.G = gridDim.x; F.bx = blockIdx.x;
    F.in = args.in; F.out = args.out; F.ws = args.ws;
    volatile LAS unsigned* MISC = (volatile LAS unsigned*)(F.lds + MISC_OFF);
    if (F.tid < 32) MISC[F.tid] = 0u;
    __syncthreads();
    const int lo = args.ph_lo, hi = args.ph_hi;
    const bool use_bar = (hi - lo) > 1;
    XcdBarrier bar; bar.bar = (unsigned*)(F.ws + WS_CTL) + CW_BAR + args.li * XCD_BAR_WORDS; bar.x = 0; bar.st = nullptr;
    if (use_bar) bar = xcd_barrier_post((unsigned*)(F.ws + WS_CTL) + CW_BAR + args.li * XCD_BAR_WORDS, MISC + 8);
#ifdef PH_ONLY
#define IN(k) ((k) == PH_ONLY && lo <= (k) && (k) < hi)
#else
#define IN(k) (lo <= (k) && (k) < hi)
#endif
#define SEAM(k) do { if (IN(k) && IN((k) + 1)) xcd_barrier(bar); } while (0)
    LAS unsigned char* ring = F.lds;

#ifndef PROBE_MASK
#define PROBE_MASK 0ull
#endif
    constexpr unsigned long long REP_MASK = PROBE_MASK;
#define PHASE(k, ...) if (IN(k)) { if (((REP_MASK >> (k)) & 1ull) != 0ull) { const bool dry_ = true; (void)dry_; __VA_ARGS__ xcd_barrier(bar); } { const bool dry_ = false; (void)dry_; __VA_ARGS__ } } SEAM(k);
#define GATE(L, q) (dry_ ? (const float*)(F.ws + WS_CTL + 524288) : WSP(float, WS_MOD) + (size_t)((L) * 3) * 12288 + (q) * 2048)
#define NORMIN(site) NormIn{WSP(float, WS_PART) + (size_t)(site) * MTOK * 32, WSP(float, WS_SW) + (size_t)(site) * 3 * 8192, (const LAS float*)(F.lds + LDS_RSTD_OFF), pm0_}
    PHASE(0, p0_prologue(F);)
    PHASE(1, p1_phase(F);)

#define GEMM_PHASE(EpiT, epi, Aptr, Bptr, M_, N_, K_) do { int kk_ = (K_); asm volatile("" : "+s"(kk_)); pg8::Gemm g{(const pg8::bf16_t*)(Aptr), (const pg8::bf16_t*)(Bptr), (M_), (N_), kk_}; pg8::StaticOrder S; S.init((M_), (N_), F.G, F.bx); \
        pg8::gemm_phase<EpiT, pg8::StaticOrder, PG8_ALIGN, PG8_SP2>(ring, g, S, epi); } while (0)

#ifndef FFN2_WGM
#define FFN2_WGM 4
#endif
#define GEMM_PHASE_W(EpiT, epi, Aptr, Bptr, M_, N_, K_, WGM_) do { int kk_ = (K_); asm volatile("" : "+s"(kk_)); pg8::Gemm g{(const pg8::bf16_t*)(Aptr), (const pg8::bf16_t*)(Bptr), (M_), (N_), kk_, 1}; pg8::SwapOrder S; S.init((M_), (N_), F.G, F.bx, (WGM_)); \
        pg8::gemm_phase<EpiT, pg8::SwapOrder, PG8_ALIGN, PG8_SP2>(ring, g, S, epi); } while (0)
#define GEMM_PHASE_N(site, EpiT, EPI_INIT, Aptr, Bptr, M_, N_, K_) do { int kk_ = (K_); asm volatile("" : "+s"(kk_)); pg8::Gemm g{(const pg8::bf16_t*)(Aptr), (const pg8::bf16_t*)(Bptr), (M_), (N_), kk_}; pg8::StaticOrder S; S.init((M_), (N_), F.G, F.bx); \
        const int pm0_ = prep_rstd(F, S, (site)); EpiT E EPI_INIT; pg8::gemm_phase<EpiT, pg8::StaticOrder, PG8_ALIGN, PG8_SP2>(ring, g, S, E); } while (0)
#define ARGS(...) {__VA_ARGS__}
#ifndef RES_ALIGN
#define RES_ALIGN true
#endif
#define GEMM_PHASE_R(EpiT, epi, Aptr, Bptr, M_, N_, K_) do { int kk_ = (K_); asm volatile("" : "+s"(kk_)); pg8::Gemm g{(const pg8::bf16_t*)(Aptr), (const pg8::bf16_t*)(Bptr), (M_), (N_), kk_}; pg8::StaticOrder S; S.init((M_), (N_), F.G, F.bx); \
        pg8::gemm_phase<EpiT, pg8::StaticOrder, RES_ALIGN, PG8_SP2>(ring, g, S, epi); } while (0)
#define LAYER_TAIL(P, L) \
    PHASE((P), { EpiResidT<true> E{F.in[I_XP], F.in[I_XS], WSP(float, WS_X), GATE((L), 2), (L) == 0 ? 1 : 0, WSP(float, WS_AROW), WSP(float, WS_SCOLO) + (L) * 2048, dry_ ? (bf16*)nullptr : WSP(bf16, WS_H), F.in[I_NORMG] + (size_t)((L) * 2 + 1) * 2048, \
            WSP(float, WS_MOD) + (size_t)((L) * 3) * 12288 + 4 * 2048, WSP(float, WS_PART) + (size_t)(2 * (L) + 1) * MTOK * 32, WSP(float, WS_PMAX) + (size_t)(2 * (L) + 1) * MTOK * 32}; \
            int kk_ = 1024; asm volatile("" : "+s"(kk_)); pg8::Gemm g{(const pg8::bf16_t*)(F.ws + WS_AO8), (const pg8::bf16_t*)(F.ws + WS_WWOT + (size_t)(L) * 2048 * 2048), MTOK, DM, kk_}; pg8::StaticOrder S; S.init(MTOK, DM, F.G, F.bx); \
            pg8::gemm_phase<EpiResidT<true>, pg8::StaticOrder, PG8_ALIGN, PG8_SP2, true>(ring, g, S, E); }) \
    PHASE((P) + 1, q8_phase(F, (L), (L) == 0);) \
    PHASE((P) + 2, { EpiRelu2I8 E{WSP(bf16, WS_HID), FFH, WSP(float, WS_FROW) + (size_t)(L) * MTOK, WSP(float, WS_SCOL) + (L) * 8192, WSP(float, WS_SW) + (size_t)(2 * (L) + 1) * 3 * 8192}; \
            int kk_ = 1024; asm volatile("" : "+s"(kk_)); pg8::Gemm g{(const pg8::bf16_t*)(F.ws + WS_H8), (const pg8::bf16_t*)(F.ws + WS_W1T + (size_t)(L) * 8192 * 2048), MTOK, FFH, kk_}; pg8::StaticOrder S; S.init(MTOK, FFH, F.G, F.bx, 4); \
            pg8::gemm_phase<EpiRelu2I8, pg8::StaticOrder, I8_ALIGN, I8_SP2, true>(ring, g, S, E); }) \
    PHASE((P) + 3, EpiResid E{F.in[I_XP], F.in[I_XS], WSP(float, WS_X), GATE((L), 5), 0, (const float*)nullptr, (const float*)nullptr, (dry_ || (L) == 3) ? (bf16*)nullptr : WSP(bf16, WS_H), F.in[I_NORMG] + (size_t)(((L) + 1) * 2) * 2048, \
            WSP(float, WS_MOD) + (size_t)(((L) + 1) * 3) * 12288 + 1 * 2048, WSP(float, WS_PART) + (size_t)(2 * ((L) + 1)) * MTOK * 32, (float*)nullptr}; GEMM_PHASE_W(EpiResid, E, WSP(bf16, WS_HID), WSP(bf16, WS_W2T) + (size_t)(L) * DM * FFH, MTOK, DM, FFH, FFN2_WGM);)

#define WIN_LAYER(P, L, J) \
    PHASE((P), GEMM_PHASE_N(2 * (L), EpiQkvWin, ARGS(WSP(bf16, WS_WQ), WSP(bf16, WS_WK), WSP(bf16, WS_WV), F.out + O_WK, F.out + O_WV, (J), WSP(f32x2, WS_TABW), NORMIN(2 * (L))), \
        WSP(bf16, WS_H), WSP(bf16, WS_WQKVT) + (size_t)(J) * 3072 * DM, MTOK, 3072, DM);) \
    PHASE((P) + 1, attn_win_phase(F, (J));) \
    PHASE((P) + 2, aoq_phase(F);) \
    LAYER_TAIL((P) + 3, (L))

    WIN_LAYER(2, 0, 0)
    PHASE(9, GEMM_PHASE_N(2, EpiF32, ARGS(WSP(float, WS_MD), 1024, NORMIN(2)), WSP(bf16, WS_H), WSP(bf16, WS_MWDT), MTOK, 1024, DM);)
    PHASE(10, mla_norm_phase(F);)
    PHASE(11, { EpiMlaQ E{WSP(bf16, WS_MQ), WSP(f32x2, WS_TABM)}; GEMM_PHASE(EpiMlaQ, E, WSP(bf16, WS_MCQ), WSP(bf16, WS_MWUQT), MTOK, 3072, 512); }
             { EpiMlaKV E{WSP(bf16, WS_MKN), WSP(bf16, WS_MV)}; GEMM_PHASE(EpiMlaKV, E, WSP(bf16, WS_MCKV), WSP(bf16, WS_MWUKVT), MTOK + 1024, 4096, 256); })
#ifdef PROBE_SLEEP
    if (IN(11)) { const unsigned long long t0_ = __builtin_amdgcn_s_memrealtime(); while (__builtin_amdgcn_s_memrealtime() - t0_ < (unsigned long long)PROBE_SLEEP * 100ull) __builtin_amdgcn_s_sleep(8); }
#endif
    PHASE(12, attn_mla_phase(F);)
    PHASE(13, aoq_phase(F);)
    LAYER_TAIL(14, 1)
    PHASE(18, GEMM_PHASE_N(4, EpiGlaIn, ARGS(WSP(bf16, WS_GQ), WSP(bf16, WS_GK), WSP(bf16, WS_GV), WSP(bf16, WS_GR), WSP(float, WS_GU), NORMIN(4)), WSP(bf16, WS_H), WSP(bf16, WS_GWINT), MTOK, 6144, DM); gla_u_phase(F);)
    PHASE(19, gla_prep_phase(F);)
    PHASE(20, gla_scanA_phase(F);)
    PHASE(21, gla_scan_phase(F);)
    PHASE(22, gla_post_phase(F);)
    LAYER_TAIL(23, 2)
    WIN_LAYER(27, 3, 1)
    PHASE(34, final_phase(F);)
#undef IN
#undef SEAM
}

extern "C" void kernel_launch(void* const* d_in, const int* in_sizes, int n_in, void* d_out, int out_size, void* d_ws, size_t ws_size, hipStream_t stream) {
    static int grid = 0;
    if (grid == 0) {
        if (n_in != 31 || (size_t)out_size != O_END || ws_size < WS_END) { fprintf(stderr, "kernel_launch: shape mismatch n_in %d out %d ws %zu (need %zu)\n", n_in, out_size, ws_size, (size_t)WS_END); grid = -1; return; }
        int dev = 0, cus = 0, per_cu = 0;
        if (hipGetDevice(&dev) != hipSuccess || hipDeviceGetAttribute(&cus, hipDeviceAttributeMultiprocessorCount, dev) != hipSuccess) { grid = -1; return; }
        if (hipFuncSetAttribute((const void*)mk_fwd, hipFuncAttributeMaxDynamicSharedMemorySize, LDS_BYTES) != hipSuccess) { fprintf(stderr, "kernel_launch: hipFuncSetAttribute failed\n"); grid = -1; return; }
        if (hipOccupancyMaxActiveBlocksPerMultiprocessor(&per_cu, (const void*)mk_fwd, NWAVES * 64, LDS_BYTES) != hipSuccess || per_cu < 1) fprintf(stderr, "kernel_launch: occupancy query says %d\n", per_cu);
        (void)hipGetLastError();
        grid = cus;
    }
    if (grid < 0) return;
    if (hipMemsetAsync((char*)d_ws + WS_CTL, 0, CTL_ZERO_BYTES, stream) != hipSuccess) return;
    Args a{};
    for (int i = 0; i < 31; ++i) a.in[i] = (const float*)d_in[i];
    a.in[31] = nullptr;
    a.out = (float*)d_out; a.ws = (unsigned char*)d_ws; a.pad = 0; a.rep_mask = 0ull; a.rep_n = 1; a.pad2 = 0;
#if MK_N_LAUNCHES == 1
    a.ph_lo = 0; a.ph_hi = N_PHASES; a.li = 0;
    hipLaunchKernelGGL(mk_fwd, dim3(grid), dim3(NWAVES * 64), LDS_BYTES, stream, a);
#else
    for (int p = 0; p < N_PHASES; ++p) { a.ph_lo = p; a.ph_hi = p + 1; a.li = 0; hipLaunchKernelGGL(mk_fwd, dim3(grid), dim3(NWAVES * 64), LDS_BYTES, stream, a); }
#endif
}
```
